# Optimizing an MI355X kernel written in HIP

```python
import jax
import jax.numpy as jnp
from jax import lax
import numpy as np

D_MODEL = 2048
BATCH = 4
SEQ = 4096
DEPTH = 2

GRID_W = 64
CTX_LEN = 256
HEAD_DIM = 128
NA_HEADS = D_MODEL // (2 * HEAD_DIM)
NA_WIN_ROWS = 8
NA_WIN_COLS = 16
GQA_Q_HEADS = D_MODEL // (2 * HEAD_DIM)
GQA_KV_HEADS = 2
GQA_GROUP = GQA_Q_HEADS // GQA_KV_HEADS
Q_BLOCK = 128
ROPE_THETA = 10000.0
NA_WIDTH = NA_HEADS * HEAD_DIM
GQA_Q_WIDTH = GQA_Q_HEADS * HEAD_DIM
GQA_KV_WIDTH = GQA_KV_HEADS * HEAD_DIM
ATTN_SPLITS = (NA_WIDTH, 2 * NA_WIDTH, 3 * NA_WIDTH, 3 * NA_WIDTH + GQA_Q_WIDTH, 3 * NA_WIDTH + GQA_Q_WIDTH + GQA_KV_WIDTH)
ATTN_IN_WIDTH = 3 * NA_WIDTH + GQA_Q_WIDTH + 2 * GQA_KV_WIDTH
ATTN_OUT_WIDTH = NA_WIDTH + GQA_Q_WIDTH
ML_HEADS = 8
ML_V_DIM = D_MODEL // ML_HEADS
ML_QK_DIM = ML_V_DIM // 2
ML_CHUNK = 64
ML_QK_WIDTH = ML_HEADS * ML_QK_DIM
ML_V_WIDTH = ML_HEADS * ML_V_DIM
ML_SPLITS = (ML_QK_WIDTH, 2 * ML_QK_WIDTH, 2 * ML_QK_WIDTH + ML_V_WIDTH, 2 * ML_QK_WIDTH + 2 * ML_V_WIDTH)
ML_IN_WIDTH = 2 * ML_QK_WIDTH + 2 * ML_V_WIDTH + 4 * ML_HEADS
N_EXPERTS = 64
TOP_K = 8
N_GROUPS = 8
TOPK_GROUPS = 4
EXPERTS_PER_GROUP = N_EXPERTS // N_GROUPS
EXPERT_DIM = D_MODEL // 4
SHARED_DIM = D_MODEL // 4
ROUTED_SCALE = 2.5
MOE_BLOCK = 256
NORM_EPS = 1e-6
NEG_INF = -1e30
N_EVEN = (DEPTH + 1) // 2
N_ODD = DEPTH // 2

kernel_name = 'hybrid_natten_gqa_mlstm_moe_dit'


def rms_norm(x, gain):
    xf = x.astype(jnp.float32)
    y = xf * lax.rsqrt(jnp.mean(xf * xf, axis=-1, keepdims=True) + NORM_EPS)
    return (y * gain.astype(jnp.float32)).astype(x.dtype)


def to_heads(t, n_heads):
    b, n, w = t.shape
    return t.reshape(b, n, n_heads, w // n_heads).transpose(0, 2, 1, 3)


def from_heads(t):
    b, h, n, d = t.shape
    return t.transpose(0, 2, 1, 3).reshape(b, n, h * d)


def rope_2d_tables(n_tokens):
    t = jnp.arange(n_tokens, dtype=jnp.int32)
    row = (t // GRID_W).astype(jnp.float32)
    col = (t % GRID_W).astype(jnp.float32)
    n_freq = HEAD_DIM // 4
    inv_freq = ROPE_THETA ** (-jnp.arange(n_freq, dtype=jnp.float32) / n_freq)
    ang = jnp.concatenate([row[:, None] * inv_freq, col[:, None] * inv_freq], axis=-1)
    return jnp.cos(ang), jnp.sin(ang)


def apply_rope(x, cos, sin):
    xf = x.astype(jnp.float32)
    x1, x2 = xf[..., 0::2], xf[..., 1::2]
    out = jnp.stack([x1 * cos - x2 * sin, x1 * sin + x2 * cos], axis=-1)
    return out.reshape(x.shape).astype(x.dtype)


def grouped_attention(q, k, v):
    s = jnp.einsum('bngqd,bnkd->bngqk', q, k, preferred_element_type=jnp.float32) * (q.shape[-1] ** -0.5)
    p = jax.nn.softmax(s, axis=-1).astype(v.dtype)
    return jnp.einsum('bngqk,bnkd->bngqd', p, v)


def blocked_grouped_attention(q, k, v):
    b, nkv, g, s, dh = q.shape
    nb = s // Q_BLOCK
    qb = jnp.moveaxis(q.reshape(b, nkv, g, nb, Q_BLOCK, dh), 3, 0)
    ob = lax.map(lambda qi: grouped_attention(qi, k, v), qb)
    return jnp.moveaxis(ob, 0, 3).reshape(b, nkv, g, s, dh)


def neighborhood_attention(q, k, v, k_ctx, v_ctx, rpb):
    b, nh, s, dh = q.shape
    rows = s // GRID_W
    wr = min(NA_WIN_ROWS, rows)
    r = jnp.arange(rows)
    key_rows = jnp.clip(r - wr // 2, 0, rows - wr)[:, None] + jnp.arange(wr)[None, :]
    cq = jnp.arange(GRID_W)
    col_start = jnp.clip(cq - NA_WIN_COLS // 2, 0, GRID_W - NA_WIN_COLS)
    col_ok = (cq[None, :] >= col_start[:, None]) & (cq[None, :] < col_start[:, None] + NA_WIN_COLS)
    row_idx = key_rows - r[:, None] + NA_WIN_ROWS - 1
    col_idx = jnp.clip(cq[None, :] - cq[:, None] + NA_WIN_COLS - 1, 0, 2 * NA_WIN_COLS - 2)
    bias = rpb.astype(jnp.float32)[:, row_idx[:, None, :, None], col_idx[None, :, None, :]]
    qg = q.reshape(b, nh, rows, GRID_W, dh)
    kg = k.reshape(b, nh, rows, GRID_W, dh)[:, :, key_rows]
    vg = v.reshape(b, nh, rows, GRID_W, dh)[:, :, key_rows]
    scale = dh ** -0.5
    s_win = jnp.einsum('bhrqd,bhrwkd->bhrqwk', qg, kg, preferred_element_type=jnp.float32) * scale + bias[None]
    s_win = jnp.where(col_ok[:, None, :], s_win, NEG_INF).reshape(b, nh, rows, GRID_W, wr * GRID_W)
    s_ctx = jnp.einsum('bhrqd,bhld->bhrql', qg, k_ctx, preferred_element_type=jnp.float32) * scale
    p = jax.nn.softmax(jnp.concatenate([s_win, s_ctx], axis=-1), axis=-1).astype(v.dtype)
    p_win = p[..., :wr * GRID_W].reshape(b, nh, rows, GRID_W, wr, GRID_W)
    p_ctx = p[..., wr * GRID_W:]
    out = jnp.einsum('bhrqwk,bhrwkd->bhrqd', p_win, vg) + jnp.einsum('bhrql,bhld->bhrqd', p_ctx, v_ctx)
    return out.reshape(b, nh, s, dh)


def attn_mixer(h, hc, w_in, w_out, rpb, q_gain, k_gain, cos, sin, with_ctx_out):
    def project(t):
        qa, ka, va, qb, kb, vb = jnp.split(t @ w_in, ATTN_SPLITS, axis=-1)
        qa, ka, va = to_heads(qa, NA_HEADS), to_heads(ka, NA_HEADS), to_heads(va, NA_HEADS)
        qb = rms_norm(to_heads(qb, GQA_Q_HEADS), q_gain)
        kb = rms_norm(to_heads(kb, GQA_KV_HEADS), k_gain)
        vb = to_heads(vb, GQA_KV_HEADS)
        return qa, ka, va, qb, kb, vb

    qa, ka, va, qb, kb, vb = project(h)
    qa_c, ka_c, va_c, qb_c, kb_c, vb_c = project(hc)
    bsz, _, s, _ = qb.shape
    oa = neighborhood_attention(qa, ka, va, ka_c, va_c, rpb)
    qb = apply_rope(qb, cos, sin)
    kb = apply_rope(kb, cos, sin)
    k_all = jnp.concatenate([kb_c, kb], axis=2)
    v_all = jnp.concatenate([vb_c, vb], axis=2)
    ob = blocked_grouped_attention(qb.reshape(bsz, GQA_KV_HEADS, GQA_GROUP, s, HEAD_DIM), k_all, v_all)
    ob = ob.reshape(bsz, GQA_Q_HEADS, s, HEAD_DIM)
    y = jnp.concatenate([from_heads(oa), from_heads(ob)], axis=-1) @ w_out
    if not with_ctx_out:
        return y, None
    n_ctx = hc.shape[1]
    oa_c = grouped_attention(qa_c[:, :, None], ka_c, va_c)[:, :, 0]
    ob_c = grouped_attention(qb_c.reshape(bsz, GQA_KV_HEADS, GQA_GROUP, n_ctx, HEAD_DIM), kb_c, vb_c)
    ob_c = ob_c.reshape(bsz, GQA_Q_HEADS, n_ctx, HEAD_DIM)
    yc = jnp.concatenate([from_heads(oa_c), from_heads(ob_c)], axis=-1) @ w_out
    return y, yc


def mlstm_scan(q, k, v, log_i, log_f, state, with_outputs):
    b, nh, t, _ = q.shape
    nc = t // ML_CHUNK

    def chunks(a):
        return jnp.moveaxis(a.reshape(b, nh, nc, ML_CHUNK, *a.shape[3:]), 2, 0)

    causal = jnp.tril(jnp.ones((ML_CHUNK, ML_CHUNK), dtype=bool))

    def step(carry, xs):
        c_st, n_st, m_st = carry
        qc, kc, vc, li, lf = xs
        bc = jnp.cumsum(lf, axis=-1)
        b_tot = bc[..., -1]
        a_end = b_tot[..., None] - bc + li
        m_new = jnp.maximum(b_tot + m_st, jnp.max(a_end, axis=-1))
        w_end = jnp.exp(a_end - m_new[..., None])
        decay = jnp.exp(b_tot + m_st - m_new)
        c_new = decay[..., None, None] * c_st + jnp.einsum('bhsk,bhsv->bhkv', kc * w_end[..., None], vc)
        n_new = decay[..., None] * n_st + jnp.einsum('bhs,bhsk->bhk', w_end, kc)
        if not with_outputs:
            return (c_new, n_new, m_new), None
        d_mat = jnp.where(causal, bc[..., :, None] - bc[..., None, :] + li[..., None, :], -jnp.inf)
        m_row = jnp.maximum(bc + m_st[..., None], jnp.max(d_mat, axis=-1))
        w_inter = jnp.exp(bc + m_st[..., None] - m_row)
        s_mat = jnp.einsum('bhtk,bhsk->bhts', qc, kc) * jnp.exp(d_mat - m_row[..., None])
        num = w_inter[..., None] * jnp.einsum('bhtk,bhkv->bhtv', qc, c_st) + jnp.einsum('bhts,bhsv->bhtv', s_mat, vc)
        den = w_inter * jnp.einsum('bhtk,bhk->bht', qc, n_st) + jnp.sum(s_mat, axis=-1)
        h = num / jnp.maximum(jnp.abs(den), jnp.exp(-m_row))[..., None]
        return (c_new, n_new, m_new), h

    state, hs = lax.scan(step, state, (chunks(q), chunks(k), chunks(v), chunks(log_i), chunks(log_f)))
    if not with_outputs:
        return None, state
    return jnp.moveaxis(hs, 0, 2).reshape(b, nh, t, v.shape[-1]), state


def mlstm_mixer(h, hc, w_in, w_out, gate_b, head_gain, with_ctx_out):
    def project(t):
        bsz, n, _ = t.shape
        q, k, v, o, g = jnp.split(t @ w_in, ML_SPLITS, axis=-1)
        q = to_heads(q, ML_HEADS).astype(jnp.float32)
        k = to_heads(k, ML_HEADS).astype(jnp.float32) * (ML_QK_DIM ** -0.5)
        v = to_heads(v, ML_HEADS).astype(jnp.float32)
        g = (g.astype(jnp.float32).reshape(bsz, n, 4, ML_HEADS) + gate_b.astype(jnp.float32)).transpose(2, 0, 3, 1)
        return q, k, v, o, g[:2], jax.nn.log_sigmoid(g[2:])

    def readout(h_sum, o):
        bsz, _, n, _ = h_sum.shape
        hn = rms_norm(h_sum.transpose(0, 2, 1, 3), head_gain.reshape(ML_HEADS, ML_V_DIM))
        return (hn.reshape(bsz, n, ML_V_WIDTH).astype(o.dtype) * jax.nn.sigmoid(o)) @ w_out

    q, k, v, o, log_i, log_f = project(h)
    qc, kc, vc, oc, log_ic, log_fc = project(hc)
    bsz = h.shape[0]
    zero_state = (jnp.zeros((bsz, ML_HEADS, ML_QK_DIM, ML_V_DIM), jnp.float32),
                  jnp.zeros((bsz, ML_HEADS, ML_QK_DIM), jnp.float32),
                  jnp.zeros((bsz, ML_HEADS), jnp.float32))
    h_lat = 0.0
    h_ctx = 0.0
    for direction in range(2):
        rev = (lambda a: jnp.flip(a, axis=2)) if direction == 1 else (lambda a: a)
        hc_d, ctx_state = mlstm_scan(rev(qc), rev(kc), rev(vc), rev(log_ic[direction]), rev(log_fc[direction]), zero_state, with_ctx_out)
        hl_d, _ = mlstm_scan(rev(q), rev(k), rev(v), rev(log_i[direction]), rev(log_f[direction]), ctx_state, True)
        h_lat = h_lat + rev(hl_d)
        if with_ctx_out:
            h_ctx = h_ctx + rev(hc_d)
    y = readout(h_lat, o)
    yc = readout(h_ctx, oc) if with_ctx_out else None
    return y, yc


def moe_ffn(h, router_w, router_b, w1, w3, w2, sw1, sw3, sw2):
    t, d = h.shape
    s = jax.nn.sigmoid(jnp.dot(h, router_w, preferred_element_type=jnp.float32))
    s_sel = s + router_b.astype(jnp.float32)
    group_score = jnp.sum(lax.top_k(s_sel.reshape(t, N_GROUPS, EXPERTS_PER_GROUP), 2)[0], axis=-1)
    _, g_idx = lax.top_k(group_score, TOPK_GROUPS)
    g_mask = jnp.any(g_idx[:, :, None] == jnp.arange(N_GROUPS)[None, None, :], axis=1)
    s_sel = jnp.where(jnp.repeat(g_mask, EXPERTS_PER_GROUP, axis=1), s_sel, -jnp.inf)
    _, e_idx = lax.top_k(s_sel, TOP_K)
    w = jnp.take_along_axis(s, e_idx, axis=1)
    w = w / jnp.sum(w, axis=-1, keepdims=True) * ROUTED_SCALE

    tk = t * TOP_K
    e_flat = e_idx.reshape(-1)
    tok_flat = jnp.repeat(jnp.arange(t, dtype=jnp.int32), TOP_K)
    order = jnp.argsort(e_flat)
    e_s, tok_s, w_s = e_flat[order], tok_flat[order], w.reshape(-1)[order]
    counts = jnp.bincount(e_flat, length=N_EXPERTS)
    padded = (counts + MOE_BLOCK - 1) // MOE_BLOCK * MOE_BLOCK
    pad_end = jnp.cumsum(padded)
    pad_start = pad_end - padded
    start = jnp.cumsum(counts) - counts
    dest = pad_start[e_s] + jnp.arange(tk, dtype=jnp.int32) - start[e_s]
    n_blocks = -(-tk // MOE_BLOCK) + N_EXPERTS
    n_rows = n_blocks * MOE_BLOCK
    src_tok = jnp.zeros((n_rows,), jnp.int32).at[dest].set(tok_s)
    src_w = jnp.zeros((n_rows,), jnp.float32).at[dest].set(w_s)
    block_e = jnp.minimum(jnp.searchsorted(pad_end, jnp.arange(n_blocks) * MOE_BLOCK, side='right'), N_EXPERTS - 1)

    def expert_block(args):
        tok, wt, e = args
        xb = h[tok]
        y = (jax.nn.silu(xb @ w1[e]) * (xb @ w3[e])) @ w2[e]
        return y * wt[:, None].astype(y.dtype)

    y_buf = lax.map(expert_block, (src_tok.reshape(n_blocks, MOE_BLOCK), src_w.reshape(n_blocks, MOE_BLOCK), block_e))
    routed = jax.ops.segment_sum(y_buf.reshape(n_rows, d), src_tok, num_segments=t)
    shared = (jax.nn.silu(h @ sw1) * (h @ sw3)) @ sw2
    return shared + routed


def setup_inputs(seed: int = 0) -> dict:
    key = jax.random.key(seed)
    ks = iter(jax.random.split(key, 40))

    def nrm(shape, scale):
        return jax.random.normal(next(ks), shape, jnp.float32) * scale

    d = D_MODEL
    x = nrm((BATCH, SEQ, d), 1.0)
    c = nrm((BATCH, d), 1.0)
    ctx = nrm((BATCH, CTX_LEN, d), 1.0)
    c_ctx = nrm((d,), 1.0)
    ada_w = nrm((DEPTH, d, 6 * d), 0.5 * d ** -0.5)
    ada_b = nrm((DEPTH, 6 * d), 0.02)
    norm_mix = 1.0 + nrm((DEPTH, d), 0.02)
    norm_ffn = 1.0 + nrm((DEPTH, d), 0.02)
    attn_w_in = nrm((N_EVEN, d, ATTN_IN_WIDTH), d ** -0.5)
    attn_w_out = nrm((N_EVEN, ATTN_OUT_WIDTH, d), ATTN_OUT_WIDTH ** -0.5)
    attn_rpb = nrm((N_EVEN, NA_HEADS, 2 * NA_WIN_ROWS - 1, 2 * NA_WIN_COLS - 1), 0.05)
    attn_q_gain = 1.0 + nrm((N_EVEN, HEAD_DIM), 0.02)
    attn_k_gain = 1.0 + nrm((N_EVEN, HEAD_DIM), 0.02)
    ml_w_in = nrm((N_ODD, d, ML_IN_WIDTH), d ** -0.5)
    ml_w_out = nrm((N_ODD, ML_V_WIDTH, d), ML_V_WIDTH ** -0.5)
    in_gate_b = nrm((N_ODD, 2, ML_HEADS), 0.1)
    forget_gate_b = 3.0 + 3.0 * jax.random.uniform(next(ks), (N_ODD, 2, ML_HEADS), jnp.float32)
    ml_gate_b = jnp.concatenate([in_gate_b, forget_gate_b], axis=1)
    ml_head_gain = 1.0 + nrm((N_ODD, ML_V_WIDTH), 0.02)
    router_w = nrm((DEPTH, d, N_EXPERTS), d ** -0.5)
    router_b = nrm((DEPTH, N_EXPERTS), 0.01)
    exp_w1 = nrm((DEPTH, N_EXPERTS, d, EXPERT_DIM), d ** -0.5)
    exp_w3 = nrm((DEPTH, N_EXPERTS, d, EXPERT_DIM), d ** -0.5)
    exp_w2 = nrm((DEPTH, N_EXPERTS, EXPERT_DIM, d), EXPERT_DIM ** -0.5)
    sh_w1 = nrm((DEPTH, d, SHARED_DIM), d ** -0.5)
    sh_w3 = nrm((DEPTH, d, SHARED_DIM), d ** -0.5)
    sh_w2 = nrm((DEPTH, SHARED_DIM, d), SHARED_DIM ** -0.5)
    final_norm = 1.0 + nrm((d,), 0.02)
    return {'x': x, 'c': c, 'ctx': ctx, 'c_ctx': c_ctx, 'ada_w': ada_w, 'ada_b': ada_b,
            'norm_mix': norm_mix, 'norm_ffn': norm_ffn, 'attn_w_in': attn_w_in, 'attn_w_out': attn_w_out,
            'attn_rpb': attn_rpb, 'attn_q_gain': attn_q_gain, 'attn_k_gain': attn_k_gain,
            'ml_w_in': ml_w_in, 'ml_w_out': ml_w_out, 'ml_gate_b': ml_gate_b, 'ml_head_gain': ml_head_gain,
            'router_w': router_w, 'router_b': router_b, 'exp_w1': exp_w1, 'exp_w3': exp_w3, 'exp_w2': exp_w2,
            'sh_w1': sh_w1, 'sh_w3': sh_w3, 'sh_w2': sh_w2, 'final_norm': final_norm}


def reference(x, c, ctx, c_ctx, ada_w, ada_b, norm_mix, norm_ffn, attn_w_in, attn_w_out, attn_rpb,
              attn_q_gain, attn_k_gain, ml_w_in, ml_w_out, ml_gate_b, ml_head_gain, router_w, router_b,
              exp_w1, exp_w3, exp_w2, sh_w1, sh_w3, sh_w2, final_norm):
    b, s, d = x.shape
    cos, sin = rope_2d_tables(s)
    xc = ctx
    for layer in range(DEPTH):
        last = layer == DEPTH - 1
        mod = (jax.nn.silu(c) @ ada_w[layer] + ada_b[layer]).reshape(b, 6, 1, d)
        mod_c = (jax.nn.silu(c_ctx) @ ada_w[layer] + ada_b[layer]).reshape(6, d)
        hx = rms_norm(x, norm_mix[layer]) * (1.0 + mod[:, 1]) + mod[:, 0]
        hc = rms_norm(xc, norm_mix[layer]) * (1.0 + mod_c[1]) + mod_c[0]
        j = layer // 2
        if layer % 2 == 0:
            y, yc = attn_mixer(hx, hc, attn_w_in[j], attn_w_out[j], attn_rpb[j], attn_q_gain[j], attn_k_gain[j], cos, sin, not last)
        else:
            y, yc = mlstm_mixer(hx, hc, ml_w_in[j], ml_w_out[j], ml_gate_b[j], ml_head_gain[j], not last)
        x = x + mod[:, 2] * y
        hx = rms_norm(x, norm_ffn[layer]) * (1.0 + mod[:, 4]) + mod[:, 3]
        moe_args = (router_w[layer], router_b[layer], exp_w1[layer], exp_w3[layer], exp_w2[layer],
                    sh_w1[layer], sh_w3[layer], sh_w2[layer])
        if last:
            f = moe_ffn(hx.reshape(b * s, d), *moe_args).reshape(b, s, d)
        else:
            xc = xc + mod_c[2] * yc
            hc = rms_norm(xc, norm_ffn[layer]) * (1.0 + mod_c[4]) + mod_c[3]
            f_all = moe_ffn(jnp.concatenate([hx.reshape(b * s, d), hc.reshape(-1, d)], axis=0), *moe_args)
            f = f_all[:b * s].reshape(b, s, d)
            xc = xc + mod_c[5] * f_all[b * s:].reshape(xc.shape)
        x = x + mod[:, 5] * f
    return rms_norm(x, final_norm)
```

```cpp
#include <hip/hip_runtime.h>
#include <cstdio>
#include <cstdint>

#define DEVI __device__ __forceinline__
typedef unsigned short bf16;
typedef unsigned int u32;

constexpr int D = 2048, NB = 4, SEQ = 4096, CTXL = 256, GRIDW = 64;
constexpr int ML = NB * SEQ;
constexpr int MC = NB * CTXL;
constexpr int MT = ML + MC;
constexpr int AIW = 4608;
constexpr int MIW = 6176, MIWM = 6144;
constexpr int NE = 64, TOPK = 8, EDIM = 512;
constexpr int RS = MT * 8 + 64 * 256;
constexpr int SH0 = RS;
constexpr int NSLOT = RS + MT;
constexpr float EPS = 1e-6f;
constexpr float QSCALE = 0.08838834764831845f;

constexpr size_t MiB = (size_t)1 << 20;
constexpr size_t WS_CTL = 0, CTL_BYTES = 1 * MiB;
constexpr size_t WS_MOD = 1 * MiB;
constexpr size_t WS_XC = 2 * MiB;
constexpr size_t WS_G = 10 * MiB;
constexpr size_t WS_EIDX = 13 * MiB, WS_EW = 14 * MiB, WS_EPOS = 15 * MiB, WS_TSLOT = 16 * MiB, WS_STOK = 17 * MiB, WS_SW = 18 * MiB, WS_EOFF = 19 * MiB;
constexpr size_t WS_HB = 20 * MiB;
constexpr size_t WS_ACT = 88 * MiB;
constexpr size_t WS_Y = 257 * MiB;
constexpr size_t WS_QKV = 257 * MiB;
constexpr size_t WS_AO = 461 * MiB;
constexpr size_t WS_HD = 529 * MiB;
constexpr size_t WS_WT = 933 * MiB;
constexpr size_t WS_END = 1780 * MiB;
constexpr int CW_CNT = 1024;

struct Params {
    const float *x, *c, *ctx, *c_ctx, *ada_w, *ada_b, *norm_mix, *norm_ffn, *attn_w_in, *attn_w_out, *attn_rpb, *attn_q_gain, *attn_k_gain,
        *ml_w_in, *ml_w_out, *ml_gate_b, *ml_head_gain, *router_w, *router_b, *exp_w1, *exp_w3, *exp_w2, *sh_w1, *sh_w3, *sh_w2, *final_norm;
    float* out; unsigned char* ws;
    int lo, hi;
};

DEVI float bf2f(bf16 b) { return __uint_as_float(((u32)b) << 16); }
DEVI bf16 f2bf(float f) { u32 u = __float_as_uint(f); u += 0x7fffu + ((u >> 16) & 1u); return (bf16)(u >> 16); }
DEVI u32 pk2(float lo, float hi) { return (u32)f2bf(lo) | ((u32)f2bf(hi) << 16); }
DEVI float wave_sum(float v) {
#pragma unroll
    for (int o = 32; o >= 1; o >>= 1) v += __shfl_xor(v, o);
    return v;
}
DEVI int bidx(int m) { return m < ML ? (m >> 12) : 4; }
DEVI const float* modp(const Params& p, int layer, int bb, int i) { return (const float*)(p.ws + WS_MOD) + ((size_t)((layer * 5 + bb) * 6 + i)) * D; }
DEVI float silu(float x) { return x / (1.f + __expf(-x)); }
DEVI float sigmoidf(float x) { return 1.f / (1.f + __expf(-x)); }

DEVI void ph_mods(const Params& p, float* lds, int vcu, int G) {
    float* sc = lds;
    float* red = lds + 5 * D;
    const int tid = threadIdx.x;
    for (int i = tid; i < 5 * D; i += 512) { const int bb = i / D, k = i % D; const float v = bb < 4 ? p.c[bb * D + k] : p.c_ctx[k]; sc[i] = silu(v); }
    __syncthreads();
    const int tn = tid & 15, tk = tid >> 4;
    for (int item = vcu; item < 2 * 192; item += G) {
        const int l = item / 192, n0 = (item % 192) * 64;
        const float* W = p.ada_w + (size_t)l * D * 12288 + n0 + tn * 4;
        float4 acc[5];
#pragma unroll
        for (int b = 0; b < 5; ++b) acc[b] = make_float4(0.f, 0.f, 0.f, 0.f);
#pragma unroll 4
        for (int kk = 0; kk < 64; ++kk) {
            const int k = tk * 64 + kk;
            const float4 w = *(const float4*)(W + (size_t)k * 12288);
#pragma unroll
            for (int b = 0; b < 5; ++b) { const float s = sc[b * D + k]; acc[b].x += s * w.x; acc[b].y += s * w.y; acc[b].z += s * w.z; acc[b].w += s * w.w; }
        }
#pragma unroll
        for (int b = 0; b < 5; ++b) *(float4*)(red + (tk * 5 + b) * 64 + tn * 4) = acc[b];
        __syncthreads();
        if (tid < 320) {
            const int b = tid / 64, n = tid % 64; float s = 0.f;
            for (int g = 0; g < 32; ++g) s += red[(g * 5 + b) * 64 + n];
            ((float*)(p.ws + WS_MOD))[(size_t)(l * 5 + b) * 12288 + n0 + n] = s + p.ada_b[l * 12288 + n0 + n];
        }
        __syncthreads();
    }
}

DEVI void norm_row_load(const float* src, float4 (&v)[8], float& rstd, int lane) {
    float ss = 0.f;
#pragma unroll
    for (int j = 0; j < 8; ++j) { v[j] = *(const float4*)(src + 4 * lane + 256 * j); ss += v[j].x * v[j].x + v[j].y * v[j].y + v[j].z * v[j].z + v[j].w * v[j].w; }
    ss = wave_sum(ss);
    rstd = rsqrtf(ss * (1.f / D) + EPS);
}
DEVI void ph_norm(const Params& p, int layer, const float* xlat, const float* xctx, const float* gain, int ish, int isc, int nrows, int vcu, int G) {
    const int lane = threadIdx.x & 63, wave = threadIdx.x >> 6;
    bf16* HB = (bf16*)(p.ws + WS_HB);
    for (int m = vcu * 8 + wave; m < nrows; m += G * 8) {
        const float* src = m < ML ? xlat + (size_t)m * D : xctx + (size_t)(m - ML) * D;
        float4 v[8]; float rstd; norm_row_load(src, v, rstd, lane);
        const int bb = bidx(m); const float* sh = modp(p, layer, bb, ish); const float* scl = modp(p, layer, bb, isc);
#pragma unroll
        for (int j = 0; j < 8; ++j) {
            const int c = 4 * lane + 256 * j;
            const float4 g = *(const float4*)(gain + c), s1 = *(const float4*)(scl + c), s0 = *(const float4*)(sh + c);
            const float a = v[j].x * rstd * g.x * (1.f + s1.x) + s0.x, b = v[j].y * rstd * g.y * (1.f + s1.y) + s0.y;
            const float cc = v[j].z * rstd * g.z * (1.f + s1.z) + s0.z, d = v[j].w * rstd * g.w * (1.f + s1.w) + s0.w;
            uint2 o; o.x = pk2(a, b); o.y = pk2(cc, d);
            *(uint2*)(HB + (size_t)m * D + c) = o;
        }
    }
}

DEVI void ph_normr(const Params& p, int layer, const float* xlat, const float* xctx, int nrows, float* lds, int vcu, int G) {
    float* hrow = lds;
    float* sraw = lds + 8 * D;
    float* ssel = sraw + 512;
    float* gsc = ssel + 512;
    float* wtmp = gsc + 64;
    int* etmp = (int*)(wtmp + 64);
    const int tid = threadIdx.x, lane = tid & 63, wave = tid >> 6;
    bf16* HB = (bf16*)(p.ws + WS_HB);
    const float* gain = p.norm_ffn + layer * D;
    const float* RW = p.router_w + (size_t)layer * D * NE;
    const float* RB = p.router_b + layer * NE;
    int* eidx = (int*)(p.ws + WS_EIDX); float* ew = (float*)(p.ws + WS_EW); int* epos = (int*)(p.ws + WS_EPOS);
    u32* cnt = (u32*)(p.ws + WS_CTL) + CW_CNT + layer * 64;
    for (int base = vcu * 8; base < nrows; base += G * 8) {
        const int m = base + wave;
        {
            const float* src = m < ML ? xlat + (size_t)m * D : xctx + (size_t)(m - ML) * D;
            float4 v[8]; float rstd; norm_row_load(src, v, rstd, lane);
            const int bb = bidx(m); const float* sh = modp(p, layer, bb, 3); const float* scl = modp(p, layer, bb, 4);
#pragma unroll
            for (int j = 0; j < 8; ++j) {
                const int c = 4 * lane + 256 * j;
                const float4 g = *(const float4*)(gain + c), s1 = *(const float4*)(scl + c), s0 = *(const float4*)(sh + c);
                float4 h;
                h.x = v[j].x * rstd * g.x * (1.f + s1.x) + s0.x; h.y = v[j].y * rstd * g.y * (1.f + s1.y) + s0.y;
                h.z = v[j].z * rstd * g.z * (1.f + s1.z) + s0.z; h.w = v[j].w * rstd * g.w * (1.f + s1.w) + s0.w;
                *(float4*)(hrow + wave * D + c) = h;
                uint2 o; o.x = pk2(h.x, h.y); o.y = pk2(h.z, h.w);
                *(uint2*)(HB + (size_t)m * D + c) = o;
            }
        }
        __syncthreads();
        {
            const float* hr = hrow + wave * D; float acc = 0.f;
#pragma unroll 8
            for (int k = 0; k < D; ++k) acc += hr[k] * RW[(size_t)k * NE + lane];
            const float s = 1.f / (1.f + expf(-acc));
            sraw[wave * 64 + lane] = s; ssel[wave * 64 + lane] = s + RB[lane];
        }
        __syncthreads();
        if (tid < 8) {
            const int r = tid; const float* sv = ssel + r * 64;
            for (int g = 0; g < 8; ++g) { float m1 = -INFINITY, m2 = -INFINITY; for (int j = 0; j < 8; ++j) { const float v = sv[g * 8 + j]; if (v > m1) { m2 = m1; m1 = v; } else if (v > m2) m2 = v; } gsc[r * 8 + g] = m1 + m2; }
            u32 gmask = 0;
            for (int t = 0; t < 4; ++t) { float best = -INFINITY; int bi = -1; for (int g = 0; g < 8; ++g) { const float v = gsc[r * 8 + g]; if (!((gmask >> g) & 1u) && (bi < 0 || v > best)) { best = v; bi = g; } } gmask |= 1u << bi; }
            unsigned long long taken = 0ull; float wsum = 0.f;
            for (int t = 0; t < 8; ++t) {
                float best = -INFINITY; int bi = -1;
                for (int e = 0; e < 64; ++e) { if (!((gmask >> (e >> 3)) & 1u) || ((taken >> e) & 1ull)) continue; const float v = sv[e]; if (bi < 0 || v > best) { best = v; bi = e; } }
                taken |= 1ull << bi; const float w = sraw[r * 64 + bi]; wtmp[r * 8 + t] = w; etmp[r * 8 + t] = bi; wsum += w;
            }
            const int mm = base + r; const float inv = 2.5f / wsum;
            for (int t = 0; t < 8; ++t) { const int e = etmp[r * 8 + t]; eidx[mm * 8 + t] = e; ew[mm * 8 + t] = wtmp[r * 8 + t] * inv; epos[mm * 8 + t] = (int)atomicAdd(&cnt[e], 1u); }
        }
        __syncthreads();
    }
}

DEVI void ph_dispatch(const Params& p, int layer, int nrows, float* lds, int vcu, int G) {
    int* off = (int*)lds;
    const int tid = threadIdx.x;
    const u32* cnt = (const u32*)(p.ws + WS_CTL) + CW_CNT + layer * 64;
    if (tid == 0) { int o = 0; for (int e = 0; e < 64; ++e) { off[e] = o; o += ((int)cnt[e] + 255) / 256 * 256; } off[64] = o; }
    __syncthreads();
    int* eoff = (int*)(p.ws + WS_EOFF);
    if (vcu == 0 && tid < 65) eoff[tid] = off[tid];
    const int* eidx = (const int*)(p.ws + WS_EIDX); const float* ew = (const float*)(p.ws + WS_EW); const int* epos = (const int*)(p.ws + WS_EPOS);
    int* tslot = (int*)(p.ws + WS_TSLOT); int* stok = (int*)(p.ws + WS_STOK); float* sw = (float*)(p.ws + WS_SW);
    for (int i = vcu * 512 + tid; i < nrows * 8; i += G * 512) {
        const int e = eidx[i], slot = off[e] + epos[i];
        stok[slot] = i >> 3; sw[slot] = ew[i]; tslot[i] = slot;
    }
    for (int e = vcu; e < 64; e += G) for (int s = off[e] + (int)cnt[e] + tid; s < off[e + 1]; s += 512) { stok[s] = 0; sw[s] = 0.f; }
}

template <bool DUAL, class FA, class FW, class FE>
DEVI void ngemm(float* lds, int vcu, int G, int ntm, int ntn, int K, int N, int ldw, FA arow, FW wsel, FE epi) {
    float* As = lds;
    float* Bs = lds + 16 * 132;
    float* B3 = Bs + 16 * 128;
    const int tid = threadIdx.x, tx = tid & 15, ty = tid >> 4;
    const int ar = tid >> 2, akq = (tid & 3) * 4;
    const int bk = tid >> 5, bn = (tid & 31) * 4;
    for (int t = vcu; t < ntm * ntn; t += G) {
        const int tm = t / ntn, tn = t % ntn, n0 = tn * 128;
        const bf16* ap = arow(tm * 128 + ar);
        const float* W1; const float* W3; wsel(tm, W1, W3);
        float acc[4][8], acc3[DUAL ? 4 : 1][8];
#pragma unroll
        for (int i = 0; i < 4; ++i)
#pragma unroll
            for (int j = 0; j < 8; ++j) { acc[i][j] = 0.f; if (DUAL) acc3[i][j] = 0.f; }
        const bool bok = (n0 + bn) < N;
        for (int k0 = 0; k0 < K; k0 += 16) {
            const uint2 av = *(const uint2*)(ap + k0 + akq);
            As[(akq + 0) * 132 + ar] = __uint_as_float(av.x << 16); As[(akq + 1) * 132 + ar] = __uint_as_float(av.x & 0xffff0000u);
            As[(akq + 2) * 132 + ar] = __uint_as_float(av.y << 16); As[(akq + 3) * 132 + ar] = __uint_as_float(av.y & 0xffff0000u);
            float4 bv = make_float4(0.f, 0.f, 0.f, 0.f), b3 = bv;
            if (bok) { bv = *(const float4*)(W1 + (size_t)(k0 + bk) * ldw + n0 + bn); if (DUAL) b3 = *(const float4*)(W3 + (size_t)(k0 + bk) * ldw + n0 + bn); }
            *(float4*)(Bs + bk * 128 + bn) = bv; if (DUAL) *(float4*)(B3 + bk * 128 + bn) = b3;
            __syncthreads();
#pragma unroll
            for (int k = 0; k < 16; ++k) {
                const float4 a = *(const float4*)(As + k * 132 + ty * 4);
                const float4 b0 = *(const float4*)(Bs + k * 128 + tx * 8), b1 = *(const float4*)(Bs + k * 128 + tx * 8 + 4);
                const float aa[4] = {a.x, a.y, a.z, a.w}; const float bb[8] = {b0.x, b0.y, b0.z, b0.w, b1.x, b1.y, b1.z, b1.w};
#pragma unroll
                for (int i = 0; i < 4; ++i)
#pragma unroll
                    for (int j = 0; j < 8; ++j) acc[i][j] += aa[i] * bb[j];
                if (DUAL) {
                    const float4 c0 = *(const float4*)(B3 + k * 128 + tx * 8), c1 = *(const float4*)(B3 + k * 128 + tx * 8 + 4);
                    const float cc[8] = {c0.x, c0.y, c0.z, c0.w, c1.x, c1.y, c1.z, c1.w};
#pragma unroll
                    for (int i = 0; i < 4; ++i)
#pragma unroll
                        for (int j = 0; j < 8; ++j) acc3[i][j] += aa[i] * cc[j];
                }
            }
            __syncthreads();
        }
#pragma unroll
        for (int i = 0; i < 4; ++i)
#pragma unroll
            for (int j = 0; j < 8; ++j) { const int n = n0 + tx * 8 + j; if (n < N) { if constexpr (DUAL) epi(tm * 128 + ty * 4 + i, n, acc[i][j], acc3[i][j]); else epi(tm * 128 + ty * 4 + i, n, acc[i][j], 0.f); } }
    }
}

DEVI int expert_of(const int* eoff, int slot0) { int e = 0; for (int i = 1; i < 64; ++i) if (eoff[i] <= slot0) e = i; return e; }

struct OS { float m, l, a0, a1; };
DEVI void os_step(OS& s, float sc, float v0, float v1) {
    const float mn = fmaxf(s.m, sc), al = __expf(s.m - mn), pp = __expf(sc - mn);
    s.l = s.l * al + pp; s.a0 = s.a0 * al + pp * v0; s.a1 = s.a1 * al + pp * v1; s.m = mn;
}
DEVI float dot2(u32 q, u32 k) { return __uint_as_float(q << 16) * __uint_as_float(k << 16) + __uint_as_float(q & 0xffff0000u) * __uint_as_float(k & 0xffff0000u); }
DEVI void os_key(OS& s, u32 q, const bf16* kp, const bf16* vp, float bias, int lane) {
    const u32 kk = *(const u32*)(kp + 2 * lane), vv = *(const u32*)(vp + 2 * lane);
    const float sc = wave_sum(dot2(q, kk)) * QSCALE + bias;
    os_step(s, sc, __uint_as_float(vv << 16), __uint_as_float(vv & 0xffff0000u));
}
DEVI void ph_attn0_naive(const Params& p, int vcu, int G) {
    const int lane = threadIdx.x & 63, wave = threadIdx.x >> 6;
    const bf16* Q = (const bf16*)(p.ws + WS_QKV); bf16* AO = (bf16*)(p.ws + WS_AO);
    const int gw = vcu * 8 + wave, NGW = G * 8;
    for (int it = gw; it < 278528; it += NGW) {
        OS s; s.m = -3.0e38f; s.l = 0.f; s.a0 = 0.f; s.a1 = 0.f;
        int orow, ocol;
        if (it < 131072) {
            const int b = it >> 15, qh = (it >> 12) & 7, sq = it & 4095, kvh = qh >> 2;
            const int qrow = b * SEQ + sq; const u32 q = *(const u32*)(Q + (size_t)qrow * AIW + 3072 + qh * 128 + 2 * lane);
            for (int j = 0; j < CTXL + SEQ; ++j) {
                const int row = j < CTXL ? ML + b * CTXL + j : b * SEQ + (j - CTXL);
                const bf16* rp = Q + (size_t)row * AIW; os_key(s, q, rp + 4096 + kvh * 128, rp + 4352 + kvh * 128, 0.f, lane);
            }
            orow = qrow; ocol = 1024 + qh * 128;
        } else if (it < 262144) {
            const int i2 = it - 131072; const int b = i2 >> 15, h = (i2 >> 12) & 7, sq = i2 & 4095;
            const int r = sq >> 6, cq = sq & 63;
            const int kr0 = min(max(r - 4, 0), 56), cs = min(max(cq - 8, 0), 48);
            const int qrow = b * SEQ + sq; const u32 q = *(const u32*)(Q + (size_t)qrow * AIW + h * 128 + 2 * lane);
            const float* rpb = p.attn_rpb + h * 15 * 31;
            for (int dr = 0; dr < 8; ++dr) for (int dc = 0; dc < 16; ++dc) {
                const int kr = kr0 + dr, ck = cs + dc; const int row = b * SEQ + kr * 64 + ck;
                const bf16* rp = Q + (size_t)row * AIW; os_key(s, q, rp + 1024 + h * 128, rp + 2048 + h * 128, rpb[(kr - r + 7) * 31 + (ck - cq + 15)], lane);
            }
            for (int j = 0; j < CTXL; ++j) { const bf16* rp = Q + (size_t)(ML + b * CTXL + j) * AIW; os_key(s, q, rp + 1024 + h * 128, rp + 2048 + h * 128, 0.f, lane); }
            orow = qrow; ocol = h * 128;
        } else if (it < 270336) {
            const int i2 = it - 262144; const int b = i2 >> 11, h = (i2 >> 8) & 7, l = i2 & 255;
            const int qrow = ML + b * CTXL + l; const u32 q = *(const u32*)(Q + (size_t)qrow * AIW + h * 128 + 2 * lane);
            for (int j = 0; j < CTXL; ++j) { const bf16* rp = Q + (size_t)(ML + b * CTXL + j) * AIW; os_key(s, q, rp + 1024 + h * 128, rp + 2048 + h * 128, 0.f, lane); }
            orow = qrow; ocol = h * 128;
        } else {
            const int i2 = it - 270336; const int b = i2 >> 11, qh = (i2 >> 8) & 7, l = i2 & 255, kvh = qh >> 2;
            const int qrow = ML + b * CTXL + l; const u32 q = *(const u32*)(Q + (size_t)qrow * AIW + 3072 + qh * 128 + 2 * lane);
            for (int j = 0; j < CTXL; ++j) { const bf16* rp = Q + (size_t)(ML + b * CTXL + j) * AIW; os_key(s, q, rp + 4096 + kvh * 128, rp + 4352 + kvh * 128, 0.f, lane); }
            orow = qrow; ocol = 1024 + qh * 128;
        }
        const float inv = 1.f / s.l;
        *(u32*)(AO + (size_t)orow * D + ocol + 2 * lane) = pk2(s.a0 * inv, s.a1 * inv);
    }
}

DEVI void ph_qknorm(const Params& p, int vcu, int G) {
    const int lane = threadIdx.x & 63, wave = threadIdx.x >> 6;
    bf16* Q = (bf16*)(p.ws + WS_QKV);
    const float invf = exp2f(-(float)(lane & 31) * (13.287712379549449f / 32.f));
    for (int it = vcu * 8 + wave; it < MT * 10; it += G * 8) {
        const int m = it / 10, hh = it % 10;
        bf16* ptr = Q + (size_t)m * AIW + 3072 + hh * 128 + 2 * lane;
        const u32 v = *(const u32*)ptr; float x0 = __uint_as_float(v << 16), x1 = __uint_as_float(v & 0xffff0000u);
        const float ss = wave_sum(x0 * x0 + x1 * x1); const float rstd = rsqrtf(ss * (1.f / 128.f) + EPS);
        const float* gn = hh < 8 ? p.attn_q_gain : p.attn_k_gain;
        x0 = x0 * rstd * gn[2 * lane]; x1 = x1 * rstd * gn[2 * lane + 1];
        if (m < ML) {
            const int sq = m & 4095; const float pos = lane < 32 ? (float)(sq >> 6) : (float)(sq & 63);
            float sn, cs; sincosf(pos * invf, &sn, &cs);
            const float y0 = x0 * cs - x1 * sn, y1 = x0 * sn + x1 * cs; x0 = y0; x1 = y1;
        }
        *(u32*)ptr = pk2(x0, x1);
    }
}

DEVI void ph_mlstm_naive(const Params& p, float* lds, int vcu, int G) {
    float* C = lds;
    float* qs = C + 128 * 64;
    float* ks = qs + 64 * 129;
    float* vs = ks + 64 * 129;
    float* Sm = vs + 64 * 65;
    float* nv = Sm + 64 * 65;
    float* li = nv + 128; float* lf = li + 64; float* bc = lf + 64; float* mrow = bc + 64; float* wint = mrow + 64; float* wend = wint + 64; float* den = wend + 64; float* sc = den + 64;
    const int tid = threadIdx.x;
    const bf16* Q = (const bf16*)(p.ws + WS_QKV); const float* Gt = (const float*)(p.ws + WS_G);
    bf16* HD = (bf16*)(p.ws + WS_HD);
    for (int item = vcu; item < 256; item += G) {
        const int b = item >> 6, h = (item >> 3) & 7, dir = (item >> 2) & 1, sl = item & 3;
        for (int i = tid; i < 128 * 64; i += 512) C[i] = 0.f;
        if (tid < 128) nv[tid] = 0.f;
        float mst = 0.f;
        __syncthreads();
        for (int c = 0; c < 68; ++c) {
            const bool lat = c >= 4;
#define TOKROW(i) (lat ? (b * SEQ + (dir ? (SEQ - 1 - ((c - 4) * 64 + (i))) : ((c - 4) * 64 + (i)))) : (ML + b * CTXL + (dir ? (CTXL - 1 - (c * 64 + (i))) : (c * 64 + (i)))))
            if (tid < 64) {
                const int row = TOKROW(tid);
                li[tid] = Gt[(size_t)row * 32 + dir * 8 + h] + p.ml_gate_b[dir * 8 + h];
                const float f = Gt[(size_t)row * 32 + 16 + dir * 8 + h] + p.ml_gate_b[(2 + dir) * 8 + h];
                lf[tid] = fminf(f, 0.f) - log1pf(expf(-fabsf(f)));
            }
            for (int idx = tid; idx < 64 * 128; idx += 512) {
                const int t = idx >> 7, k = idx & 127; const int row = TOKROW(t);
                qs[t * 129 + k] = bf2f(Q[(size_t)row * MIWM + h * 128 + k]);
                ks[t * 129 + k] = bf2f(Q[(size_t)row * MIWM + 1024 + h * 128 + k]) * QSCALE;
            }
            for (int idx = tid; idx < 64 * 64; idx += 512) {
                const int t = idx >> 6, v = idx & 63; const int row = TOKROW(t);
                vs[t * 65 + v] = bf2f(Q[(size_t)row * MIWM + 2048 + h * 256 + sl * 64 + v]);
            }
            __syncthreads();
            if (tid == 0) {
                float run = 0.f; for (int i = 0; i < 64; ++i) { run += lf[i]; bc[i] = run; }
                const float btot = run; float amax = -INFINITY; for (int i = 0; i < 64; ++i) amax = fmaxf(amax, btot - bc[i] + li[i]);
                const float mnew = fmaxf(btot + mst, amax);
                sc[0] = mnew; sc[1] = expf(btot + mst - mnew); sc[2] = btot;
            }
            __syncthreads();
            const float mnew = sc[0], decay = sc[1], btot = sc[2];
            if (tid < 64) {
                wend[tid] = expf(btot - bc[tid] + li[tid] - mnew);
                if (lat) { float mr = bc[tid] + mst; for (int s = 0; s <= tid; ++s) mr = fmaxf(mr, bc[tid] - bc[s] + li[s]); mrow[tid] = mr; wint[tid] = expf(bc[tid] + mst - mr); }
            }
            __syncthreads();
            if (lat) {
                for (int idx = tid; idx < 64 * 64; idx += 512) {
                    const int t = idx >> 6, s = idx & 63; float r = 0.f;
                    if (s <= t) { float d = 0.f; for (int k = 0; k < 128; ++k) d += qs[t * 129 + k] * ks[s * 129 + k]; r = d * expf(bc[t] - bc[s] + li[s] - mrow[t]); }
                    Sm[t * 65 + s] = r;
                }
                __syncthreads();
                if (tid < 64) {
                    float qn = 0.f; for (int k = 0; k < 128; ++k) qn += qs[tid * 129 + k] * nv[k];
                    float ssum = 0.f; for (int s = 0; s < 64; ++s) ssum += Sm[tid * 65 + s];
                    den[tid] = wint[tid] * qn + ssum;
                }
                __syncthreads();
                for (int idx = tid; idx < 64 * 64; idx += 512) {
                    const int t = idx >> 6, v = idx & 63;
                    float a1 = 0.f; for (int k = 0; k < 128; ++k) a1 += qs[t * 129 + k] * C[k * 64 + v];
                    float a2 = 0.f; for (int s = 0; s < 64; ++s) a2 += Sm[t * 65 + s] * vs[s * 65 + v];
                    const float num = wint[t] * a1 + a2; const float dn = fmaxf(fabsf(den[t]), expf(-mrow[t]));
                    const int row = TOKROW(t);
                    HD[((size_t)dir * ML + row) * D + h * 256 + sl * 64 + v] = f2bf(num / dn);
                }
                __syncthreads();
            }
            for (int idx = tid; idx < 128 * 64; idx += 512) {
                const int kk = idx >> 6, v = idx & 63; float a = 0.f;
                for (int s = 0; s < 64; ++s) a += wend[s] * ks[s * 129 + kk] * vs[s * 65 + v];
                C[idx] = decay * C[idx] + a;
            }
            if (tid < 128) { float a = 0.f; for (int s = 0; s < 64; ++s) a += wend[s] * ks[s * 129 + tid]; nv[tid] = decay * nv[tid] + a; }
            mst = mnew;
            __syncthreads();
#undef TOKROW
        }
    }
}

DEVI void ph_readout(const Params& p, int vcu, int G) {
    const int lane = threadIdx.x & 63, wave = threadIdx.x >> 6;
    const bf16* HD = (const bf16*)(p.ws + WS_HD); const bf16* Q = (const bf16*)(p.ws + WS_QKV); bf16* AO = (bf16*)(p.ws + WS_AO);
    for (int it = vcu * 8 + wave; it < ML * 8; it += G * 8) {
        const int m = it >> 3, h = it & 7, c = h * 256 + 4 * lane;
        const uint2 a = *(const uint2*)(HD + (size_t)m * D + c), b2 = *(const uint2*)(HD + ((size_t)ML + m) * D + c);
        float x[4] = {__uint_as_float(a.x << 16) + __uint_as_float(b2.x << 16), __uint_as_float(a.x & 0xffff0000u) + __uint_as_float(b2.x & 0xffff0000u),
                      __uint_as_float(a.y << 16) + __uint_as_float(b2.y << 16), __uint_as_float(a.y & 0xffff0000u) + __uint_as_float(b2.y & 0xffff0000u)};
        const float ss = wave_sum(x[0] * x[0] + x[1] * x[1] + x[2] * x[2] + x[3] * x[3]); const float rstd = rsqrtf(ss * (1.f / 256.f) + EPS);
        const float4 g = *(const float4*)(p.ml_head_gain + c);
        const uint2 ov = *(const uint2*)(Q + (size_t)m * MIWM + 4096 + c);
        const float o0 = __uint_as_float(ov.x << 16), o1 = __uint_as_float(ov.x & 0xffff0000u), o2 = __uint_as_float(ov.y << 16), o3 = __uint_as_float(ov.y & 0xffff0000u);
        uint2 r; r.x = pk2(x[0] * rstd * g.x * sigmoidf(o0), x[1] * rstd * g.y * sigmoidf(o1)); r.y = pk2(x[2] * rstd * g.z * sigmoidf(o2), x[3] * rstd * g.w * sigmoidf(o3));
        *(uint2*)(AO + (size_t)m * D + c) = r;
    }
}

template <int MODE>
DEVI void ph_combine(const Params& p, int vcu, int G) {
    const int lane = threadIdx.x & 63, wave = threadIdx.x >> 6;
    const bf16* Y = (const bf16*)(p.ws + WS_Y); const int* tslot = (const int*)(p.ws + WS_TSLOT);
    bf16* HB = (bf16*)(p.ws + WS_HB); float* XC = (float*)(p.ws + WS_XC);
    const int nrows = MODE == 0 ? MT : ML, layer = MODE;
    for (int m = vcu * 8 + wave; m < nrows; m += G * 8) {
        float* xr = m < ML ? p.out + (size_t)m * D : XC + (size_t)(m - ML) * D;
        const int bb = bidx(m); const float* g5 = modp(p, layer, bb, 5);
        int sl[9];
#pragma unroll
        for (int k = 0; k < 8; ++k) sl[k] = tslot[m * 8 + k];
        sl[8] = SH0 + m;
        float4 v[8]; float ss = 0.f;
#pragma unroll
        for (int j = 0; j < 8; ++j) {
            const int c = 4 * lane + 256 * j;
            float f0 = 0.f, f1 = 0.f, f2 = 0.f, f3 = 0.f;
#pragma unroll
            for (int k = 0; k < 9; ++k) {
                const uint2 y = *(const uint2*)(Y + (size_t)sl[k] * D + c);
                f0 += __uint_as_float(y.x << 16); f1 += __uint_as_float(y.x & 0xffff0000u); f2 += __uint_as_float(y.y << 16); f3 += __uint_as_float(y.y & 0xffff0000u);
            }
            const float4 xv = *(const float4*)(xr + c), gg = *(const float4*)(g5 + c);
            v[j].x = xv.x + gg.x * f0; v[j].y = xv.y + gg.y * f1; v[j].z = xv.z + gg.z * f2; v[j].w = xv.w + gg.w * f3;
            ss += v[j].x * v[j].x + v[j].y * v[j].y + v[j].z * v[j].z + v[j].w * v[j].w;
        }
        ss = wave_sum(ss); const float rstd = rsqrtf(ss * (1.f / D) + EPS);
        if (MODE == 0) {
            const float* gain = p.norm_mix + D; const float* sh = modp(p, 1, bb, 0); const float* scl = modp(p, 1, bb, 1);
#pragma unroll
            for (int j = 0; j < 8; ++j) {
                const int c = 4 * lane + 256 * j;
                *(float4*)(xr + c) = v[j];
                const float4 g = *(const float4*)(gain + c), s1 = *(const float4*)(scl + c), s0 = *(const float4*)(sh + c);
                uint2 o; o.x = pk2(v[j].x * rstd * g.x * (1.f + s1.x) + s0.x, v[j].y * rstd * g.y * (1.f + s1.y) + s0.y);
                o.y = pk2(v[j].z * rstd * g.z * (1.f + s1.z) + s0.z, v[j].w * rstd * g.w * (1.f + s1.w) + s0.w);
                *(uint2*)(HB + (size_t)m * D + c) = o;
            }
        } else {
#pragma unroll
            for (int j = 0; j < 8; ++j) {
                const int c = 4 * lane + 256 * j; const float4 g = *(const float4*)(p.final_norm + c);
                float4 o; o.x = v[j].x * rstd * g.x; o.y = v[j].y * rstd * g.y; o.z = v[j].z * rstd * g.z; o.w = v[j].w * rstd * g.w;
                *(float4*)(xr + c) = o;
            }
        }
    }
}

enum Phase { PH_MODS = 0, PH_NORM0, PH_INPROJ0, PH_QKNORM, PH_ATTN0, PH_OUTPROJ0, PH_NORMR0, PH_DISP0, PH_G1_0, PH_G2_0, PH_COMB0,
             PH_INPROJ1, PH_MLSTM, PH_READOUT, PH_OUTPROJ1, PH_NORMR1, PH_DISP1, PH_G1_1, PH_G2_1, PH_COMB1, PH_COUNT };

template <int LAYER> DEVI void moe_g1_naive(const Params& p, float* lds, int vcu, int G) {
    const int nrows = LAYER == 0 ? MT : ML;
    const bf16* HB = (const bf16*)(p.ws + WS_HB); bf16* ACT = (bf16*)(p.ws + WS_ACT);
    const int* eoff = (const int*)(p.ws + WS_EOFF); const int* stok = (const int*)(p.ws + WS_STOK);
    const int nrt = eoff[64] / 128, nst = nrows / 128;
    auto arow = [&](int r) -> const bf16* { const int tm = r >> 7; if (tm < nrt) return HB + (size_t)stok[r] * D; return HB + (size_t)(r - nrt * 128) * D; };
    auto wsel = [&](int tm, const float*& W1, const float*& W3) {
        if (tm < nrt) { const int e = expert_of(eoff, tm * 128); W1 = p.exp_w1 + ((size_t)LAYER * 64 + e) * D * EDIM; W3 = p.exp_w3 + ((size_t)LAYER * 64 + e) * D * EDIM; }
        else { W1 = p.sh_w1 + (size_t)LAYER * D * EDIM; W3 = p.sh_w3 + (size_t)LAYER * D * EDIM; } };
    auto epi = [&](int r, int n, float a1, float a3) { const int tm = r >> 7; const int slot = tm < nrt ? r : SH0 + (r - nrt * 128); ACT[(size_t)slot * EDIM + n] = f2bf(silu(a1) * a3); };
    ngemm<true>(lds, vcu, G, nrt + nst, EDIM / 128, D, EDIM, EDIM, arow, wsel, epi);
}
template <int LAYER> DEVI void moe_g2_naive(const Params& p, float* lds, int vcu, int G) {
    const int nrows = LAYER == 0 ? MT : ML;
    const bf16* ACT = (const bf16*)(p.ws + WS_ACT); bf16* Y = (bf16*)(p.ws + WS_Y);
    const int* eoff = (const int*)(p.ws + WS_EOFF); const float* sw = (const float*)(p.ws + WS_SW);
    const int nrt = eoff[64] / 128, nst = nrows / 128;
    auto arow = [&](int r) -> const bf16* { const int tm = r >> 7; const int slot = tm < nrt ? r : SH0 + (r - nrt * 128); return ACT + (size_t)slot * EDIM; };
    auto wsel = [&](int tm, const float*& W1, const float*& W3) {
        if (tm < nrt) { const int e = expert_of(eoff, tm * 128); W1 = p.exp_w2 + ((size_t)LAYER * 64 + e) * EDIM * D; } else W1 = p.sh_w2 + (size_t)LAYER * EDIM * D; W3 = W1; };
    auto epi = [&](int r, int n, float a1, float) { const int tm = r >> 7; const bool routed = tm < nrt; const int slot = routed ? r : SH0 + (r - nrt * 128); const float w = routed ? sw[slot] : 1.f; Y[(size_t)slot * D + n] = f2bf(a1 * w); };
    ngemm<false>(lds, vcu, G, nrt + nst, D / 128, EDIM, D, D, arow, wsel, epi);
}

template <int PH> __global__ void __launch_bounds__(512) k_run(Params p) {
    extern __shared__ __attribute__((aligned(16))) unsigned char lds_raw[];
    float* lds = (float*)lds_raw;
    const int vcu = blockIdx.x, G = gridDim.x;
    bf16* HB = (bf16*)(p.ws + WS_HB); bf16* QKV = (bf16*)(p.ws + WS_QKV); bf16* AO = (bf16*)(p.ws + WS_AO); float* XC = (float*)(p.ws + WS_XC); float* Gt = (float*)(p.ws + WS_G);
#define IN(k) constexpr (PH == (k))
    if IN(PH_MODS) ph_mods(p, lds, vcu, G);
    if IN(PH_NORM0) ph_norm(p, 0, p.x, p.ctx, p.norm_mix, 0, 1, MT, vcu, G);
    if IN(PH_INPROJ0) {
        auto arow = [&](int r) -> const bf16* { return HB + (size_t)r * D; };
        auto wsel = [&](int, const float*& W1, const float*& W3) { W1 = p.attn_w_in; W3 = W1; };
        auto epi = [&](int r, int n, float a, float) { QKV[(size_t)r * AIW + n] = f2bf(a); };
        ngemm<false>(lds, vcu, G, MT / 128, AIW / 128, D, AIW, AIW, arow, wsel, epi);
    }
    if IN(PH_QKNORM) ph_qknorm(p, vcu, G);
    if IN(PH_ATTN0) ph_attn0_naive(p, vcu, G);
    if IN(PH_OUTPROJ0) {
        auto arow = [&](int r) -> const bf16* { return AO + (size_t)r * D; };
        auto wsel = [&](int, const float*& W1, const float*& W3) { W1 = p.attn_w_out; W3 = W1; };
        auto epi = [&](int r, int n, float a, float) {
            const float g = modp(p, 0, bidx(r), 2)[n];
            if (r < ML) p.out[(size_t)r * D + n] = p.x[(size_t)r * D + n] + g * a; else XC[(size_t)(r - ML) * D + n] = p.ctx[(size_t)(r - ML) * D + n] + g * a; };
        ngemm<false>(lds, vcu, G, MT / 128, D / 128, D, D, D, arow, wsel, epi);
    }
    if IN(PH_NORMR0) ph_normr(p, 0, p.out, XC, MT, lds, vcu, G);
    if IN(PH_DISP0) ph_dispatch(p, 0, MT, lds, vcu, G);
    if IN(PH_G1_0) moe_g1_naive<0>(p, lds, vcu, G);
    if IN(PH_G2_0) moe_g2_naive<0>(p, lds, vcu, G);
    if IN(PH_COMB0) ph_combine<0>(p, vcu, G);
    if IN(PH_INPROJ1) {
        auto arow = [&](int r) -> const bf16* { return HB + (size_t)r * D; };
        auto wsel = [&](int, const float*& W1, const float*& W3) { W1 = p.ml_w_in; W3 = W1; };
        auto epi = [&](int r, int n, float a, float) { if (n < MIWM) QKV[(size_t)r * MIWM + n] = f2bf(a); else Gt[(size_t)r * 32 + (n - MIWM)] = a; };
        ngemm<false>(lds, vcu, G, MT / 128, (MIW + 127) / 128, D, MIW, MIW, arow, wsel, epi);
    }
    if IN(PH_MLSTM) ph_mlstm_naive(p, lds, vcu, G);
    if IN(PH_READOUT) ph_readout(p, vcu, G);
    if IN(PH_OUTPROJ1) {
        auto arow = [&](int r) -> const bf16* { return AO + (size_t)r * D; };
        auto wsel = [&](int, const float*& W1, const float*& W3) { W1 = p.ml_w_out; W3 = W1; };
        auto epi = [&](int r, int n, float a, float) { p.out[(size_t)r * D + n] += modp(p, 1, bidx(r), 2)[n] * a; };
        ngemm<false>(lds, vcu, G, ML / 128, D / 128, D, D, D, arow, wsel, epi);
    }
    if IN(PH_NORMR1) ph_normr(p, 1, p.out, XC, ML, lds, vcu, G);
    if IN(PH_DISP1) ph_dispatch(p, 1, ML, lds, vcu, G);
    if IN(PH_G1_1) moe_g1_naive<1>(p, lds, vcu, G);
    if IN(PH_G2_1) moe_g2_naive<1>(p, lds, vcu, G);
    if IN(PH_COMB1) ph_combine<1>(p, vcu, G);
#undef IN
}

constexpr int LDS_BYTES = 144 * 1024;
typedef void (*kern_t)(Params);
template <int PH> struct KTab { static void fill(kern_t* t) { t[PH] = k_run<PH>; KTab<PH - 1>::fill(t); } };
template <> struct KTab<-1> { static void fill(kern_t*) {} };
extern "C" void kernel_launch(void* const* d_in, const int* in_sizes, int n_in, void* d_out, int out_size, void* d_ws, size_t ws_size, hipStream_t stream) {
    if (n_in != 26 || out_size != ML * D || ws_size < WS_END) { fprintf(stderr, "kernel_launch: unexpected shapes n_in %d out %d ws %zu\n", n_in, out_size, ws_size); return; }
    kern_t tab[PH_COUNT]; KTab<PH_COUNT - 1>::fill(tab);
    (void)hipMemsetAsync((char*)d_ws + WS_CTL, 0, CTL_BYTES, stream);
    Params p{};
    const float** pp = (const float**)&p;
    for (int i = 0; i < 26; ++i) pp[i] = (const float*)d_in[i];
    p.out = (float*)d_out; p.ws = (unsigned char*)d_ws;
    for (int ph = 0; ph < PH_COUNT; ++ph) {
        p.lo = ph; p.hi = ph + 1;
        int grid = 1024, ldsb = 32 * 1024;
        if (ph == PH_MODS) { grid = 384; ldsb = 96 * 1024; }
        if (ph == PH_NORMR0 || ph == PH_NORMR1) { grid = 512; ldsb = 72 * 1024; }
        if (ph == PH_MLSTM) { grid = 256; ldsb = LDS_BYTES; }
        if (ldsb > 64 * 1024 && hipFuncSetAttribute((const void*)tab[ph], hipFuncAttributeMaxDynamicSharedMemorySize, ldsb) != hipSuccess) { fprintf(stderr, "kernel_launch: hipFuncSetAttribute failed\n"); return; }
        hipLaunchKernelGGL(tab[ph], dim3(grid), dim3(512), ldsb, stream, p);
    }
    const hipError_t le = hipPeekAtLastError();
    if (le != hipSuccess) fprintf(stderr, "kernel_launch: launch failed: %s\n", hipGetErrorName(le));
}
```

```cpp
#include <hip/hip_runtime.h>
#include <cstdio>
#include <cstdint>

#define DEVI __device__ __forceinline__
typedef unsigned short bf16;
typedef unsigned int u32;

constexpr int D = 2048, NB = 4, SEQ = 4096, CTXL = 256, GRIDW = 64;
constexpr int ML = NB * SEQ;
constexpr int MC = NB * CTXL;
constexpr int MT = ML + MC;
constexpr int AIW = 4608;
constexpr int MIW = 6176, MIWM = 6144;
constexpr int NE = 64, TOPK = 8, EDIM = 512;
constexpr int RS = MT * 8 + 64 * 256;
constexpr int SH0 = RS;
constexpr int NSLOT = RS + MT;
constexpr float EPS = 1e-6f;
constexpr float QSCALE = 0.08838834764831845f;

constexpr size_t MiB = (size_t)1 << 20;
constexpr size_t WS_CTL = 0, CTL_BYTES = 1 * MiB;
constexpr size_t WS_MOD = 1 * MiB;
constexpr size_t WS_XC = 2 * MiB;
constexpr size_t WS_G = 10 * MiB;
constexpr size_t WS_EIDX = 13 * MiB, WS_EW = 14 * MiB, WS_EPOS = 15 * MiB, WS_TSLOT = 16 * MiB, WS_STOK = 17 * MiB, WS_SW = 18 * MiB, WS_EOFF = 19 * MiB;
constexpr size_t WS_HB = 20 * MiB;
constexpr size_t WS_ACT = 88 * MiB;
constexpr size_t WS_Y = 257 * MiB;
constexpr size_t WS_QKV = 257 * MiB;
constexpr size_t WS_AO = 461 * MiB;
constexpr size_t WS_HD = 529 * MiB;
constexpr size_t WS_WT = 933 * MiB;
constexpr size_t WS_END = 1780 * MiB;
constexpr int CW_CNT = 1024;

struct Params {
    const float *x, *c, *ctx, *c_ctx, *ada_w, *ada_b, *norm_mix, *norm_ffn, *attn_w_in, *attn_w_out, *attn_rpb, *attn_q_gain, *attn_k_gain,
        *ml_w_in, *ml_w_out, *ml_gate_b, *ml_head_gain, *router_w, *router_b, *exp_w1, *exp_w3, *exp_w2, *sh_w1, *sh_w3, *sh_w2, *final_norm;
    float* out; unsigned char* ws;
    int lo, hi;
};

DEVI float bf2f(bf16 b) { return __uint_as_float(((u32)b) << 16); }
DEVI bf16 f2bf(float f) { u32 u = __float_as_uint(f); u += 0x7fffu + ((u >> 16) & 1u); return (bf16)(u >> 16); }
DEVI u32 pk2(float lo, float hi) { return (u32)f2bf(lo) | ((u32)f2bf(hi) << 16); }
DEVI float wave_sum(float v) {
#pragma unroll
    for (int o = 32; o >= 1; o >>= 1) v += __shfl_xor(v, o);
    return v;
}
DEVI int bidx(int m) { return m < ML ? (m >> 12) : 4; }
DEVI const float* modp(const Params& p, int layer, int bb, int i) { return (const float*)(p.ws + WS_MOD) + ((size_t)((layer * 5 + bb) * 6 + i)) * D; }
DEVI float silu(float x) { return x / (1.f + __expf(-x)); }
DEVI float sigmoidf(float x) { return 1.f / (1.f + __expf(-x)); }

DEVI void ph_mods(const Params& p, float* lds, int vcu, int G) {
    float* sc = lds;
    float* red = lds + 5 * D;
    const int tid = threadIdx.x;
    for (int i = tid; i < 5 * D; i += 512) { const int bb = i / D, k = i % D; const float v = bb < 4 ? p.c[bb * D + k] : p.c_ctx[k]; sc[i] = silu(v); }
    __syncthreads();
    const int tn = tid & 15, tk = tid >> 4;
    for (int item = vcu; item < 2 * 192; item += G) {
        const int l = item / 192, n0 = (item % 192) * 64;
        const float* W = p.ada_w + (size_t)l * D * 12288 + n0 + tn * 4;
        float4 acc[5];
#pragma unroll
        for (int b = 0; b < 5; ++b) acc[b] = make_float4(0.f, 0.f, 0.f, 0.f);
#pragma unroll 4
        for (int kk = 0; kk < 64; ++kk) {
            const int k = tk * 64 + kk;
            const float4 w = *(const float4*)(W + (size_t)k * 12288);
#pragma unroll
            for (int b = 0; b < 5; ++b) { const float s = sc[b * D + k]; acc[b].x += s * w.x; acc[b].y += s * w.y; acc[b].z += s * w.z; acc[b].w += s * w.w; }
        }
#pragma unroll
        for (int b = 0; b < 5; ++b) *(float4*)(red + (tk * 5 + b) * 64 + tn * 4) = acc[b];
        __syncthreads();
        if (tid < 320) {
            const int b = tid / 64, n = tid % 64; float s = 0.f;
            for (int g = 0; g < 32; ++g) s += red[(g * 5 + b) * 64 + n];
            ((float*)(p.ws + WS_MOD))[(size_t)(l * 5 + b) * 12288 + n0 + n] = s + p.ada_b[l * 12288 + n0 + n];
        }
        __syncthreads();
    }
}

DEVI void norm_row_load(const float* src, float4 (&v)[8], float& rstd, int lane) {
    float ss = 0.f;
#pragma unroll
    for (int j = 0; j < 8; ++j) { v[j] = *(const float4*)(src + 4 * lane + 256 * j); ss += v[j].x * v[j].x + v[j].y * v[j].y + v[j].z * v[j].z + v[j].w * v[j].w; }
    ss = wave_sum(ss);
    rstd = rsqrtf(ss * (1.f / D) + EPS);
}
DEVI void ph_norm(const Params& p, int layer, const float* xlat, const float* xctx, const float* gain, int ish, int isc, int nrows, int vcu, int G) {
    const int lane = threadIdx.x & 63, wave = threadIdx.x >> 6;
    bf16* HB = (bf16*)(p.ws + WS_HB);
    for (int m = vcu * 8 + wave; m < nrows; m += G * 8) {
        const float* src = m < ML ? xlat + (size_t)m * D : xctx + (size_t)(m - ML) * D;
        float4 v[8]; float rstd; norm_row_load(src, v, rstd, lane);
        const int bb = bidx(m); const float* sh = modp(p, layer, bb, ish); const float* scl = modp(p, layer, bb, isc);
#pragma unroll
        for (int j = 0; j < 8; ++j) {
            const int c = 4 * lane + 256 * j;
            const float4 g = *(const float4*)(gain + c), s1 = *(const float4*)(scl + c), s0 = *(const float4*)(sh + c);
            const float a = v[j].x * rstd * g.x * (1.f + s1.x) + s0.x, b = v[j].y * rstd * g.y * (1.f + s1.y) + s0.y;
            const float cc = v[j].z * rstd * g.z * (1.f + s1.z) + s0.z, d = v[j].w * rstd * g.w * (1.f + s1.w) + s0.w;
            uint2 o; o.x = pk2(a, b); o.y = pk2(cc, d);
            *(uint2*)(HB + (size_t)m * D + c) = o;
        }
    }
}

DEVI void ph_normr(const Params& p, int layer, const float* xlat, const float* xctx, int nrows, float* lds, int vcu, int G) {
    float* hrow = lds;
    float* sraw = lds + 8 * D;
    float* ssel = sraw + 512;
    float* gsc = ssel + 512;
    float* wtmp = gsc + 64;
    int* etmp = (int*)(wtmp + 64);
    const int tid = threadIdx.x, lane = tid & 63, wave = tid >> 6;
    bf16* HB = (bf16*)(p.ws + WS_HB);
    const float* gain = p.norm_ffn + layer * D;
    const float* RW = p.router_w + (size_t)layer * D * NE;
    const float* RB = p.router_b + layer * NE;
    int* eidx = (int*)(p.ws + WS_EIDX); float* ew = (float*)(p.ws + WS_EW); int* epos = (int*)(p.ws + WS_EPOS);
    u32* cnt = (u32*)(p.ws + WS_CTL) + CW_CNT + layer * 64;
    for (int base = vcu * 8; base < nrows; base += G * 8) {
        const int m = base + wave;
        {
            const float* src = m < ML ? xlat + (size_t)m * D : xctx + (size_t)(m - ML) * D;
            float4 v[8]; float rstd; norm_row_load(src, v, rstd, lane);
            const int bb = bidx(m); const float* sh = modp(p, layer, bb, 3); const float* scl = modp(p, layer, bb, 4);
#pragma unroll
            for (int j = 0; j < 8; ++j) {
                const int c = 4 * lane + 256 * j;
                const float4 g = *(const float4*)(gain + c), s1 = *(const float4*)(scl + c), s0 = *(const float4*)(sh + c);
                float4 h;
                h.x = v[j].x * rstd * g.x * (1.f + s1.x) + s0.x; h.y = v[j].y * rstd * g.y * (1.f + s1.y) + s0.y;
                h.z = v[j].z * rstd * g.z * (1.f + s1.z) + s0.z; h.w = v[j].w * rstd * g.w * (1.f + s1.w) + s0.w;
                *(float4*)(hrow + wave * D + c) = h;
                uint2 o; o.x = pk2(h.x, h.y); o.y = pk2(h.z, h.w);
                *(uint2*)(HB + (size_t)m * D + c) = o;
            }
        }
        __syncthreads();
        {
            const float* hr = hrow + wave * D; float acc = 0.f;
#pragma unroll 8
            for (int k = 0; k < D; ++k) acc += hr[k] * RW[(size_t)k * NE + lane];
            const float s = 1.f / (1.f + expf(-acc));
            sraw[wave * 64 + lane] = s; ssel[wave * 64 + lane] = s + RB[lane];
        }
        __syncthreads();
        if (tid < 8) {
            const int r = tid; const float* sv = ssel + r * 64;
            for (int g = 0; g < 8; ++g) { float m1 = -INFINITY, m2 = -INFINITY; for (int j = 0; j < 8; ++j) { const float v = sv[g * 8 + j]; if (v > m1) { m2 = m1; m1 = v; } else if (v > m2) m2 = v; } gsc[r * 8 + g] = m1 + m2; }
            u32 gmask = 0;
            for (int t = 0; t < 4; ++t) { float best = -INFINITY; int bi = -1; for (int g = 0; g < 8; ++g) { const float v = gsc[r * 8 + g]; if (!((gmask >> g) & 1u) && (bi < 0 || v > best)) { best = v; bi = g; } } gmask |= 1u << bi; }
            unsigned long long taken = 0ull; float wsum = 0.f;
            for (int t = 0; t < 8; ++t) {
                float best = -INFINITY; int bi = -1;
                for (int e = 0; e < 64; ++e) { if (!((gmask >> (e >> 3)) & 1u) || ((taken >> e) & 1ull)) continue; const float v = sv[e]; if (bi < 0 || v > best) { best = v; bi = e; } }
                taken |= 1ull << bi; const float w = sraw[r * 64 + bi]; wtmp[r * 8 + t] = w; etmp[r * 8 + t] = bi; wsum += w;
            }
            const int mm = base + r; const float inv = 2.5f / wsum;
            for (int t = 0; t < 8; ++t) { const int e = etmp[r * 8 + t]; eidx[mm * 8 + t] = e; ew[mm * 8 + t] = wtmp[r * 8 + t] * inv; epos[mm * 8 + t] = (int)atomicAdd(&cnt[e], 1u); }
        }
        __syncthreads();
    }
}

DEVI void ph_dispatch(const Params& p, int layer, int nrows, float* lds, int vcu, int G) {
    int* off = (int*)lds;
    const int tid = threadIdx.x;
    const u32* cnt = (const u32*)(p.ws + WS_CTL) + CW_CNT + layer * 64;
    if (tid == 0) { int o = 0; for (int e = 0; e < 64; ++e) { off[e] = o; o += ((int)cnt[e] + 255) / 256 * 256; } off[64] = o; }
    __syncthreads();
    int* eoff = (int*)(p.ws + WS_EOFF);
    if (vcu == 0 && tid < 65) eoff[tid] = off[tid];
    const int* eidx = (const int*)(p.ws + WS_EIDX); const float* ew = (const float*)(p.ws + WS_EW); const int* epos = (const int*)(p.ws + WS_EPOS);
    int* tslot = (int*)(p.ws + WS_TSLOT); int* stok = (int*)(p.ws + WS_STOK); float* sw = (float*)(p.ws + WS_SW);
    for (int i = vcu * 512 + tid; i < nrows * 8; i += G * 512) {
        const int e = eidx[i], slot = off[e] + epos[i];
        stok[slot] = i >> 3; sw[slot] = ew[i]; tslot[i] = slot;
    }
    for (int e = vcu; e < 64; e += G) for (int s = off[e] + (int)cnt[e] + tid; s < off[e + 1]; s += 512) { stok[s] = 0; sw[s] = 0.f; }
}

template <bool DUAL, class FA, class FW, class FE>
DEVI void ngemm(float* lds, int vcu, int G, int ntm, int ntn, int K, int N, int ldw, FA arow, FW wsel, FE epi) {
    float* As = lds;
    float* Bs = lds + 16 * 132;
    float* B3 = Bs + 16 * 128;
    const int tid = threadIdx.x, tx = tid & 15, ty = tid >> 4;
    const int ar = tid >> 2, akq = (tid & 3) * 4;
    const int bk = tid >> 5, bn = (tid & 31) * 4;
    for (int t = vcu; t < ntm * ntn; t += G) {
        const int tm = t / ntn, tn = t % ntn, n0 = tn * 128;
        const bf16* ap = arow(tm * 128 + ar);
        const float* W1; const float* W3; wsel(tm, W1, W3);
        float acc[4][8], acc3[DUAL ? 4 : 1][8];
#pragma unroll
        for (int i = 0; i < 4; ++i)
#pragma unroll
            for (int j = 0; j < 8; ++j) { acc[i][j] = 0.f; if (DUAL) acc3[i][j] = 0.f; }
        const bool bok = (n0 + bn) < N;
        for (int k0 = 0; k0 < K; k0 += 16) {
            const uint2 av = *(const uint2*)(ap + k0 + akq);
            As[(akq + 0) * 132 + ar] = __uint_as_float(av.x << 16); As[(akq + 1) * 132 + ar] = __uint_as_float(av.x & 0xffff0000u);
            As[(akq + 2) * 132 + ar] = __uint_as_float(av.y << 16); As[(akq + 3) * 132 + ar] = __uint_as_float(av.y & 0xffff0000u);
            float4 bv = make_float4(0.f, 0.f, 0.f, 0.f), b3 = bv;
            if (bok) { bv = *(const float4*)(W1 + (size_t)(k0 + bk) * ldw + n0 + bn); if (DUAL) b3 = *(const float4*)(W3 + (size_t)(k0 + bk) * ldw + n0 + bn); }
            *(float4*)(Bs + bk * 128 + bn) = bv; if (DUAL) *(float4*)(B3 + bk * 128 + bn) = b3;
            __syncthreads();
#pragma unroll
            for (int k = 0; k < 16; ++k) {
                const float4 a = *(const float4*)(As + k * 132 + ty * 4);
                const float4 b0 = *(const float4*)(Bs + k * 128 + tx * 8), b1 = *(const float4*)(Bs + k * 128 + tx * 8 + 4);
                const float aa[4] = {a.x, a.y, a.z, a.w}; const float bb[8] = {b0.x, b0.y, b0.z, b0.w, b1.x, b1.y, b1.z, b1.w};
#pragma unroll
                for (int i = 0; i < 4; ++i)
#pragma unroll
                    for (int j = 0; j < 8; ++j) acc[i][j] += aa[i] * bb[j];
                if (DUAL) {
                    const float4 c0 = *(const float4*)(B3 + k * 128 + tx * 8), c1 = *(const float4*)(B3 + k * 128 + tx * 8 + 4);
                    const float cc[8] = {c0.x, c0.y, c0.z, c0.w, c1.x, c1.y, c1.z, c1.w};
#pragma unroll
                    for (int i = 0; i < 4; ++i)
#pragma unroll
                        for (int j = 0; j < 8; ++j) acc3[i][j] += aa[i] * cc[j];
                }
            }
            __syncthreads();
        }
#pragma unroll
        for (int i = 0; i < 4; ++i)
#pragma unroll
            for (int j = 0; j < 8; ++j) { const int n = n0 + tx * 8 + j; if (n < N) { if constexpr (DUAL) epi(tm * 128 + ty * 4 + i, n, acc[i][j], acc3[i][j]); else epi(tm * 128 + ty * 4 + i, n, acc[i][j], 0.f); } }
    }
}

DEVI int expert_of(const int* eoff, int slot0) { int e = 0; for (int i = 1; i < 64; ++i) if (eoff[i] <= slot0) e = i; return e; }

struct OS { float m, l, a0, a1; };
DEVI void os_step(OS& s, float sc, float v0, float v1) {
    const float mn = fmaxf(s.m, sc), al = __expf(s.m - mn), pp = __expf(sc - mn);
    s.l = s.l * al + pp; s.a0 = s.a0 * al + pp * v0; s.a1 = s.a1 * al + pp * v1; s.m = mn;
}
DEVI float dot2(u32 q, u32 k) { return __uint_as_float(q << 16) * __uint_as_float(k << 16) + __uint_as_float(q & 0xffff0000u) * __uint_as_float(k & 0xffff0000u); }
DEVI void os_key(OS& s, u32 q, const bf16* kp, const bf16* vp, float bias, int lane) {
    const u32 kk = *(const u32*)(kp + 2 * lane), vv = *(const u32*)(vp + 2 * lane);
    const float sc = wave_sum(dot2(q, kk)) * QSCALE + bias;
    os_step(s, sc, __uint_as_float(vv << 16), __uint_as_float(vv & 0xffff0000u));
}
DEVI void ph_attn0_naive(const Params& p, int vcu, int G) {
    const int lane = threadIdx.x & 63, wave = threadIdx.x >> 6;
    const bf16* Q = (const bf16*)(p.ws + WS_QKV); bf16* AO = (bf16*)(p.ws + WS_AO);
    const int gw = vcu * 8 + wave, NGW = G * 8;
    for (int it = gw; it < 278528; it += NGW) {
        OS s; s.m = -3.0e38f; s.l = 0.f; s.a0 = 0.f; s.a1 = 0.f;
        int orow, ocol;
        if (it < 131072) {
            const int b = it >> 15, qh = (it >> 12) & 7, sq = it & 4095, kvh = qh >> 2;
            const int qrow = b * SEQ + sq; const u32 q = *(const u32*)(Q + (size_t)qrow * AIW + 3072 + qh * 128 + 2 * lane);
            for (int j = 0; j < CTXL + SEQ; ++j) {
                const int row = j < CTXL ? ML + b * CTXL + j : b * SEQ + (j - CTXL);
                const bf16* rp = Q + (size_t)row * AIW; os_key(s, q, rp + 4096 + kvh * 128, rp + 4352 + kvh * 128, 0.f, lane);
            }
            orow = qrow; ocol = 1024 + qh * 128;
        } else if (it < 262144) {
            const int i2 = it - 131072; const int b = i2 >> 15, h = (i2 >> 12) & 7, sq = i2 & 4095;
            const int r = sq >> 6, cq = sq & 63;
            const int kr0 = min(max(r - 4, 0), 56), cs = min(max(cq - 8, 0), 48);
            const int qrow = b * SEQ + sq; const u32 q = *(const u32*)(Q + (size_t)qrow * AIW + h * 128 + 2 * lane);
            const float* rpb = p.attn_rpb + h * 15 * 31;
            for (int dr = 0; dr < 8; ++dr) for (int dc = 0; dc < 16; ++dc) {
                const int kr = kr0 + dr, ck = cs + dc; const int row = b * SEQ + kr * 64 + ck;
                const bf16* rp = Q + (size_t)row * AIW; os_key(s, q, rp + 1024 + h * 128, rp + 2048 + h * 128, rpb[(kr - r + 7) * 31 + (ck - cq + 15)], lane);
            }
            for (int j = 0; j < CTXL; ++j) { const bf16* rp = Q + (size_t)(ML + b * CTXL + j) * AIW; os_key(s, q, rp + 1024 + h * 128, rp + 2048 + h * 128, 0.f, lane); }
            orow = qrow; ocol = h * 128;
        } else if (it < 270336) {
            const int i2 = it - 262144; const int b = i2 >> 11, h = (i2 >> 8) & 7, l = i2 & 255;
            const int qrow = ML + b * CTXL + l; const u32 q = *(const u32*)(Q + (size_t)qrow * AIW + h * 128 + 2 * lane);
            for (int j = 0; j < CTXL; ++j) { const bf16* rp = Q + (size_t)(ML + b * CTXL + j) * AIW; os_key(s, q, rp + 1024 + h * 128, rp + 2048 + h * 128, 0.f, lane); }
            orow = qrow; ocol = h * 128;
        } else {
            const int i2 = it - 270336; const int b = i2 >> 11, qh = (i2 >> 8) & 7, l = i2 & 255, kvh = qh >> 2;
            const int qrow = ML + b * CTXL + l; const u32 q = *(const u32*)(Q + (size_t)qrow * AIW + 3072 + qh * 128 + 2 * lane);
            for (int j = 0; j < CTXL; ++j) { const bf16* rp = Q + (size_t)(ML + b * CTXL + j) * AIW; os_key(s, q, rp + 4096 + kvh * 128, rp + 4352 + kvh * 128, 0.f, lane); }
            orow = qrow; ocol = 1024 + qh * 128;
        }
        const float inv = 1.f / s.l;
        *(u32*)(AO + (size_t)orow * D + ocol + 2 * lane) = pk2(s.a0 * inv, s.a1 * inv);
    }
}

DEVI void ph_qknorm(const Params& p, int vcu, int G) {
    const int lane = threadIdx.x & 63, wave = threadIdx.x >> 6;
    bf16* Q = (bf16*)(p.ws + WS_QKV);
    const float invf = exp2f(-(float)(lane & 31) * (13.287712379549449f / 32.f));
    for (int it = vcu * 8 + wave; it < MT * 10; it += G * 8) {
        const int m = it / 10, hh = it % 10;
        bf16* ptr = Q + (size_t)m * AIW + 3072 + hh * 128 + 2 * lane;
        const u32 v = *(const u32*)ptr; float x0 = __uint_as_float(v << 16), x1 = __uint_as_float(v & 0xffff0000u);
        const float ss = wave_sum(x0 * x0 + x1 * x1); const float rstd = rsqrtf(ss * (1.f / 128.f) + EPS);
        const float* gn = hh < 8 ? p.attn_q_gain : p.attn_k_gain;
        x0 = x0 * rstd * gn[2 * lane]; x1 = x1 * rstd * gn[2 * lane + 1];
        if (m < ML) {
            const int sq = m & 4095; const float pos = lane < 32 ? (float)(sq >> 6) : (float)(sq & 63);
            float sn, cs; sincosf(pos * invf, &sn, &cs);
            const float y0 = x0 * cs - x1 * sn, y1 = x0 * sn + x1 * cs; x0 = y0; x1 = y1;
        }
        *(u32*)ptr = pk2(x0, x1);
    }
}

DEVI void ph_mlstm_naive(const Params& p, float* lds, int vcu, int G) {
    float* C = lds;
    float* qs = C + 128 * 64;
    float* ks = qs + 64 * 129;
    float* vs = ks + 64 * 129;
    float* Sm = vs + 64 * 65;
    float* nv = Sm + 64 * 65;
    float* li = nv + 128; float* lf = li + 64; float* bc = lf + 64; float* mrow = bc + 64; float* wint = mrow + 64; float* wend = wint + 64; float* den = wend + 64; float* sc = den + 64;
    const int tid = threadIdx.x;
    const bf16* Q = (const bf16*)(p.ws + WS_QKV); const float* Gt = (const float*)(p.ws + WS_G);
    bf16* HD = (bf16*)(p.ws + WS_HD);
    for (int item = vcu; item < 256; item += G) {
        const int b = item >> 6, h = (item >> 3) & 7, dir = (item >> 2) & 1, sl = item & 3;
        for (int i = tid; i < 128 * 64; i += 512) C[i] = 0.f;
        if (tid < 128) nv[tid] = 0.f;
        float mst = 0.f;
        __syncthreads();
        for (int c = 0; c < 68; ++c) {
            const bool lat = c >= 4;
#define TOKROW(i) (lat ? (b * SEQ + (dir ? (SEQ - 1 - ((c - 4) * 64 + (i))) : ((c - 4) * 64 + (i)))) : (ML + b * CTXL + (dir ? (CTXL - 1 - (c * 64 + (i))) : (c * 64 + (i)))))
            if (tid < 64) {
                const int row = TOKROW(tid);
                li[tid] = Gt[(size_t)row * 32 + dir * 8 + h] + p.ml_gate_b[dir * 8 + h];
                const float f = Gt[(size_t)row * 32 + 16 + dir * 8 + h] + p.ml_gate_b[(2 + dir) * 8 + h];
                lf[tid] = fminf(f, 0.f) - log1pf(expf(-fabsf(f)));
            }
            for (int idx = tid; idx < 64 * 128; idx += 512) {
                const int t = idx >> 7, k = idx & 127; const int row = TOKROW(t);
                qs[t * 129 + k] = bf2f(Q[(size_t)row * MIWM + h * 128 + k]);
                ks[t * 129 + k] = bf2f(Q[(size_t)row * MIWM + 1024 + h * 128 + k]) * QSCALE;
            }
            for (int idx = tid; idx < 64 * 64; idx += 512) {
                const int t = idx >> 6, v = idx & 63; const int row = TOKROW(t);
                vs[t * 65 + v] = bf2f(Q[(size_t)row * MIWM + 2048 + h * 256 + sl * 64 + v]);
            }
            __syncthreads();
            if (tid == 0) {
                float run = 0.f; for (int i = 0; i < 64; ++i) { run += lf[i]; bc[i] = run; }
                const float btot = run; float amax = -INFINITY; for (int i = 0; i < 64; ++i) amax = fmaxf(amax, btot - bc[i] + li[i]);
                const float mnew = fmaxf(btot + mst, amax);
                sc[0] = mnew; sc[1] = expf(btot + mst - mnew); sc[2] = btot;
            }
            __syncthreads();
            const float mnew = sc[0], decay = sc[1], btot = sc[2];
            if (tid < 64) {
                wend[tid] = expf(btot - bc[tid] + li[tid] - mnew);
                if (lat) { float mr = bc[tid] + mst; for (int s = 0; s <= tid; ++s) mr = fmaxf(mr, bc[tid] - bc[s] + li[s]); mrow[tid] = mr; wint[tid] = expf(bc[tid] + mst - mr); }
            }
            __syncthreads();
            if (lat) {
                for (int idx = tid; idx < 64 * 64; idx += 512) {
                    const int t = idx >> 6, s = idx & 63; float r = 0.f;
                    if (s <= t) { float d = 0.f; for (int k = 0; k < 128; ++k) d += qs[t * 129 + k] * ks[s * 129 + k]; r = d * expf(bc[t] - bc[s] + li[s] - mrow[t]); }
                    Sm[t * 65 + s] = r;
                }
                __syncthreads();
                if (tid < 64) {
                    float qn = 0.f; for (int k = 0; k < 128; ++k) qn += qs[tid * 129 + k] * nv[k];
                    float ssum = 0.f; for (int s = 0; s < 64; ++s) ssum += Sm[tid * 65 + s];
                    den[tid] = wint[tid] * qn + ssum;
                }
                __syncthreads();
                for (int idx = tid; idx < 64 * 64; idx += 512) {
                    const int t = idx >> 6, v = idx & 63;
                    float a1 = 0.f; for (int k = 0; k < 128; ++k) a1 += qs[t * 129 + k] * C[k * 64 + v];
                    float a2 = 0.f; for (int s = 0; s < 64; ++s) a2 += Sm[t * 65 + s] * vs[s * 65 + v];
                    const float num = wint[t] * a1 + a2; const float dn = fmaxf(fabsf(den[t]), expf(-mrow[t]));
                    const int row = TOKROW(t);
                    HD[((size_t)dir * ML + row) * D + h * 256 + sl * 64 + v] = f2bf(num / dn);
                }
                __syncthreads();
            }
            for (int idx = tid; idx < 128 * 64; idx += 512) {
                const int kk = idx >> 6, v = idx & 63; float a = 0.f;
                for (int s = 0; s < 64; ++s) a += wend[s] * ks[s * 129 + kk] * vs[s * 65 + v];
                C[idx] = decay * C[idx] + a;
            }
            if (tid < 128) { float a = 0.f; for (int s = 0; s < 64; ++s) a += wend[s] * ks[s * 129 + tid]; nv[tid] = decay * nv[tid] + a; }
            mst = mnew;
            __syncthreads();
#undef TOKROW
        }
    }
}

DEVI void ph_readout(const Params& p, int vcu, int G) {
    const int lane = threadIdx.x & 63, wave = threadIdx.x >> 6;
    const bf16* HD = (const bf16*)(p.ws + WS_HD); const bf16* Q = (const bf16*)(p.ws + WS_QKV); bf16* AO = (bf16*)(p.ws + WS_AO);
    for (int it = vcu * 8 + wave; it < ML * 8; it += G * 8) {
        const int m = it >> 3, h = it & 7, c = h * 256 + 4 * lane;
        const uint2 a = *(const uint2*)(HD + (size_t)m * D + c), b2 = *(const uint2*)(HD + ((size_t)ML + m) * D + c);
        float x[4] = {__uint_as_float(a.x << 16) + __uint_as_float(b2.x << 16), __uint_as_float(a.x & 0xffff0000u) + __uint_as_float(b2.x & 0xffff0000u),
                      __uint_as_float(a.y << 16) + __uint_as_float(b2.y << 16), __uint_as_float(a.y & 0xffff0000u) + __uint_as_float(b2.y & 0xffff0000u)};
        const float ss = wave_sum(x[0] * x[0] + x[1] * x[1] + x[2] * x[2] + x[3] * x[3]); const float rstd = rsqrtf(ss * (1.f / 256.f) + EPS);
        const float4 g = *(const float4*)(p.ml_head_gain + c);
        const uint2 ov = *(const uint2*)(Q + (size_t)m * MIWM + 4096 + c);
        const float o0 = __uint_as_float(ov.x << 16), o1 = __uint_as_float(ov.x & 0xffff0000u), o2 = __uint_as_float(ov.y << 16), o3 = __uint_as_float(ov.y & 0xffff0000u);
        uint2 r; r.x = pk2(x[0] * rstd * g.x * sigmoidf(o0), x[1] * rstd * g.y * sigmoidf(o1)); r.y = pk2(x[2] * rstd * g.z * sigmoidf(o2), x[3] * rstd * g.w * sigmoidf(o3));
        *(uint2*)(AO + (size_t)m * D + c) = r;
    }
}

template <int MODE>
DEVI void ph_combine(const Params& p, int vcu, int G) {
    const int lane = threadIdx.x & 63, wave = threadIdx.x >> 6;
    const bf16* Y = (const bf16*)(p.ws + WS_Y); const int* tslot = (const int*)(p.ws + WS_TSLOT);
    bf16* HB = (bf16*)(p.ws + WS_HB); float* XC = (float*)(p.ws + WS_XC);
    const int nrows = MODE == 0 ? MT : ML, layer = MODE;
    for (int m = vcu * 8 + wave; m < nrows; m += G * 8) {
        float* xr = m < ML ? p.out + (size_t)m * D : XC + (size_t)(m - ML) * D;
        const int bb = bidx(m); const float* g5 = modp(p, layer, bb, 5);
        int sl[9];
#pragma unroll
        for (int k = 0; k < 8; ++k) sl[k] = tslot[m * 8 + k];
        sl[8] = SH0 + m;
        float4 v[8]; float ss = 0.f;
#pragma unroll
        for (int j = 0; j < 8; ++j) {
            const int c = 4 * lane + 256 * j;
            float f0 = 0.f, f1 = 0.f, f2 = 0.f, f3 = 0.f;
#pragma unroll
            for (int k = 0; k < 9; ++k) {
                const uint2 y = *(const uint2*)(Y + (size_t)sl[k] * D + c);
                f0 += __uint_as_float(y.x << 16); f1 += __uint_as_float(y.x & 0xffff0000u); f2 += __uint_as_float(y.y << 16); f3 += __uint_as_float(y.y & 0xffff0000u);
            }
            const float4 xv = *(const float4*)(xr + c), gg = *(const float4*)(g5 + c);
            v[j].x = xv.x + gg.x * f0; v[j].y = xv.y + gg.y * f1; v[j].z = xv.z + gg.z * f2; v[j].w = xv.w + gg.w * f3;
            ss += v[j].x * v[j].x + v[j].y * v[j].y + v[j].z * v[j].z + v[j].w * v[j].w;
        }
        ss = wave_sum(ss); const float rstd = rsqrtf(ss * (1.f / D) + EPS);
        if (MODE == 0) {
            const float* gain = p.norm_mix + D; const float* sh = modp(p, 1, bb, 0); const float* scl = modp(p, 1, bb, 1);
#pragma unroll
            for (int j = 0; j < 8; ++j) {
                const int c = 4 * lane + 256 * j;
                *(float4*)(xr + c) = v[j];
                const float4 g = *(const float4*)(gain + c), s1 = *(const float4*)(scl + c), s0 = *(const float4*)(sh + c);
                uint2 o; o.x = pk2(v[j].x * rstd * g.x * (1.f + s1.x) + s0.x, v[j].y * rstd * g.y * (1.f + s1.y) + s0.y);
                o.y = pk2(v[j].z * rstd * g.z * (1.f + s1.z) + s0.z, v[j].w * rstd * g.w * (1.f + s1.w) + s0.w);
                *(uint2*)(HB + (size_t)m * D + c) = o;
            }
        } else {
#pragma unroll
            for (int j = 0; j < 8; ++j) {
                const int c = 4 * lane + 256 * j; const float4 g = *(const float4*)(p.final_norm + c);
                float4 o; o.x = v[j].x * rstd * g.x; o.y = v[j].y * rstd * g.y; o.z = v[j].z * rstd * g.z; o.w = v[j].w * rstd * g.w;
                *(float4*)(xr + c) = o;
            }
        }
    }
}

#define LAS __attribute__((address_space(3)))
typedef short bf16x8 __attribute__((ext_vector_type(8)));
typedef float f32x4 __attribute__((ext_vector_type(4)));
typedef unsigned u32x4 __attribute__((ext_vector_type(4)));
namespace pg {
constexpr int BM = 256, BK = 64, HALF = 128, HTB = HALF * BK * 2, STAGE_BYTES = 8 * HTB, NXCD = 8, WGM = 8;
__host__ __device__ __forceinline__ int lds_byte(int r, int c) { const int st = (r >> 4) * 2 + (c >> 5), rr = r & 15, cc = c & 31, ob = rr * 64 + cc * 2; return st * 1024 + (ob ^ (((ob >> 9) & 1) << 5)); }
__host__ __device__ __forceinline__ void stage_rc(int b, int& R, int& C) { const int st = b / 1024, sb = b % 1024, swz = sb ^ (((sb >> 9) & 1) << 5); R = (st >> 1) * 16 + swz / 64; C = (st & 1) * 32 + (swz % 64) / 2; }
__host__ __device__ __forceinline__ int perm32(int rho) { const int n = rho >> 4, i = rho & 15; return 8 * (i >> 2) + 4 * n + (i & 3); }
DEVI unsigned cvt_pk_bf16(float lo, float hi) { unsigned r; asm volatile("v_cvt_pk_bf16_f32 %0, %1, %2" : "=v"(r) : "v"(lo), "v"(hi)); return r; }

struct Unit { int pm, pn, e; };
constexpr int GT_OFF = STAGE_BYTES;
constexpr int UD_OFF = GT_OFF + 16 * 256 * 4;
constexpr int EO_OFF = UD_OFF + 32 * 16;
constexpr int MISC_OFF = EO_OFF + 72 * 4;
constexpr int LDS_TOTAL = MISC_OFF + 64;

struct ListOrder {
    const LAS int* ud; int nu;
    DEVI bool next(int i, Unit& u) const {
        if (i >= nu) return false;
        u.pm = __builtin_amdgcn_readfirstlane(ud[i * 4 + 0]); u.pn = __builtin_amdgcn_readfirstlane(ud[i * 4 + 1]); u.e = __builtin_amdgcn_readfirstlane(ud[i * 4 + 2]); return true;
    }
};
DEVI bool dense_unit(int nM, int nN, int G, int c, int i, Unit& u) {
    const int nwg = nM * nN; const long L = (long)i * G + c; if (L >= nwg) return false;
    int wgid = (int)L; { const int q = nwg / NXCD, r = nwg % NXCD, xcd = wgid % NXCD, off = wgid / NXCD; wgid = (xcd < r ? xcd * (q + 1) : r * (q + 1) + (xcd - r) * q) + off; }
    const int nig = WGM * nN, gid = wgid / nig, fm = gid * WGM, gsz = (nM - fm) < WGM ? (nM - fm) : WGM;
    u.pm = fm + ((wgid % nig) % gsz); u.pn = (wgid % nig) / gsz; u.e = 0; return true;
}
DEVI int fill_dense(LAS unsigned char* lds, int nM, int nN, int G, int c) {
    LAS int* ud = (LAS int*)(lds + UD_OFF); int nu = 0;
    for (int i = 0; i < 32; ++i) { Unit u; if (!dense_unit(nM, nN, G, c, i, u)) break; if (threadIdx.x == 0) { ud[i * 4 + 0] = u.pm; ud[i * 4 + 1] = u.pn; ud[i * 4 + 2] = 0; } ++nu; }
    return nu;
}

template <class Epi, bool GATHER>
DEVI void gemm_phase(LAS unsigned char* lds, const bf16* A, const bf16* Bt, int K, size_t bgroup_bytes, const ListOrder& S, const Epi& E) {
    int tid = threadIdx.x; asm volatile("" : "+v"(tid));
    const int wid = __builtin_amdgcn_readfirstlane(tid >> 6), lane = tid & 63, wr = wid >> 2, wc = wid & 3, fr = lane & 15, fq = lane >> 4;
    const int nt = K / BK;
    const LAS int* gtab = (const LAS int*)(lds + GT_OFF);
    unsigned voffA[2], voffB[2]; int Rrow[2];
#pragma unroll
    for (int i = 0; i < 2; ++i) { int R, C; stage_rc(tid * 16 + i * 8192, R, C); const int Rb = Epi::PERM ? ((R & ~31) + perm32(R & 31)) : R;
        voffA[i] = GATHER ? (unsigned)(C * 2) : (unsigned)(R * K + C) * 2u; voffB[i] = (unsigned)(Rb * K + C) * 2u; Rrow[i] = R; }
    const size_t kstep = (size_t)(BK * 2);
    const size_t hstep = (size_t)HALF * K * 2;
    const size_t tstep = 2 * hstep;
    const unsigned ldsw = (unsigned)wid * 1024u;
    const int aoff = lds_byte(wr * 64 + fr, fq * 8), boff = lds_byte(wc * 32 + fr, fq * 8);
#define PG_SA(b, h) (((b) * 2 + (h)) * HTB)
#define PG_SB(b, h) ((4 + (b) * 2 + (h)) * HTB)
#define PG_STAGE(bufoff, gbase, voff) do { _Pragma("unroll") for (int _i = 0; _i < 2; ++_i) \
        __builtin_amdgcn_global_load_lds((const unsigned*)((const char*)(gbase) + (voff)[_i]), (LAS unsigned*)(lds + (bufoff) + ldsw + _i * 8192), 16, 0, 0); } while (0)
#define PG_STAGE_A(bufoff, abase, h, goff) do { if constexpr (GATHER) { PG_STAGE(bufoff, abase, goff[h]); } else { PG_STAGE(bufoff, (abase) + (h) * hstep, voffA); } } while (0)
#define PG_LDA(dst, b, h) do { _Pragma("unroll") for (int m = 0; m < 4; ++m) _Pragma("unroll") for (int k = 0; k < 2; ++k) dst[m][k] = *(const LAS bf16x8*)(lds + PG_SA(b, h) + aoff + m * 2048 + k * 1024); } while (0)
#define PG_LDB(dst, b, h) do { _Pragma("unroll") for (int n = 0; n < 2; ++n) _Pragma("unroll") for (int k = 0; k < 2; ++k) dst[n][k] = *(const LAS bf16x8*)(lds + PG_SB(b, h) + boff + n * 2048 + k * 1024); } while (0)
#define PG_MMA(ai, bj, At, Bt_) do { __builtin_amdgcn_s_setprio(1); _Pragma("unroll") for (int m = 0; m < 4; ++m) _Pragma("unroll") for (int n = 0; n < 2; ++n) _Pragma("unroll") for (int k = 0; k < 2; ++k) \
        acc[ai][bj][m][n] = __builtin_amdgcn_mfma_f32_16x16x32_bf16(Bt_[n][k], At[m][k], acc[ai][bj][m][n], 0, 0, 0); __builtin_amdgcn_s_setprio(0); } while (0)
#define PG_WAIT_V(n) asm volatile("s_waitcnt vmcnt(" #n ")" ::: "memory")
#define PG_WAIT_L(n) asm volatile("s_waitcnt lgkmcnt(" #n ")" ::: "memory")
#define PG_BAR __builtin_amdgcn_s_barrier()
#define PG_SCHED __builtin_amdgcn_sched_barrier(0)
    Unit cur, nxt; int ui = 0;
    if (!S.next(0, cur)) return;
    f32x4 acc[2][2][4][2];
#pragma unroll
    for (int a = 0; a < 2; ++a)
#pragma unroll
        for (int b = 0; b < 2; ++b)
#pragma unroll
            for (int m = 0; m < 4; ++m)
#pragma unroll
                for (int n = 0; n < 2; ++n) acc[a][b][m][n] = (f32x4){0.f, 0.f, 0.f, 0.f};
    bf16x8 At[4][2], B0[2][2], B1[2][2];
    unsigned gC[2][2], gN[2][2];
    auto gload = [&](int uidx, unsigned (&g)[2][2]) {
#pragma unroll
        for (int h = 0; h < 2; ++h)
#pragma unroll
            for (int i = 0; i < 2; ++i) g[h][i] = (unsigned)gtab[uidx * 256 + h * HALF + Rrow[i]] * (unsigned)(K * 2) + voffA[i];
    };
    if constexpr (GATHER) { gload(0, gC); gN[0][0] = gC[0][0]; gN[0][1] = gC[0][1]; gN[1][0] = gC[1][0]; gN[1][1] = gC[1][1]; }
    const char* cA = GATHER ? (const char*)A : (const char*)A + (size_t)cur.pm * tstep;
    const char* cB = (const char*)Bt + (size_t)cur.e * bgroup_bytes + (size_t)cur.pn * tstep;
    PG_STAGE(PG_SB(0, 0), cB, voffB); PG_STAGE(PG_SB(0, 1), cB + hstep, voffB); PG_STAGE_A(PG_SA(0, 0), cA, 0, gC); PG_STAGE_A(PG_SA(0, 1), cA, 1, gC);
    if (wr == 1) PG_BAR;
    PG_WAIT_V(2); PG_BAR;
    PG_STAGE(PG_SB(1, 0), cB + kstep, voffB); PG_STAGE_A(PG_SA(1, 0), cA + kstep, 0, gC); PG_STAGE(PG_SB(1, 1), cB + hstep + kstep, voffB);
    PG_WAIT_V(6); PG_BAR;
    for (;;) {
        const bool has_next = S.next(ui + 1, nxt);
        const char* nA = GATHER ? (const char*)A : (has_next ? (const char*)A + (size_t)nxt.pm * tstep : cA);
        const char* nB = has_next ? (const char*)Bt + (size_t)nxt.e * bgroup_bytes + (size_t)nxt.pn * tstep : cB;
#pragma unroll 1
        for (int t = 0; t < nt; t += 2) {
            const bool last = (t == nt - 2);
            const char* a1 = cA + (size_t)(t + 1) * kstep;
            const char* a2 = last ? nA : cA + (size_t)(t + 2) * kstep; const char* b2 = last ? nB : cB + (size_t)(t + 2) * kstep;
            const char* a3 = a2 + kstep; const char* b3 = b2 + kstep;
            unsigned gS[2][2];
            if constexpr (GATHER) {
                if (last && has_next) gload(ui + 1, gN);
#pragma unroll
                for (int h = 0; h < 2; ++h)
#pragma unroll
                    for (int i = 0; i < 2; ++i) gS[h][i] = (last && has_next) ? gN[h][i] : gC[h][i];
            }
            PG_LDB(B0, 0, 0); PG_LDB(B1, 0, 1); PG_SCHED; PG_LDA(At, 0, 0); PG_STAGE_A(PG_SA(1, 1), a1, 1, gC);
            PG_WAIT_V(8); PG_WAIT_L(0); PG_BAR; PG_MMA(0, 0, At, B0); PG_MMA(0, 1, At, B1); PG_BAR; PG_SCHED;
            PG_LDA(At, 0, 1); PG_STAGE(PG_SB(0, 0), b2, voffB); PG_STAGE(PG_SB(0, 1), b2 + hstep, voffB); PG_STAGE_A(PG_SA(0, 0), a2, 0, gS);
            PG_WAIT_V(8); PG_WAIT_L(0); PG_BAR; PG_MMA(1, 0, At, B0); PG_MMA(1, 1, At, B1); PG_BAR; PG_SCHED;
            PG_LDB(B0, 1, 0); PG_LDB(B1, 1, 1); PG_SCHED; PG_LDA(At, 1, 0); PG_STAGE_A(PG_SA(0, 1), a2, 1, gS);
            PG_WAIT_V(8); PG_WAIT_L(0); PG_BAR; PG_MMA(0, 0, At, B0); PG_MMA(0, 1, At, B1); PG_BAR; PG_SCHED;
            PG_LDA(At, 1, 1); PG_STAGE(PG_SB(1, 0), b3, voffB); PG_STAGE(PG_SB(1, 1), b3 + hstep, voffB); PG_STAGE_A(PG_SA(1, 0), a3, 0, gS);
            PG_WAIT_V(8); PG_WAIT_L(0); PG_BAR; PG_MMA(1, 0, At, B0); PG_MMA(1, 1, At, B1); PG_BAR; PG_SCHED;
        }
        if (wr == 0) PG_BAR;
        E(acc, cur, wr, wc, fr, fq);
        if (!has_next) break;
#pragma unroll
        for (int a = 0; a < 2; ++a)
#pragma unroll
            for (int b = 0; b < 2; ++b)
#pragma unroll
                for (int m = 0; m < 4; ++m)
#pragma unroll
                    for (int n = 0; n < 2; ++n) acc[a][b][m][n] = (f32x4){0.f, 0.f, 0.f, 0.f};
        cur = nxt; cA = nA; cB = nB; ++ui;
        if constexpr (GATHER) { gC[0][0] = gN[0][0]; gC[0][1] = gN[0][1]; gC[1][0] = gN[1][0]; gC[1][1] = gN[1][1]; }
        if (wr == 1) PG_BAR;
    }
    PG_WAIT_V(0);
    PG_BAR;
#undef PG_SA
#undef PG_SB
#undef PG_STAGE
#undef PG_STAGE_A
#undef PG_LDA
#undef PG_LDB
#undef PG_MMA
#undef PG_WAIT_V
#undef PG_WAIT_L
#undef PG_BAR
#undef PG_SCHED
}
}

constexpr size_t WT_AIN = WS_WT, WT_AOUT = WS_WT + 18 * MiB, WT_MIN = WS_WT + 26 * MiB, WT_MOUT = WS_WT + 51 * MiB, WT_W13 = WS_WT + 59 * MiB, WT_W2 = WS_WT + 579 * MiB;
constexpr int MINP = 6400;
static_assert(WT_W2 + (size_t)2 * 65 * 2 * MiB <= WS_END, "weight copies fit");
#define LDS_WAIT() asm volatile("s_waitcnt lgkmcnt(0)" ::: "memory")
DEVI void cvt_item(const float* W, int ldw, int k0, int n0, bf16* WT, int dK, int drow0, LAS float* scr, int lane) {
#pragma unroll 8
    for (int i = 0; i < 32; ++i) { const int kk = 2 * i + (lane >> 5); scr[kk * 33 + (lane & 31)] = W[(size_t)(k0 + kk) * ldw + n0 + (lane & 31)]; }
    LDS_WAIT(); asm volatile("" ::: "memory");
    const int c = lane & 7;
#pragma unroll
    for (int j = 0; j < 4; ++j) { const int n = (lane >> 3) + 8 * j; const LAS float* sp = scr + (8 * c) * 33 + n;
        u32x4 o; o.x = pk2(sp[0 * 33], sp[1 * 33]); o.y = pk2(sp[2 * 33], sp[3 * 33]); o.z = pk2(sp[4 * 33], sp[5 * 33]); o.w = pk2(sp[6 * 33], sp[7 * 33]);
        *(u32x4*)(WT + (size_t)(drow0 + n) * dK + k0 + 8 * c) = o; }
    LDS_WAIT(); asm volatile("" ::: "memory");
}
DEVI void ph_cvt(const Params& p, LAS unsigned char* lds, int vcu, int G) {
    const int lane = threadIdx.x & 63, wave = threadIdx.x >> 6;
    LAS float* scr = (LAS float*)(lds + wave * 16384);
    const int gw = vcu * 8 + wave, NGW = G * 8;
    constexpr int I_AIN = 32 * 144, I_AOUT = 32 * 64, I_MIN = 32 * 193, I_MOUT = 32 * 64, I_EXP = 2 * 65 * 3 * 512;
    constexpr int NITEMS = I_AIN + I_AOUT + I_MIN + I_MOUT + I_EXP;
    for (int it = gw; it < NITEMS; it += NGW) {
        int r = it;
        if (r < I_AIN) { cvt_item(p.attn_w_in, AIW, 64 * (r / 144), 32 * (r % 144), (bf16*)(p.ws + WT_AIN), D, 32 * (r % 144), scr, lane); continue; } r -= I_AIN;
        if (r < I_AOUT) { cvt_item(p.attn_w_out, D, 64 * (r / 64), 32 * (r % 64), (bf16*)(p.ws + WT_AOUT), D, 32 * (r % 64), scr, lane); continue; } r -= I_AOUT;
        if (r < I_MIN) { cvt_item(p.ml_w_in, MIW, 64 * (r / 193), 32 * (r % 193), (bf16*)(p.ws + WT_MIN), D, 32 * (r % 193), scr, lane); continue; } r -= I_MIN;
        if (r < I_MOUT) { cvt_item(p.ml_w_out, D, 64 * (r / 64), 32 * (r % 64), (bf16*)(p.ws + WT_MOUT), D, 32 * (r % 64), scr, lane); continue; } r -= I_MOUT;
        const int mat = r >> 9, ii = r & 511; const int l = mat / 195, q = mat % 195, e = q / 3, which = q % 3;
        if (which < 2) {
            const float* W = e < 64 ? (which == 0 ? p.exp_w1 : p.exp_w3) + ((size_t)l * 64 + e) * D * EDIM : (which == 0 ? p.sh_w1 : p.sh_w3) + (size_t)l * D * EDIM;
            const int kb = ii / 16, nb = ii % 16, n0 = 32 * nb;
            cvt_item(W, EDIM, 64 * kb, n0, (bf16*)(p.ws + WT_W13) + ((size_t)l * 65 + e) * 1024 * D, D, (n0 >> 7) * 256 + which * 128 + (n0 & 127), scr, lane);
        } else {
            const float* W = e < 64 ? p.exp_w2 + ((size_t)l * 64 + e) * EDIM * D : p.sh_w2 + (size_t)l * EDIM * D;
            const int kb = ii / 64, nb = ii % 64;
            cvt_item(W, D, 64 * kb, 32 * nb, (bf16*)(p.ws + WT_W2) + ((size_t)l * 65 + e) * D * EDIM, EDIM, 32 * nb, scr, lane);
        }
    }
    { u32x4* z = (u32x4*)((bf16*)(p.ws + WT_MIN) + (size_t)MIW * D); const int n16 = (MINP - MIW) * D * 2 / 16;
      for (int i = vcu * 512 + threadIdx.x; i < n16; i += G * 512) z[i] = (u32x4){0u, 0u, 0u, 0u}; }
}

typedef float f32x4e __attribute__((ext_vector_type(4)));
struct EpiBf16Store {
    static constexpr bool PERM = true;
    bf16* O; int ld; float* gates; int gate_pn;
    DEVI void operator()(const f32x4 (&acc)[2][2][4][2], const pg::Unit& u, int wr, int wc, int fr, int fq) const {
        const int row0 = u.pm * 256 + wr * 64 + fr;
        if (u.pn == gate_pn) {
            if (wc == 0) {
#pragma unroll
                for (int ai = 0; ai < 2; ++ai)
#pragma unroll
                    for (int m = 0; m < 4; ++m) { float* gp = gates + (size_t)(row0 + ai * 128 + m * 16) * 32 + 8 * fq;
                        *(f32x4*)(gp) = acc[ai][0][m][0]; *(f32x4*)(gp + 4) = acc[ai][0][m][1]; }
            }
            return;
        }
        const int col0 = u.pn * 256 + wc * 32 + 8 * fq;
#pragma unroll
        for (int ai = 0; ai < 2; ++ai)
#pragma unroll
            for (int m = 0; m < 4; ++m) { bf16* rowp = O + (size_t)(row0 + ai * 128 + m * 16) * ld + col0;
#pragma unroll
                for (int bj = 0; bj < 2; ++bj) { const f32x4 v0 = acc[ai][bj][m][0], v1 = acc[ai][bj][m][1];
                    u32x4 w; w.x = pg::cvt_pk_bf16(v0[0], v0[1]); w.y = pg::cvt_pk_bf16(v0[2], v0[3]); w.z = pg::cvt_pk_bf16(v1[0], v1[1]); w.w = pg::cvt_pk_bf16(v1[2], v1[3]);
                    *(u32x4*)(rowp + bj * 128) = w; } }
    }
};
struct EpiSwiGLU {
    static constexpr bool PERM = true;
    bf16* ACT;
    DEVI void operator()(const f32x4 (&acc)[2][2][4][2], const pg::Unit& u, int wr, int wc, int fr, int fq) const {
        const int row0 = u.pm * 256 + wr * 64 + fr, col0 = u.pn * 128 + wc * 32 + 8 * fq;
#pragma unroll
        for (int ai = 0; ai < 2; ++ai)
#pragma unroll
            for (int m = 0; m < 4; ++m) {
                float r[8];
#pragma unroll
                for (int n = 0; n < 2; ++n)
#pragma unroll
                    for (int j = 0; j < 4; ++j) { const float a = acc[ai][0][m][n][j], b = acc[ai][1][m][n][j]; r[n * 4 + j] = a * __builtin_amdgcn_rcpf(1.f + __expf(-a)) * b; }
                u32x4 w; w.x = pg::cvt_pk_bf16(r[0], r[1]); w.y = pg::cvt_pk_bf16(r[2], r[3]); w.z = pg::cvt_pk_bf16(r[4], r[5]); w.w = pg::cvt_pk_bf16(r[6], r[7]);
                *(u32x4*)(ACT + (size_t)(row0 + ai * 128 + m * 16) * EDIM + col0) = w; }
    }
};
struct EpiScale {
    static constexpr bool PERM = true;
    bf16* Y; const float* sw;
    DEVI void operator()(const f32x4 (&acc)[2][2][4][2], const pg::Unit& u, int wr, int wc, int fr, int fq) const {
        const int row0 = u.pm * 256 + wr * 64 + fr, col0 = u.pn * 256 + wc * 32 + 8 * fq;
        const bool routed = u.pm * 256 < SH0;
#pragma unroll
        for (int ai = 0; ai < 2; ++ai)
#pragma unroll
            for (int m = 0; m < 4; ++m) { const int slot = row0 + ai * 128 + m * 16; const float w8 = routed ? sw[slot] : 1.f; bf16* rowp = Y + (size_t)slot * D + col0;
#pragma unroll
                for (int bj = 0; bj < 2; ++bj) { const f32x4 v0 = acc[ai][bj][m][0] * w8, v1 = acc[ai][bj][m][1] * w8;
                    u32x4 w; w.x = pg::cvt_pk_bf16(v0[0], v0[1]); w.y = pg::cvt_pk_bf16(v0[2], v0[3]); w.z = pg::cvt_pk_bf16(v1[0], v1[1]); w.w = pg::cvt_pk_bf16(v1[2], v1[3]);
                    *(u32x4*)(rowp + bj * 128) = w; } }
    }
};
struct EpiResid {
    static constexpr bool PERM = false;
    const float* xin_lat; const float* xin_ctx; float* xout_lat; float* xout_ctx; const float* modl;
    DEVI void operator()(const f32x4 (&acc)[2][2][4][2], const pg::Unit& u, int wr, int wc, int fr, int fq) const {
        const bool lat = u.pm < 64; const int bb = lat ? (u.pm >> 4) : 4;
        const float* gate = modl + (size_t)(bb * 6 + 2) * D; const float* xin = lat ? xin_lat : xin_ctx; float* xout = lat ? xout_lat : xout_ctx;
        const int row0 = (lat ? u.pm : u.pm - 64) * 256 + wr * 64 + fr, col0 = u.pn * 256 + wc * 32 + 4 * fq;
        f32x4 gv[2][2];
#pragma unroll
        for (int bj = 0; bj < 2; ++bj)
#pragma unroll
            for (int n = 0; n < 2; ++n) gv[bj][n] = *(const f32x4*)(gate + col0 + bj * 128 + n * 16);
#pragma unroll
        for (int ai = 0; ai < 2; ++ai)
#pragma unroll
            for (int m = 0; m < 4; ++m) { const size_t off = (size_t)(row0 + ai * 128 + m * 16) * D + col0;
#pragma unroll
                for (int bj = 0; bj < 2; ++bj)
#pragma unroll
                    for (int n = 0; n < 2; ++n) { const f32x4 xv = *(const f32x4*)(xin + off + bj * 128 + n * 16); *(f32x4*)(xout + off + bj * 128 + n * 16) = xv + gv[bj][n] * acc[ai][bj][m][n]; }
                asm volatile("" ::: "memory"); }
    }
};

template <bool G1>
DEVI int moe_setup(const Params& p, LAS unsigned char* lds, int nrows, int vcu, int G) {
    LAS int* eo = (LAS int*)(lds + pg::EO_OFF); LAS int* ud = (LAS int*)(lds + pg::UD_OFF); LAS int* gt = (LAS int*)(lds + pg::GT_OFF);
    const int tid = threadIdx.x; const int* eoff = (const int*)(p.ws + WS_EOFF); const int* stok = (const int*)(p.ws + WS_STOK);
    if (tid < 65) eo[tid] = eoff[tid];
    __syncthreads();
    constexpr int NT = G1 ? 4 : 8, CAP = G1 ? 16 : 32;
    const int PR = eo[64] >> 8, PS = nrows >> 8, total = (PR + PS) * NT;
    int nu = total > vcu ? (total - vcu + G - 1) / G : 0; if (nu > CAP) nu = CAP;
    if (tid < nu) {
        const int L = tid * G + vcu, pp = L / NT, pn = L % NT; int e = 64, pm = SH0 / 256 + (pp - PR);
        if (pp < PR) { pm = pp; e = 0; for (int i = 1; i < 64; ++i) if (eo[i] <= pp * 256) e = i; }
        ud[tid * 4 + 0] = pm; ud[tid * 4 + 1] = pn; ud[tid * 4 + 2] = e;
    }
    __syncthreads();
    if (G1) { for (int idx = tid; idx < nu * 256; idx += 512) { const int slot = ud[(idx >> 8) * 4] * 256 + (idx & 255); gt[idx] = slot < SH0 ? stok[slot] : slot - SH0; } }
    __syncthreads();
    return nu;
}

enum Phase { PH_MODS = 0, PH_NORM0, PH_INPROJ0, PH_QKNORM, PH_ATTN0, PH_OUTPROJ0, PH_NORMR0, PH_DISP0, PH_G1_0, PH_G2_0, PH_COMB0,
             PH_INPROJ1, PH_MLSTM, PH_READOUT, PH_OUTPROJ1, PH_NORMR1, PH_DISP1, PH_G1_1, PH_G2_1, PH_COMB1, PH_COUNT };

template <int LAYER> DEVI void moe_g1_naive(const Params& p, float* lds, int vcu, int G) {
    const int nrows = LAYER == 0 ? MT : ML;
    const bf16* HB = (const bf16*)(p.ws + WS_HB); bf16* ACT = (bf16*)(p.ws + WS_ACT);
    const int* eoff = (const int*)(p.ws + WS_EOFF); const int* stok = (const int*)(p.ws + WS_STOK);
    const int nrt = eoff[64] / 128, nst = nrows / 128;
    auto arow = [&](int r) -> const bf16* { const int tm = r >> 7; if (tm < nrt) return HB + (size_t)stok[r] * D; return HB + (size_t)(r - nrt * 128) * D; };
    auto wsel = [&](int tm, const float*& W1, const float*& W3) {
        if (tm < nrt) { const int e = expert_of(eoff, tm * 128); W1 = p.exp_w1 + ((size_t)LAYER * 64 + e) * D * EDIM; W3 = p.exp_w3 + ((size_t)LAYER * 64 + e) * D * EDIM; }
        else { W1 = p.sh_w1 + (size_t)LAYER * D * EDIM; W3 = p.sh_w3 + (size_t)LAYER * D * EDIM; } };
    auto epi = [&](int r, int n, float a1, float a3) { const int tm = r >> 7; const int slot = tm < nrt ? r : SH0 + (r - nrt * 128); ACT[(size_t)slot * EDIM + n] = f2bf(silu(a1) * a3); };
    ngemm<true>(lds, vcu, G, nrt + nst, EDIM / 128, D, EDIM, EDIM, arow, wsel, epi);
}
template <int LAYER> DEVI void moe_g2_naive(const Params& p, float* lds, int vcu, int G) {
    const int nrows = LAYER == 0 ? MT : ML;
    const bf16* ACT = (const bf16*)(p.ws + WS_ACT); bf16* Y = (bf16*)(p.ws + WS_Y);
    const int* eoff = (const int*)(p.ws + WS_EOFF); const float* sw = (const float*)(p.ws + WS_SW);
    const int nrt = eoff[64] / 128, nst = nrows / 128;
    auto arow = [&](int r) -> const bf16* { const int tm = r >> 7; const int slot = tm < nrt ? r : SH0 + (r - nrt * 128); return ACT + (size_t)slot * EDIM; };
    auto wsel = [&](int tm, const float*& W1, const float*& W3) {
        if (tm < nrt) { const int e = expert_of(eoff, tm * 128); W1 = p.exp_w2 + ((size_t)LAYER * 64 + e) * EDIM * D; } else W1 = p.sh_w2 + (size_t)LAYER * EDIM * D; W3 = W1; };
    auto epi = [&](int r, int n, float a1, float) { const int tm = r >> 7; const bool routed = tm < nrt; const int slot = routed ? r : SH0 + (r - nrt * 128); const float w = routed ? sw[slot] : 1.f; Y[(size_t)slot * D + n] = f2bf(a1 * w); };
    ngemm<false>(lds, vcu, G, nrt + nst, D / 128, EDIM, D, D, arow, wsel, epi);
}

template <int PH> __global__ void __launch_bounds__(512) k_run(Params p) {
    extern __shared__ __attribute__((aligned(16))) unsigned char lds_raw[];
    float* lds = (float*)lds_raw;
    const int vcu = blockIdx.x, G = gridDim.x;
    bf16* HB = (bf16*)(p.ws + WS_HB); bf16* QKV = (bf16*)(p.ws + WS_QKV); bf16* AO = (bf16*)(p.ws + WS_AO); float* XC = (float*)(p.ws + WS_XC); float* Gt = (float*)(p.ws + WS_G);
#define IN(k) constexpr (PH == (k))
    if IN(PH_MODS) ph_mods(p, lds, vcu, G);
    if IN(PH_NORM0) ph_norm(p, 0, p.x, p.ctx, p.norm_mix, 0, 1, MT, vcu, G);
    if IN(PH_INPROJ0) {
        auto arow = [&](int r) -> const bf16* { return HB + (size_t)r * D; };
        auto wsel = [&](int, const float*& W1, const float*& W3) { W1 = p.attn_w_in; W3 = W1; };
        auto epi = [&](int r, int n, float a, float) { QKV[(size_t)r * AIW + n] = f2bf(a); };
        ngemm<false>(lds, vcu, G, MT / 128, AIW / 128, D, AIW, AIW, arow, wsel, epi);
    }
    if IN(PH_QKNORM) ph_qknorm(p, vcu, G);
    if IN(PH_ATTN0) ph_attn0_naive(p, vcu, G);
    if IN(PH_OUTPROJ0) {
        auto arow = [&](int r) -> const bf16* { return AO + (size_t)r * D; };
        auto wsel = [&](int, const float*& W1, const float*& W3) { W1 = p.attn_w_out; W3 = W1; };
        auto epi = [&](int r, int n, float a, float) {
            const float g = modp(p, 0, bidx(r), 2)[n];
            if (r < ML) p.out[(size_t)r * D + n] = p.x[(size_t)r * D + n] + g * a; else XC[(size_t)(r - ML) * D + n] = p.ctx[(size_t)(r - ML) * D + n] + g * a; };
        ngemm<false>(lds, vcu, G, MT / 128, D / 128, D, D, D, arow, wsel, epi);
    }
    if IN(PH_NORMR0) ph_normr(p, 0, p.out, XC, MT, lds, vcu, G);
    if IN(PH_DISP0) ph_dispatch(p, 0, MT, lds, vcu, G);
    if IN(PH_G1_0) moe_g1_naive<0>(p, lds, vcu, G);
    if IN(PH_G2_0) moe_g2_naive<0>(p, lds, vcu, G);
    if IN(PH_COMB0) ph_combine<0>(p, vcu, G);
    if IN(PH_INPROJ1) {
        auto arow = [&](int r) -> const bf16* { return HB + (size_t)r * D; };
        auto wsel = [&](int, const float*& W1, const float*& W3) { W1 = p.ml_w_in; W3 = W1; };
        auto epi = [&](int r, int n, float a, float) { if (n < MIWM) QKV[(size_t)r * MIWM + n] = f2bf(a); else Gt[(size_t)r * 32 + (n - MIWM)] = a; };
        ngemm<false>(lds, vcu, G, MT / 128, (MIW + 127) / 128, D, MIW, MIW, arow, wsel, epi);
    }
    if IN(PH_MLSTM) ph_mlstm_naive(p, lds, vcu, G);
    if IN(PH_READOUT) ph_readout(p, vcu, G);
    if IN(PH_OUTPROJ1) {
        auto arow = [&](int r) -> const bf16* { return AO + (size_t)r * D; };
        auto wsel = [&](int, const float*& W1, const float*& W3) { W1 = p.ml_w_out; W3 = W1; };
        auto epi = [&](int r, int n, float a, float) { p.out[(size_t)r * D + n] += modp(p, 1, bidx(r), 2)[n] * a; };
        ngemm<false>(lds, vcu, G, ML / 128, D / 128, D, D, D, arow, wsel, epi);
    }
    if IN(PH_NORMR1) ph_normr(p, 1, p.out, XC, ML, lds, vcu, G);
    if IN(PH_DISP1) ph_dispatch(p, 1, ML, lds, vcu, G);
    if IN(PH_G1_1) moe_g1_naive<1>(p, lds, vcu, G);
    if IN(PH_G2_1) moe_g2_naive<1>(p, lds, vcu, G);
    if IN(PH_COMB1) ph_combine<1>(p, vcu, G);
#undef IN
}

constexpr int FAST_LDS = 152 * 1024;
static_assert(pg::LDS_TOTAL <= FAST_LDS, "LDS map");
__global__ void __launch_bounds__(512, 2) k_fast(Params p) {
    extern __shared__ __attribute__((aligned(16))) unsigned char lds_raw[];
    LAS unsigned char* lds = (LAS unsigned char*)lds_raw;
    const int G = gridDim.x, bx = blockIdx.x;
    const int vcu = (G % 8 == 0) ? (bx % 8) * (G / 8) + bx / 8 : bx;
#define INF(k) (p.lo <= (k) && (k) < p.hi)
    if (INF(PH_MODS)) ph_cvt(p, lds, vcu, G);
    for (int layer = 0; layer < 2; ++layer) {
        if (INF(layer == 0 ? PH_INPROJ0 : PH_INPROJ1)) {
            const int nN = layer == 0 ? AIW / 256 : MINP / 256;
            const int nu = pg::fill_dense(lds, MT / 256, nN, G, bx);
            __syncthreads();
            pg::ListOrder S{(const LAS int*)(lds + pg::UD_OFF), nu};
            EpiBf16Store E{(bf16*)(p.ws + WS_QKV), layer == 0 ? AIW : MIWM, (float*)(p.ws + WS_G), layer == 0 ? -1 : MIWM / 256};
            pg::gemm_phase<EpiBf16Store, false>(lds, (const bf16*)(p.ws + WS_HB), (const bf16*)(p.ws + (layer == 0 ? WT_AIN : WT_MIN)), D, 0, S, E);
        }
        if (INF(PH_OUTPROJ0 + 9 * layer)) {
            const int nu = pg::fill_dense(lds, (layer == 0 ? MT : ML) / 256, D / 256, G, bx);
            __syncthreads();
            pg::ListOrder S{(const LAS int*)(lds + pg::UD_OFF), nu};
            EpiResid E{layer == 0 ? p.x : p.out, layer == 0 ? p.ctx : (const float*)(p.ws + WS_XC), p.out, (float*)(p.ws + WS_XC), (const float*)(p.ws + WS_MOD) + (size_t)layer * 5 * 6 * D};
            pg::gemm_phase<EpiResid, false>(lds, (const bf16*)(p.ws + WS_AO), (const bf16*)(p.ws + (layer == 0 ? WT_AOUT : WT_MOUT)), D, 0, S, E);
        }
        if (INF(PH_G1_0 + 9 * layer)) {
            const int nu = moe_setup<true>(p, lds, layer == 0 ? MT : ML, vcu, G);
            pg::ListOrder S{(const LAS int*)(lds + pg::UD_OFF), nu};
            EpiSwiGLU E{(bf16*)(p.ws + WS_ACT)};
            pg::gemm_phase<EpiSwiGLU, true>(lds, (const bf16*)(p.ws + WS_HB), (const bf16*)(p.ws + WT_W13) + (size_t)layer * 65 * 1024 * D, D, (size_t)1024 * D * 2, S, E);
        }
        if (INF(PH_G2_0 + 9 * layer)) {
            const int nu = moe_setup<false>(p, lds, layer == 0 ? MT : ML, vcu, G);
            pg::ListOrder S{(const LAS int*)(lds + pg::UD_OFF), nu};
            EpiScale E{(bf16*)(p.ws + WS_Y), (const float*)(p.ws + WS_SW)};
            pg::gemm_phase<EpiScale, false>(lds, (const bf16*)(p.ws + WS_ACT), (const bf16*)(p.ws + WT_W2) + (size_t)layer * 65 * D * EDIM, EDIM, (size_t)D * EDIM * 2, S, E);
        }
    }
#undef INF
}

constexpr int LDS_BYTES = 144 * 1024;
#ifndef FASTMASK
#define FASTMASK ((1u << PH_MODS) | (1u << PH_INPROJ0) | (1u << PH_OUTPROJ0) | (1u << PH_G1_0) | (1u << PH_G2_0) | (1u << PH_INPROJ1) | (1u << PH_OUTPROJ1) | (1u << PH_G1_1) | (1u << PH_G2_1))
#endif
typedef void (*kern_t)(Params);
template <int PH> struct KTab { static void fill(kern_t* t) { t[PH] = k_run<PH>; KTab<PH - 1>::fill(t); } };
template <> struct KTab<-1> { static void fill(kern_t*) {} };
extern "C" void kernel_launch(void* const* d_in, const int* in_sizes, int n_in, void* d_out, int out_size, void* d_ws, size_t ws_size, hipStream_t stream) {
    if (n_in != 26 || out_size != ML * D || ws_size < WS_END) { fprintf(stderr, "kernel_launch: unexpected shapes n_in %d out %d ws %zu\n", n_in, out_size, ws_size); return; }
    kern_t tab[PH_COUNT]; KTab<PH_COUNT - 1>::fill(tab);
    (void)hipMemsetAsync((char*)d_ws + WS_CTL, 0, CTL_BYTES, stream);
    Params p{};
    const float** pp = (const float**)&p;
    for (int i = 0; i < 26; ++i) pp[i] = (const float*)d_in[i];
    p.out = (float*)d_out; p.ws = (unsigned char*)d_ws;
    if (hipFuncSetAttribute((const void*)k_fast, hipFuncAttributeMaxDynamicSharedMemorySize, FAST_LDS) != hipSuccess) { fprintf(stderr, "kernel_launch: hipFuncSetAttribute(k_fast) failed\n"); return; }
    for (int ph = 0; ph < PH_COUNT; ++ph) {
        p.lo = ph; p.hi = ph + 1;
        const bool fast = FASTMASK & (1u << ph);
        if (fast) hipLaunchKernelGGL(k_fast, dim3(256), dim3(512), FAST_LDS, stream, p);
        if (fast && ph != PH_MODS) continue;
        int grid = 1024, ldsb = 32 * 1024;
        if (ph == PH_MODS) { grid = 384; ldsb = 96 * 1024; }
        if (ph == PH_NORMR0 || ph == PH_NORMR1) { grid = 512; ldsb = 72 * 1024; }
        if (ph == PH_MLSTM) { grid = 256; ldsb = LDS_BYTES; }
        if (ldsb > 64 * 1024 && hipFuncSetAttribute((const void*)tab[ph], hipFuncAttributeMaxDynamicSharedMemorySize, ldsb) != hipSuccess) { fprintf(stderr, "kernel_launch: hipFuncSetAttribute failed\n"); return; }
        hipLaunchKernelGGL(tab[ph], dim3(grid), dim3(512), ldsb, stream, p);
    }
    const hipError_t le = hipPeekAtLastError();
    if (le != hipSuccess) fprintf(stderr, "kernel_launch: launch failed: %s\n", hipGetErrorName(le));
}
```

```cpp
#include <hip/hip_runtime.h>
#include <cstdio>
#include <cstdint>
#include <type_traits>

#define DEVI __device__ __forceinline__
#define LAS __attribute__((address_space(3)))
typedef short bf16x8 __attribute__((ext_vector_type(8)));
typedef float f32x4 __attribute__((ext_vector_type(4)));
typedef unsigned u32x4 __attribute__((ext_vector_type(4)));
typedef int v4i32 __attribute__((ext_vector_type(4)));
typedef int v8i32 __attribute__((ext_vector_type(8)));
typedef unsigned short bf16;
typedef unsigned int u32;

constexpr int D = 2048, NB = 4, SEQ = 4096, CTXL = 256, GRIDW = 64;
constexpr int ML = NB * SEQ;
constexpr int MC = NB * CTXL;
constexpr int MT = ML + MC;
constexpr int AIW = 4608;
constexpr int MIW = 6176, MIWM = 6144;
constexpr int NE = 64, TOPK = 8, EDIM = 512;
constexpr int RS = MT * 8 + 64 * 256;
constexpr int SH0 = RS;
constexpr int NSLOT = RS + MT;
constexpr float EPS = 1e-6f;
constexpr float QSCALE = 0.08838834764831845f;

constexpr size_t MiB = (size_t)1 << 20;
constexpr size_t WS_CTL = 0, CTL_BYTES = 1 * MiB;
constexpr size_t WS_MOD = 1 * MiB;
constexpr size_t WS_XC = 2 * MiB;
constexpr size_t WS_G = 10 * MiB;
constexpr size_t WS_EIDX = 13 * MiB, WS_EW = 14 * MiB, WS_EPOS = 15 * MiB, WS_TSLOT = 16 * MiB, WS_STOK = 17 * MiB, WS_SW = 18 * MiB, WS_EOFF = 19 * MiB;
constexpr size_t WS_HB = 20 * MiB;
constexpr size_t WS_ACT = 88 * MiB;
constexpr size_t WS_Y = 257 * MiB;
constexpr size_t WS_QKV = 257 * MiB;
constexpr size_t WS_AO = 461 * MiB;
constexpr size_t WS_HD = 529 * MiB;
constexpr size_t WS_WT = 933 * MiB;
constexpr size_t WS_RWP = 1772 * MiB;
constexpr size_t WS_RC = 1777 * MiB;
constexpr size_t WS_LTOK = 1780 * MiB;
constexpr size_t WS_LW = 1785 * MiB;
constexpr size_t WS_X = 1790 * MiB;
constexpr size_t WS_END = 1858 * MiB;
constexpr int CW_TQ = 24576;
constexpr int CW_CNT = 16384, CNT_PAD = 32;

struct Params {
    const float *x, *c, *ctx, *c_ctx, *ada_w, *ada_b, *norm_mix, *norm_ffn, *attn_w_in, *attn_w_out, *attn_rpb, *attn_q_gain, *attn_k_gain,
        *ml_w_in, *ml_w_out, *ml_gate_b, *ml_head_gain, *router_w, *router_b, *exp_w1, *exp_w3, *exp_w2, *sh_w1, *sh_w3, *sh_w2, *final_norm;
    float* out; unsigned char* ws;
    int lo, hi;
};

DEVI int otid() { int t = threadIdx.x; asm volatile("" : "+v"(t)); return t; }
DEVI float bf2f(bf16 b) { return __uint_as_float(((u32)b) << 16); }
DEVI bf16 f2bf(float f) { u32 u = __float_as_uint(f); u += 0x7fffu + ((u >> 16) & 1u); return (bf16)(u >> 16); }
DEVI u32 pk2(float lo, float hi) { return (u32)f2bf(lo) | ((u32)f2bf(hi) << 16); }
DEVI float wave_sum(float v) {
#pragma unroll
    for (int o = 32; o >= 1; o >>= 1) v += __shfl_xor(v, o);
    return v;
}
DEVI unsigned pg_cvt_pk_bf16(float lo, float hi) { unsigned r; asm volatile("v_cvt_pk_bf16_f32 %0, %1, %2" : "=v"(r) : "v"(lo), "v"(hi)); return r; }
DEVI float wave_prefix_dpp(float x) {
#define WS_DPP(ctrl, rmask) x += __int_as_float(__builtin_amdgcn_update_dpp(0, __float_as_int(x), ctrl, rmask, 0xf, false))
    WS_DPP(0x111, 0xf); WS_DPP(0x112, 0xf); WS_DPP(0x114, 0xf); WS_DPP(0x118, 0xf); WS_DPP(0x142, 0xa); WS_DPP(0x143, 0xc);
#undef WS_DPP
    return x;
}
DEVI float wave_sum_dpp(float x) {
#define WS_DPP(ctrl, rmask) x += __int_as_float(__builtin_amdgcn_update_dpp(0, __float_as_int(x), ctrl, rmask, 0xf, false))
    WS_DPP(0x111, 0xf); WS_DPP(0x112, 0xf); WS_DPP(0x114, 0xf); WS_DPP(0x118, 0xf); WS_DPP(0x142, 0xa); WS_DPP(0x143, 0xc);
#undef WS_DPP
    return __int_as_float(__builtin_amdgcn_readlane(__float_as_int(x), 63));
}
DEVI u32 pk4_fp8(float a, float b, float c, float d) { int w = 0; w = __builtin_amdgcn_cvt_pk_fp8_f32(a, b, w, false); w = __builtin_amdgcn_cvt_pk_fp8_f32(c, d, w, true); return (u32)w; }
DEVI int bidx(int m) { return m < ML ? (m >> 12) : 4; }
DEVI const float* modp(const Params& p, int layer, int bb, int i) { return (const float*)(p.ws + WS_MOD) + ((size_t)((layer * 5 + bb) * 6 + i)) * D; }
DEVI float silu(float x) { return x / (1.f + __expf(-x)); }
DEVI float sigmoidf(float x) { return 1.f / (1.f + __expf(-x)); }

DEVI void ph_mods(const Params& p, float* lds, int vcu, int G) {
    float* sc = lds;
    float* red = lds + 5 * D;
    const int tid = otid();
    for (int i = tid; i < 5 * D; i += 512) { const int bb = i / D, k = i % D; const float v = bb < 4 ? p.c[bb * D + k] : p.c_ctx[k]; sc[i] = silu(v); }
    __syncthreads();
    const int tn = tid & 7, tk = tid >> 3;
    for (int item = vcu; item < 2 * 384; item += G) {
        const int l = item / 384, n0 = (item % 384) * 32;
        const float* W = p.ada_w + (size_t)l * D * 12288 + n0 + tn * 4;
        float4 acc[5];
#pragma unroll
        for (int b = 0; b < 5; ++b) acc[b] = make_float4(0.f, 0.f, 0.f, 0.f);
#pragma unroll 1
        for (int k8 = 0; k8 < 4; ++k8) {
            float4 w[8];
#pragma unroll
            for (int j = 0; j < 8; ++j) w[j] = *(const float4*)(W + (size_t)(tk * 32 + k8 * 8 + j) * 12288);
#pragma unroll
            for (int j = 0; j < 8; ++j) { const int k = tk * 32 + k8 * 8 + j;
#pragma unroll
                for (int b = 0; b < 5; ++b) { const float s_ = sc[b * D + k]; acc[b].x += s_ * w[j].x; acc[b].y += s_ * w[j].y; acc[b].z += s_ * w[j].z; acc[b].w += s_ * w[j].w; } }
        }
#pragma unroll
        for (int b = 0; b < 5; ++b) *(float4*)(red + (tk * 5 + b) * 32 + tn * 4) = acc[b];
        __syncthreads();
        if (tid < 160) {
            const int b = tid / 32, n = tid % 32; float s_ = 0.f;
            for (int g = 0; g < 64; ++g) s_ += red[(g * 5 + b) * 32 + n];
            ((float*)(p.ws + WS_MOD))[(size_t)(l * 5 + b) * 12288 + n0 + n] = s_ + p.ada_b[l * 12288 + n0 + n];
        }
        __syncthreads();
    }
}

DEVI void norm_row_load(const float* src, float4 (&v)[8], float& rstd, int lane) {
    float ss = 0.f;
#pragma unroll
    for (int j = 0; j < 8; ++j) { v[j] = *(const float4*)(src + 4 * lane + 256 * j); ss += v[j].x * v[j].x + v[j].y * v[j].y + v[j].z * v[j].z + v[j].w * v[j].w; }
    ss = wave_sum(ss);
    rstd = rsqrtf(ss * (1.f / D) + EPS);
}
DEVI void ph_norm(const Params& p, int layer, const float* xlat, const float* xctx, const float* gain, int ish, int isc, int nrows, int vcu, int G) {
    const int tid = otid(), lane = tid & 63, wave = tid >> 6;
    bf16* HB = (bf16*)(p.ws + WS_HB); bf16* X = (bf16*)(p.ws + WS_X);
    const int rot = (vcu * 8 + wave) & 7;
    for (int m0 = vcu * 8 + wave; m0 < nrows; m0 += 2 * G * 8) {
        const int mA = m0, mB = m0 + G * 8 < nrows ? m0 + G * 8 : m0;
        const float* srcA = mA < ML ? xlat + (size_t)mA * D : xctx + (size_t)(mA - ML) * D;
        const float* srcB = mB < ML ? xlat + (size_t)mB * D : xctx + (size_t)(mB - ML) * D;
        float4 vA[8], vB[8]; float ssA = 0.f, ssB = 0.f;
#pragma unroll
        for (int j = 0; j < 8; ++j) { vA[j] = *(const float4*)(srcA + 4 * lane + 256 * ((j + rot) & 7)); vB[j] = *(const float4*)(srcB + 4 * lane + 256 * ((j + rot) & 7)); }
#pragma unroll
        for (int j = 0; j < 8; ++j) { ssA += vA[j].x * vA[j].x + vA[j].y * vA[j].y + vA[j].z * vA[j].z + vA[j].w * vA[j].w; ssB += vB[j].x * vB[j].x + vB[j].y * vB[j].y + vB[j].z * vB[j].z + vB[j].w * vB[j].w; }
        const float rstdA = rsqrtf(wave_sum_dpp(ssA) * (1.f / D) + EPS), rstdB = rsqrtf(wave_sum_dpp(ssB) * (1.f / D) + EPS);
        const int bA = bidx(mA), bB = bidx(mB);
        const float* shA = modp(p, layer, bA, ish); const float* sclA = modp(p, layer, bA, isc); const float* shB = modp(p, layer, bB, ish); const float* sclB = modp(p, layer, bB, isc);
#pragma unroll
        for (int j = 0; j < 8; ++j) {
            const int c = 4 * lane + 256 * ((j + rot) & 7);
            const float4 g = *(const float4*)(gain + c), s1 = *(const float4*)(sclA + c), s0 = *(const float4*)(shA + c), t1 = *(const float4*)(sclB + c), t0 = *(const float4*)(shB + c);
            *(u32*)((unsigned char*)HB + (size_t)mA * D + c) = pk4_fp8(vA[j].x * rstdA * g.x * (1.f + s1.x) + s0.x, vA[j].y * rstdA * g.y * (1.f + s1.y) + s0.y, vA[j].z * rstdA * g.z * (1.f + s1.z) + s0.z, vA[j].w * rstdA * g.w * (1.f + s1.w) + s0.w);
            *(u32*)((unsigned char*)HB + (size_t)mB * D + c) = pk4_fp8(vB[j].x * rstdB * g.x * (1.f + t1.x) + t0.x, vB[j].y * rstdB * g.y * (1.f + t1.y) + t0.y, vB[j].z * rstdB * g.z * (1.f + t1.z) + t0.z, vB[j].w * rstdB * g.w * (1.f + t1.w) + t0.w);
            uint2 xw; xw.x = pk2(vA[j].x, vA[j].y); xw.y = pk2(vA[j].z, vA[j].w); *(uint2*)(X + (size_t)mA * D + c) = xw;
            uint2 yw; yw.x = pk2(vB[j].x, vB[j].y); yw.y = pk2(vB[j].z, vB[j].w); *(uint2*)(X + (size_t)mB * D + c) = yw;
        }
    }
}

DEVI void ph_qknorm(const Params& p, int vcu, int G) {
    const int tid = otid(), lane = tid & 63, wave = tid >> 6;
    bf16* Q = (bf16*)(p.ws + WS_QKV);
    const float invf = exp2f(-(float)(lane & 31) * (13.287712379549449f / 32.f));
    const float gq0 = p.attn_q_gain[2 * lane], gq1 = p.attn_q_gain[2 * lane + 1], gk0 = p.attn_k_gain[2 * lane], gk1 = p.attn_k_gain[2 * lane + 1];
    for (int m = vcu * 8 + wave; m < MT; m += G * 8) {
        bf16* ptr = Q + (size_t)m * AIW + 3072 + 2 * lane;
        u32 v[10];
#pragma unroll
        for (int hh = 0; hh < 10; ++hh) v[hh] = *(const u32*)(ptr + hh * 128);
        float sn = 0.f, cs = 1.f;
        if (m < ML) { const int sq = m & 4095; const float pos = lane < 32 ? (float)(sq >> 6) : (float)(sq & 63);
            sn = __sinf(pos * invf); cs = __cosf(pos * invf); }
#pragma unroll
        for (int hh = 0; hh < 10; ++hh) {
            float x0 = __uint_as_float(v[hh] << 16), x1 = __uint_as_float(v[hh] & 0xffff0000u);
            const float ss = wave_sum_dpp(x0 * x0 + x1 * x1); const float rstd = rsqrtf(ss * (1.f / 128.f) + EPS);
            x0 = x0 * rstd * (hh < 8 ? gq0 : gk0); x1 = x1 * rstd * (hh < 8 ? gq1 : gk1);
            const float y0 = x0 * cs - x1 * sn, y1 = x0 * sn + x1 * cs;
            *(u32*)(ptr + hh * 128) = pk2(y0, y1);
        }
    }
}

DEVI void ph_readout(const Params& p, int vcu, int G) {
    const int tid = otid(), lane = tid & 63, wave = tid >> 6;
    const bf16* HD = (const bf16*)(p.ws + WS_HD); const bf16* Q = (const bf16*)(p.ws + WS_QKV); bf16* AO = (bf16*)(p.ws + WS_AO);
    float4 g[8];
#pragma unroll
    for (int h = 0; h < 8; ++h) g[h] = *(const float4*)(p.ml_head_gain + h * 256 + 4 * lane);
    typedef unsigned u32x2_ __attribute__((ext_vector_type(2)));
    for (int m = vcu * 8 + wave; m < ML; m += G * 8) {
        u32x2_ a[8], b2[8], ov[8];
#pragma unroll
        for (int h = 0; h < 8; ++h) { const int c = h * 256 + 4 * lane;
            a[h] = __builtin_nontemporal_load((const u32x2_*)(HD + (size_t)m * D + c)); b2[h] = __builtin_nontemporal_load((const u32x2_*)(HD + ((size_t)ML + m) * D + c));
            ov[h] = __builtin_nontemporal_load((const u32x2_*)(Q + (size_t)m * MIWM + 4096 + c)); }
#pragma unroll
        for (int h = 0; h < 8; ++h) { const int c = h * 256 + 4 * lane;
            const float x[4] = {__uint_as_float(a[h].x << 16) + __uint_as_float(b2[h].x << 16), __uint_as_float(a[h].x & 0xffff0000u) + __uint_as_float(b2[h].x & 0xffff0000u),
                                __uint_as_float(a[h].y << 16) + __uint_as_float(b2[h].y << 16), __uint_as_float(a[h].y & 0xffff0000u) + __uint_as_float(b2[h].y & 0xffff0000u)};
            const float ss = wave_sum_dpp(x[0] * x[0] + x[1] * x[1] + x[2] * x[2] + x[3] * x[3]); const float rstd = rsqrtf(ss * (1.f / 256.f) + EPS);
            const float o0 = __uint_as_float(ov[h].x << 16), o1 = __uint_as_float(ov[h].x & 0xffff0000u), o2 = __uint_as_float(ov[h].y << 16), o3 = __uint_as_float(ov[h].y & 0xffff0000u);
            const float s0 = __builtin_amdgcn_rcpf(1.f + __expf(-o0)), s1 = __builtin_amdgcn_rcpf(1.f + __expf(-o1)), s2 = __builtin_amdgcn_rcpf(1.f + __expf(-o2)), s3 = __builtin_amdgcn_rcpf(1.f + __expf(-o3));
            *(u32*)((unsigned char*)AO + (size_t)m * D + c) = pk4_fp8(x[0] * rstd * g[h].x * s0, x[1] * rstd * g[h].y * s1, x[2] * rstd * g[h].z * s2, x[3] * rstd * g[h].w * s3);
        }
    }
}

DEVI void ph_combine(const Params& p, int layer, int* offl, int vcu, int G) {
    const int tid = otid(), lane = tid & 63, wave = tid >> 6;
    const unsigned char* Y = (const unsigned char*)(p.ws + WS_Y);
    unsigned char* HB = (unsigned char*)(p.ws + WS_HB); bf16* X = (bf16*)(p.ws + WS_X);
    const int nrows = layer == 0 ? MT : ML;
    {
        const u32* cnt = (const u32*)(p.ws + WS_CTL) + CW_CNT + layer * 64 * CNT_PAD;
        if (tid < 64) { const int c_ = (int)cnt[tid * CNT_PAD]; const int pc = (c_ + 255) & ~255; offl[64 + tid] = c_; offl[tid] = (int)wave_prefix_dpp((float)pc) - pc; }
        __syncthreads();
    }
    const int* eidx = (const int*)(p.ws + WS_EIDX); const int* epos = (const int*)(p.ws + WS_EPOS);
    for (int m = vcu * 8 + wave; m < nrows; m += G * 8) {
        bf16* xr = X + (size_t)m * D; float* orow = p.out + (size_t)m * D;
        const int bb = bidx(m); const float* g5 = modp(p, layer, bb, 5);
        int sl[9];
#pragma unroll
        for (int k = 0; k < 8; ++k) sl[k] = offl[eidx[m * 8 + k]] + epos[m * 8 + k];
        sl[8] = SH0 + m;
        u32x4 y[2][9], xv[2][2];
#pragma unroll
        for (int j = 0; j < 2; ++j) {
#pragma unroll
            for (int k = 0; k < 9; ++k) y[j][k] = __builtin_nontemporal_load((const u32x4*)(Y + (size_t)sl[k] * D + j * 1024 + lane * 16));
            xv[j][0] = *(const u32x4*)(xr + j * 1024 + lane * 16); xv[j][1] = *(const u32x4*)(xr + j * 1024 + lane * 16 + 8);
        }
        float o[32]; float ss = 0.f;
#pragma unroll
        for (int j = 0; j < 2; ++j) {
            const int c = j * 1024 + lane * 16;
            float f[16];
#pragma unroll
            for (int i = 0; i < 16; ++i) f[i] = 0.f;
#pragma unroll
            for (int k = 0; k < 9; ++k) {
                const unsigned yy[4] = {y[j][k].x, y[j][k].y, y[j][k].z, y[j][k].w};
#pragma unroll
                for (int q = 0; q < 4; ++q) { const auto lo = __builtin_amdgcn_cvt_pk_f32_fp8((int)yy[q], false), hi = __builtin_amdgcn_cvt_pk_f32_fp8((int)yy[q], true);
                    f[4 * q + 0] += lo[0]; f[4 * q + 1] += lo[1]; f[4 * q + 2] += hi[0]; f[4 * q + 3] += hi[1]; }
            }
            const unsigned xw[8] = {xv[j][0].x, xv[j][0].y, xv[j][0].z, xv[j][0].w, xv[j][1].x, xv[j][1].y, xv[j][1].z, xv[j][1].w};
#pragma unroll
            for (int q = 0; q < 4; ++q) {
                const float4 g0 = *(const float4*)(g5 + c + 4 * q);
                const float o0 = __uint_as_float(xw[2 * q] << 16) + g0.x * f[4 * q + 0] * (1.f / 8.f), o1 = __uint_as_float(xw[2 * q] & 0xffff0000u) + g0.y * f[4 * q + 1] * (1.f / 8.f);
                const float o2 = __uint_as_float(xw[2 * q + 1] << 16) + g0.z * f[4 * q + 2] * (1.f / 8.f), o3 = __uint_as_float(xw[2 * q + 1] & 0xffff0000u) + g0.w * f[4 * q + 3] * (1.f / 8.f);
                ss += o0 * o0 + o1 * o1 + o2 * o2 + o3 * o3;
                o[j * 16 + 4 * q + 0] = o0; o[j * 16 + 4 * q + 1] = o1; o[j * 16 + 4 * q + 2] = o2; o[j * 16 + 4 * q + 3] = o3;
            }
        }
        const float rstd = rsqrtf(wave_sum_dpp(ss) * (1.f / D) + EPS);
        const float* gain = layer == 0 ? p.norm_mix + D : p.final_norm;
        const float* sh = modp(p, 1, bb, 0); const float* scl = modp(p, 1, bb, 1);
#pragma unroll
        for (int j = 0; j < 2; ++j) {
            const int c = j * 1024 + lane * 16;
            if (layer == 0) {
                u32x4 w0, w1, ob;
#pragma unroll
                for (int q = 0; q < 4; ++q) {
                    const float4 g0 = *(const float4*)(gain + c + 4 * q), a0 = *(const float4*)(scl + c + 4 * q), b0 = *(const float4*)(sh + c + 4 * q);
                    const float x0 = o[j * 16 + 4 * q + 0], x1 = o[j * 16 + 4 * q + 1], x2 = o[j * 16 + 4 * q + 2], x3 = o[j * 16 + 4 * q + 3];
                    const unsigned p0 = pg_cvt_pk_bf16(x0, x1), p1 = pg_cvt_pk_bf16(x2, x3);
                    if (q < 2) { w0[2 * q] = p0; w0[2 * q + 1] = p1; } else { w1[2 * (q - 2)] = p0; w1[2 * (q - 2) + 1] = p1; }
                    ob[q] = pk4_fp8(x0 * rstd * g0.x * (1.f + a0.x) + b0.x, x1 * rstd * g0.y * (1.f + a0.y) + b0.y, x2 * rstd * g0.z * (1.f + a0.z) + b0.z, x3 * rstd * g0.w * (1.f + a0.w) + b0.w);
                }
                *(u32x4*)(xr + c) = w0; *(u32x4*)(xr + c + 8) = w1;
                *(u32x4*)(HB + (size_t)m * D + c) = ob;
            } else {
#pragma unroll
                for (int q = 0; q < 4; ++q) {
                    const float4 g0 = *(const float4*)(gain + c + 4 * q);
                    float4 r0; r0.x = o[j * 16 + 4 * q + 0] * rstd * g0.x; r0.y = o[j * 16 + 4 * q + 1] * rstd * g0.y; r0.z = o[j * 16 + 4 * q + 2] * rstd * g0.z; r0.w = o[j * 16 + 4 * q + 3] * rstd * g0.w;
                    *(float4*)(orow + c + 4 * q) = r0;
                }
            }
        }
    }
}

namespace pg {
struct Frag2 { bf16x8 k[2]; };
template <bool F8> struct FragT { typedef Frag2 T; };
template <> struct FragT<true> { typedef v8i32 T; };
constexpr int BM = 256, BK = 64, HALF = 128, HTB = HALF * BK * 2, STAGE_BYTES = 8 * HTB, NXCD = 8, WGM = 8;
__host__ __device__ __forceinline__ int lds_byte(int r, int c) { const int st = (r >> 4) * 2 + (c >> 5), rr = r & 15, cc = c & 31, ob = rr * 64 + cc * 2; return st * 1024 + (ob ^ (((ob >> 9) & 1) << 5)); }
__host__ __device__ __forceinline__ void stage_rc(int b, int& R, int& C) { const int st = b / 1024, sb = b % 1024, swz = sb ^ (((sb >> 9) & 1) << 5); R = (st >> 1) * 16 + swz / 64; C = (st & 1) * 32 + (swz % 64) / 2; }
__host__ __device__ __forceinline__ int perm32(int rho) { const int n = rho >> 4, i = rho & 15; return 8 * (i >> 2) + 4 * n + (i & 3); }
DEVI unsigned cvt_pk_bf16(float lo, float hi) { unsigned r; asm volatile("v_cvt_pk_bf16_f32 %0, %1, %2" : "=v"(r) : "v"(lo), "v"(hi)); return r; }

struct Unit { int pm, pn, e; };
constexpr int GT_OFF = STAGE_BYTES;
constexpr int UD_OFF = GT_OFF + 24 * 256 * 4;
constexpr int EO_OFF = UD_OFF + 32 * 16;
constexpr int MISC_OFF = EO_OFF + 136 * 4;
constexpr int LDS_TOTAL = MISC_OFF + 64;

struct ListOrder {
    const LAS int* ud; int nu;
    DEVI bool next(int i, Unit& u) const {
        if (i >= nu) return false;
        u.pm = __builtin_amdgcn_readfirstlane(ud[i * 4 + 0]); u.pn = __builtin_amdgcn_readfirstlane(ud[i * 4 + 1]); u.e = __builtin_amdgcn_readfirstlane(ud[i * 4 + 2]); return true;
    }
};
DEVI bool dense_unit(int nM, int nN, int G, int c, int i, Unit& u) {
    const int nwg = nM * nN; const long L = (long)i * G + c; if (L >= nwg) return false;
    int wgid = (int)L; { const int q = nwg / NXCD, r = nwg % NXCD, xcd = wgid % NXCD, off = wgid / NXCD; wgid = (xcd < r ? xcd * (q + 1) : r * (q + 1) + (xcd - r) * q) + off; }
    const int nig = WGM * nN, gid = wgid / nig, fm = gid * WGM, gsz = (nM - fm) < WGM ? (nM - fm) : WGM;
    u.pm = fm + ((wgid % nig) % gsz); u.pn = (wgid % nig) / gsz; u.e = 0; return true;
}
DEVI int fill_dense(LAS unsigned char* lds, int nM, int nN, int G, int c) {
    LAS int* ud = (LAS int*)(lds + UD_OFF); int nu = 0;
    for (int i = 0; i < 32; ++i) { Unit u; if (!dense_unit(nM, nN, G, c, i, u)) break; if (otid() == 0) { ud[i * 4 + 0] = u.pm; ud[i * 4 + 1] = u.pn; ud[i * 4 + 2] = 0; } ++nu; }
    return nu;
}

template <class Epi, bool GATHER, bool F8 = false>
DEVI void gemm_phase(LAS unsigned char* lds, const void* A, const void* Bt, int KB, size_t bgroup_bytes, const ListOrder& S, const Epi& E) {
    const int tid = otid();
    const int wid = __builtin_amdgcn_readfirstlane(tid >> 6), lane = tid & 63, wr = wid >> 2, wc = wid & 3, fr = lane & 15, fq = lane >> 4;
    const int nt = KB / 128;
    const LAS int* gtab = (const LAS int*)(lds + GT_OFF);
    unsigned voffA[2], voffB[2];
#pragma unroll
    for (int i = 0; i < 2; ++i) { int R, C; stage_rc(tid * 16 + i * 8192, R, C); const int Rb = Epi::B16 ? (64 * (R >> 5) + 16 * ((R & 15) >> 2) + 4 * ((R >> 4) & 1) + (R & 3)) : (Epi::PERM ? ((R & ~31) + perm32(R & 31)) : R);
        voffA[i] = GATHER ? (unsigned)(C * 2) : (unsigned)(R * KB + C * 2); voffB[i] = (unsigned)(Rb * KB + C * 2); }
    const size_t kstep = (size_t)(BK * 2);
    const size_t hstep = (size_t)HALF * KB;
    const size_t bhs = Epi::B16 ? (size_t)8 * KB : hstep;
    const size_t tstep = 2 * hstep;
    const unsigned ldsw = (unsigned)wid * 1024u;
    const int aoff = lds_byte(wr * 64 + fr, fq * 8); int boff = 4 * HTB + lds_byte(wc * 32 + fr, fq * 8); asm volatile("" : "+v"(boff));
#define PG_SA(b, h) (((b) * 2 + (h)) * HTB)
#define PG_SB(b, h) ((4 + (b) * 2 + (h)) * HTB)
#define PG_STAGE(bufoff, gbase, voff) do { _Pragma("unroll") for (int _i = 0; _i < 2; ++_i) \
        __builtin_amdgcn_global_load_lds((const unsigned*)((const char*)(gbase) + (voff)[_i]), (LAS unsigned*)(lds + (bufoff) + ldsw + _i * 8192), 16, 0, 0); } while (0)
#define PG_STAGE_A(bufoff, abase, h, goff) do { if constexpr (GATHER) { PG_STAGE(bufoff, abase, goff[h]); } else { PG_STAGE(bufoff, (abase) + (h) * hstep, voffA); } } while (0)
#define PG_LD1(dst, addr) do { if constexpr (F8) { const v4i32 lo_ = *(const LAS v4i32*)(lds + (addr)), hi_ = *(const LAS v4i32*)(lds + (addr) + 1024); dst = __builtin_shufflevector(lo_, hi_, 0, 1, 2, 3, 4, 5, 6, 7); } \
        else { dst.k[0] = *(const LAS bf16x8*)(lds + (addr)); dst.k[1] = *(const LAS bf16x8*)(lds + (addr) + 1024); } } while (0)
#define PG_LDA(dst, b, h) do { _Pragma("unroll") for (int m = 0; m < 4; ++m) PG_LD1(dst[m], PG_SA(b, h) + aoff + m * 2048); } while (0)
#define PG_LDB(dst, b, h) do { _Pragma("unroll") for (int n = 0; n < 2; ++n) PG_LD1(dst[n], boff + ((b) * 2 + (h)) * HTB + n * 2048); } while (0)
#define PG_MMA(ai, bj, At, Bt_) do { __builtin_amdgcn_s_setprio(1); _Pragma("unroll") for (int m = 0; m < 4; ++m) _Pragma("unroll") for (int n = 0; n < 2; ++n) { \
        if constexpr (F8) { asm volatile("v_mfma_scale_f32_16x16x128_f8f6f4 %0, %1, %2, %0, %3, %3 op_sel_hi:[0,0,0]" : "+v"(acc[ai][bj][m][n]) : "v"(Bt_[n]), "v"(At[m]), "v"(sc1)); } \
        else { _Pragma("unroll") for (int k = 0; k < 2; ++k) acc[ai][bj][m][n] = __builtin_amdgcn_mfma_f32_16x16x32_bf16(Bt_[n].k[k], At[m].k[k], acc[ai][bj][m][n], 0, 0, 0); } } \
        __builtin_amdgcn_s_setprio(0); } while (0)
#define PG_MMAZ(ai, bj, At, Bt_) do { __builtin_amdgcn_s_setprio(1); _Pragma("unroll") for (int m = 0; m < 4; ++m) _Pragma("unroll") for (int n = 0; n < 2; ++n) \
        asm volatile("v_mfma_scale_f32_16x16x128_f8f6f4 %0, %1, %2, 0, %3, %3 op_sel_hi:[0,0,0]" : "+v"(acc[ai][bj][m][n]) : "v"(Bt_[n]), "v"(At[m]), "v"(sc1)); \
        __builtin_amdgcn_s_setprio(0); } while (0)
#define PG_WAIT_V(n) asm volatile("s_waitcnt vmcnt(" #n ")" ::: "memory")
#define PG_WAIT_L(n) asm volatile("s_waitcnt lgkmcnt(" #n ")" ::: "memory")
#define PG_WAIT_VR(rl) do { if ((rl) == 0) PG_WAIT_V(8); else if ((rl) == 8) PG_WAIT_V(16); else if ((rl) == 16) PG_WAIT_V(24); else PG_WAIT_V(40); } while (0)
#define PG_BAR __builtin_amdgcn_s_barrier()
#define PG_SCHED __builtin_amdgcn_sched_barrier(0)
    Unit cur, nxt; int ui = 0, relax = 0;
    if (!S.next(0, cur)) return;
    int sc1 = 0x7F7F7F7F; asm volatile("" : "+v"(sc1));
    static_assert(F8, "the first-tile C = 0 form below is written for the fp8 MFMA");
    f32x4 acc[2][2][4][2];
#pragma unroll
    for (int a = 0; a < 2; ++a)
#pragma unroll
        for (int b = 0; b < 2; ++b)
#pragma unroll
            for (int m = 0; m < 4; ++m)
#pragma unroll
                for (int n = 0; n < 2; ++n) acc[a][b][m][n] = (f32x4){0.f, 0.f, 0.f, 0.f};
    typename FragT<F8>::T At[4], B0[2], B1[2];
    unsigned gC[2][2];
    auto gload = [&](int uidx, unsigned (&g)[2][2]) {
        const int tt = otid();
#pragma unroll
        for (int i = 0; i < 2; ++i) { int R, C; stage_rc(tt * 16 + i * 8192, R, C);
#pragma unroll
            for (int h = 0; h < 2; ++h) g[h][i] = (unsigned)gtab[uidx * 256 + h * HALF + R] * (unsigned)KB + (unsigned)(C * 2); }
    };
    if constexpr (GATHER) gload(0, gC);
    const char* cA = GATHER ? (const char*)A : (const char*)A + (size_t)cur.pm * tstep;
    const char* cB = (const char*)Bt + (size_t)cur.e * bgroup_bytes + (size_t)cur.pn * tstep;
    PG_STAGE(PG_SB(0, 0), cB, voffB); PG_STAGE(PG_SB(0, 1), cB + bhs, voffB); PG_STAGE_A(PG_SA(0, 0), cA, 0, gC); PG_STAGE_A(PG_SA(0, 1), cA, 1, gC);
    if (wr == 1) PG_BAR;
    PG_WAIT_V(2); PG_BAR;
    PG_STAGE(PG_SB(1, 0), cB + kstep, voffB); PG_STAGE_A(PG_SA(1, 0), cA + kstep, 0, gC); PG_STAGE(PG_SB(1, 1), cB + bhs + kstep, voffB);
    PG_WAIT_V(6); PG_BAR;
    for (;;) {
        const bool has_next = S.next(ui + 1, nxt);
        const char* nA = GATHER ? (const char*)A : (has_next ? (const char*)A + (size_t)nxt.pm * tstep : cA);
        const char* nB = has_next ? (const char*)Bt + (size_t)nxt.e * bgroup_bytes + (size_t)nxt.pn * tstep : cB;
#define PG_KITER(MMAX, WAITX, LASTX) do { \
            const bool last = LASTX; \
            const char* a1 = cA + (size_t)(t + 1) * kstep; \
            const char* a2 = last ? nA : cA + (size_t)(t + 2) * kstep; const char* b2 = last ? nB : cB + (size_t)(t + 2) * kstep; \
            const char* a3 = a2 + kstep; const char* b3 = b2 + kstep; \
            unsigned gS[2][2]; \
            if constexpr (GATHER) { \
                if (last && has_next) gload(ui + 1, gS); \
                else { gS[0][0] = gC[0][0]; gS[0][1] = gC[0][1]; gS[1][0] = gC[1][0]; gS[1][1] = gC[1][1]; } \
            } \
 \
            PG_LDB(B0, 0, 0); PG_LDB(B1, 0, 1); PG_SCHED; PG_LDA(At, 0, 0); PG_STAGE_A(PG_SA(1, 1), a1, 1, gC); \
            WAITX; PG_WAIT_L(0); PG_BAR; MMAX(0, 0, At, B0); MMAX(0, 1, At, B1); PG_BAR; PG_SCHED; \
 \
            PG_LDA(At, 0, 1); PG_STAGE(PG_SB(0, 0), b2, voffB); PG_STAGE(PG_SB(0, 1), b2 + bhs, voffB); PG_STAGE_A(PG_SA(0, 0), a2, 0, gS); \
            WAITX; PG_WAIT_L(0); PG_BAR; MMAX(1, 0, At, B0); MMAX(1, 1, At, B1); PG_BAR; PG_SCHED; \
 \
            PG_LDB(B0, 1, 0); PG_LDB(B1, 1, 1); PG_SCHED; PG_LDA(At, 1, 0); PG_STAGE_A(PG_SA(0, 1), a2, 1, gS); \
            PG_WAIT_V(8); PG_WAIT_L(0); PG_BAR; PG_MMA(0, 0, At, B0); PG_MMA(0, 1, At, B1); PG_BAR; PG_SCHED; \
 \
            PG_LDA(At, 1, 1); PG_STAGE(PG_SB(1, 0), b3, voffB); PG_STAGE(PG_SB(1, 1), b3 + bhs, voffB); PG_STAGE_A(PG_SA(1, 0), a3, 0, gS); \
            PG_WAIT_V(8); PG_WAIT_L(0); PG_BAR; PG_MMA(1, 0, At, B0); PG_MMA(1, 1, At, B1); PG_BAR; PG_SCHED; \
        } while (0)
        { const int t = 0; PG_KITER(PG_MMAZ, PG_WAIT_VR(relax), false); }
#pragma unroll 1
        for (int t = 2; t < nt; t += 2) { PG_KITER(PG_MMA, PG_WAIT_V(8), (t == nt - 2)); }
#undef PG_KITER
        if (wr == 0) PG_BAR;
        if constexpr (F8) asm volatile("s_nop 15\n\ts_nop 15" ::: "memory");
        E(acc, cur, ui, wr, wc, fr, fq); relax = E.nst(cur);
        if (!has_next) break;
        cur = nxt; cA = nA; cB = nB; ++ui;
        if constexpr (GATHER) gload(ui, gC);
        if (wr == 1) PG_BAR;
    }
    PG_WAIT_V(0);
    PG_BAR;
#undef PG_SA
#undef PG_SB
#undef PG_STAGE
#undef PG_STAGE_A
#undef PG_LDA
#undef PG_LDB
#undef PG_MMA
#undef PG_MMAZ
#undef PG_WAIT_V
#undef PG_WAIT_VR
#undef PG_WAIT_L
#undef PG_BAR
#undef PG_SCHED
}
}

constexpr size_t WT_AIN = WS_WT, WT_AOUT = WS_WT + 18 * MiB, WT_MIN = WS_WT + 26 * MiB, WT_MOUT = WS_WT + 51 * MiB, WT_W13 = WS_WT + 59 * MiB, WT_W2 = WS_WT + 579 * MiB;
constexpr int MINP = 6400;
constexpr float W13_SCALE = 64.f, W2_SCALE = 32.f;
static_assert(WT_W2 + (size_t)2 * 65 * 2 * MiB <= WS_END, "weight copies fit");
#define LDS_WAIT() asm volatile("s_waitcnt lgkmcnt(0)" ::: "memory")
struct CvtDesc { const float* W; unsigned char* dst; int ldw, dK; float sc; };
DEVI CvtDesc cvt_decode(const Params& p, int it) {
    constexpr int I_AIN = 16 * 144, I_AOUT = 16 * 64, I_MIN = 16 * 193, I_MOUT = 16 * 64;
    CvtDesc d; int r = it; d.sc = W13_SCALE; d.dK = D;
    const float *w_ain = p.attn_w_in, *w_aout = p.attn_w_out, *w_min = p.ml_w_in, *w_mout = p.ml_w_out, *w_e1 = p.exp_w1, *w_e3 = p.exp_w3, *w_e2 = p.exp_w2, *w_s1 = p.sh_w1, *w_s3 = p.sh_w3, *w_s2 = p.sh_w2;
    asm volatile("" : "+s"(w_ain), "+s"(w_aout), "+s"(w_min), "+s"(w_mout), "+s"(w_e1), "+s"(w_e3), "+s"(w_e2), "+s"(w_s1), "+s"(w_s3), "+s"(w_s2));
    if (r < I_AIN) { const int kb = r / 144, nb = r % 144; d.W = w_ain + (size_t)(128 * kb) * AIW + 32 * nb; d.ldw = AIW; d.dst = (unsigned char*)(p.ws + WT_AIN) + (size_t)(32 * nb) * D + 128 * kb; return d; } r -= I_AIN;
    if (r < I_AOUT) { const int kb = r / 64, nb = r % 64; d.W = w_aout + (size_t)(128 * kb) * D + 32 * nb; d.ldw = D; d.dst = (unsigned char*)(p.ws + WT_AOUT) + (size_t)(32 * nb) * D + 128 * kb; return d; } r -= I_AOUT;
    if (r < I_MIN) { const int kb = r / 193, nb = r % 193; d.W = w_min + (size_t)(128 * kb) * MIW + 32 * nb; d.ldw = MIW; d.dst = (unsigned char*)(p.ws + WT_MIN) + (size_t)(32 * nb) * D + 128 * kb; return d; } r -= I_MIN;
    if (r < I_MOUT) { const int kb = r / 64, nb = r % 64; d.W = w_mout + (size_t)(128 * kb) * D + 32 * nb; d.ldw = D; d.dst = (unsigned char*)(p.ws + WT_MOUT) + (size_t)(32 * nb) * D + 128 * kb; return d; } r -= I_MOUT;
    const int mat = r >> 8, ii = r & 255; const int l = mat / 195, q = mat % 195, e = q / 3, which = q % 3;
    if (which < 2) {
        const float* W = e < 64 ? (which == 0 ? w_e1 : w_e3) + ((size_t)l * 64 + e) * D * EDIM : (which == 0 ? w_s1 : w_s3) + (size_t)l * D * EDIM;
        const int kb = ii / 16, nb = ii % 16, n0 = 32 * nb;
        d.W = W + (size_t)(128 * kb) * EDIM + n0; d.ldw = EDIM;
        d.dst = (unsigned char*)(p.ws + WT_W13) + ((size_t)l * 65 + e) * 1024 * D + (size_t)((n0 >> 7) * 256 + which * 128 + (n0 & 127)) * D + 128 * kb;
    } else {
        const float* W = e < 64 ? w_e2 + ((size_t)l * 64 + e) * EDIM * D : w_s2 + (size_t)l * EDIM * D;
        const int kb = ii / 64, nb = ii % 64;
        d.W = W + (size_t)(128 * kb) * D + 32 * nb; d.ldw = D; d.dK = EDIM; d.sc = W2_SCALE;
        d.dst = (unsigned char*)(p.ws + WT_W2) + ((size_t)l * 65 + e) * D * EDIM + (size_t)(32 * nb) * EDIM + 128 * kb;
    }
    return d;
}
DEVI void ph_cvt(const Params& p, LAS unsigned char* lds, int vcu, int G) {
    const int tid = otid(), lane = tid & 63, wave = __builtin_amdgcn_readfirstlane(tid >> 6);
    LAS float* scr = (LAS float*)(lds + wave * 17408);
    const int gw = vcu * 8 + wave, NGW = G * 8;
    constexpr int NITEMS = 16 * 144 + 16 * 64 + 16 * 193 + 16 * 64 + 2 * 65 * 3 * 256;
    const int lr = lane >> 3, lc = (lane & 7) * 4;
    const int sn = lane >> 3, sc8 = lane & 7;
    if (gw < NITEMS) {
        int it = gw; CvtDesc dc = cvt_decode(p, it);
        typedef const __attribute__((address_space(1))) f32x4* GV4;
        f32x4 cur[16];
#pragma unroll
        for (int i = 0; i < 16; ++i) cur[i] = __builtin_nontemporal_load((GV4)(dc.W + (size_t)(lr + 8 * i) * dc.ldw + lc));
        for (;;) {
            const int nx = it + NGW; const CvtDesc dn = cvt_decode(p, nx < NITEMS ? nx : it);
            f32x4 nxt[16];
#pragma unroll
            for (int i = 0; i < 16; ++i) nxt[i] = __builtin_nontemporal_load((GV4)(dn.W + (size_t)(lr + 8 * i) * dn.ldw + lc));
#pragma unroll
            for (int i = 0; i < 16; ++i) { LAS float* sp = scr + (lr + 8 * i) * 33 + 4 * (i >> 1) + lc; sp[0] = cur[i][0] * dc.sc; sp[1] = cur[i][1] * dc.sc; sp[2] = cur[i][2] * dc.sc; sp[3] = cur[i][3] * dc.sc; }
            LDS_WAIT(); asm volatile("" ::: "memory");
#pragma unroll
            for (int j = 0; j < 4; ++j) { const int n = sn + 8 * j; const LAS float* sp = scr + (16 * sc8) * 33 + 4 * sc8 + n;
                u32x4 o;
#pragma unroll
                for (int q = 0; q < 4; ++q) o[q] = pk4_fp8(sp[(4 * q + 0) * 33], sp[(4 * q + 1) * 33], sp[(4 * q + 2) * 33], sp[(4 * q + 3) * 33]);
                *(u32x4*)(dc.dst + (size_t)n * dc.dK + 16 * sc8) = o; }
            LDS_WAIT(); asm volatile("" ::: "memory");
            if (nx >= NITEMS) break;
#pragma unroll
            for (int i = 0; i < 16; ++i) cur[i] = nxt[i];
            dc = dn; it = nx;
        }
    }
    { u32x4* z = (u32x4*)((unsigned char*)(p.ws + WT_MIN) + (size_t)MIW * D); const int n16 = (MINP - MIW) * D / 16;
      for (int i = vcu * 512 + tid; i < n16; i += G * 512) z[i] = (u32x4){0u, 0u, 0u, 0u}; }
}

typedef float f32x4e __attribute__((ext_vector_type(4)));
struct EpiBf16Store {
    static constexpr bool PERM = true, B16 = false;
    bf16* O; int ld; float* gates; int gate_pn; float sc;
    DEVI int nst(const pg::Unit& u) const { return u.pn == gate_pn ? 0 : 16; }
    DEVI void operator()(const f32x4 (&acc)[2][2][4][2], const pg::Unit& u, int ui, int wr, int wc, int fr, int fq) const {
        const int row0 = u.pm * 256 + wr * 64 + fr;
        if (u.pn == gate_pn) {
            if (wc == 0) {
#pragma unroll
                for (int ai = 0; ai < 2; ++ai)
#pragma unroll
                    for (int m = 0; m < 4; ++m) { float* gp = gates + (size_t)(row0 + ai * 128 + m * 16) * 32 + 8 * fq;
                        *(f32x4*)(gp) = acc[ai][0][m][0] * sc; *(f32x4*)(gp + 4) = acc[ai][0][m][1] * sc; }
            }
            return;
        }
        const int col0 = u.pn * 256 + wc * 32 + 8 * fq;
#pragma unroll
        for (int ai = 0; ai < 2; ++ai)
#pragma unroll
            for (int m = 0; m < 4; ++m) { bf16* rowp = O + (size_t)(row0 + ai * 128 + m * 16) * ld + col0;
#pragma unroll
                for (int bj = 0; bj < 2; ++bj) { const f32x4 v0 = acc[ai][bj][m][0] * sc, v1 = acc[ai][bj][m][1] * sc;
                    u32x4 w; w.x = pg::cvt_pk_bf16(v0[0], v0[1]); w.y = pg::cvt_pk_bf16(v0[2], v0[3]); w.z = pg::cvt_pk_bf16(v1[0], v1[1]); w.w = pg::cvt_pk_bf16(v1[2], v1[3]);
                    *(u32x4*)(rowp + bj * 128) = w; } }
    }
};
struct EpiSwiGLU {
    static constexpr bool PERM = true, B16 = false;
    bf16* ACT;
    DEVI int nst(const pg::Unit&) const { return 8; }
    DEVI void operator()(const f32x4 (&acc)[2][2][4][2], const pg::Unit& u, int ui, int wr, int wc, int fr, int fq) const {
        const int row0 = u.pm * 256 + wr * 64 + fr, col0 = u.pn * 128 + wc * 32 + 8 * fq;
#pragma unroll
        for (int ai = 0; ai < 2; ++ai)
#pragma unroll
            for (int m = 0; m < 4; ++m) {
                f32x4 o[2];
#pragma unroll
                for (int n = 0; n < 2; ++n) { const f32x4 a = acc[ai][0][m][n], b = acc[ai][1][m][n]; const f32x4 t = a * (-1.4426950408889634f / W13_SCALE);
                    f32x4 e; e[0] = __builtin_amdgcn_exp2f(t[0]); e[1] = __builtin_amdgcn_exp2f(t[1]); e[2] = __builtin_amdgcn_exp2f(t[2]); e[3] = __builtin_amdgcn_exp2f(t[3]);
                    const f32x4 d = e * (W13_SCALE * W13_SCALE) + (W13_SCALE * W13_SCALE);
                    f32x4 r; r[0] = __builtin_amdgcn_rcpf(d[0]); r[1] = __builtin_amdgcn_rcpf(d[1]); r[2] = __builtin_amdgcn_rcpf(d[2]); r[3] = __builtin_amdgcn_rcpf(d[3]);
                    o[n] = (a * b) * r; }
                uint2 w; w.x = pk4_fp8(o[0][0], o[0][1], o[0][2], o[0][3]); w.y = pk4_fp8(o[1][0], o[1][1], o[1][2], o[1][3]);
                *(uint2*)((unsigned char*)ACT + (size_t)(row0 + ai * 128 + m * 16) * EDIM + col0) = w; }
    }
};
constexpr float Y_SCALE = 8.f;
struct EpiScale {
    static constexpr bool PERM = true, B16 = true;
    unsigned char* Y; const LAS float* swt;
    DEVI int nst(const pg::Unit&) const { return 8; }
    DEVI void operator()(const f32x4 (&acc)[2][2][4][2], const pg::Unit& u, int ui, int wr, int wc, int fr, int fq) const {
        const int row0 = u.pm * 256 + wr * 64 + fr, col0 = u.pn * 256 + wc * 64 + 16 * fq;
#pragma unroll
        for (int ai = 0; ai < 2; ++ai)
#pragma unroll
            for (int m = 0; m < 4; ++m) { const int slot = row0 + ai * 128 + m * 16; const float w8 = swt[ui * 256 + wr * 64 + fr + ai * 128 + m * 16];
                const f32x4 a = acc[ai][0][m][0] * w8, b = acc[ai][0][m][1] * w8, c = acc[ai][1][m][0] * w8, d = acc[ai][1][m][1] * w8;
                u32x4 w; w.x = pk4_fp8(a[0], a[1], a[2], a[3]); w.y = pk4_fp8(b[0], b[1], b[2], b[3]); w.z = pk4_fp8(c[0], c[1], c[2], c[3]); w.w = pk4_fp8(d[0], d[1], d[2], d[3]);
                __builtin_nontemporal_store(w, (u32x4*)(Y + (size_t)slot * D + col0)); }
    }
};
struct EpiResid {
    static constexpr bool PERM = true, B16 = false;
    bf16* X; const float* modl;
    DEVI int nst(const pg::Unit&) const { return 16; }
    DEVI void operator()(const f32x4 (&acc)[2][2][4][2], const pg::Unit& u, int ui, int wr, int wc, int fr, int fq) const {
        const int bb = u.pm < 64 ? (u.pm >> 4) : 4;
        const float* gate = modl + (size_t)(bb * 6 + 2) * D;
        const int row0 = u.pm * 256 + wr * 64 + fr, col0 = u.pn * 256 + wc * 32 + 8 * fq;
        f32x4 gv[2][2];
#pragma unroll
        for (int bj = 0; bj < 2; ++bj)
#pragma unroll
            for (int n = 0; n < 2; ++n) gv[bj][n] = *(const f32x4*)(gate + col0 + bj * 128 + 4 * n) * (1.f / W13_SCALE);
        u32x4 xa[2], xb[2];
#define RLOAD(Xr, g) do { const size_t off_ = (size_t)(row0 + ((g) >> 2) * 128 + ((g) & 3) * 16) * D + col0; _Pragma("unroll") for (int bj = 0; bj < 2; ++bj) Xr[bj] = *(const u32x4*)(X + off_ + bj * 128); } while (0)
#define RMIX(w, a, b, ga, gb) pg::cvt_pk_bf16(__uint_as_float((w) << 16) + (ga) * (a), __uint_as_float((w) & 0xffff0000u) + (gb) * (b))
#define RSTORE(Xr, g) do { const size_t off_ = (size_t)(row0 + ((g) >> 2) * 128 + ((g) & 3) * 16) * D + col0; _Pragma("unroll") for (int bj = 0; bj < 2; ++bj) { \
            const f32x4 a0 = acc[(g) >> 2][bj][(g) & 3][0], a1 = acc[(g) >> 2][bj][(g) & 3][1]; u32x4 w; \
            w.x = RMIX(Xr[bj].x, a0[0], a0[1], gv[bj][0][0], gv[bj][0][1]); w.y = RMIX(Xr[bj].y, a0[2], a0[3], gv[bj][0][2], gv[bj][0][3]); \
            w.z = RMIX(Xr[bj].z, a1[0], a1[1], gv[bj][1][0], gv[bj][1][1]); w.w = RMIX(Xr[bj].w, a1[2], a1[3], gv[bj][1][2], gv[bj][1][3]); \
            *(u32x4*)(X + off_ + bj * 128) = w; } } while (0)
        RLOAD(xa, 0);
#pragma unroll
        for (int g = 0; g < 8; g += 2) {
            RLOAD(xb, g + 1); asm volatile("" ::: "memory");
            RSTORE(xa, g); asm volatile("" ::: "memory");
            if (g + 2 < 8) { RLOAD(xa, g + 2); asm volatile("" ::: "memory"); }
            RSTORE(xb, g + 1); asm volatile("" ::: "memory");
        }
#undef RLOAD
#undef RMIX
#undef RSTORE
    }
};

template <bool G1>
DEVI int moe_setup(const Params& p, LAS unsigned char* lds, int layer, int nrows, int vcu, int G) {
    LAS int* eo = (LAS int*)(lds + pg::EO_OFF); LAS int* ud = (LAS int*)(lds + pg::UD_OFF); LAS int* gt = (LAS int*)(lds + pg::GT_OFF);
    const int tid = otid(); const u32* cnt = (const u32*)(p.ws + WS_CTL) + CW_CNT + layer * 64 * CNT_PAD;
    LAS int* ec = eo + 68;
    if (tid < 64) { const int c_ = (int)cnt[tid * CNT_PAD]; const int pc = (c_ + 255) & ~255; const int incl = (int)wave_prefix_dpp((float)pc);
        ec[tid] = c_; eo[tid] = incl - pc; if (tid == 63) eo[64] = incl; }
    __syncthreads();
    constexpr int NT = G1 ? 4 : 8, CAP = G1 ? 16 : 24;
    const int PR = eo[64] >> 8, PS = nrows >> 8, total = (PR + PS) * NT;
    int nu = total > vcu ? (total - vcu + G - 1) / G : 0; if (nu > CAP) nu = CAP;
    if (tid < nu) {
        const int L = tid * G + vcu, pp = L / NT, pn = L % NT; int e = 64, pm = SH0 / 256 + (pp - PR);
        if (pp < PR) { pm = pp; e = 0; for (int i = 1; i < 64; ++i) if (eo[i] <= pp * 256) e = i; }
        ud[tid * 4 + 0] = pm; ud[tid * 4 + 1] = pn; ud[tid * 4 + 2] = e;
    }
    __syncthreads();
    if (G1) { const int* ltok = (const int*)(p.ws + WS_LTOK);
        for (int idx = tid; idx < nu * 256; idx += 512) { const int u_ = idx >> 8, slot = ud[u_ * 4] * 256 + (idx & 255), e = ud[u_ * 4 + 2];
            int t = slot - SH0; if (slot < SH0) { const int pos = slot - eo[e]; t = pos < ec[e] ? ltok[(size_t)e * MT + pos] : 0; } gt[idx] = t; } }
    else { const float* lw = (const float*)(p.ws + WS_LW); LAS float* st = (LAS float*)gt;
        for (int idx = tid; idx < nu * 256; idx += 512) { const int u_ = idx >> 8, slot = ud[u_ * 4] * 256 + (idx & 255), e = ud[u_ * 4 + 2];
            float w = 1.f; if (slot < SH0) { const int pos = slot - eo[e]; w = pos < ec[e] ? lw[(size_t)e * MT + pos] : 0.f; } st[idx] = w * (Y_SCALE / W2_SCALE); } }
    __syncthreads();
    return nu;
}

namespace fa {
typedef short s16x4 __attribute__((ext_vector_type(4)));
typedef float f32x16 __attribute__((ext_vector_type(16)));
constexpr int HD = 128, NW = 8, QBLK = 32, KVBLK = 64;
constexpr float SCALE = 0.088388347648318440f, THR = 8.f;
constexpr int SHM_V = KVBLK * HD * 2, SHM_K = KVBLK * HD * 2, SCR_OFF = 2 * SHM_V + 2 * SHM_K, BIAS_OFF = SCR_OFF + NW * 64 * 4, SHM_ATTN = BIAS_OFF + 512 * 4;
#define KSWZ(row, colB) ((row) * 256 + ((colB) ^ (((row) & 7) << 4)))
#define SBAR() __builtin_amdgcn_sched_barrier(0)
DEVI int crow(int r, int hi) { return (r & 3) + 8 * (r >> 2) + 4 * hi; }
DEVI unsigned cvtpk(float lo, float hi) { unsigned r; asm volatile("v_cvt_pk_bf16_f32 %0, %1, %2" : "=v"(r) : "v"(lo), "v"(hi)); return r; }
DEVI void partialSM(f32x16& p0, f32x16& p1, float& m_reg, float& mn, float& alpha) {
    constexpr float C = SCALE * 1.4426950408889634f;
    float pmax = p0[0];
#pragma unroll
    for (int r = 1; r < 16; ++r) pmax = fmaxf(pmax, p0[r]);
#pragma unroll
    for (int r = 0; r < 16; ++r) pmax = fmaxf(pmax, p1[r]);
    { auto rr = __builtin_amdgcn_permlane32_swap(__float_as_uint(pmax), __float_as_uint(pmax), false, false); pmax = fmaxf(__uint_as_float(rr[0]), __uint_as_float(rr[1])); }
    if (__builtin_expect(__all(pmax - m_reg <= THR / SCALE), 1)) { mn = m_reg; alpha = 1.f; }
    else { mn = fmaxf(m_reg, pmax); alpha = __builtin_amdgcn_exp2f((m_reg - mn) * C); m_reg = mn; }
    const float mnC = -mn * C;
#pragma unroll
    for (int r = 0; r < 16; ++r) p0[r] = fmaf(p0[r], C, mnC);
#pragma unroll
    for (int r = 0; r < 16; ++r) p1[r] = fmaf(p1[r], C, mnC);
#pragma unroll
    for (int r = 0; r < 16; ++r) p0[r] = __builtin_amdgcn_exp2f(p0[r]);
}
DEVI void finishSM(f32x16& p0, f32x16& p1, float alpha, float& l_reg, bf16x8& pa0, bf16x8& pa1, bf16x8& pa2, bf16x8& pa3) {
#pragma unroll
    for (int r = 0; r < 16; ++r) p1[r] = __builtin_amdgcn_exp2f(p1[r]);
    float ps = 0;
#pragma unroll
    for (int r = 0; r < 16; ++r) ps += p0[r];
#pragma unroll
    for (int r = 0; r < 16; ++r) ps += p1[r];
    { auto rr = __builtin_amdgcn_permlane32_swap(__float_as_uint(ps), __float_as_uint(ps), false, false); ps = __uint_as_float(rr[0]) + __uint_as_float(rr[1]); }
    l_reg = l_reg * alpha + ps;
#define PK4(P, BASE, OUT) do { unsigned a0 = cvtpk(P[BASE + 0], P[BASE + 1]), a1 = cvtpk(P[BASE + 2], P[BASE + 3]);   \
    unsigned b0 = cvtpk(P[BASE + 4], P[BASE + 5]), b1 = cvtpk(P[BASE + 6], P[BASE + 7]);                              \
    auto r0 = __builtin_amdgcn_permlane32_swap(a0, b0, false, false); auto r1 = __builtin_amdgcn_permlane32_swap(a1, b1, false, false); \
    u32x4 w = {r0[0], r1[0], r0[1], r1[1]}; OUT = *reinterpret_cast<bf16x8*>(&w); } while (0)
    PK4(p0, 0, pa0); PK4(p0, 8, pa1); PK4(p1, 0, pa2); PK4(p1, 8, pa3);
#undef PK4
}
DEVI void qkt(f32x16& p0, f32x16& p1, const char* Ks, const bf16x8* qr, int r32, int hi) {
    p0 = f32x16{}; p1 = f32x16{};
#pragma unroll
    for (int d0 = 0; d0 < 8; ++d0) { const int cb = (d0 * 16 + hi * 8) * 2;
        const bf16x8 b0 = *reinterpret_cast<const bf16x8*>(Ks + KSWZ(r32, cb));
        const bf16x8 b1 = *reinterpret_cast<const bf16x8*>(Ks + KSWZ(32 + r32, cb));
        p0 = __builtin_amdgcn_mfma_f32_32x32x16_bf16(b0, qr[d0], p0, 0, 0, 0);
        p1 = __builtin_amdgcn_mfma_f32_32x32x16_bf16(b1, qr[d0], p1, 0, 0, 0); }
}
DEVI int v_st(int k, int c) { const int kk = (k & ~0xC) | ((k & 4) << 1) | ((k & 8) >> 1); return ((kk >> 3) * 4 + (c >> 5)) * 512 + ((kk & 7) * 32 + (c & 31)) * 2; }
DEVI int v_rd_base(int lane) { return ((lane & 3) << 3) | (((lane >> 2) & 3) << 6) | (((lane >> 4) & 1) << 5) | (((lane >> 5) & 1) << 8); }
constexpr int v_rd_off(int d0, int ks, int half) { return d0 * 512 + ks * 4096 + half * 2048; }
template <int OFF> DEVI s16x4 tr_read(int vb) { s16x4 r; asm volatile("ds_read_b64_tr_b16 %0, %1 offset:%2" : "=&v"(r) : "v"(vb), "i"(OFF) : "memory"); return r; }
template <int D0> DEVI void pv_one(f32x16& od, int vb, bf16x8 pa0, bf16x8 pa1, bf16x8 pa2, bf16x8 pa3) {
    const s16x4 l0 = tr_read<v_rd_off(D0, 0, 0)>(vb), h0 = tr_read<v_rd_off(D0, 0, 1)>(vb), l1 = tr_read<v_rd_off(D0, 1, 0)>(vb), h1 = tr_read<v_rd_off(D0, 1, 1)>(vb);
    const s16x4 l2 = tr_read<v_rd_off(D0, 2, 0)>(vb), h2 = tr_read<v_rd_off(D0, 2, 1)>(vb), l3 = tr_read<v_rd_off(D0, 3, 0)>(vb), h3 = tr_read<v_rd_off(D0, 3, 1)>(vb);
    asm volatile("s_waitcnt lgkmcnt(0)" ::: "memory"); SBAR();
#define PK(L, H) (bf16x8){L[0], L[1], L[2], L[3], H[0], H[1], H[2], H[3]}
    od = __builtin_amdgcn_mfma_f32_32x32x16_bf16(pa0, PK(l0, h0), od, 0, 0, 0);
    od = __builtin_amdgcn_mfma_f32_32x32x16_bf16(pa1, PK(l1, h1), od, 0, 0, 0);
    od = __builtin_amdgcn_mfma_f32_32x32x16_bf16(pa2, PK(l2, h2), od, 0, 0, 0);
    od = __builtin_amdgcn_mfma_f32_32x32x16_bf16(pa3, PK(l3, h3), od, 0, 0, 0);
#undef PK
}
DEVI void pv_d0(f32x16* o, int vb, bf16x8 pa0, bf16x8 pa1, bf16x8 pa2, bf16x8 pa3) {
    pv_one<0>(o[0], vb, pa0, pa1, pa2, pa3); pv_one<1>(o[1], vb, pa0, pa1, pa2, pa3); pv_one<2>(o[2], vb, pa0, pa1, pa2, pa3); pv_one<3>(o[3], vb, pa0, pa1, pa2, pa3);
}
DEVI void na_mask(f32x16& p0, f32x16& p1, const float* brow, int cq, int hi) {
    const int cs = min(max(cq - 8, 0), 48);
    const float* bl = brow + (4 * hi - cq + 15);
    const int d0 = 4 * hi - cs;
#pragma unroll
    for (int r = 0; r < 16; ++r) {
        const int kc0 = (r & 3) + 8 * (r >> 2), kc1 = kc0 + 32;
        const bool ok0 = (unsigned)(kc0 + d0) < 16u, ok1 = (unsigned)(kc1 + d0) < 16u;
        const float b0 = bl[ok0 ? kc0 : 0], b1 = bl[ok1 ? kc1 : 0];
        p0[r] = ok0 ? p0[r] + b0 : -1e30f; p1[r] = ok1 ? p1[r] + b1 : -1e30f;
    }
}
DEVI void attn_unit(const bf16* __restrict__ Qb, const bf16* __restrict__ kc, const bf16* __restrict__ kl, int vdelta, int NT, unsigned char* __restrict__ Ob, char* lds) {
    constexpr int ldq = AIW, ldk = AIW, ldo = D; constexpr bool NA = false; const int tbase = 0, nwin = 64, krmin = 0, rq0 = 0; const float* rpb_h = nullptr;
    auto tile = [&](int t, const bf16*& kp, const bf16*& vp) { kp = t < 4 ? kc + (size_t)t * 64 * ldk : kl + (size_t)(tbase + min(t - 4, nwin - 1)) * 64 * ldk; vp = kp + vdelta; };
    const int tid = otid(), wid = tid >> 6, lane = tid & 63, r32 = lane & 31, hi = lane >> 5;
    char* V_lds = lds; char* K_lds = lds + 2 * SHM_V;
    float* wsc = (float*)(lds + SCR_OFF) + wid * 64; float* li_l = wsc; float* al_l = wsc + 32;
    float* btab = (float*)(lds + BIAS_OFF);
    float m_reg = -1e30f, l_reg = 0; f32x16 o[4] = {}; bf16x8 qr[8];
    const bf16* Qw = Qb + (size_t)(wid * QBLK + r32) * ldq + hi * 8;
#pragma unroll
    for (int d0 = 0; d0 < 8; ++d0) qr[d0] = *reinterpret_cast<const bf16x8*>(Qw + d0 * 16);
    if (NA) { for (int i = tid; i < 465; i += 512) btab[i] = rpb_h[i] * (1.f / SCALE); }
    const int sr = tid >> 4, sc = (tid & 15) * 8, vst0 = v_st(sr, sc), vst1 = v_st(32 + sr, sc);
    const int vb0 = (int)(uintptr_t)V_lds + v_rd_base(lane);
    const int rq = rq0 + (wid >> 1), cq = (wid & 1) * 32 + r32, kr0 = min(max(rq - 4, 0), 56);
    struct { bf16x8 vs0, vs1, ks0, ks1; } st_[2];
#define SLOAD(i, t) do { const bf16* kp_; const bf16* vp_; tile((t), kp_, vp_); \
    st_[i].vs0 = *reinterpret_cast<const bf16x8*>(vp_ + (size_t)sr * ldk + sc); st_[i].vs1 = *reinterpret_cast<const bf16x8*>(vp_ + (size_t)(32 + sr) * ldk + sc); \
    st_[i].ks0 = *reinterpret_cast<const bf16x8*>(kp_ + (size_t)sr * ldk + sc); st_[i].ks1 = *reinterpret_cast<const bf16x8*>(kp_ + (size_t)(32 + sr) * ldk + sc); } while (0)
#define SWRITE(b, i) do { *(bf16x8*)(V_lds + (b) * SHM_V + vst0) = st_[i].vs0; *(bf16x8*)(V_lds + (b) * SHM_V + vst1) = st_[i].vs1; const int kc = sc * 2; \
    *(bf16x8*)(K_lds + (b) * SHM_K + KSWZ(sr, kc)) = st_[i].ks0; *(bf16x8*)(K_lds + (b) * SHM_K + KSWZ(32 + sr, kc)) = st_[i].ks1; } while (0)
#define SWAIT() asm volatile("s_waitcnt vmcnt(4)" ::: "memory")
#define RESC(a) do { if (__any((a) < 1.f)) { if (hi == 0) al_l[r32] = (a); asm volatile("s_waitcnt lgkmcnt(0)" ::: "memory"); \
    _Pragma("unroll") for (int d = 0; d < 4; ++d) _Pragma("unroll") for (int r = 0; r < 16; ++r) o[d][r] *= al_l[crow(r, hi)]; } } while (0)
#define MASK(P0, P1, t) do { if (NA) { if ((t) >= 4) { const int kr_ = krmin + (t) - 4; const bool v_ = ((t) - 4 < nwin) && kr_ >= kr0 && kr_ <= kr0 + 7; (void)v_; } } } while (0)
    f32x16 pA0, pA1, pB0, pB1; float mnA, mnB, alA, alB; bf16x8 pa0, pa1, pa2, pa3;
    constexpr int SE = 0, SO = 1;
    SLOAD(SE, 0); asm volatile("s_waitcnt vmcnt(0)" ::: "memory"); SWRITE(0, SE); __syncthreads();
    qkt(pA0, pA1, K_lds, qr, r32, hi); MASK(pA0, pA1, 0); partialSM(pA0, pA1, m_reg, mnA, alA);
    SLOAD(SO, 1); SLOAD(SE, 2);
    SWAIT(); SWRITE(1, SO); __syncthreads();
    for (int j = 1; j + 1 < NT; j += 2) {
        SBAR(); qkt(pB0, pB1, K_lds + SHM_K, qr, r32, hi); MASK(pB0, pB1, j);
        finishSM(pA0, pA1, alA, l_reg, pa0, pa1, pa2, pa3); SBAR();
        SLOAD(SO, j + 2); SBAR();
        pv_d0(o, vb0, pa0, pa1, pa2, pa3); partialSM(pB0, pB1, m_reg, mnB, alB);
        __syncthreads(); SWAIT(); SWRITE(0, SE);
        RESC(alB); __syncthreads();
        SBAR(); qkt(pA0, pA1, K_lds, qr, r32, hi); MASK(pA0, pA1, j + 1);
        finishSM(pB0, pB1, alB, l_reg, pa0, pa1, pa2, pa3); SBAR();
        SLOAD(SE, min(j + 3, NT - 1)); SBAR();
        pv_d0(o, vb0 + SHM_V, pa0, pa1, pa2, pa3); partialSM(pA0, pA1, m_reg, mnA, alA);
        __syncthreads(); SWAIT(); SWRITE(1, SO);
        RESC(alA); __syncthreads();
    }
    SBAR(); qkt(pB0, pB1, K_lds + SHM_K, qr, r32, hi); MASK(pB0, pB1, NT - 1);
    finishSM(pA0, pA1, alA, l_reg, pa0, pa1, pa2, pa3); SBAR();
    pv_d0(o, vb0, pa0, pa1, pa2, pa3); partialSM(pB0, pB1, m_reg, mnB, alB);
    __syncthreads(); RESC(alB);
    finishSM(pB0, pB1, alB, l_reg, pa0, pa1, pa2, pa3); SBAR();
    pv_d0(o, vb0 + SHM_V, pa0, pa1, pa2, pa3);
    if (hi == 0) li_l[r32] = l_reg; asm volatile("s_waitcnt lgkmcnt(0)" ::: "memory");
#pragma unroll
    for (int r = 0; r < 16; ++r) { const int orow = crow(r, hi); const float rl = __builtin_amdgcn_rcpf(li_l[orow]);
#pragma unroll
        for (int d0 = 0; d0 < 4; ++d0) ((unsigned char*)Ob)[(size_t)(wid * QBLK + orow) * ldo + d0 * 32 + r32] = (unsigned char)(pk4_fp8(o[d0][r] * rl, 0.f, 0.f, 0.f) & 0xffu); }
    __syncthreads();
#undef SLOAD
#undef SWRITE
#undef SWAIT
#undef RESC
#undef MASK
}
DEVI void attn_unit_na(const bf16* __restrict__ Qb, const bf16* __restrict__ kc, const bf16* __restrict__ kl, int krmin, int nwin, int vdelta, unsigned char* __restrict__ Ob, char* lds, int rq0, const float* rpb_h) {
    constexpr int ldq = AIW, ldk = AIW, ldo = D;
    const int tid = otid(), wid = tid >> 6, lane = tid & 63, r32 = lane & 31, hi = lane >> 5;
    char* V_lds = lds; char* K_lds = lds + 2 * SHM_V;
    float* wsc = (float*)(lds + SCR_OFF) + wid * 64; float* li_l = wsc; float* al_l = wsc + 32;
    float* btab = (float*)(lds + BIAS_OFF);
    float m_reg = -1e30f, l_reg = 0; f32x16 o[4] = {}; bf16x8 qr[8];
    const bf16* Qw = Qb + (size_t)(wid * QBLK + r32) * ldq + hi * 8;
#pragma unroll
    for (int d0 = 0; d0 < 8; ++d0) qr[d0] = *reinterpret_cast<const bf16x8*>(Qw + d0 * 16);
    for (int i = tid; i < 465; i += 512) btab[i] = rpb_h[i] * (1.f / SCALE);
    const int sr = tid >> 4, sc = (tid & 15) * 8, vst0 = v_st(sr, sc), vst1 = v_st(32 + sr, sc);
    const int vb0 = (int)(uintptr_t)V_lds + v_rd_base(lane);
    const int rq = rq0 + (wid >> 1), cq = (wid & 1) * 32 + r32, kr0 = min(max(rq - 4, 0), 56);
    bf16x8 vs0, vs1, ks0, ks1;
    const int NT = 4 + nwin;
#define NLOAD(t) do { const bf16* kp_ = (t) < 4 ? kc + (size_t)(t) * 64 * ldk : kl + (size_t)(krmin + (t) - 4) * 64 * ldk; const bf16* vp_ = kp_ + vdelta; \
    vs0 = *reinterpret_cast<const bf16x8*>(vp_ + (size_t)sr * ldk + sc); vs1 = *reinterpret_cast<const bf16x8*>(vp_ + (size_t)(32 + sr) * ldk + sc); \
    ks0 = *reinterpret_cast<const bf16x8*>(kp_ + (size_t)sr * ldk + sc); ks1 = *reinterpret_cast<const bf16x8*>(kp_ + (size_t)(32 + sr) * ldk + sc); } while (0)
    NLOAD(0);
    for (int t = 0; t < NT; ++t) {
        __syncthreads();
        *(bf16x8*)(V_lds + vst0) = vs0; *(bf16x8*)(V_lds + vst1) = vs1;
        *(bf16x8*)(K_lds + KSWZ(sr, sc * 2)) = ks0; *(bf16x8*)(K_lds + KSWZ(32 + sr, sc * 2)) = ks1;
        __syncthreads();
        NLOAD(min(t + 1, NT - 1));
        const int kr = krmin + t - 4;
        if (t < 4 || (kr >= kr0 && kr <= kr0 + 7)) {
            f32x16 p0, p1; float mn, al; bf16x8 pa0, pa1, pa2, pa3;
            qkt(p0, p1, K_lds, qr, r32, hi);
            if (t >= 4) na_mask(p0, p1, btab + (kr - rq + 7) * 31, cq, hi);
            partialSM(p0, p1, m_reg, mn, al);
            if (__any(al < 1.f)) { if (hi == 0) al_l[r32] = al; asm volatile("s_waitcnt lgkmcnt(0)" ::: "memory");
#pragma unroll
                for (int d = 0; d < 4; ++d)
#pragma unroll
                    for (int r = 0; r < 16; ++r) o[d][r] *= al_l[crow(r, hi)]; }
            finishSM(p0, p1, al, l_reg, pa0, pa1, pa2, pa3);
            pv_d0(o, vb0, pa0, pa1, pa2, pa3);
        }
    }
#undef NLOAD
    if (hi == 0) li_l[r32] = l_reg; asm volatile("s_waitcnt lgkmcnt(0)" ::: "memory");
#pragma unroll
    for (int r = 0; r < 16; ++r) { const int orow = crow(r, hi); const float rl = __builtin_amdgcn_rcpf(li_l[orow]);
#pragma unroll
        for (int d0 = 0; d0 < 4; ++d0) ((unsigned char*)Ob)[(size_t)(wid * QBLK + orow) * ldo + d0 * 32 + r32] = (unsigned char)(pk4_fp8(o[d0][r] * rl, 0.f, 0.f, 0.f) & 0xffu); }
    __syncthreads();
}
}

namespace ml {
using fa::f32x16; using fa::s16x4;
constexpr int K_OFF = 0, KP_OFF = 16384, V_OFF = 32768, C2_OFF = 49152, GA_OFF = C2_OFF + 2 * 24576, DEN_OFF = GA_OFF + 3072, CF_OFF = DEN_OFF + 1024, ML_LDS = CF_OFF + 49152;
static_assert(ML_LDS <= 157 * 1024, "mLSTM LDS map");
constexpr int GA_STRIDE = 6 * 64 * 4;
DEVI int tokrow(int b, int dir, int c, int i) {
    return c >= 4 ? (b * SEQ + (dir ? (SEQ - 1 - ((c - 4) * 64 + i)) : ((c - 4) * 64 + i))) : (ML + b * CTXL + (dir ? (CTXL - 1 - (c * 64 + i)) : (c * 64 + i)));
}
template <int CTRL, int ROWMASK> DEVI float dpp_f(float ident, float src) {
    return __int_as_float(__builtin_amdgcn_update_dpp(__float_as_int(ident), __float_as_int(src), CTRL, ROWMASK, 0xf, false));
}
DEVI float prefix_sum64(float x, int) {
    x += dpp_f<0x111, 0xf>(0.f, x); x += dpp_f<0x112, 0xf>(0.f, x); x += dpp_f<0x114, 0xf>(0.f, x); x += dpp_f<0x118, 0xf>(0.f, x);
    x += dpp_f<0x142, 0xa>(0.f, x); x += dpp_f<0x143, 0xc>(0.f, x);
    return x;
}
DEVI float prefix_max64(float x, int) {
    const float ninf = -INFINITY;
    x = fmaxf(x, dpp_f<0x111, 0xf>(ninf, x)); x = fmaxf(x, dpp_f<0x112, 0xf>(ninf, x)); x = fmaxf(x, dpp_f<0x114, 0xf>(ninf, x)); x = fmaxf(x, dpp_f<0x118, 0xf>(ninf, x));
    x = fmaxf(x, dpp_f<0x142, 0xa>(ninf, x)); x = fmaxf(x, dpp_f<0x143, 0xc>(ninf, x));
    return x;
}
DEVI float lane63(float v) { return __int_as_float(__builtin_amdgcn_readlane(__float_as_int(v), 63)); }
DEVI float gate_chunk(float li, float f, float mprev, float* ga, int lane) {
    const float lf = fminf(f, 0.f) - log1pf(__expf(-fabsf(f)));
    const float bc = prefix_sum64(lf, lane), btot = lane63(bc);
    const float colt = li - bc, aend = btot + colt, pm = prefix_max64(colt, lane), amax = btot + lane63(pm), mnew = fmaxf(btot + mprev, amax);
    const float cm = fmaxf(mprev, pm);
    ga[lane] = __expf(aend - mnew) * QSCALE;
    ga[64 + lane] = colt;
    ga[128 + lane] = -cm;
    ga[192 + lane] = __expf(mprev - cm);
    ga[256 + lane] = __expf(-bc - cm);
    if (lane == 0) ga[320] = __expf(btot + mprev - mnew);
    return mnew;
}
DEVI void ph_mlstm(const Params& p, char* lds, int vcu, int G) {
    const int tid = otid(), wid = __builtin_amdgcn_readfirstlane(tid >> 6), lane = tid & 63, r32 = lane & 31, hi = lane >> 5;
    const bf16* Q = (const bf16*)(p.ws + WS_QKV); const float* Gt = (const float*)(p.ws + WS_G); bf16* HD = (bf16*)(p.ws + WS_HD);
    char* K_lds = lds + K_OFF; char* Kp_lds = lds + KP_OFF; char* V_lds = lds + V_OFF; char* C_lds = lds + C2_OFF;
    float* GA = (float*)(lds + GA_OFF); float* den_l = (float*)(lds + DEN_OFF) + (wid & 3) * 64;
    const int sr = tid >> 4, sc = (tid & 15) * 8;
    const int vr = tid >> 3, vc = (tid & 7) * 8;
    const int vbK = (int)(uintptr_t)Kp_lds + fa::v_rd_base(lane), vbV = (int)(uintptr_t)V_lds + fa::v_rd_base(lane);
    for (int item = vcu; item < 256; item += G) {
        const int b = item >> 6, h = (item >> 3) & 7, dir = (item >> 2) & 1, sl = item & 3;
        const float bi = p.ml_gate_b[dir * 8 + h], bf_ = p.ml_gate_b[(2 + dir) * 8 + h];
        __syncthreads();
        for (int i = tid; i < 16384 / 16; i += 512) ((u32x4*)(V_lds))[i] = (u32x4){0u, 0u, 0u, 0u};
        for (int i = tid; i < 24576 / 16; i += 512) ((u32x4*)(C_lds))[i] = (u32x4){0u, 0u, 0u, 0u};
        __syncthreads();
        if (tid < 64) *(bf16*)(V_lds + fa::v_st(tid, 64)) = (bf16)0x3F80;
        for (int i = tid; i < 49152 / 16; i += 512) ((u32x4*)(lds + CF_OFF))[i] = (u32x4){0u, 0u, 0u, 0u};
        float mprev = 0.f;
        if (wid == 4) { const int row = tokrow(b, dir, 0, lane); mprev = gate_chunk(Gt[(size_t)row * 32 + dir * 8 + h] + bi, Gt[(size_t)row * 32 + 16 + dir * 8 + h] + bf_, 0.f, GA, lane); }
        bf16x8 kr0, kr1, vreg, qr[8];
        { const int r0 = tokrow(b, dir, 0, sr), r1 = tokrow(b, dir, 0, sr + 32), r2 = tokrow(b, dir, 0, vr);
          kr0 = *(const bf16x8*)(Q + (size_t)r0 * MIWM + 1024 + h * 128 + sc); kr1 = *(const bf16x8*)(Q + (size_t)r1 * MIWM + 1024 + h * 128 + sc);
          vreg = *(const bf16x8*)(Q + (size_t)r2 * MIWM + 2048 + h * 256 + sl * 64 + vc); }
#pragma unroll
        for (int d0 = 0; d0 < 8; ++d0) qr[d0] = (bf16x8){0, 0, 0, 0, 0, 0, 0, 0};
        __syncthreads();
        auto chunk_loop = [&](auto role_, auto lat_, const int c_begin, const int c_end) __attribute__((always_inline)) {
            constexpr bool OUT = decltype(role_)::value, LATC = decltype(lat_)::value;
#pragma unroll 1
            for (int c = c_begin; c < c_end; ++c) {
                const bool lat = c >= 4;
                const float* ga = GA + (c & 1) * (GA_STRIDE / 4);
                {
                    *(bf16x8*)(K_lds + KSWZ(sr, sc * 2)) = kr0; *(bf16x8*)(K_lds + KSWZ(32 + sr, sc * 2)) = kr1;
                    const float w0 = ga[sr], w1 = ga[sr + 32];
                    u32x4 a = *(u32x4*)&kr0, bq = *(u32x4*)&kr1, oa, ob;
#define SC2(x, w) fa::cvtpk(__uint_as_float((x) << 16) * (w), __uint_as_float((x) & 0xffff0000u) * (w))
                    oa.x = SC2(a.x, w0); oa.y = SC2(a.y, w0); oa.z = SC2(a.z, w0); oa.w = SC2(a.w, w0);
                    ob.x = SC2(bq.x, w1); ob.y = SC2(bq.y, w1); ob.z = SC2(bq.z, w1); ob.w = SC2(bq.w, w1);
#undef SC2
                    *(u32x4*)(Kp_lds + fa::v_st(sr, sc)) = oa; *(u32x4*)(Kp_lds + fa::v_st(32 + sr, sc)) = ob;
                    *(bf16x8*)(V_lds + fa::v_st(vr, vc)) = vreg;
                }
                float gli, gf;
                {
                    const int cn = c + 1 < 68 ? c + 1 : 67;
                    const int r0 = tokrow(b, dir, cn, sr), r1 = tokrow(b, dir, cn, sr + 32), r2 = tokrow(b, dir, cn, vr);
                    kr0 = *(const bf16x8*)(Q + (size_t)r0 * MIWM + 1024 + h * 128 + sc); kr1 = *(const bf16x8*)(Q + (size_t)r1 * MIWM + 1024 + h * 128 + sc);
                    vreg = *(const bf16x8*)(Q + (size_t)r2 * MIWM + 2048 + h * 256 + sl * 64 + vc);
                    const int row = tokrow(b, dir, cn, lane); gli = Gt[(size_t)row * 32 + dir * 8 + h] + bi; gf = Gt[(size_t)row * 32 + 16 + dir * 8 + h] + bf_;
                }
                __syncthreads();
                const char* Cc = C_lds + (c & 1) * 24576;
                if constexpr (OUT) {
                    if constexpr (LATC) {
                        const int tq = wid >> 1, vq = wid & 1, t = tq * 32 + r32;
                        bf16x8 kf0[8], kf1[8], cfr[8];
#pragma unroll
                        for (int d0 = 0; d0 < 8; ++d0) { const int cb = (d0 * 16 + hi * 8) * 2;
                            kf0[d0] = *reinterpret_cast<const bf16x8*>(K_lds + KSWZ(r32, cb)); kf1[d0] = *reinterpret_cast<const bf16x8*>(K_lds + KSWZ(32 + r32, cb));
                            cfr[d0] = *reinterpret_cast<const bf16x8*>(Cc + KSWZ(vq * 32 + r32, cb)); }
                        asm volatile("s_waitcnt lgkmcnt(0)" ::: "memory"); SBAR();
                        f32x16 p0 = {}, p1 = {}, acc = {};
#pragma unroll
                        for (int d0 = 0; d0 < 8; ++d0) p0 = __builtin_amdgcn_mfma_f32_32x32x16_bf16(kf0[d0], qr[d0], p0, 0, 0, 0);
                        if (tq == 1) {
#pragma unroll
                            for (int d0 = 0; d0 < 8; ++d0) p1 = __builtin_amdgcn_mfma_f32_32x32x16_bf16(kf1[d0], qr[d0], p1, 0, 0, 0); }
#pragma unroll
                        for (int d0 = 0; d0 < 8; ++d0) acc = __builtin_amdgcn_mfma_f32_32x32x16_bf16(qr[d0], cfr[d0], acc, 0, 0, 0);
                        bf16x8 cfn[8];
#pragma unroll
                        for (int d0 = 0; d0 < 8; ++d0) cfn[d0] = *reinterpret_cast<const bf16x8*>(Cc + KSWZ(64 + r32, (d0 * 16 + hi * 8) * 2));
                        asm volatile("s_waitcnt lgkmcnt(0)" ::: "memory"); SBAR();
                        f32x16 qnacc = {};
#pragma unroll
                        for (int d0 = 0; d0 < 8; ++d0) qnacc = __builtin_amdgcn_mfma_f32_32x32x16_bf16(cfn[d0], qr[d0], qnacc, 0, 0, 0);
                        { const int cq = c + 1 < 68 ? c + 1 : 67; const bf16* Qw = Q + (size_t)tokrow(b, dir, cq, (wid >> 1) * 32 + r32) * MIWM + h * 128 + hi * 8;
#pragma unroll
                          for (int d0 = 0; d0 < 8; ++d0) qr[d0] = *(const bf16x8*)(Qw + d0 * 16); }
                        float ct0[16], ct1[16], wi[16];
#pragma unroll
                        for (int r = 0; r < 16; ++r) { const int s0 = fa::crow(r, hi); ct0[r] = ga[64 + s0]; ct1[r] = ga[64 + s0 + 32]; wi[r] = ga[192 + tq * 32 + s0]; }
                        const float rown = ga[128 + t] * 1.4426950408889634f, wint_t = ga[192 + t], emr_t = ga[256 + t];
                        asm volatile("s_waitcnt lgkmcnt(0)" ::: "memory"); SBAR();
                        float ps = 0.f;
#pragma unroll
                        for (int r = 0; r < 16; ++r) {
                            const int s0 = fa::crow(r, hi), s1 = s0 + 32;
                            const float e0 = __builtin_amdgcn_exp2f(fmaf(ct0[r], 1.4426950408889634f, rown)), e1 = __builtin_amdgcn_exp2f(fmaf(ct1[r], 1.4426950408889634f, rown));
                            p0[r] = s0 <= t ? p0[r] * QSCALE * e0 : 0.f; p1[r] = s1 <= t ? p1[r] * QSCALE * e1 : 0.f;
                            ps += p0[r] + p1[r];
                        }
                        { auto rr = __builtin_amdgcn_permlane32_swap(__float_as_uint(ps), __float_as_uint(ps), false, false); ps = __uint_as_float(rr[0]) + __uint_as_float(rr[1]); }
                        bf16x8 pa0, pa1, pa2, pa3;
#define PK4(P, BASE, OUT) do { unsigned a0 = fa::cvtpk(P[BASE + 0], P[BASE + 1]), a1 = fa::cvtpk(P[BASE + 2], P[BASE + 3]);   \
        unsigned b0 = fa::cvtpk(P[BASE + 4], P[BASE + 5]), b1 = fa::cvtpk(P[BASE + 6], P[BASE + 7]);                              \
        auto r0 = __builtin_amdgcn_permlane32_swap(a0, b0, false, false); auto r1 = __builtin_amdgcn_permlane32_swap(a1, b1, false, false); \
        u32x4 w = {r0[0], r1[0], r0[1], r1[1]}; OUT = *reinterpret_cast<bf16x8*>(&w); } while (0)
                        PK4(p0, 0, pa0); PK4(p0, 8, pa1); PK4(p1, 0, pa2); PK4(p1, 8, pa3);
                        float qn_ = qnacc[0];
                        { auto rr = __builtin_amdgcn_permlane32_swap(__float_as_uint(qn_), __float_as_uint(qn_), false, false); qn_ = __uint_as_float(rr[0]); }
                        const float den = wint_t * qn_ + ps;
                        if (hi == 0) den_l[r32] = fmaxf(fabsf(den), emr_t);
#pragma unroll
                        for (int r = 0; r < 16; ++r) acc[r] *= wi[r];
                        fa::pv_one<0>(acc, vbV + vq * 512, pa0, pa1, pa2, pa3);
                        float dl[16];
#pragma unroll
                        for (int r = 0; r < 16; ++r) dl[r] = den_l[fa::crow(r, hi)];
                        asm volatile("s_waitcnt lgkmcnt(0)" ::: "memory"); SBAR();
                        const long stepE = dir ? -(long)D : (long)D;
                        bf16* hb = HD + ((size_t)dir * ML + tokrow(b, dir, c, tq * 32 + 4 * hi)) * D + h * 256 + sl * 64 + vq * 32 + r32;
#pragma unroll
                        for (int r = 0; r < 16; ++r) hb[stepE * ((r & 3) + 8 * (r >> 2))] = f2bf(acc[r] * __builtin_amdgcn_rcpf(dl[r]));
                    }
                    if constexpr (!LATC) if (c == 3) { const bf16* Qw = Q + (size_t)tokrow(b, dir, c + 1, (wid >> 1) * 32 + r32) * MIWM + h * 128 + hi * 8;
#pragma unroll
                        for (int d0 = 0; d0 < 8; ++d0) qr[d0] = *(const bf16x8*)(Qw + d0 * 16); }
                } else {
                    const int kq = wid - 4; const float decay = ga[320];
                    f32x4* CF = (f32x4*)(lds + CF_OFF) + kq * 3 * 4 * 64 + lane;
                    f32x4 cfv[12]; s16x4 kt[8], vt[24];
#pragma unroll
                    for (int i = 0; i < 12; ++i) cfv[i] = CF[i * 64];
                    typedef short v4i16_t __attribute__((ext_vector_type(4)));
#define TRB(base, off) __builtin_bit_cast(s16x4, __builtin_amdgcn_ds_read_tr16_b64_v4i16((LAS v4i16_t*)(size_t)(unsigned)((base) + (off))))
                    const int ak = vbK + kq * 512;
#pragma unroll
                    for (int ks = 0; ks < 4; ++ks) { kt[2 * ks] = TRB(ak, fa::v_rd_off(0, ks, 0)); kt[2 * ks + 1] = TRB(ak, fa::v_rd_off(0, ks, 1)); }
#pragma unroll
                    for (int j = 0; j < 3; ++j)
#pragma unroll
                        for (int ks = 0; ks < 4; ++ks) { vt[8 * j + 2 * ks] = TRB(vbV, fa::v_rd_off(j, ks, 0)); vt[8 * j + 2 * ks + 1] = TRB(vbV, fa::v_rd_off(j, ks, 1)); }
#undef TRB
                    f32x16 cacc[3];
#pragma unroll
                    for (int j = 0; j < 3; ++j)
#pragma unroll
                        for (int r4 = 0; r4 < 4; ++r4) { const f32x4 v4 = cfv[j * 4 + r4] * decay; cacc[j][r4 * 4 + 0] = v4[0]; cacc[j][r4 * 4 + 1] = v4[1]; cacc[j][r4 * 4 + 2] = v4[2]; cacc[j][r4 * 4 + 3] = v4[3]; }
#define PKF(L, H) (bf16x8){L[0], L[1], L[2], L[3], H[0], H[1], H[2], H[3]}
#pragma unroll
                    for (int j = 0; j < 3; ++j)
#pragma unroll
                        for (int ks = 0; ks < 4; ++ks) cacc[j] = __builtin_amdgcn_mfma_f32_32x32x16_bf16(PKF(kt[2 * ks], kt[2 * ks + 1]), PKF(vt[8 * j + 2 * ks], vt[8 * j + 2 * ks + 1]), cacc[j], 0, 0, 0);
#undef PKF
                    char* Cn = C_lds + ((c + 1) & 1) * 24576;
#pragma unroll
                    for (int j = 0; j < 3; ++j) { bf16x8 f0, f1; PK4(cacc[j], 0, f0); PK4(cacc[j], 8, f1);
                        *(bf16x8*)(Cn + KSWZ(j * 32 + r32, (kq * 32 + hi * 8) * 2)) = f0; *(bf16x8*)(Cn + KSWZ(j * 32 + r32, (kq * 32 + 16 + hi * 8) * 2)) = f1; }
#pragma unroll
                    for (int j = 0; j < 3; ++j)
#pragma unroll
                        for (int r4 = 0; r4 < 4; ++r4) CF[(j * 4 + r4) * 64] = (f32x4){cacc[j][r4 * 4 + 0], cacc[j][r4 * 4 + 1], cacc[j][r4 * 4 + 2], cacc[j][r4 * 4 + 3]};
                    if (wid == 4 && c + 1 < 68) mprev = gate_chunk(gli, gf, mprev, GA + ((c + 1) & 1) * (GA_STRIDE / 4), lane);
                }
                __syncthreads();
            }
        };
        if (wid < 4) { chunk_loop(std::true_type{}, std::false_type{}, 0, 4);
            __builtin_amdgcn_s_waitcnt(0);
            chunk_loop(std::true_type{}, std::true_type{}, 4, 68); }
        else chunk_loop(std::false_type{}, std::false_type{}, 0, 68);
#undef PK4
    }
}
}

DEVI void ph_attn0(const Params& p, char* lds, int vcu, int G) {
    const bf16* Q = (const bf16*)(p.ws + WS_QKV); unsigned char* AO = (unsigned char*)(p.ws + WS_AO);
    const int nG = (512 - vcu + G - 1) / G, nC = vcu < 64 ? (64 - vcu + G - 1) / G : 0;
    for (int i = 0; i < 2 * nG + nC; ++i) {
        const bf16 *Qb, *kc, *kl; unsigned char* Ob; int tbase = 0, nwin = 64, vdelta, NT, rq0 = 0; bool na = false; const float* rpb = p.attn_rpb;
        if (i < nG) {
            const int u = vcu + i * G; int b, qh, qb;
            if (G == 256) { const int grp = vcu >> 5, idx = (vcu & 31) + 32 * i; b = grp >> 1; qh = (grp & 1) * 4 + (idx >> 4); qb = idx & 15; } else { b = u >> 7; qh = (u >> 4) & 7; qb = u & 15; }
            const int kvh = qh >> 2;
            kc = Q + (size_t)(ML + b * CTXL) * AIW + 4096 + kvh * 128; kl = Q + (size_t)(b * SEQ) * AIW + 4096 + kvh * 128; vdelta = 256; NT = 68;
            Qb = Q + (size_t)(b * SEQ + qb * 256) * AIW + 3072 + qh * 128; Ob = AO + (size_t)(b * SEQ + qb * 256) * D + 1024 + qh * 128;
        } else if (i < 2 * nG) {
            const int u = vcu + (i - nG) * G; const int b = u >> 7, h = (u >> 4) & 7, qb = u & 15;
            const int krmin = min(max(4 * qb - 4, 0), 56), krmax = min(max(4 * qb - 1, 0), 56) + 7;
            tbase = krmin; nwin = krmax - krmin + 1; NT = (4 + nwin + 1) & ~1; na = true; rq0 = 4 * qb; rpb = p.attn_rpb + h * 465;
            kc = Q + (size_t)(ML + b * CTXL) * AIW + 1024 + h * 128; kl = Q + (size_t)(b * SEQ) * AIW + 1024 + h * 128; vdelta = 1024;
            Qb = Q + (size_t)(b * SEQ + qb * 256) * AIW + h * 128; Ob = AO + (size_t)(b * SEQ + qb * 256) * D + h * 128;
        } else {
            const int u = vcu + (i - 2 * nG) * G; const int b = (u >> 3) & 3, hh = u & 7; const bool gq = u >= 32;
            const int qcol = gq ? 3072 + hh * 128 : hh * 128, kcol = gq ? 4096 + (hh >> 2) * 128 : 1024 + hh * 128, ocol = gq ? 1024 + hh * 128 : hh * 128;
            kc = Q + (size_t)(ML + b * CTXL) * AIW + kcol; kl = kc; vdelta = gq ? 256 : 1024; NT = 4;
            Qb = Q + (size_t)(ML + b * CTXL) * AIW + qcol; Ob = AO + (size_t)(ML + b * CTXL) * D + ocol;
        }
        if (na) fa::attn_unit_na(Qb, kc, kl, tbase, nwin, vdelta, Ob, lds, rq0, rpb); else fa::attn_unit(Qb, kc, kl, vdelta, NT, Ob, lds);
    }
}

DEVI unsigned cvtpk_s(float lo, float hi) { unsigned r; asm volatile("v_cvt_pk_bf16_f32 %0, %1, %2" : "=v"(r) : "v"(lo), "v"(hi)); return r; }
DEVI void ph_router_prep(const Params& p, float* lds, int vcu, int G) {
    const int tid = otid(), lane = tid & 63, wave = tid >> 6;
    bf16* RWP = (bf16*)(p.ws + WS_RWP); float* RC = (float*)(p.ws + WS_RC);
    for (int idx = vcu * 512 + tid; idx < 10 * 256 * 64; idx += G * 512) {
        const int e = idx & 63, kg = (idx >> 6) & 255, lb = idx >> 14, l = lb / 5, bb = lb % 5;
        const float* W = p.router_w + (size_t)l * D * NE + e; const float* gn = p.norm_ffn + l * D + kg * 8; const float* scl = modp(p, l, bb, 4) + kg * 8;
        float v[8]; unsigned hi[4], lo[4];
#pragma unroll
        for (int j = 0; j < 8; ++j) v[j] = gn[j] * (1.f + scl[j]) * W[(size_t)(kg * 8 + j) * NE];
#pragma unroll
        for (int j = 0; j < 4; ++j) { hi[j] = cvtpk_s(v[2 * j], v[2 * j + 1]); lo[j] = cvtpk_s(v[2 * j] - __uint_as_float(hi[j] << 16), v[2 * j + 1] - __uint_as_float(hi[j] & 0xffff0000u)); }
        bf16* dst = RWP + (((size_t)lb * 2 * 128 + (kg >> 1)) * 64 + e) * 16 + (kg & 1) * 8;
        *(u32x4*)dst = (u32x4){hi[0], hi[1], hi[2], hi[3]}; *(u32x4*)(dst + (size_t)128 * 64 * 16) = (u32x4){lo[0], lo[1], lo[2], lo[3]};
    }
    for (int c = vcu; c < 80; c += G) {
        const int lb = c % 10, sl = c / 10, l = lb / 5, bb = lb % 5; const float* W = p.router_w + (size_t)l * D * NE + lane; const float* sh = modp(p, l, bb, 3);
        float a = 0.f;
#pragma unroll 32
        for (int k = sl * 256 + wave * 32; k < sl * 256 + wave * 32 + 32; ++k) a += sh[k] * W[(size_t)k * NE];
        __syncthreads(); lds[wave * 64 + lane] = a; __syncthreads();
        if (wave == 0) { float t = 0.f; for (int w = 0; w < 8; ++w) t += lds[w * 64 + lane]; RC[(lb * 8 + sl) * 64 + lane] = t; }
    }
}
DEVI void ph_normr2(const Params& p, int layer, int nrows, float* lds, int vcu, int G) {
    using fa::f32x16;
    float* part = lds; float* ssq = lds + 8 * 4096; float* rstd_l = ssq + 256; float* sraw = rstd_l + 32; float* ssel = sraw + 2048; float* gsc = ssel + 2048;
    int* gsel = (int*)(gsc + 256); int* esel = gsel + 256; float* wsel = (float*)(esel + 256);
    LAS int* hist = (LAS int*)(wsel + 256); LAS int* hbase = hist + 64;
    const int tid = otid(), lane = tid & 63, wave = __builtin_amdgcn_readfirstlane(tid >> 6), r32 = lane & 31, kgp = lane >> 5;
    bf16* HB = (bf16*)(p.ws + WS_HB);
    int* eidx = (int*)(p.ws + WS_EIDX); float* ew = (float*)(p.ws + WS_EW); int* epos = (int*)(p.ws + WS_EPOS);
    u32* cnt = (u32*)(p.ws + WS_CTL) + CW_CNT + layer * 64 * CNT_PAD;
    const float* RB = p.router_b + layer * NE; const float* gain = p.norm_ffn + layer * D;
    LAS int* tq = hbase + 64;
    unsigned* tcnt = (unsigned*)(p.ws + WS_CTL) + CW_TQ + layer * 64;
    const int ntiles = nrows >> 5;
    if (tid == 0) tq[0] = (int)atomicAdd(tcnt, 1u);
    __syncthreads();
    int tile = __builtin_amdgcn_readfirstlane(tq[0]);
    while (tile < ntiles) {
        int nxt_reg = 0;
        const int m0 = tile * 32, bb = bidx(m0);
        const bf16* xbase = (const bf16*)(p.ws + WS_X) + (size_t)m0 * D;
        {
            LAS unsigned char* xs = (LAS unsigned char*)lds + wave * 16384;
            {
                const int rr_ = lane >> 5, cc = lane & 31;
                const unsigned char* xg = (const unsigned char*)xbase + (size_t)rr_ * (D * 2) + wave * 512 + cc * 16;
                u32x4 xv[16];
#pragma unroll
                for (int i = 0; i < 16; ++i) xv[i] = *(const u32x4*)(xg + (size_t)(2 * i) * (D * 2));
#pragma unroll
                for (int i = 0; i < 16; ++i) { const int row = 2 * i + rr_; *(LAS u32x4*)(xs + row * 512 + ((cc ^ row) & 31) * 16) = xv[i]; }
            }
            const bf16* wb = (const bf16*)(p.ws + WS_RWP) + (((size_t)(layer * 5 + bb) * 2 * 128 + wave * 16) * 64 + r32) * 16 + kgp * 8;
            f32x16 acc0 = {}, acc1 = {}; float ss = 0.f;
            bf16x8 wv[2][4][4];
#pragma unroll
            for (int t = 0; t < 4; ++t) { const bf16* w_ = wb + (size_t)t * 1024;
                wv[0][t][0] = *(const bf16x8*)(w_); wv[0][t][1] = *(const bf16x8*)(w_ + 512); wv[0][t][2] = *(const bf16x8*)(w_ + (size_t)128 * 1024); wv[0][t][3] = *(const bf16x8*)(w_ + (size_t)128 * 1024 + 512); }
            asm volatile("s_waitcnt lgkmcnt(0)" ::: "memory");
#pragma unroll
            for (int sb = 0; sb < 4; ++sb) {
                if (sb < 3) {
#pragma unroll
                    for (int t = 0; t < 4; ++t) { const bf16* w_ = wb + (size_t)((sb + 1) * 4 + t) * 1024;
                        wv[(sb + 1) & 1][t][0] = *(const bf16x8*)(w_); wv[(sb + 1) & 1][t][1] = *(const bf16x8*)(w_ + 512); wv[(sb + 1) & 1][t][2] = *(const bf16x8*)(w_ + (size_t)128 * 1024); wv[(sb + 1) & 1][t][3] = *(const bf16x8*)(w_ + (size_t)128 * 1024 + 512); }
                }
                u32x4 ahv[4];
#pragma unroll
                for (int t = 0; t < 4; ++t) { const int ch = 2 * (sb * 4 + t) + kgp; ahv[t] = *(const LAS u32x4*)(xs + r32 * 512 + ((ch ^ r32) & 31) * 16); }
#pragma unroll
                for (int t = 0; t < 4; ++t) {
                    const u32x4 ah = ahv[t];
#pragma unroll
                    for (int q = 0; q < 4; ++q) { const float a = __uint_as_float(ah[q] << 16), b = __uint_as_float(ah[q] & 0xffff0000u); ss += a * a + b * b; }
                    const bf16x8 Ah = __builtin_bit_cast(bf16x8, ah);
                    acc0 = __builtin_amdgcn_mfma_f32_32x32x16_bf16(Ah, wv[sb & 1][t][0], acc0, 0, 0, 0); acc1 = __builtin_amdgcn_mfma_f32_32x32x16_bf16(Ah, wv[sb & 1][t][1], acc1, 0, 0, 0);
                    acc0 = __builtin_amdgcn_mfma_f32_32x32x16_bf16(Ah, wv[sb & 1][t][2], acc0, 0, 0, 0); acc1 = __builtin_amdgcn_mfma_f32_32x32x16_bf16(Ah, wv[sb & 1][t][3], acc1, 0, 0, 0);
                }
            }
            { auto rr = __builtin_amdgcn_permlane32_swap(__float_as_uint(ss), __float_as_uint(ss), false, false); ss = __uint_as_float(rr[0]) + __uint_as_float(rr[1]); }
            if (kgp == 0) ssq[wave * 32 + r32] = ss;
#pragma unroll
            for (int r = 0; r < 16; ++r) { part[wave * 4096 + (0 * 16 + r) * 64 + lane] = acc0[r]; part[wave * 4096 + (1 * 16 + r) * 64 + lane] = acc1[r]; }
        }
        __syncthreads();
        if (tid == 0) nxt_reg = (int)atomicAdd(tcnt, 1u);
        if (tid < 32) { float t = 0.f; for (int w = 0; w < 8; ++w) t += ssq[w * 32 + tid]; rstd_l[tid] = rsqrtf(t * (1.f / D) + EPS); }
        __syncthreads();
        {
            if (tid < 64) hist[tid] = 0;
            const float* rc = (const float*)(p.ws + WS_RC) + (layer * 5 + bb) * 8 * 64;
            float rcsum = 0.f;
#pragma unroll
            for (int sl = 0; sl < 8; ++sl) rcsum += rc[sl * 64 + lane];
            const float rbe = RB[lane]; const int g = lane >> 3;
#define DPPF(x, ctrl) __int_as_float(__builtin_amdgcn_update_dpp(0, __float_as_int(x), ctrl, 0xf, 0xf, false))
#pragma unroll 1
            for (int q = 0; q < 4; ++q) {
                const int row = wave + 8 * q, rr = (row & 3) + 4 * (row >> 3), ll = (lane & 31) + 32 * ((row >> 2) & 1), eb = lane >> 5;
                float t = 0.f;
#pragma unroll
                for (int w = 0; w < 8; ++w) t += part[w * 4096 + (eb * 16 + rr) * 64 + ll];
                const float lg = t * rstd_l[row] + rcsum; const float sg = 1.f / (1.f + expf(-lg));
                const float v = sg + rbe;
                float m1 = v, m2 = -INFINITY;
                { const float o1 = DPPF(m1, 0xB1); m2 = fminf(m1, o1); m1 = fmaxf(m1, o1); }
                { const float o1 = DPPF(m1, 0x4E), o2 = DPPF(m2, 0x4E); m2 = fmaxf(fminf(m1, o1), fmaxf(m2, o2)); m1 = fmaxf(m1, o1); }
                { const float o1 = DPPF(m1, 0x141), o2 = DPPF(m2, 0x141); m2 = fmaxf(fminf(m1, o1), fmaxf(m2, o2)); m1 = fmaxf(m1, o1); }
                const float gs = m1 + m2;
                int grank = 0;
#pragma unroll
                for (int j = 0; j < 8; ++j) { const float sj = __int_as_float(__builtin_amdgcn_readlane(__float_as_int(gs), 8 * j)); grank += (sj > gs || (sj == gs && j < g)) ? 1 : 0; }
                float vm = grank < 4 ? v : -INFINITY;
#pragma unroll 1
                for (int r = 0; r < 8; ++r) {
                    const float mx = ml::lane63(ml::prefix_max64(vm, 0));
                    const unsigned long long bal = __ballot(vm == mx);
                    const int idx = __ffsll((long long)bal) - 1;
                    if (lane == idx) { esel[row * 8 + r] = lane; wsel[row * 8 + r] = sg; vm = -INFINITY; }
                }
            }
#undef DPPF
        }
        __syncthreads();
        int lrank = 0;
        if (tid < 256) lrank = __hip_atomic_fetch_add(hist + esel[tid], 1, __ATOMIC_RELAXED, __HIP_MEMORY_SCOPE_WORKGROUP);
        __syncthreads();
        if (tid < 64) { const int c_ = hist[tid]; hbase[tid] = c_ > 0 ? (int)atomicAdd(&cnt[tid * CNT_PAD], (u32)c_) : 0; }
        __syncthreads();
        if (tid < 256) {
            const int row = tid >> 3, k = tid & 7; float wsum = 0.f;
#pragma unroll
            for (int j = 0; j < 8; ++j) wsum += wsel[row * 8 + j];
            const int e = esel[tid]; const int mm = m0 + row;
            const int pos = hbase[e] + lrank;
            eidx[mm * 8 + k] = e; epos[mm * 8 + k] = pos;
            ((int*)(p.ws + WS_LTOK))[(size_t)e * MT + pos] = mm; ((float*)(p.ws + WS_LW))[(size_t)e * MT + pos] = wsel[tid] * (2.5f / wsum);
        }
        {
            const float* sh = modp(p, layer, bb, 3); const float* scl = modp(p, layer, bb, 4);
            const float rs0 = rstd_l[wave * 4 + 0], rs1 = rstd_l[wave * 4 + 1], rs2 = rstd_l[wave * 4 + 2], rs3 = rstd_l[wave * 4 + 3];
            const bf16* src = xbase + (size_t)(wave * 4) * D; unsigned char* dstb = (unsigned char*)HB + (size_t)(m0 + wave * 4) * D;
#pragma unroll 2
            for (int j = 0; j < 8; ++j) {
                const int c = 4 * lane + 256 * j;
                uint2 xv[4];
#pragma unroll
                for (int rr = 0; rr < 4; ++rr) xv[rr] = *(const uint2*)(src + (size_t)rr * D + c);
                const float4 g = *(const float4*)(gain + c), s1 = *(const float4*)(scl + c), s0 = *(const float4*)(sh + c);
                const float gx = g.x * (1.f + s1.x), gy = g.y * (1.f + s1.y), gz = g.z * (1.f + s1.z), gw_ = g.w * (1.f + s1.w);
#pragma unroll
                for (int rr = 0; rr < 4; ++rr) { const float rs = rr == 0 ? rs0 : rr == 1 ? rs1 : rr == 2 ? rs2 : rs3;
                    const float vx = __uint_as_float(xv[rr].x << 16), vy = __uint_as_float(xv[rr].x & 0xffff0000u), vz = __uint_as_float(xv[rr].y << 16), vw = __uint_as_float(xv[rr].y & 0xffff0000u);
                    *(u32*)(dstb + (size_t)rr * D + c) = pk4_fp8(vx * rs * gx + s0.x, vy * rs * gy + s0.y, vz * rs * gz + s0.z, vw * rs * gw_ + s0.w); }
            }
        }
        if (tid == 0) tq[1] = nxt_reg;
        __syncthreads();
        tile = __builtin_amdgcn_readfirstlane(tq[1]);
    }
}

enum Phase { PH_MODS = 0, PH_NORM0, PH_INPROJ0, PH_QKNORM, PH_ATTN0, PH_OUTPROJ0, PH_NORMR0, PH_DISP0, PH_G1_0, PH_G2_0, PH_COMB0,
             PH_INPROJ1, PH_MLSTM, PH_READOUT, PH_OUTPROJ1, PH_NORMR1, PH_DISP1, PH_G1_1, PH_G2_1, PH_COMB1, PH_COUNT };

#define XB_TMO      128
#define XB_XCNT(j)  (256  + 64 * (j))
#define XB_XSUB(j)  (1280 + 64 * (j))
#define XB_XGEN(j)  (2304 + 64 * (j))
#define XB_TOP      3328
#define XB_TOPGEN   3392
#define XCD_BAR_WORDS 3456
#define XB_SPIN_CAP (1u << 18)
__device__ __forceinline__ unsigned xb_ld(unsigned* p)              { return __hip_atomic_load(p, __ATOMIC_RELAXED, __HIP_MEMORY_SCOPE_AGENT); }
__device__ __forceinline__ unsigned xb_add(unsigned* p, unsigned v) { return __hip_atomic_fetch_add(p, v, __ATOMIC_RELAXED, __HIP_MEMORY_SCOPE_AGENT); }
__device__ __forceinline__ unsigned xb_xcc_id() { return (unsigned)__builtin_amdgcn_s_getreg((3 << 11) | 20) & 0xFu; }
#define XB_SPIN(cond, bar) do { unsigned _sp = 0; while (cond) { __builtin_amdgcn_s_sleep(1); \
    if ((++_sp & 255u) == 0u) { if (xb_ld(&(bar)[XB_TMO])) break; if (_sp > XB_SPIN_CAP) { atomicAdd(&(bar)[XB_TMO], 1u); break; } } } } while (0)
struct XcdBarrier { unsigned* bar; unsigned x; volatile LAS unsigned* st; };
__device__ __forceinline__ XcdBarrier xcd_barrier_post(unsigned* bar, volatile LAS unsigned* st) {
    XcdBarrier b; b.bar = bar; b.x = xb_xcc_id(); b.st = st;
    if (threadIdx.x == 0) (void)xb_add(&bar[XB_XCNT(b.x)], 1u);
    return b;
}
__device__ __forceinline__ void xcd_barrier_complete(unsigned* bar, unsigned x, unsigned& nloc, unsigned& nx) {
    const unsigned G = gridDim.x * gridDim.y * gridDim.z;
    unsigned sum, cnt, mine, sp = 0u;
    for (;;) {
        sum = 0u; cnt = 0u; mine = 0u;
#pragma unroll 1
        for (unsigned j = 0; j < 16; ++j) { const unsigned c = xb_ld(&bar[XB_XCNT(j)]); sum += c; cnt += (c > 0u) ? 1u : 0u; mine = (j == x) ? c : mine; }
        if (sum == G) break;
        __builtin_amdgcn_s_sleep(1);
        if ((++sp & 255u) == 0u) { if (xb_ld(&bar[XB_TMO])) break; if (sp > XB_SPIN_CAP) { atomicAdd(&bar[XB_TMO], 1u); break; } }
    }
    nloc = mine > 0u ? mine : 1u; nx = cnt > 0u ? cnt : 1u;
}
__device__ __forceinline__ void xcd_barrier(const XcdBarrier& b) {
    asm volatile("s_waitcnt vmcnt(0)" ::: "memory");
    __syncthreads();
    if (threadIdx.x == 0) {
        unsigned* bar = b.bar;
        __builtin_amdgcn_s_waitcnt(0);
        unsigned nloc = b.st[0], nx = b.st[1];
        if (nloc == 0u) { xcd_barrier_complete(bar, b.x, nloc, nx); b.st[0] = nloc; b.st[1] = nx; }
        const unsigned old = xb_add(&bar[XB_XSUB(b.x)], 1u);
        const unsigned gen = old / nloc;
        if (old + 1u == (gen + 1u) * nloc) {
            __builtin_amdgcn_fence(__ATOMIC_RELEASE, "agent");
            asm volatile("s_waitcnt vmcnt(0)" ::: "memory");
            const unsigned og = xb_add(&bar[XB_TOP], 1u);
            const unsigned tg = og / nx;
            if (og + 1u == (tg + 1u) * nx) xb_add(&bar[XB_TOPGEN], 1u);
            else XB_SPIN(xb_ld(&bar[XB_TOPGEN]) == tg, bar);
            __builtin_amdgcn_fence(__ATOMIC_ACQUIRE, "agent");
            xb_add(&bar[XB_XGEN(b.x)], 1u);
            asm volatile("s_waitcnt vmcnt(0)" ::: "memory");
        } else {
            XB_SPIN(xb_ld(&bar[XB_XGEN(b.x)]) == gen, bar);
            __builtin_amdgcn_fence(__ATOMIC_ACQUIRE, "agent");
            asm volatile("s_waitcnt vmcnt(0)" ::: "memory");
        }
    }
    __syncthreads();
}
constexpr int CW_BAR = 4096;
static_assert((CW_BAR + XCD_BAR_WORDS) * 4 <= (int)CTL_BYTES, "barrier words inside the memset region");

typedef const __attribute__((address_space(4))) Params* KArgs;
#if defined(__HIP_DEVICE_COMPILE__)
DEVI Params kargs() { KArgs k = (KArgs)__builtin_amdgcn_kernarg_segment_ptr(); asm volatile("" : "+s"(k)); Params q; q.x = k->x; q.c = k->c; q.ctx = k->ctx; q.c_ctx = k->c_ctx; q.ada_w = k->ada_w; q.ada_b = k->ada_b; q.norm_mix = k->norm_mix; q.norm_ffn = k->norm_ffn; q.attn_w_in = k->attn_w_in; q.attn_w_out = k->attn_w_out; q.attn_rpb = k->attn_rpb; q.attn_q_gain = k->attn_q_gain; q.attn_k_gain = k->attn_k_gain; q.ml_w_in = k->ml_w_in; q.ml_w_out = k->ml_w_out; q.ml_gate_b = k->ml_gate_b; q.ml_head_gain = k->ml_head_gain; q.router_w = k->router_w; q.router_b = k->router_b; q.exp_w1 = k->exp_w1; q.exp_w3 = k->exp_w3; q.exp_w2 = k->exp_w2; q.sh_w1 = k->sh_w1; q.sh_w3 = k->sh_w3; q.sh_w2 = k->sh_w2; q.final_norm = k->final_norm; q.out = k->out; q.ws = k->ws; q.lo = k->lo; q.hi = k->hi; return q; }
#else
DEVI Params kargs() { return Params{}; }
#endif
constexpr int MEGA_LDS = 157 * 1024;
static_assert(pg::LDS_TOTAL <= MEGA_LDS, "LDS map");
__global__ void __launch_bounds__(512, 2) k_mega(Params p) {
    extern __shared__ __attribute__((aligned(16))) unsigned char lds_raw[];
    LAS unsigned char* lds = (LAS unsigned char*)lds_raw;
    float* ldsf = (float*)lds_raw;
    const int G = gridDim.x, bx = blockIdx.x;
    const int vcu = (G % 8 == 0) ? (bx % 8) * (G / 8) + bx / 8 : bx;
    if (threadIdx.x < 16) ((LAS unsigned*)(lds + pg::MISC_OFF))[threadIdx.x] = 0u;
    __syncthreads();
    XcdBarrier bar; bar.bar = (unsigned*)(p.ws + WS_CTL) + CW_BAR; bar.x = 0; bar.st = nullptr;
    if (p.hi - p.lo > 1) bar = xcd_barrier_post((unsigned*)(p.ws + WS_CTL) + CW_BAR, (volatile LAS unsigned*)(lds + pg::MISC_OFF));
#ifndef SITEMASK
#define SITEMASK 0xFFFFFu
#endif
#define INF(k) (p.lo <= (k) && (k) < p.hi)
#define INS(site, k) (((SITEMASK >> (site)) & 1u) && INF(k))
#ifdef PROBE_REP
#define REPF(k) for (int rep_ = 0; rep_ < (((k) == PROBE_REP) ? 2 : 1); ++rep_)
#else
#define REPF(k)
#endif
#define SEAM(k) do { if (INF(k) && INF((k) + 1)) xcd_barrier(bar); } while (0)
    REPF(PH_MODS) if (INS(PH_MODS, PH_MODS)) { const Params q = kargs(); __syncthreads(); ph_mods(q, ldsf, vcu, G); __syncthreads(); ph_cvt(q, lds, vcu, G); }
    SEAM(PH_MODS);
    REPF(PH_NORM0) if (INS(PH_NORM0, PH_NORM0)) { const Params q = kargs(); ph_norm(q, 0, q.x, q.ctx, q.norm_mix, 0, 1, MT, vcu, G); ph_router_prep(q, ldsf, vcu, G); }
    SEAM(PH_NORM0);
    for (int layer = 0; layer < 2; ++layer) {
        const int po = 9 * layer;
        REPF(PH_INPROJ0 + po) if (INS(PH_INPROJ0, PH_INPROJ0 + po)) {
            const Params q = kargs();
            const int nN = layer == 0 ? AIW / 256 : MINP / 256;
            const int nu = pg::fill_dense(lds, MT / 256, nN, G, bx);
            __syncthreads();
            pg::ListOrder S{(const LAS int*)(lds + pg::UD_OFF), nu};
            EpiBf16Store E{(bf16*)(q.ws + WS_QKV), layer == 0 ? AIW : MIWM, (float*)(q.ws + WS_G), layer == 0 ? -1 : MIWM / 256, 1.f / W13_SCALE};
            pg::gemm_phase<EpiBf16Store, false, true>(lds, q.ws + WS_HB, q.ws + (layer == 0 ? WT_AIN : WT_MIN), D, 0, S, E);
        }
        SEAM(PH_INPROJ0 + po);
        if (layer == 0) {
            REPF(PH_QKNORM) if (INS(PH_QKNORM, PH_QKNORM)) { const Params q = kargs(); ph_qknorm(q, vcu, G); }
            SEAM(PH_QKNORM);
            REPF(PH_ATTN0) if (INS(PH_ATTN0, PH_ATTN0)) { const Params q = kargs(); ph_attn0(q, (char*)lds_raw, vcu, G); }
            SEAM(PH_ATTN0);
        } else {
            REPF(PH_MLSTM) if (INS(PH_MLSTM, PH_MLSTM)) { const Params q = kargs(); ml::ph_mlstm(q, (char*)lds_raw, vcu, G); }
            SEAM(PH_MLSTM);
            REPF(PH_READOUT) if (INS(PH_READOUT, PH_READOUT)) { const Params q = kargs(); ph_readout(q, vcu, G); }
            SEAM(PH_READOUT);
        }
        REPF(PH_OUTPROJ0 + po) if (INS(PH_OUTPROJ0, PH_OUTPROJ0 + po)) {
            const Params q = kargs();
            const int nu = pg::fill_dense(lds, (layer == 0 ? MT : ML) / 256, D / 256, G, bx);
            __syncthreads();
            pg::ListOrder S{(const LAS int*)(lds + pg::UD_OFF), nu};
            EpiResid E{(bf16*)(q.ws + WS_X), (const float*)(q.ws + WS_MOD) + (size_t)layer * 5 * 6 * D};
            pg::gemm_phase<EpiResid, false, true>(lds, q.ws + WS_AO, q.ws + (layer == 0 ? WT_AOUT : WT_MOUT), D, 0, S, E);
        }
        SEAM(PH_OUTPROJ0 + po);
        REPF(PH_NORMR0 + po) if (INS(PH_NORMR0, PH_NORMR0 + po)) { const Params q = kargs(); ph_normr2(q, layer, layer == 0 ? MT : ML, ldsf, vcu, G); }
        SEAM(PH_NORMR0 + po);
        REPF(PH_G1_0 + po) if (INS(PH_G1_0, PH_G1_0 + po)) {
            const Params q = kargs();
            const int nu = moe_setup<true>(q, lds, layer, layer == 0 ? MT : ML, vcu, G);
            pg::ListOrder S{(const LAS int*)(lds + pg::UD_OFF), nu};
            EpiSwiGLU E{(bf16*)(q.ws + WS_ACT)};
            pg::gemm_phase<EpiSwiGLU, true, true>(lds, q.ws + WS_HB, q.ws + WT_W13 + (size_t)layer * 65 * 1024 * D, D, (size_t)1024 * D, S, E);
        }
        SEAM(PH_G1_0 + po);
        REPF(PH_G2_0 + po) if (INS(PH_G2_0, PH_G2_0 + po)) {
            const Params q = kargs();
            const int nu = moe_setup<false>(q, lds, layer, layer == 0 ? MT : ML, vcu, G);
            pg::ListOrder S{(const LAS int*)(lds + pg::UD_OFF), nu};
            EpiScale E{(unsigned char*)(q.ws + WS_Y), (const LAS float*)(lds + pg::GT_OFF)};
            pg::gemm_phase<EpiScale, false, true>(lds, q.ws + WS_ACT, q.ws + WT_W2 + (size_t)layer * 65 * D * EDIM, EDIM, (size_t)D * EDIM, S, E);
        }
        SEAM(PH_G2_0 + po);
        REPF(PH_COMB0 + po) if (INS(PH_COMB0, PH_COMB0 + po)) { const Params q = kargs(); ph_combine(q, layer, (int*)ldsf, vcu, G); }
        if (layer == 0) SEAM(PH_COMB0);
    }
#undef INF
#undef INS
#undef SEAM
}

#ifndef N_LAUNCH
#define N_LAUNCH 1
#endif
extern "C" void kernel_launch(void* const* d_in, const int* in_sizes, int n_in, void* d_out, int out_size, void* d_ws, size_t ws_size, hipStream_t stream) {
    static int grid = 0;
    if (grid == 0) {
        if (n_in != 26 || out_size != ML * D || ws_size < WS_END) { fprintf(stderr, "kernel_launch: unexpected shapes n_in %d out %d ws %zu\n", n_in, out_size, ws_size); grid = -1; return; }
        int dev = 0, cus = 0, per_cu = 0;
        if (hipGetDevice(&dev) != hipSuccess || hipDeviceGetAttribute(&cus, hipDeviceAttributeMultiprocessorCount, dev) != hipSuccess) { fprintf(stderr, "kernel_launch: device query failed\n"); grid = -1; return; }
        if (hipFuncSetAttribute((const void*)k_mega, hipFuncAttributeMaxDynamicSharedMemorySize, MEGA_LDS) != hipSuccess) { fprintf(stderr, "kernel_launch: hipFuncSetAttribute failed\n"); grid = -1; return; }
        if (hipOccupancyMaxActiveBlocksPerMultiprocessor(&per_cu, (const void*)k_mega, 512, MEGA_LDS) != hipSuccess || per_cu < 1) fprintf(stderr, "kernel_launch: note: occupancy query reports %d blocks per CU\n", per_cu);
        (void)hipGetLastError();
        grid = cus;
    }
    if (grid < 0) return;
    unsigned char* wsb = (unsigned char*)d_ws + (((ws_size - WS_END) >> 21) << 21);
    (void)hipMemsetAsync((char*)wsb + WS_CTL, 0, CTL_BYTES, stream);
    Params p{};
    const float** pp = (const float**)&p;
    for (int i = 0; i < 26; ++i) pp[i] = (const float*)d_in[i];
    p.out = (float*)d_out; p.ws = wsb;
#if N_LAUNCH == 1
    p.lo = 0; p.hi = PH_COUNT;
    hipLaunchKernelGGL(k_mega, dim3(grid), dim3(512), MEGA_LDS, stream, p);
#else
    for (int ph = 0; ph < PH_COUNT; ++ph) { p.lo = ph; p.hi = ph + 1; hipLaunchKernelGGL(k_mega, dim3(grid), dim3(512), MEGA_LDS, stream, p); }
#endif
    const hipError_t le = hipPeekAtLastError();
    if (le != hipSuccess) fprintf(stderr, "kernel_launch: launch failed: %s\n", hipGetErrorName(le));
}
```

```cpp
#include <hip/hip_runtime.h>
#include <cstdio>
#include <cstdint>
#include <type_traits>

#define DEVI __device__ __forceinline__
#define LAS __attribute__((address_space(3)))
typedef short bf16x8 __attribute__((ext_vector_type(8)));
typedef float f32x4 __attribute__((ext_vector_type(4)));
typedef unsigned u32x4 __attribute__((ext_vector_type(4)));
typedef int v4i32 __attribute__((ext_vector_type(4)));
typedef int v8i32 __attribute__((ext_vector_type(8)));
typedef unsigned short bf16;
typedef unsigned int u32;

constexpr int D = 2048, NB = 4, SEQ = 4096, CTXL = 256, GRIDW = 64;
constexpr int ML = NB * SEQ;
constexpr int MC = NB * CTXL;
constexpr int MT = ML + MC;
constexpr int AIW = 4608;
constexpr int MIW = 6176, MIWM = 6144;
constexpr int NE = 64, TOPK = 8, EDIM = 512;
constexpr int RS = MT * 8 + 64 * 256;
constexpr int SH0 = RS;
constexpr int NSLOT = RS + MT;
constexpr float EPS = 1e-6f;
constexpr float QSCALE = 0.08838834764831845f;

constexpr size_t MiB = (size_t)1 << 20;
constexpr size_t WS_CTL = 0, CTL_BYTES = 1 * MiB;
constexpr size_t WS_MOD = 1 * MiB;
constexpr size_t WS_XC = 2 * MiB;
constexpr size_t WS_G = 10 * MiB;
constexpr size_t WS_EIDX = 13 * MiB, WS_EW = 14 * MiB, WS_EPOS = 15 * MiB, WS_TSLOT = 16 * MiB, WS_STOK = 17 * MiB, WS_SW = 18 * MiB, WS_EOFF = 19 * MiB;
constexpr size_t WS_HB = 20 * MiB;
constexpr size_t WS_ACT = 88 * MiB;
constexpr size_t WS_Y = 257 * MiB;
constexpr size_t WS_QKV = 257 * MiB;
constexpr size_t WS_AO = 461 * MiB;
constexpr size_t WS_HD = 529 * MiB;
constexpr size_t WS_WT = 933 * MiB;
constexpr size_t WS_RWP = 1772 * MiB;
constexpr size_t WS_RC = 1777 * MiB;
constexpr size_t WS_LTOK = 1780 * MiB;
constexpr size_t WS_LW = 1785 * MiB;
constexpr size_t WS_X = 1790 * MiB;
constexpr size_t WS_END = 1858 * MiB;
constexpr int CW_TQ = 24576;
constexpr int CW_CNT = 16384, CNT_PAD = 32;

struct Params {
    const float *x, *c, *ctx, *c_ctx, *ada_w, *ada_b, *norm_mix, *norm_ffn, *attn_w_in, *attn_w_out, *attn_rpb, *attn_q_gain, *attn_k_gain,
        *ml_w_in, *ml_w_out, *ml_gate_b, *ml_head_gain, *router_w, *router_b, *exp_w1, *exp_w3, *exp_w2, *sh_w1, *sh_w3, *sh_w2, *final_norm;
    float* out; unsigned char* ws;
    int lo, hi;
};

DEVI int otid() { int t = threadIdx.x; asm volatile("" : "+v"(t)); return t; }
DEVI float bf2f(bf16 b) { return __uint_as_float(((u32)b) << 16); }
DEVI bf16 f2bf(float f) { u32 u = __float_as_uint(f); u += 0x7fffu + ((u >> 16) & 1u); return (bf16)(u >> 16); }
DEVI u32 pk2(float lo, float hi) { return (u32)f2bf(lo) | ((u32)f2bf(hi) << 16); }
DEVI float wave_sum(float v) {
#pragma unroll
    for (int o = 32; o >= 1; o >>= 1) v += __shfl_xor(v, o);
    return v;
}
DEVI unsigned pg_cvt_pk_bf16(float lo, float hi) { unsigned r; asm volatile("v_cvt_pk_bf16_f32 %0, %1, %2" : "=v"(r) : "v"(lo), "v"(hi)); return r; }
DEVI float wave_prefix_dpp(float x) {
#define WS_DPP(ctrl, rmask) x += __int_as_float(__builtin_amdgcn_update_dpp(0, __float_as_int(x), ctrl, rmask, 0xf, false))
    WS_DPP(0x111, 0xf); WS_DPP(0x112, 0xf); WS_DPP(0x114, 0xf); WS_DPP(0x118, 0xf); WS_DPP(0x142, 0xa); WS_DPP(0x143, 0xc);
#undef WS_DPP
    return x;
}
DEVI float wave_sum_dpp(float x) {
#define WS_DPP(ctrl, rmask) x += __int_as_float(__builtin_amdgcn_update_dpp(0, __float_as_int(x), ctrl, rmask, 0xf, false))
    WS_DPP(0x111, 0xf); WS_DPP(0x112, 0xf); WS_DPP(0x114, 0xf); WS_DPP(0x118, 0xf); WS_DPP(0x142, 0xa); WS_DPP(0x143, 0xc);
#undef WS_DPP
    return __int_as_float(__builtin_amdgcn_readlane(__float_as_int(x), 63));
}
DEVI u32 pk4_fp8(float a, float b, float c, float d) { int w = 0; w = __builtin_amdgcn_cvt_pk_fp8_f32(a, b, w, false); w = __builtin_amdgcn_cvt_pk_fp8_f32(c, d, w, true); return (u32)w; }
DEVI int bidx(int m) { return m < ML ? (m >> 12) : 4; }
DEVI const float* modp(const Params& p, int layer, int bb, int i) { return (const float*)(p.ws + WS_MOD) + ((size_t)((layer * 5 + bb) * 6 + i)) * D; }
DEVI float silu(float x) { return x / (1.f + __expf(-x)); }
DEVI float sigmoidf(float x) { return 1.f / (1.f + __expf(-x)); }

DEVI void ph_mods(const Params& p, float* lds, int vcu, int G) {
    float* sc = lds;
    float* red = lds + 5 * D;
    const int tid = otid();
    for (int i = tid; i < 5 * D; i += 512) { const int bb = i / D, k = i % D; const float v = bb < 4 ? p.c[bb * D + k] : p.c_ctx[k]; sc[i] = silu(v); }
    __syncthreads();
    const int tn = tid & 7, tk = tid >> 3;
    for (int item = vcu; item < 2 * 384; item += G) {
        const int l = item / 384, n0 = (item % 384) * 32;
        const float* W = p.ada_w + (size_t)l * D * 12288 + n0 + tn * 4;
        float4 acc[5];
#pragma unroll
        for (int b = 0; b < 5; ++b) acc[b] = make_float4(0.f, 0.f, 0.f, 0.f);
#pragma unroll 1
        for (int k8 = 0; k8 < 4; ++k8) {
            float4 w[8];
#pragma unroll
            for (int j = 0; j < 8; ++j) w[j] = *(const float4*)(W + (size_t)(tk * 32 + k8 * 8 + j) * 12288);
#pragma unroll
            for (int j = 0; j < 8; ++j) { const int k = tk * 32 + k8 * 8 + j;
#pragma unroll
                for (int b = 0; b < 5; ++b) { const float s_ = sc[b * D + k]; acc[b].x += s_ * w[j].x; acc[b].y += s_ * w[j].y; acc[b].z += s_ * w[j].z; acc[b].w += s_ * w[j].w; } }
        }
#pragma unroll
        for (int b = 0; b < 5; ++b) *(float4*)(red + (tk * 5 + b) * 32 + tn * 4) = acc[b];
        __syncthreads();
        if (tid < 160) {
            const int b = tid / 32, n = tid % 32; float s_ = 0.f;
            for (int g = 0; g < 64; ++g) s_ += red[(g * 5 + b) * 32 + n];
            ((float*)(p.ws + WS_MOD))[(size_t)(l * 5 + b) * 12288 + n0 + n] = s_ + p.ada_b[l * 12288 + n0 + n];
        }
        __syncthreads();
    }
}

DEVI void norm_row_load(const float* src, float4 (&v)[8], float& rstd, int lane) {
    float ss = 0.f;
#pragma unroll
    for (int j = 0; j < 8; ++j) { v[j] = *(const float4*)(src + 4 * lane + 256 * j); ss += v[j].x * v[j].x + v[j].y * v[j].y + v[j].z * v[j].z + v[j].w * v[j].w; }
    ss = wave_sum(ss);
    rstd = rsqrtf(ss * (1.f / D) + EPS);
}
DEVI void ph_norm(const Params& p, int layer, const float* xlat, const float* xctx, const float* gain, int ish, int isc, int nrows, int vcu, int G) {
    const int tid = otid(), lane = tid & 63, wave = tid >> 6;
    bf16* HB = (bf16*)(p.ws + WS_HB); bf16* X = (bf16*)(p.ws + WS_X);
    const int rot = (vcu * 8 + wave) & 7;
    for (int m0 = vcu * 8 + wave; m0 < nrows; m0 += 2 * G * 8) {
        const int mA = m0, mB = m0 + G * 8 < nrows ? m0 + G * 8 : m0;
        const float* srcA = mA < ML ? xlat + (size_t)mA * D : xctx + (size_t)(mA - ML) * D;
        const float* srcB = mB < ML ? xlat + (size_t)mB * D : xctx + (size_t)(mB - ML) * D;
        float4 vA[8], vB[8]; float ssA = 0.f, ssB = 0.f;
#pragma unroll
        for (int j = 0; j < 8; ++j) { vA[j] = *(const float4*)(srcA + 4 * lane + 256 * ((j + rot) & 7)); vB[j] = *(const float4*)(srcB + 4 * lane + 256 * ((j + rot) & 7)); }
#pragma unroll
        for (int j = 0; j < 8; ++j) { ssA += vA[j].x * vA[j].x + vA[j].y * vA[j].y + vA[j].z * vA[j].z + vA[j].w * vA[j].w; ssB += vB[j].x * vB[j].x + vB[j].y * vB[j].y + vB[j].z * vB[j].z + vB[j].w * vB[j].w; }
        const float rstdA = rsqrtf(wave_sum_dpp(ssA) * (1.f / D) + EPS), rstdB = rsqrtf(wave_sum_dpp(ssB) * (1.f / D) + EPS);
        const int bA = bidx(mA), bB = bidx(mB);
        const float* shA = modp(p, layer, bA, ish); const float* sclA = modp(p, layer, bA, isc); const float* shB = modp(p, layer, bB, ish); const float* sclB = modp(p, layer, bB, isc);
#pragma unroll
        for (int j = 0; j < 8; ++j) {
            const int c = 4 * lane + 256 * ((j + rot) & 7);
            const float4 g = *(const float4*)(gain + c), s1 = *(const float4*)(sclA + c), s0 = *(const float4*)(shA + c), t1 = *(const float4*)(sclB + c), t0 = *(const float4*)(shB + c);
            *(u32*)((unsigned char*)HB + (size_t)mA * D + c) = pk4_fp8(vA[j].x * rstdA * g.x * (1.f + s1.x) + s0.x, vA[j].y * rstdA * g.y * (1.f + s1.y) + s0.y, vA[j].z * rstdA * g.z * (1.f + s1.z) + s0.z, vA[j].w * rstdA * g.w * (1.f + s1.w) + s0.w);
            *(u32*)((unsigned char*)HB + (size_t)mB * D + c) = pk4_fp8(vB[j].x * rstdB * g.x * (1.f + t1.x) + t0.x, vB[j].y * rstdB * g.y * (1.f + t1.y) + t0.y, vB[j].z * rstdB * g.z * (1.f + t1.z) + t0.z, vB[j].w * rstdB * g.w * (1.f + t1.w) + t0.w);
            uint2 xw; xw.x = pk2(vA[j].x, vA[j].y); xw.y = pk2(vA[j].z, vA[j].w); *(uint2*)(X + (size_t)mA * D + c) = xw;
            uint2 yw; yw.x = pk2(vB[j].x, vB[j].y); yw.y = pk2(vB[j].z, vB[j].w); *(uint2*)(X + (size_t)mB * D + c) = yw;
        }
    }
}

DEVI void ph_qknorm(const Params& p, int vcu, int G) {
    const int tid = otid(), lane = tid & 63, wave = tid >> 6;
    bf16* Q = (bf16*)(p.ws + WS_QKV);
    const float invf = exp2f(-(float)(lane & 31) * (13.287712379549449f / 32.f));
    const float gq0 = p.attn_q_gain[2 * lane], gq1 = p.attn_q_gain[2 * lane + 1], gk0 = p.attn_k_gain[2 * lane], gk1 = p.attn_k_gain[2 * lane + 1];
    for (int m = vcu * 8 + wave; m < MT; m += G * 8) {
        bf16* ptr = Q + (size_t)m * AIW + 3072 + 2 * lane;
        u32 v[10];
#pragma unroll
        for (int hh = 0; hh < 10; ++hh) v[hh] = *(const u32*)(ptr + hh * 128);
        float sn = 0.f, cs = 1.f;
        if (m < ML) { const int sq = m & 4095; const float pos = lane < 32 ? (float)(sq >> 6) : (float)(sq & 63);
            sn = __sinf(pos * invf); cs = __cosf(pos * invf); }
#pragma unroll
        for (int hh = 0; hh < 10; ++hh) {
            float x0 = __uint_as_float(v[hh] << 16), x1 = __uint_as_float(v[hh] & 0xffff0000u);
            const float ss = wave_sum_dpp(x0 * x0 + x1 * x1); const float rstd = rsqrtf(ss * (1.f / 128.f) + EPS);
            x0 = x0 * rstd * (hh < 8 ? gq0 : gk0); x1 = x1 * rstd * (hh < 8 ? gq1 : gk1);
            const float y0 = x0 * cs - x1 * sn, y1 = x0 * sn + x1 * cs;
            *(u32*)(ptr + hh * 128) = pk2(y0, y1);
        }
    }
}

DEVI void ph_readout(const Params& p, int vcu, int G) {
    const int tid = otid(), lane = tid & 63, wave = tid >> 6;
    const bf16* HD = (const bf16*)(p.ws + WS_HD); const bf16* Q = (const bf16*)(p.ws + WS_QKV); bf16* AO = (bf16*)(p.ws + WS_AO);
    float4 g[8];
#pragma unroll
    for (int h = 0; h < 8; ++h) g[h] = *(const float4*)(p.ml_head_gain + h * 256 + 4 * lane);
    typedef unsigned u32x2_ __attribute__((ext_vector_type(2)));
    for (int m = vcu * 8 + wave; m < ML; m += G * 8) {
        u32x2_ a[8], b2[8], ov[8];
#pragma unroll
        for (int h = 0; h < 8; ++h) { const int c = h * 256 + 4 * lane;
            a[h] = __builtin_nontemporal_load((const u32x2_*)(HD + (size_t)m * D + c)); b2[h] = __builtin_nontemporal_load((const u32x2_*)(HD + ((size_t)ML + m) * D + c));
            ov[h] = __builtin_nontemporal_load((const u32x2_*)(Q + (size_t)m * MIWM + 4096 + c)); }
#pragma unroll
        for (int h = 0; h < 8; ++h) { const int c = h * 256 + 4 * lane;
            const float x[4] = {__uint_as_float(a[h].x << 16) + __uint_as_float(b2[h].x << 16), __uint_as_float(a[h].x & 0xffff0000u) + __uint_as_float(b2[h].x & 0xffff0000u),
                                __uint_as_float(a[h].y << 16) + __uint_as_float(b2[h].y << 16), __uint_as_float(a[h].y & 0xffff0000u) + __uint_as_float(b2[h].y & 0xffff0000u)};
            const float ss = wave_sum_dpp(x[0] * x[0] + x[1] * x[1] + x[2] * x[2] + x[3] * x[3]); const float rstd = rsqrtf(ss * (1.f / 256.f) + EPS);
            const float o0 = __uint_as_float(ov[h].x << 16), o1 = __uint_as_float(ov[h].x & 0xffff0000u), o2 = __uint_as_float(ov[h].y << 16), o3 = __uint_as_float(ov[h].y & 0xffff0000u);
            const float s0 = __builtin_amdgcn_rcpf(1.f + __expf(-o0)), s1 = __builtin_amdgcn_rcpf(1.f + __expf(-o1)), s2 = __builtin_amdgcn_rcpf(1.f + __expf(-o2)), s3 = __builtin_amdgcn_rcpf(1.f + __expf(-o3));
            *(u32*)((unsigned char*)AO + (size_t)m * D + c) = pk4_fp8(x[0] * rstd * g[h].x * s0, x[1] * rstd * g[h].y * s1, x[2] * rstd * g[h].z * s2, x[3] * rstd * g[h].w * s3);
        }
    }
}

DEVI void ph_combine(const Params& p, int layer, int* offl, int vcu, int G) {
    const int tid = otid(), lane = tid & 63, wave = tid >> 6;
    const unsigned char* Y = (const unsigned char*)(p.ws + WS_Y);
    unsigned char* HB = (unsigned char*)(p.ws + WS_HB); bf16* X = (bf16*)(p.ws + WS_X);
    const int nrows = layer == 0 ? MT : ML;
    {
        const u32* cnt = (const u32*)(p.ws + WS_CTL) + CW_CNT + layer * 64 * CNT_PAD;
        if (tid < 64) { const int c_ = (int)cnt[tid * CNT_PAD]; const int pc = (c_ + 255) & ~255; offl[64 + tid] = c_; offl[tid] = (int)wave_prefix_dpp((float)pc) - pc; }
        __syncthreads();
    }
    const int* eidx = (const int*)(p.ws + WS_EIDX); const int* epos = (const int*)(p.ws + WS_EPOS);
    for (int m = vcu * 8 + wave; m < nrows; m += G * 8) {
        bf16* xr = X + (size_t)m * D; float* orow = p.out + (size_t)m * D;
        const int bb = bidx(m); const float* g5 = modp(p, layer, bb, 5);
        int sl[9];
#pragma unroll
        for (int k = 0; k < 8; ++k) sl[k] = offl[eidx[m * 8 + k]] + epos[m * 8 + k];
        sl[8] = SH0 + m;
        u32x4 y[2][9], xv[2][2];
#pragma unroll
        for (int j = 0; j < 2; ++j) {
#pragma unroll
            for (int k = 0; k < 9; ++k) y[j][k] = __builtin_nontemporal_load((const u32x4*)(Y + (size_t)sl[k] * D + j * 1024 + lane * 16));
            xv[j][0] = *(const u32x4*)(xr + j * 1024 + lane * 16); xv[j][1] = *(const u32x4*)(xr + j * 1024 + lane * 16 + 8);
        }
        float o[32]; float ss = 0.f;
#pragma unroll
        for (int j = 0; j < 2; ++j) {
            const int c = j * 1024 + lane * 16;
            float f[16];
#pragma unroll
            for (int i = 0; i < 16; ++i) f[i] = 0.f;
#pragma unroll
            for (int k = 0; k < 9; ++k) {
                const unsigned yy[4] = {y[j][k].x, y[j][k].y, y[j][k].z, y[j][k].w};
#pragma unroll
                for (int q = 0; q < 4; ++q) { const auto lo = __builtin_amdgcn_cvt_pk_f32_fp8((int)yy[q], false), hi = __builtin_amdgcn_cvt_pk_f32_fp8((int)yy[q], true);
                    f[4 * q + 0] += lo[0]; f[4 * q + 1] += lo[1]; f[4 * q + 2] += hi[0]; f[4 * q + 3] += hi[1]; }
            }
            const unsigned xw[8] = {xv[j][0].x, xv[j][0].y, xv[j][0].z, xv[j][0].w, xv[j][1].x, xv[j][1].y, xv[j][1].z, xv[j][1].w};
#pragma unroll
            for (int q = 0; q < 4; ++q) {
                const float4 g0 = *(const float4*)(g5 + c + 4 * q);
                const float o0 = __uint_as_float(xw[2 * q] << 16) + g0.x * f[4 * q + 0] * (1.f / 8.f), o1 = __uint_as_float(xw[2 * q] & 0xffff0000u) + g0.y * f[4 * q + 1] * (1.f / 8.f);
                const float o2 = __uint_as_float(xw[2 * q + 1] << 16) + g0.z * f[4 * q + 2] * (1.f / 8.f), o3 = __uint_as_float(xw[2 * q + 1] & 0xffff0000u) + g0.w * f[4 * q + 3] * (1.f / 8.f);
                ss += o0 * o0 + o1 * o1 + o2 * o2 + o3 * o3;
                o[j * 16 + 4 * q + 0] = o0; o[j * 16 + 4 * q + 1] = o1; o[j * 16 + 4 * q + 2] = o2; o[j * 16 + 4 * q + 3] = o3;
            }
        }
        const float rstd = rsqrtf(wave_sum_dpp(ss) * (1.f / D) + EPS);
        const float* gain = layer == 0 ? p.norm_mix + D : p.final_norm;
        const float* sh = modp(p, 1, bb, 0); const float* scl = modp(p, 1, bb, 1);
#pragma unroll
        for (int j = 0; j < 2; ++j) {
            const int c = j * 1024 + lane * 16;
            if (layer == 0) {
                u32x4 w0, w1, ob;
#pragma unroll
                for (int q = 0; q < 4; ++q) {
                    const float4 g0 = *(const float4*)(gain + c + 4 * q), a0 = *(const float4*)(scl + c + 4 * q), b0 = *(const float4*)(sh + c + 4 * q);
                    const float x0 = o[j * 16 + 4 * q + 0], x1 = o[j * 16 + 4 * q + 1], x2 = o[j * 16 + 4 * q + 2], x3 = o[j * 16 + 4 * q + 3];
                    const unsigned p0 = pg_cvt_pk_bf16(x0, x1), p1 = pg_cvt_pk_bf16(x2, x3);
                    if (q < 2) { w0[2 * q] = p0; w0[2 * q + 1] = p1; } else { w1[2 * (q - 2)] = p0; w1[2 * (q - 2) + 1] = p1; }
                    ob[q] = pk4_fp8(x0 * rstd * g0.x * (1.f + a0.x) + b0.x, x1 * rstd * g0.y * (1.f + a0.y) + b0.y, x2 * rstd * g0.z * (1.f + a0.z) + b0.z, x3 * rstd * g0.w * (1.f + a0.w) + b0.w);
                }
                *(u32x4*)(xr + c) = w0; *(u32x4*)(xr + c + 8) = w1;
                *(u32x4*)(HB + (size_t)m * D + c) = ob;
            } else {
#pragma unroll
                for (int q = 0; q < 4; ++q) {
                    const float4 g0 = *(const float4*)(gain + c + 4 * q);
                    float4 r0; r0.x = o[j * 16 + 4 * q + 0] * rstd * g0.x; r0.y = o[j * 16 + 4 * q + 1] * rstd * g0.y; r0.z = o[j * 16 + 4 * q + 2] * rstd * g0.z; r0.w = o[j * 16 + 4 * q + 3] * rstd * g0.w;
                    *(float4*)(orow + c + 4 * q) = r0;
                }
            }
        }
    }
}

namespace pg {
struct Frag2 { bf16x8 k[2]; };
template <bool F8> struct FragT { typedef Frag2 T; };
template <> struct FragT<true> { typedef v8i32 T; };
constexpr int BM = 256, BK = 64, HALF = 128, HTB = HALF * BK * 2, STAGE_BYTES = 8 * HTB, NXCD = 8, WGM = 8;
__host__ __device__ __forceinline__ int lds_byte(int r, int c) { const int st = (r >> 4) * 2 + (c >> 5), rr = r & 15, cc = c & 31, ob = rr * 64 + cc * 2; return st * 1024 + (ob ^ (((ob >> 9) & 1) << 5)); }
__host__ __device__ __forceinline__ void stage_rc(int b, int& R, int& C) { const int st = b / 1024, sb = b % 1024, swz = sb ^ (((sb >> 9) & 1) << 5); R = (st >> 1) * 16 + swz / 64; C = (st & 1) * 32 + (swz % 64) / 2; }
__host__ __device__ __forceinline__ int perm32(int rho) { const int n = rho >> 4, i = rho & 15; return 8 * (i >> 2) + 4 * n + (i & 3); }
DEVI unsigned cvt_pk_bf16(float lo, float hi) { unsigned r; asm volatile("v_cvt_pk_bf16_f32 %0, %1, %2" : "=v"(r) : "v"(lo), "v"(hi)); return r; }

struct Unit { int pm, pn, e; };
constexpr int GT_OFF = STAGE_BYTES;
constexpr int UD_OFF = GT_OFF + 24 * 256 * 4;
constexpr int EO_OFF = UD_OFF + 32 * 16;
constexpr int MISC_OFF = EO_OFF + 136 * 4;
constexpr int LDS_TOTAL = MISC_OFF + 64;

struct ListOrder {
    const LAS int* ud; int nu;
    DEVI bool next(int i, Unit& u) const {
        if (i >= nu) return false;
        u.pm = __builtin_amdgcn_readfirstlane(ud[i * 4 + 0]); u.pn = __builtin_amdgcn_readfirstlane(ud[i * 4 + 1]); u.e = __builtin_amdgcn_readfirstlane(ud[i * 4 + 2]); return true;
    }
};
DEVI bool dense_unit(int nM, int nN, int G, int c, int i, Unit& u) {
    const int nwg = nM * nN; const long L = (long)i * G + c; if (L >= nwg) return false;
    int wgid = (int)L; { const int q = nwg / NXCD, r = nwg % NXCD, xcd = wgid % NXCD, off = wgid / NXCD; wgid = (xcd < r ? xcd * (q + 1) : r * (q + 1) + (xcd - r) * q) + off; }
    const int nig = WGM * nN, gid = wgid / nig, fm = gid * WGM, gsz = (nM - fm) < WGM ? (nM - fm) : WGM;
    u.pm = fm + ((wgid % nig) % gsz); u.pn = (wgid % nig) / gsz; u.e = 0; return true;
}
DEVI int fill_dense(LAS unsigned char* lds, int nM, int nN, int G, int c) {
    LAS int* ud = (LAS int*)(lds + UD_OFF); int nu = 0;
    for (int i = 0; i < 32; ++i) { Unit u; if (!dense_unit(nM, nN, G, c, i, u)) break; if (otid() == 0) { ud[i * 4 + 0] = u.pm; ud[i * 4 + 1] = u.pn; ud[i * 4 + 2] = 0; } ++nu; }
    return nu;
}

template <class Epi, bool GATHER, bool F8 = false>
DEVI void gemm_phase(LAS unsigned char* lds, const void* A, const void* Bt, int KB, size_t bgroup_bytes, const ListOrder& S, const Epi& E) {
    const int tid = otid();
    const int wid = __builtin_amdgcn_readfirstlane(tid >> 6), lane = tid & 63, wr = wid >> 2, wc = wid & 3, fr = lane & 15, fq = lane >> 4;
    const int nt = KB / 128;
    const LAS int* gtab = (const LAS int*)(lds + GT_OFF);
    unsigned voffA[2], voffB[2];
#pragma unroll
    for (int i = 0; i < 2; ++i) { int R, C; stage_rc(tid * 16 + i * 8192, R, C); const int Rb = Epi::B16 ? (64 * (R >> 5) + 16 * ((R & 15) >> 2) + 4 * ((R >> 4) & 1) + (R & 3)) : (Epi::PERM ? ((R & ~31) + perm32(R & 31)) : R);
        voffA[i] = GATHER ? (unsigned)(C * 2) : (unsigned)(R * KB + C * 2); voffB[i] = (unsigned)(Rb * KB + C * 2); }
    const size_t kstep = (size_t)(BK * 2);
    const size_t hstep = (size_t)HALF * KB;
    const size_t bhs = Epi::B16 ? (size_t)8 * KB : hstep;
    const size_t tstep = 2 * hstep;
    const unsigned ldsw = (unsigned)wid * 1024u;
    const int aoff = lds_byte(wr * 64 + fr, fq * 8); int boff = 4 * HTB + lds_byte(wc * 32 + fr, fq * 8); asm volatile("" : "+v"(boff));
#define PG_SA(b, h) (((b) * 2 + (h)) * HTB)
#define PG_SB(b, h) ((4 + (b) * 2 + (h)) * HTB)
#define PG_STAGE(bufoff, gbase, voff) do { _Pragma("unroll") for (int _i = 0; _i < 2; ++_i) \
        __builtin_amdgcn_global_load_lds((const unsigned*)((const char*)(gbase) + (voff)[_i]), (LAS unsigned*)(lds + (bufoff) + ldsw + _i * 8192), 16, 0, 0); } while (0)
#define PG_STAGE_A(bufoff, abase, h, goff) do { if constexpr (GATHER) { PG_STAGE(bufoff, abase, goff[h]); } else { PG_STAGE(bufoff, (abase) + (h) * hstep, voffA); } } while (0)
#define PG_LD1(dst, addr) do { if constexpr (F8) { const v4i32 lo_ = *(const LAS v4i32*)(lds + (addr)), hi_ = *(const LAS v4i32*)(lds + (addr) + 1024); dst = __builtin_shufflevector(lo_, hi_, 0, 1, 2, 3, 4, 5, 6, 7); } \
        else { dst.k[0] = *(const LAS bf16x8*)(lds + (addr)); dst.k[1] = *(const LAS bf16x8*)(lds + (addr) + 1024); } } while (0)
#define PG_LDA(dst, b, h) do { _Pragma("unroll") for (int m = 0; m < 4; ++m) PG_LD1(dst[m], PG_SA(b, h) + aoff + m * 2048); } while (0)
#define PG_LDB(dst, b, h) do { _Pragma("unroll") for (int n = 0; n < 2; ++n) PG_LD1(dst[n], boff + ((b) * 2 + (h)) * HTB + n * 2048); } while (0)
#define PG_MMA(ai, bj, At, Bt_) do { __builtin_amdgcn_s_setprio(1); _Pragma("unroll") for (int m = 0; m < 4; ++m) _Pragma("unroll") for (int n = 0; n < 2; ++n) { \
        if constexpr (F8) { asm volatile("v_mfma_scale_f32_16x16x128_f8f6f4 %0, %1, %2, %0, %3, %3 op_sel_hi:[0,0,0]" : "+v"(acc[ai][bj][m][n]) : "v"(Bt_[n]), "v"(At[m]), "v"(sc1)); } \
        else { _Pragma("unroll") for (int k = 0; k < 2; ++k) acc[ai][bj][m][n] = __builtin_amdgcn_mfma_f32_16x16x32_bf16(Bt_[n].k[k], At[m].k[k], acc[ai][bj][m][n], 0, 0, 0); } } \
        __builtin_amdgcn_s_setprio(0); } while (0)
#define PG_MMAZ(ai, bj, At, Bt_) do { __builtin_amdgcn_s_setprio(1); _Pragma("unroll") for (int m = 0; m < 4; ++m) _Pragma("unroll") for (int n = 0; n < 2; ++n) \
        asm volatile("v_mfma_scale_f32_16x16x128_f8f6f4 %0, %1, %2, 0, %3, %3 op_sel_hi:[0,0,0]" : "+v"(acc[ai][bj][m][n]) : "v"(Bt_[n]), "v"(At[m]), "v"(sc1)); \
        __builtin_amdgcn_s_setprio(0); } while (0)
#define PG_WAIT_V(n) asm volatile("s_waitcnt vmcnt(" #n ")" ::: "memory")
#define PG_WAIT_L(n) asm volatile("s_waitcnt lgkmcnt(" #n ")" ::: "memory")
#define PG_WAIT_VR(rl) do { if ((rl) == 0) PG_WAIT_V(8); else if ((rl) == 8) PG_WAIT_V(16); else if ((rl) == 16) PG_WAIT_V(24); else PG_WAIT_V(40); } while (0)
#define PG_BAR __builtin_amdgcn_s_barrier()
#define PG_SCHED __builtin_amdgcn_sched_barrier(0)
    Unit cur, nxt; int ui = 0, relax = 0;
    if (!S.next(0, cur)) return;
    int sc1 = 0x7F7F7F7F; asm volatile("" : "+v"(sc1));
    static_assert(F8, "the first-tile C = 0 form below is written for the fp8 MFMA");
    f32x4 acc[2][2][4][2];
#pragma unroll
    for (int a = 0; a < 2; ++a)
#pragma unroll
        for (int b = 0; b < 2; ++b)
#pragma unroll
            for (int m = 0; m < 4; ++m)
#pragma unroll
                for (int n = 0; n < 2; ++n) acc[a][b][m][n] = (f32x4){0.f, 0.f, 0.f, 0.f};
    typename FragT<F8>::T At[4], B0[2], B1[2];
    unsigned gC[2][2];
    auto gload = [&](int uidx, unsigned (&g)[2][2]) {
        const int tt = otid();
#pragma unroll
        for (int i = 0; i < 2; ++i) { int R, C; stage_rc(tt * 16 + i * 8192, R, C);
#pragma unroll
            for (int h = 0; h < 2; ++h) g[h][i] = (unsigned)gtab[uidx * 256 + h * HALF + R] * (unsigned)KB + (unsigned)(C * 2); }
    };
    if constexpr (GATHER) gload(0, gC);
    const char* cA = GATHER ? (const char*)A : (const char*)A + (size_t)cur.pm * tstep;
    const char* cB = (const char*)Bt + (size_t)cur.e * bgroup_bytes + (size_t)cur.pn * tstep;
    PG_STAGE(PG_SB(0, 0), cB, voffB); PG_STAGE(PG_SB(0, 1), cB + bhs, voffB); PG_STAGE_A(PG_SA(0, 0), cA, 0, gC); PG_STAGE_A(PG_SA(0, 1), cA, 1, gC);
    if (wr == 1) PG_BAR;
    PG_WAIT_V(2); PG_BAR;
    PG_STAGE(PG_SB(1, 0), cB + kstep, voffB); PG_STAGE_A(PG_SA(1, 0), cA + kstep, 0, gC); PG_STAGE(PG_SB(1, 1), cB + bhs + kstep, voffB);
    PG_WAIT_V(6); PG_BAR;
    for (;;) {
        const bool has_next = S.next(ui + 1, nxt);
        const char* nA = GATHER ? (const char*)A : (has_next ? (const char*)A + (size_t)nxt.pm * tstep : cA);
        const char* nB = has_next ? (const char*)Bt + (size_t)nxt.e * bgroup_bytes + (size_t)nxt.pn * tstep : cB;
#define PG_KITER(MMAX, WAITX, LASTX) do { \
            const bool last = LASTX; \
            const char* a1 = cA + (size_t)(t + 1) * kstep; \
            const char* a2 = last ? nA : cA + (size_t)(t + 2) * kstep; const char* b2 = last ? nB : cB + (size_t)(t + 2) * kstep; \
            const char* a3 = a2 + kstep; const char* b3 = b2 + kstep; \
            unsigned gS[2][2]; \
            if constexpr (GATHER) { \
                if (last && has_next) gload(ui + 1, gS); \
                else { gS[0][0] = gC[0][0]; gS[0][1] = gC[0][1]; gS[1][0] = gC[1][0]; gS[1][1] = gC[1][1]; } \
            } \
 \
            PG_LDB(B0, 0, 0); PG_LDB(B1, 0, 1); PG_SCHED; PG_LDA(At, 0, 0); PG_STAGE_A(PG_SA(1, 1), a1, 1, gC); \
            WAITX; PG_WAIT_L(0); PG_BAR; MMAX(0, 0, At, B0); MMAX(0, 1, At, B1); PG_BAR; PG_SCHED; \
 \
            PG_LDA(At, 0, 1); PG_STAGE(PG_SB(0, 0), b2, voffB); PG_STAGE(PG_SB(0, 1), b2 + bhs, voffB); PG_STAGE_A(PG_SA(0, 0), a2, 0, gS); \
            WAITX; PG_WAIT_L(0); PG_BAR; MMAX(1, 0, At, B0); MMAX(1, 1, At, B1); PG_BAR; PG_SCHED; \
 \
            PG_LDB(B0, 1, 0); PG_LDB(B1, 1, 1); PG_SCHED; PG_LDA(At, 1, 0); PG_STAGE_A(PG_SA(0, 1), a2, 1, gS); \
            PG_WAIT_V(8); PG_WAIT_L(0); PG_BAR; PG_MMA(0, 0, At, B0); PG_MMA(0, 1, At, B1); PG_BAR; PG_SCHED; \
 \
            PG_LDA(At, 1, 1); PG_STAGE(PG_SB(1, 0), b3, voffB); PG_STAGE(PG_SB(1, 1), b3 + bhs, voffB); PG_STAGE_A(PG_SA(1, 0), a3, 0, gS); \
            PG_WAIT_V(8); PG_WAIT_L(0); PG_BAR; PG_MMA(1, 0, At, B0); PG_MMA(1, 1, At, B1); PG_BAR; PG_SCHED; \
        } while (0)
        { const int t = 0; PG_KITER(PG_MMAZ, PG_WAIT_VR(relax), false); }
#pragma unroll 1
        for (int t = 2; t < nt; t += 2) { PG_KITER(PG_MMA, PG_WAIT_V(8), (t == nt - 2)); }
#undef PG_KITER
        if (wr == 0) PG_BAR;
        if constexpr (F8) asm volatile("s_nop 15\n\ts_nop 15" ::: "memory");
        E(acc, cur, ui, wr, wc, fr, fq); relax = E.nst(cur);
        if (!has_next) break;
        cur = nxt; cA = nA; cB = nB; ++ui;
        if constexpr (GATHER) gload(ui, gC);
        if (wr == 1) PG_BAR;
    }
    PG_WAIT_V(0);
    PG_BAR;
#undef PG_SA
#undef PG_SB
#undef PG_STAGE
#undef PG_STAGE_A
#undef PG_LDA
#undef PG_LDB
#undef PG_MMA
#undef PG_MMAZ
#undef PG_WAIT_V
#undef PG_WAIT_VR
#undef PG_WAIT_L
#undef PG_BAR
#undef PG_SCHED
}
}

constexpr size_t WT_AIN = WS_WT, WT_AOUT = WS_WT + 18 * MiB, WT_MIN = WS_WT + 26 * MiB, WT_MOUT = WS_WT + 51 * MiB, WT_W13 = WS_WT + 59 * MiB, WT_W2 = WS_WT + 579 * MiB;
constexpr int MINP = 6400;
constexpr float W13_SCALE = 64.f, W2_SCALE = 32.f;
static_assert(WT_W2 + (size_t)2 * 65 * 2 * MiB <= WS_END, "weight copies fit");
#define LDS_WAIT() asm volatile("s_waitcnt lgkmcnt(0)" ::: "memory")
struct CvtDesc { const float* W; unsigned char* dst; int ldw, dK; float sc; };
DEVI CvtDesc cvt_decode(const Params& p, int it) {
    constexpr int I_AIN = 16 * 144, I_AOUT = 16 * 64, I_MIN = 16 * 193, I_MOUT = 16 * 64;
    CvtDesc d; int r = it; d.sc = W13_SCALE; d.dK = D;
    const float *w_ain = p.attn_w_in, *w_aout = p.attn_w_out, *w_min = p.ml_w_in, *w_mout = p.ml_w_out, *w_e1 = p.exp_w1, *w_e3 = p.exp_w3, *w_e2 = p.exp_w2, *w_s1 = p.sh_w1, *w_s3 = p.sh_w3, *w_s2 = p.sh_w2;
    asm volatile("" : "+s"(w_ain), "+s"(w_aout), "+s"(w_min), "+s"(w_mout), "+s"(w_e1), "+s"(w_e3), "+s"(w_e2), "+s"(w_s1), "+s"(w_s3), "+s"(w_s2));
    if (r < I_AIN) { const int kb = r / 144, nb = r % 144; d.W = w_ain + (size_t)(128 * kb) * AIW + 32 * nb; d.ldw = AIW; d.dst = (unsigned char*)(p.ws + WT_AIN) + (size_t)(32 * nb) * D + 128 * kb; return d; } r -= I_AIN;
    if (r < I_AOUT) { const int kb = r / 64, nb = r % 64; d.W = w_aout + (size_t)(128 * kb) * D + 32 * nb; d.ldw = D; d.dst = (unsigned char*)(p.ws + WT_AOUT) + (size_t)(32 * nb) * D + 128 * kb; return d; } r -= I_AOUT;
    if (r < I_MIN) { const int kb = r / 193, nb = r % 193; d.W = w_min + (size_t)(128 * kb) * MIW + 32 * nb; d.ldw = MIW; d.dst = (unsigned char*)(p.ws + WT_MIN) + (size_t)(32 * nb) * D + 128 * kb; return d; } r -= I_MIN;
    if (r < I_MOUT) { const int kb = r / 64, nb = r % 64; d.W = w_mout + (size_t)(128 * kb) * D + 32 * nb; d.ldw = D; d.dst = (unsigned char*)(p.ws + WT_MOUT) + (size_t)(32 * nb) * D + 128 * kb; return d; } r -= I_MOUT;
    const int mat = r >> 8, ii = r & 255; const int l = mat / 195, q = mat % 195, e = q / 3, which = q % 3;
    if (which < 2) {
        const float* W = e < 64 ? (which == 0 ? w_e1 : w_e3) + ((size_t)l * 64 + e) * D * EDIM : (which == 0 ? w_s1 : w_s3) + (size_t)l * D * EDIM;
        const int kb = ii / 16, nb = ii % 16, n0 = 32 * nb;
        d.W = W + (size_t)(128 * kb) * EDIM + n0; d.ldw = EDIM;
        d.dst = (unsigned char*)(p.ws + WT_W13) + ((size_t)l * 65 + e) * 1024 * D + (size_t)((n0 >> 7) * 256 + which * 128 + (n0 & 127)) * D + 128 * kb;
    } else {
        const float* W = e < 64 ? w_e2 + ((size_t)l * 64 + e) * EDIM * D : w_s2 + (size_t)l * EDIM * D;
        const int kb = ii / 64, nb = ii % 64;
        d.W = W + (size_t)(128 * kb) * D + 32 * nb; d.ldw = D; d.dK = EDIM; d.sc = W2_SCALE;
        d.dst = (unsigned char*)(p.ws + WT_W2) + ((size_t)l * 65 + e) * D * EDIM + (size_t)(32 * nb) * EDIM + 128 * kb;
    }
    return d;
}
DEVI void ph_cvt(const Params& p, LAS unsigned char* lds, int vcu, int G) {
    const int tid = otid(), lane = tid & 63, wave = __builtin_amdgcn_readfirstlane(tid >> 6);
    LAS float* scr = (LAS float*)(lds + wave * 17408);
    const int gw = vcu * 8 + wave, NGW = G * 8;
    constexpr int NITEMS = 16 * 144 + 16 * 64 + 16 * 193 + 16 * 64 + 2 * 65 * 3 * 256;
    const int lr = lane >> 3, lc = (lane & 7) * 4;
    const int sn = lane >> 3, sc8 = lane & 7;
    if (gw < NITEMS) {
        int it = gw; CvtDesc dc = cvt_decode(p, it);
        typedef const __attribute__((address_space(1))) f32x4* GV4;
        f32x4 cur[16];
#pragma unroll
        for (int i = 0; i < 16; ++i) cur[i] = __builtin_nontemporal_load((GV4)(dc.W + (size_t)(lr + 8 * i) * dc.ldw + lc));
        for (;;) {
            const int nx = it + NGW; const CvtDesc dn = cvt_decode(p, nx < NITEMS ? nx : it);
            f32x4 nxt[16];
#pragma unroll
            for (int i = 0; i < 16; ++i) nxt[i] = __builtin_nontemporal_load((GV4)(dn.W + (size_t)(lr + 8 * i) * dn.ldw + lc));
#pragma unroll
            for (int i = 0; i < 16; ++i) { LAS float* sp = scr + (lr + 8 * i) * 33 + 4 * (i >> 1) + lc; sp[0] = cur[i][0] * dc.sc; sp[1] = cur[i][1] * dc.sc; sp[2] = cur[i][2] * dc.sc; sp[3] = cur[i][3] * dc.sc; }
            LDS_WAIT(); asm volatile("" ::: "memory");
#pragma unroll
            for (int j = 0; j < 4; ++j) { const int n = sn + 8 * j; const LAS float* sp = scr + (16 * sc8) * 33 + 4 * sc8 + n;
                u32x4 o;
#pragma unroll
                for (int q = 0; q < 4; ++q) o[q] = pk4_fp8(sp[(4 * q + 0) * 33], sp[(4 * q + 1) * 33], sp[(4 * q + 2) * 33], sp[(4 * q + 3) * 33]);
                *(u32x4*)(dc.dst + (size_t)n * dc.dK + 16 * sc8) = o; }
            LDS_WAIT(); asm volatile("" ::: "memory");
            if (nx >= NITEMS) break;
#pragma unroll
            for (int i = 0; i < 16; ++i) cur[i] = nxt[i];
            dc = dn; it = nx;
        }
    }
    { u32x4* z = (u32x4*)((unsigned char*)(p.ws + WT_MIN) + (size_t)MIW * D); const int n16 = (MINP - MIW) * D / 16;
      for (int i = vcu * 512 + tid; i < n16; i += G * 512) z[i] = (u32x4){0u, 0u, 0u, 0u}; }
}

typedef float f32x4e __attribute__((ext_vector_type(4)));
struct EpiBf16Store {
    static constexpr bool PERM = true, B16 = false;
    bf16* O; int ld; float* gates; int gate_pn; float sc;
    DEVI int nst(const pg::Unit& u) const { return u.pn == gate_pn ? 0 : 16; }
    DEVI void operator()(const f32x4 (&acc)[2][2][4][2], const pg::Unit& u, int ui, int wr, int wc, int fr, int fq) const {
        const int row0 = u.pm * 256 + wr * 64 + fr;
        if (u.pn == gate_pn) {
            if (wc == 0) {
#pragma unroll
                for (int ai = 0; ai < 2; ++ai)
#pragma unroll
                    for (int m = 0; m < 4; ++m) { float* gp = gates + (size_t)(row0 + ai * 128 + m * 16) * 32 + 8 * fq;
                        *(f32x4*)(gp) = acc[ai][0][m][0] * sc; *(f32x4*)(gp + 4) = acc[ai][0][m][1] * sc; }
            }
            return;
        }
        const int col0 = u.pn * 256 + wc * 32 + 8 * fq;
#pragma unroll
        for (int ai = 0; ai < 2; ++ai)
#pragma unroll
            for (int m = 0; m < 4; ++m) { bf16* rowp = O + (size_t)(row0 + ai * 128 + m * 16) * ld + col0;
#pragma unroll
                for (int bj = 0; bj < 2; ++bj) { const f32x4 v0 = acc[ai][bj][m][0] * sc, v1 = acc[ai][bj][m][1] * sc;
                    u32x4 w; w.x = pg::cvt_pk_bf16(v0[0], v0[1]); w.y = pg::cvt_pk_bf16(v0[2], v0[3]); w.z = pg::cvt_pk_bf16(v1[0], v1[1]); w.w = pg::cvt_pk_bf16(v1[2], v1[3]);
                    *(u32x4*)(rowp + bj * 128) = w; } }
    }
};
struct EpiSwiGLU {
    static constexpr bool PERM = true, B16 = false;
    bf16* ACT;
    DEVI int nst(const pg::Unit&) const { return 8; }
    DEVI void operator()(const f32x4 (&acc)[2][2][4][2], const pg::Unit& u, int ui, int wr, int wc, int fr, int fq) const {
        const int row0 = u.pm * 256 + wr * 64 + fr, col0 = u.pn * 128 + wc * 32 + 8 * fq;
#pragma unroll
        for (int ai = 0; ai < 2; ++ai)
#pragma unroll
            for (int m = 0; m < 4; ++m) {
                f32x4 o[2];
#pragma unroll
                for (int n = 0; n < 2; ++n) { const f32x4 a = acc[ai][0][m][n], b = acc[ai][1][m][n]; const f32x4 t = a * (-1.4426950408889634f / W13_SCALE);
                    f32x4 e; e[0] = __builtin_amdgcn_exp2f(t[0]); e[1] = __builtin_amdgcn_exp2f(t[1]); e[2] = __builtin_amdgcn_exp2f(t[2]); e[3] = __builtin_amdgcn_exp2f(t[3]);
                    const f32x4 d = e * (W13_SCALE * W13_SCALE) + (W13_SCALE * W13_SCALE);
                    f32x4 r; r[0] = __builtin_amdgcn_rcpf(d[0]); r[1] = __builtin_amdgcn_rcpf(d[1]); r[2] = __builtin_amdgcn_rcpf(d[2]); r[3] = __builtin_amdgcn_rcpf(d[3]);
                    o[n] = (a * b) * r; }
                uint2 w; w.x = pk4_fp8(o[0][0], o[0][1], o[0][2], o[0][3]); w.y = pk4_fp8(o[1][0], o[1][1], o[1][2], o[1][3]);
                *(uint2*)((unsigned char*)ACT + (size_t)(row0 + ai * 128 + m * 16) * EDIM + col0) = w; }
    }
};
constexpr float Y_SCALE = 8.f;
struct EpiScale {
    static constexpr bool PERM = true, B16 = true;
    unsigned char* Y; const LAS float* swt;
    DEVI int nst(const pg::Unit&) const { return 8; }
    DEVI void operator()(const f32x4 (&acc)[2][2][4][2], const pg::Unit& u, int ui, int wr, int wc, int fr, int fq) const {
        const int row0 = u.pm * 256 + wr * 64 + fr, col0 = u.pn * 256 + wc * 64 + 16 * fq;
#pragma unroll
        for (int ai = 0; ai < 2; ++ai)
#pragma unroll
            for (int m = 0; m < 4; ++m) { const int slot = row0 + ai * 128 + m * 16; const float w8 = swt[ui * 256 + wr * 64 + fr + ai * 128 + m * 16];
                const f32x4 a = acc[ai][0][m][0] * w8, b = acc[ai][0][m][1] * w8, c = acc[ai][1][m][0] * w8, d = acc[ai][1][m][1] * w8;
                u32x4 w; w.x = pk4_fp8(a[0], a[1], a[2], a[3]); w.y = pk4_fp8(b[0], b[1], b[2], b[3]); w.z = pk4_fp8(c[0], c[1], c[2], c[3]); w.w = pk4_fp8(d[0], d[1], d[2], d[3]);
                __builtin_nontemporal_store(w, (u32x4*)(Y + (size_t)slot * D + col0)); }
    }
};
struct EpiResid {
    static constexpr bool PERM = true, B16 = false;
    bf16* X; const float* modl;
    DEVI int nst(const pg::Unit&) const { return 16; }
    DEVI void operator()(const f32x4 (&acc)[2][2][4][2], const pg::Unit& u, int ui, int wr, int wc, int fr, int fq) const {
        const int bb = u.pm < 64 ? (u.pm >> 4) : 4;
        const float* gate = modl + (size_t)(bb * 6 + 2) * D;
        const int row0 = u.pm * 256 + wr * 64 + fr, col0 = u.pn * 256 + wc * 32 + 8 * fq;
        f32x4 gv[2][2];
#pragma unroll
        for (int bj = 0; bj < 2; ++bj)
#pragma unroll
            for (int n = 0; n < 2; ++n) gv[bj][n] = *(const f32x4*)(gate + col0 + bj * 128 + 4 * n) * (1.f / W13_SCALE);
        u32x4 xa[2], xb[2];
#define RLOAD(Xr, g) do { const size_t off_ = (size_t)(row0 + ((g) >> 2) * 128 + ((g) & 3) * 16) * D + col0; _Pragma("unroll") for (int bj = 0; bj < 2; ++bj) Xr[bj] = *(const u32x4*)(X + off_ + bj * 128); } while (0)
#define RMIX(w, a, b, ga, gb) pg::cvt_pk_bf16(__uint_as_float((w) << 16) + (ga) * (a), __uint_as_float((w) & 0xffff0000u) + (gb) * (b))
#define RSTORE(Xr, g) do { const size_t off_ = (size_t)(row0 + ((g) >> 2) * 128 + ((g) & 3) * 16) * D + col0; _Pragma("unroll") for (int bj = 0; bj < 2; ++bj) { \
            const f32x4 a0 = acc[(g) >> 2][bj][(g) & 3][0], a1 = acc[(g) >> 2][bj][(g) & 3][1]; u32x4 w; \
            w.x = RMIX(Xr[bj].x, a0[0], a0[1], gv[bj][0][0], gv[bj][0][1]); w.y = RMIX(Xr[bj].y, a0[2], a0[3], gv[bj][0][2], gv[bj][0][3]); \
            w.z = RMIX(Xr[bj].z, a1[0], a1[1], gv[bj][1][0], gv[bj][1][1]); w.w = RMIX(Xr[bj].w, a1[2], a1[3], gv[bj][1][2], gv[bj][1][3]); \
            *(u32x4*)(X + off_ + bj * 128) = w; } } while (0)
        RLOAD(xa, 0);
#pragma unroll
        for (int g = 0; g < 8; g += 2) {
            RLOAD(xb, g + 1); asm volatile("" ::: "memory");
            RSTORE(xa, g); asm volatile("" ::: "memory");
            if (g + 2 < 8) { RLOAD(xa, g + 2); asm volatile("" ::: "memory"); }
            RSTORE(xb, g + 1); asm volatile("" ::: "memory");
        }
#undef RLOAD
#undef RMIX
#undef RSTORE
    }
};

template <bool G1>
DEVI int moe_setup(const Params& p, LAS unsigned char* lds, int layer, int nrows, int vcu, int G) {
    LAS int* eo = (LAS int*)(lds + pg::EO_OFF); LAS int* ud = (LAS int*)(lds + pg::UD_OFF); LAS int* gt = (LAS int*)(lds + pg::GT_OFF);
    const int tid = otid(); const u32* cnt = (const u32*)(p.ws + WS_CTL) + CW_CNT + layer * 64 * CNT_PAD;
    LAS int* ec = eo + 68;
    if (tid < 64) { const int c_ = (int)cnt[tid * CNT_PAD]; const int pc = (c_ + 255) & ~255; const int incl = (int)wave_prefix_dpp((float)pc);
        ec[tid] = c_; eo[tid] = incl - pc; if (tid == 63) eo[64] = incl; }
    __syncthreads();
    constexpr int NT = G1 ? 4 : 8, CAP = G1 ? 16 : 24;
    const int PR = eo[64] >> 8, PS = nrows >> 8, total = (PR + PS) * NT;
    int nu = total > vcu ? (total - vcu + G - 1) / G : 0; if (nu > CAP) nu = CAP;
    if (tid < nu) {
        const int L = tid * G + vcu, pp = L / NT, pn = L % NT; int e = 64, pm = SH0 / 256 + (pp - PR);
        if (pp < PR) { pm = pp; e = 0; for (int i = 1; i < 64; ++i) if (eo[i] <= pp * 256) e = i; }
        ud[tid * 4 + 0] = pm; ud[tid * 4 + 1] = pn; ud[tid * 4 + 2] = e;
    }
    __syncthreads();
    if (G1) { const int* ltok = (const int*)(p.ws + WS_LTOK);
        for (int idx = tid; idx < nu * 256; idx += 512) { const int u_ = idx >> 8, slot = ud[u_ * 4] * 256 + (idx & 255), e = ud[u_ * 4 + 2];
            int t = slot - SH0; if (slot < SH0) { const int pos = slot - eo[e]; t = pos < ec[e] ? ltok[(size_t)e * MT + pos] : 0; } gt[idx] = t; } }
    else { const float* lw = (const float*)(p.ws + WS_LW); LAS float* st = (LAS float*)gt;
        for (int idx = tid; idx < nu * 256; idx += 512) { const int u_ = idx >> 8, slot = ud[u_ * 4] * 256 + (idx & 255), e = ud[u_ * 4 + 2];
            float w = 1.f; if (slot < SH0) { const int pos = slot - eo[e]; w = pos < ec[e] ? lw[(size_t)e * MT + pos] : 0.f; } st[idx] = w * (Y_SCALE / W2_SCALE); } }
    __syncthreads();
    return nu;
}

namespace fa {
typedef short s16x4 __attribute__((ext_vector_type(4)));
typedef float f32x16 __attribute__((ext_vector_type(16)));
constexpr int HD = 128, NW = 8, QBLK = 32, KVBLK = 64;
constexpr float SCALE = 0.088388347648318440f, THR = 8.f;
constexpr int SHM_V = KVBLK * HD * 2, SHM_K = KVBLK * HD * 2, SCR_OFF = 2 * SHM_V + 2 * SHM_K, BIAS_OFF = SCR_OFF + NW * 64 * 4, SHM_ATTN = BIAS_OFF + 512 * 4;
#define KSWZ(row, colB) ((row) * 256 + ((colB) ^ (((row) & 7) << 4)))
#define SBAR() __builtin_amdgcn_sched_barrier(0)
DEVI int crow(int r, int hi) { return (r & 3) + 8 * (r >> 2) + 4 * hi; }
DEVI unsigned cvtpk(float lo, float hi) { unsigned r; asm volatile("v_cvt_pk_bf16_f32 %0, %1, %2" : "=v"(r) : "v"(lo), "v"(hi)); return r; }
DEVI void partialSM(f32x16& p0, f32x16& p1, float& m_reg, float& mn, float& alpha) {
    constexpr float C = SCALE * 1.4426950408889634f;
    float pmax = p0[0];
#pragma unroll
    for (int r = 1; r < 16; ++r) pmax = fmaxf(pmax, p0[r]);
#pragma unroll
    for (int r = 0; r < 16; ++r) pmax = fmaxf(pmax, p1[r]);
    { auto rr = __builtin_amdgcn_permlane32_swap(__float_as_uint(pmax), __float_as_uint(pmax), false, false); pmax = fmaxf(__uint_as_float(rr[0]), __uint_as_float(rr[1])); }
    if (__builtin_expect(__all(pmax - m_reg <= THR / SCALE), 1)) { mn = m_reg; alpha = 1.f; }
    else { mn = fmaxf(m_reg, pmax); alpha = __builtin_amdgcn_exp2f((m_reg - mn) * C); m_reg = mn; }
    const float mnC = -mn * C;
#pragma unroll
    for (int r = 0; r < 16; ++r) p0[r] = fmaf(p0[r], C, mnC);
#pragma unroll
    for (int r = 0; r < 16; ++r) p1[r] = fmaf(p1[r], C, mnC);
#pragma unroll
    for (int r = 0; r < 16; ++r) p0[r] = __builtin_amdgcn_exp2f(p0[r]);
}
DEVI void finishSM(f32x16& p0, f32x16& p1, float alpha, float& l_reg, bf16x8& pa0, bf16x8& pa1, bf16x8& pa2, bf16x8& pa3) {
#pragma unroll
    for (int r = 0; r < 16; ++r) p1[r] = __builtin_amdgcn_exp2f(p1[r]);
    float ps = 0;
#pragma unroll
    for (int r = 0; r < 16; ++r) ps += p0[r];
#pragma unroll
    for (int r = 0; r < 16; ++r) ps += p1[r];
    { auto rr = __builtin_amdgcn_permlane32_swap(__float_as_uint(ps), __float_as_uint(ps), false, false); ps = __uint_as_float(rr[0]) + __uint_as_float(rr[1]); }
    l_reg = l_reg * alpha + ps;
#define PK4(P, BASE, OUT) do { unsigned a0 = cvtpk(P[BASE + 0], P[BASE + 1]), a1 = cvtpk(P[BASE + 2], P[BASE + 3]);   \
    unsigned b0 = cvtpk(P[BASE + 4], P[BASE + 5]), b1 = cvtpk(P[BASE + 6], P[BASE + 7]);                              \
    auto r0 = __builtin_amdgcn_permlane32_swap(a0, b0, false, false); auto r1 = __builtin_amdgcn_permlane32_swap(a1, b1, false, false); \
    u32x4 w = {r0[0], r1[0], r0[1], r1[1]}; OUT = *reinterpret_cast<bf16x8*>(&w); } while (0)
    PK4(p0, 0, pa0); PK4(p0, 8, pa1); PK4(p1, 0, pa2); PK4(p1, 8, pa3);
#undef PK4
}
DEVI void qkt(f32x16& p0, f32x16& p1, const char* Ks, const bf16x8* qr, int r32, int hi) {
    p0 = f32x16{}; p1 = f32x16{};
#pragma unroll
    for (int d0 = 0; d0 < 8; ++d0) { const int cb = (d0 * 16 + hi * 8) * 2;
        const bf16x8 b0 = *reinterpret_cast<const bf16x8*>(Ks + KSWZ(r32, cb));
        const bf16x8 b1 = *reinterpret_cast<const bf16x8*>(Ks + KSWZ(32 + r32, cb));
        p0 = __builtin_amdgcn_mfma_f32_32x32x16_bf16(b0, qr[d0], p0, 0, 0, 0);
        p1 = __builtin_amdgcn_mfma_f32_32x32x16_bf16(b1, qr[d0], p1, 0, 0, 0); }
}
DEVI int v_st(int k, int c) { const int kk = (k & ~0xC) | ((k & 4) << 1) | ((k & 8) >> 1); return ((kk >> 3) * 4 + (c >> 5)) * 512 + ((kk & 7) * 32 + (c & 31)) * 2; }
DEVI int v_rd_base(int lane) { return ((lane & 3) << 3) | (((lane >> 2) & 3) << 6) | (((lane >> 4) & 1) << 5) | (((lane >> 5) & 1) << 8); }
constexpr int v_rd_off(int d0, int ks, int half) { return d0 * 512 + ks * 4096 + half * 2048; }
template <int OFF> DEVI s16x4 tr_read(int vb) { s16x4 r; asm volatile("ds_read_b64_tr_b16 %0, %1 offset:%2" : "=&v"(r) : "v"(vb), "i"(OFF) : "memory"); return r; }
template <int D0> DEVI void pv_one(f32x16& od, int vb, bf16x8 pa0, bf16x8 pa1, bf16x8 pa2, bf16x8 pa3) {
    const s16x4 l0 = tr_read<v_rd_off(D0, 0, 0)>(vb), h0 = tr_read<v_rd_off(D0, 0, 1)>(vb), l1 = tr_read<v_rd_off(D0, 1, 0)>(vb), h1 = tr_read<v_rd_off(D0, 1, 1)>(vb);
    const s16x4 l2 = tr_read<v_rd_off(D0, 2, 0)>(vb), h2 = tr_read<v_rd_off(D0, 2, 1)>(vb), l3 = tr_read<v_rd_off(D0, 3, 0)>(vb), h3 = tr_read<v_rd_off(D0, 3, 1)>(vb);
    asm volatile("s_waitcnt lgkmcnt(0)" ::: "memory"); SBAR();
#define PK(L, H) (bf16x8){L[0], L[1], L[2], L[3], H[0], H[1], H[2], H[3]}
    od = __builtin_amdgcn_mfma_f32_32x32x16_bf16(pa0, PK(l0, h0), od, 0, 0, 0);
    od = __builtin_amdgcn_mfma_f32_32x32x16_bf16(pa1, PK(l1, h1), od, 0, 0, 0);
    od = __builtin_amdgcn_mfma_f32_32x32x16_bf16(pa2, PK(l2, h2), od, 0, 0, 0);
    od = __builtin_amdgcn_mfma_f32_32x32x16_bf16(pa3, PK(l3, h3), od, 0, 0, 0);
#undef PK
}
DEVI void pv_d0(f32x16* o, int vb, bf16x8 pa0, bf16x8 pa1, bf16x8 pa2, bf16x8 pa3) {
    pv_one<0>(o[0], vb, pa0, pa1, pa2, pa3); pv_one<1>(o[1], vb, pa0, pa1, pa2, pa3); pv_one<2>(o[2], vb, pa0, pa1, pa2, pa3); pv_one<3>(o[3], vb, pa0, pa1, pa2, pa3);
}
DEVI void na_mask(f32x16& p0, f32x16& p1, const float* brow, int cq, int hi) {
    const int cs = min(max(cq - 8, 0), 48);
    const float* bl = brow + (4 * hi - cq + 15);
    const int d0 = 4 * hi - cs;
#pragma unroll
    for (int r = 0; r < 16; ++r) {
        const int kc0 = (r & 3) + 8 * (r >> 2), kc1 = kc0 + 32;
        const bool ok0 = (unsigned)(kc0 + d0) < 16u, ok1 = (unsigned)(kc1 + d0) < 16u;
        const float b0 = bl[ok0 ? kc0 : 0], b1 = bl[ok1 ? kc1 : 0];
        p0[r] = ok0 ? p0[r] + b0 : -1e30f; p1[r] = ok1 ? p1[r] + b1 : -1e30f;
    }
}
DEVI void attn_unit(const bf16* __restrict__ Qb, const bf16* __restrict__ kc, const bf16* __restrict__ kl, int vdelta, int NT, unsigned char* __restrict__ Ob, char* lds) {
    constexpr int ldq = AIW, ldk = AIW, ldo = D; constexpr bool NA = false; const int tbase = 0, nwin = 64, krmin = 0, rq0 = 0; const float* rpb_h = nullptr;
    auto tile = [&](int t, const bf16*& kp, const bf16*& vp) { kp = t < 4 ? kc + (size_t)t * 64 * ldk : kl + (size_t)(tbase + min(t - 4, nwin - 1)) * 64 * ldk; vp = kp + vdelta; };
    const int tid = otid(), wid = tid >> 6, lane = tid & 63, r32 = lane & 31, hi = lane >> 5;
    char* V_lds = lds; char* K_lds = lds + 2 * SHM_V;
    float* wsc = (float*)(lds + SCR_OFF) + wid * 64; float* li_l = wsc; float* al_l = wsc + 32;
    float* btab = (float*)(lds + BIAS_OFF);
    float m_reg = -1e30f, l_reg = 0; f32x16 o[4] = {}; bf16x8 qr[8];
    const bf16* Qw = Qb + (size_t)(wid * QBLK + r32) * ldq + hi * 8;
#pragma unroll
    for (int d0 = 0; d0 < 8; ++d0) qr[d0] = *reinterpret_cast<const bf16x8*>(Qw + d0 * 16);
    if (NA) { for (int i = tid; i < 465; i += 512) btab[i] = rpb_h[i] * (1.f / SCALE); }
    const int sr = tid >> 4, sc = (tid & 15) * 8, vst0 = v_st(sr, sc), vst1 = v_st(32 + sr, sc);
    const int vb0 = (int)(uintptr_t)V_lds + v_rd_base(lane);
    const int rq = rq0 + (wid >> 1), cq = (wid & 1) * 32 + r32, kr0 = min(max(rq - 4, 0), 56);
    struct { bf16x8 vs0, vs1, ks0, ks1; } st_[2];
#define SLOAD(i, t) do { const bf16* kp_; const bf16* vp_; tile((t), kp_, vp_); \
    st_[i].vs0 = *reinterpret_cast<const bf16x8*>(vp_ + (size_t)sr * ldk + sc); st_[i].vs1 = *reinterpret_cast<const bf16x8*>(vp_ + (size_t)(32 + sr) * ldk + sc); \
    st_[i].ks0 = *reinterpret_cast<const bf16x8*>(kp_ + (size_t)sr * ldk + sc); st_[i].ks1 = *reinterpret_cast<const bf16x8*>(kp_ + (size_t)(32 + sr) * ldk + sc); } while (0)
#define SWRITE(b, i) do { *(bf16x8*)(V_lds + (b) * SHM_V + vst0) = st_[i].vs0; *(bf16x8*)(V_lds + (b) * SHM_V + vst1) = st_[i].vs1; const int kc = sc * 2; \
    *(bf16x8*)(K_lds + (b) * SHM_K + KSWZ(sr, kc)) = st_[i].ks0; *(bf16x8*)(K_lds + (b) * SHM_K + KSWZ(32 + sr, kc)) = st_[i].ks1; } while (0)
#define SWAIT() asm volatile("s_waitcnt vmcnt(4)" ::: "memory")
#define RESC(a) do { if (__any((a) < 1.f)) { if (hi == 0) al_l[r32] = (a); asm volatile("s_waitcnt lgkmcnt(0)" ::: "memory"); \
    _Pragma("unroll") for (int d = 0; d < 4; ++d) _Pragma("unroll") for (int r = 0; r < 16; ++r) o[d][r] *= al_l[crow(r, hi)]; } } while (0)
#define MASK(P0, P1, t) do { if (NA) { if ((t) >= 4) { const int kr_ = krmin + (t) - 4; const bool v_ = ((t) - 4 < nwin) && kr_ >= kr0 && kr_ <= kr0 + 7; (void)v_; } } } while (0)
    f32x16 pA0, pA1, pB0, pB1; float mnA, mnB, alA, alB; bf16x8 pa0, pa1, pa2, pa3;
    constexpr int SE = 0, SO = 1;
    SLOAD(SE, 0); asm volatile("s_waitcnt vmcnt(0)" ::: "memory"); SWRITE(0, SE); __syncthreads();
    qkt(pA0, pA1, K_lds, qr, r32, hi); MASK(pA0, pA1, 0); partialSM(pA0, pA1, m_reg, mnA, alA);
    SLOAD(SO, 1); SLOAD(SE, 2);
    SWAIT(); SWRITE(1, SO); __syncthreads();
    for (int j = 1; j + 1 < NT; j += 2) {
        SBAR(); qkt(pB0, pB1, K_lds + SHM_K, qr, r32, hi); MASK(pB0, pB1, j);
        finishSM(pA0, pA1, alA, l_reg, pa0, pa1, pa2, pa3); SBAR();
        SLOAD(SO, j + 2); SBAR();
        pv_d0(o, vb0, pa0, pa1, pa2, pa3); partialSM(pB0, pB1, m_reg, mnB, alB);
        __syncthreads(); SWAIT(); SWRITE(0, SE);
        RESC(alB); __syncthreads();
        SBAR(); qkt(pA0, pA1, K_lds, qr, r32, hi); MASK(pA0, pA1, j + 1);
        finishSM(pB0, pB1, alB, l_reg, pa0, pa1, pa2, pa3); SBAR();
        SLOAD(SE, min(j + 3, NT - 1)); SBAR();
        pv_d0(o, vb0 + SHM_V, pa0, pa1, pa2, pa3); partialSM(pA0, pA1, m_reg, mnA, alA);
        __syncthreads(); SWAIT(); SWRITE(1, SO);
        RESC(alA); __syncthreads();
    }
    SBAR(); qkt(pB0, pB1, K_lds + SHM_K, qr, r32, hi); MASK(pB0, pB1, NT - 1);
    finishSM(pA0, pA1, alA, l_reg, pa0, pa1, pa2, pa3); SBAR();
    pv_d0(o, vb0, pa0, pa1, pa2, pa3); partialSM(pB0, pB1, m_reg, mnB, alB);
    __syncthreads(); RESC(alB);
    finishSM(pB0, pB1, alB, l_reg, pa0, pa1, pa2, pa3); SBAR();
    pv_d0(o, vb0 + SHM_V, pa0, pa1, pa2, pa3);
    if (hi == 0) li_l[r32] = l_reg; asm volatile("s_waitcnt lgkmcnt(0)" ::: "memory");
#pragma unroll
    for (int r = 0; r < 16; ++r) { const int orow = crow(r, hi); const float rl = __builtin_amdgcn_rcpf(li_l[orow]);
#pragma unroll
        for (int d0 = 0; d0 < 4; ++d0) ((unsigned char*)Ob)[(size_t)(wid * QBLK + orow) * ldo + d0 * 32 + r32] = (unsigned char)(pk4_fp8(o[d0][r] * rl, 0.f, 0.f, 0.f) & 0xffu); }
    __syncthreads();
#undef SLOAD
#undef SWRITE
#undef SWAIT
#undef RESC
#undef MASK
}
DEVI void attn_unit_na(const bf16* __restrict__ Qb, const bf16* __restrict__ kc, const bf16* __restrict__ kl, int krmin, int nwin, int vdelta, unsigned char* __restrict__ Ob, char* lds, int rq0, const float* rpb_h) {
    constexpr int ldq = AIW, ldk = AIW, ldo = D;
    const int tid = otid(), wid = tid >> 6, lane = tid & 63, r32 = lane & 31, hi = lane >> 5;
    char* V_lds = lds; char* K_lds = lds + 2 * SHM_V;
    float* wsc = (float*)(lds + SCR_OFF) + wid * 64; float* li_l = wsc; float* al_l = wsc + 32;
    float* btab = (float*)(lds + BIAS_OFF);
    float m_reg = -1e30f, l_reg = 0; f32x16 o[4] = {}; bf16x8 qr[8];
    const bf16* Qw = Qb + (size_t)(wid * QBLK + r32) * ldq + hi * 8;
#pragma unroll
    for (int d0 = 0; d0 < 8; ++d0) qr[d0] = *reinterpret_cast<const bf16x8*>(Qw + d0 * 16);
    for (int i = tid; i < 465; i += 512) btab[i] = rpb_h[i] * (1.f / SCALE);
    const int sr = tid >> 4, sc = (tid & 15) * 8, vst0 = v_st(sr, sc), vst1 = v_st(32 + sr, sc);
    const int vb0 = (int)(uintptr_t)V_lds + v_rd_base(lane);
    const int rq = rq0 + (wid >> 1), cq = (wid & 1) * 32 + r32, kr0 = min(max(rq - 4, 0), 56);
    bf16x8 vs0, vs1, ks0, ks1;
    const int NT = 4 + nwin;
#define NLOAD(t) do { const bf16* kp_ = (t) < 4 ? kc + (size_t)(t) * 64 * ldk : kl + (size_t)(krmin + (t) - 4) * 64 * ldk; const bf16* vp_ = kp_ + vdelta; \
    vs0 = *reinterpret_cast<const bf16x8*>(vp_ + (size_t)sr * ldk + sc); vs1 = *reinterpret_cast<const bf16x8*>(vp_ + (size_t)(32 + sr) * ldk + sc); \
    ks0 = *reinterpret_cast<const bf16x8*>(kp_ + (size_t)sr * ldk + sc); ks1 = *reinterpret_cast<const bf16x8*>(kp_ + (size_t)(32 + sr) * ldk + sc); } while (0)
    NLOAD(0);
    for (int t = 0; t < NT; ++t) {
        __syncthreads();
        *(bf16x8*)(V_lds + vst0) = vs0; *(bf16x8*)(V_lds + vst1) = vs1;
        *(bf16x8*)(K_lds + KSWZ(sr, sc * 2)) = ks0; *(bf16x8*)(K_lds + KSWZ(32 + sr, sc * 2)) = ks1;
        __syncthreads();
        NLOAD(min(t + 1, NT - 1));
        const int kr = krmin + t - 4;
        if (t < 4 || (kr >= kr0 && kr <= kr0 + 7)) {
            f32x16 p0, p1; float mn, al; bf16x8 pa0, pa1, pa2, pa3;
            qkt(p0, p1, K_lds, qr, r32, hi);
            if (t >= 4) na_mask(p0, p1, btab + (kr - rq + 7) * 31, cq, hi);
            partialSM(p0, p1, m_reg, mn, al);
            if (__any(al < 1.f)) { if (hi == 0) al_l[r32] = al; asm volatile("s_waitcnt lgkmcnt(0)" ::: "memory");
#pragma unroll
                for (int d = 0; d < 4; ++d)
#pragma unroll
                    for (int r = 0; r < 16; ++r) o[d][r] *= al_l[crow(r, hi)]; }
            finishSM(p0, p1, al, l_reg, pa0, pa1, pa2, pa3);
            pv_d0(o, vb0, pa0, pa1, pa2, pa3);
        }
    }
#undef NLOAD
    if (hi == 0) li_l[r32] = l_reg; asm volatile("s_waitcnt lgkmcnt(0)" ::: "memory");
#pragma unroll
    for (int r = 0; r < 16; ++r) { const int orow = crow(r, hi); const float rl = __builtin_amdgcn_rcpf(li_l[orow]);
#pragma unroll
        for (int d0 = 0; d0 < 4; ++d0) ((unsigned char*)Ob)[(size_t)(wid * QBLK + orow) * ldo + d0 * 32 + r32] = (unsigned char)(pk4_fp8(o[d0][r] * rl, 0.f, 0.f, 0.f) & 0xffu); }
    __syncthreads();
}
}

namespace ml {
using fa::f32x16; using fa::s16x4;
constexpr int K_OFF = 0, KP_OFF = 16384, V_OFF = 32768, C2_OFF = 49152, GA_OFF = C2_OFF + 2 * 24576, DEN_OFF = GA_OFF + 3072, CF_OFF = DEN_OFF + 1024, ML_LDS = CF_OFF + 49152;
static_assert(ML_LDS <= 157 * 1024, "mLSTM LDS map");
constexpr int GA_STRIDE = 6 * 64 * 4;
DEVI int tokrow(int b, int dir, int c, int i) {
    return c >= 4 ? (b * SEQ + (dir ? (SEQ - 1 - ((c - 4) * 64 + i)) : ((c - 4) * 64 + i))) : (ML + b * CTXL + (dir ? (CTXL - 1 - (c * 64 + i)) : (c * 64 + i)));
}
template <int CTRL, int ROWMASK> DEVI float dpp_f(float ident, float src) {
    return __int_as_float(__builtin_amdgcn_update_dpp(__float_as_int(ident), __float_as_int(src), CTRL, ROWMASK, 0xf, false));
}
DEVI float prefix_sum64(float x, int) {
    x += dpp_f<0x111, 0xf>(0.f, x); x += dpp_f<0x112, 0xf>(0.f, x); x += dpp_f<0x114, 0xf>(0.f, x); x += dpp_f<0x118, 0xf>(0.f, x);
    x += dpp_f<0x142, 0xa>(0.f, x); x += dpp_f<0x143, 0xc>(0.f, x);
    return x;
}
DEVI float prefix_max64(float x, int) {
    const float ninf = -INFINITY;
    x = fmaxf(x, dpp_f<0x111, 0xf>(ninf, x)); x = fmaxf(x, dpp_f<0x112, 0xf>(ninf, x)); x = fmaxf(x, dpp_f<0x114, 0xf>(ninf, x)); x = fmaxf(x, dpp_f<0x118, 0xf>(ninf, x));
    x = fmaxf(x, dpp_f<0x142, 0xa>(ninf, x)); x = fmaxf(x, dpp_f<0x143, 0xc>(ninf, x));
    return x;
}
DEVI float lane63(float v) { return __int_as_float(__builtin_amdgcn_readlane(__float_as_int(v), 63)); }
DEVI float gate_chunk(float li, float f, float mprev, float* ga, int lane) {
    const float lf = fminf(f, 0.f) - log1pf(__expf(-fabsf(f)));
    const float bc = prefix_sum64(lf, lane), btot = lane63(bc);
    const float colt = li - bc, aend = btot + colt, pm = prefix_max64(colt, lane), amax = btot + lane63(pm), mnew = fmaxf(btot + mprev, amax);
    const float cm = fmaxf(mprev, pm);
    ga[lane] = __expf(aend - mnew) * QSCALE;
    ga[64 + lane] = colt;
    ga[128 + lane] = -cm;
    ga[192 + lane] = __expf(mprev - cm);
    ga[256 + lane] = __expf(-bc - cm);
    if (lane == 0) ga[320] = __expf(btot + mprev - mnew);
    return mnew;
}
DEVI void ph_mlstm(const Params& p, char* lds, int vcu, int G) {
    const int tid = otid(), wid = __builtin_amdgcn_readfirstlane(tid >> 6), lane = tid & 63, r32 = lane & 31, hi = lane >> 5;
    const bf16* Q = (const bf16*)(p.ws + WS_QKV); const float* Gt = (const float*)(p.ws + WS_G); bf16* HD = (bf16*)(p.ws + WS_HD);
    char* K_lds = lds + K_OFF; char* Kp_lds = lds + KP_OFF; char* V_lds = lds + V_OFF; char* C_lds = lds + C2_OFF;
    float* GA = (float*)(lds + GA_OFF); float* den_l = (float*)(lds + DEN_OFF) + (wid & 3) * 64;
    const int sr = tid >> 4, sc = (tid & 15) * 8;
    const int vr = tid >> 3, vc = (tid & 7) * 8;
    const int vbK = (int)(uintptr_t)Kp_lds + fa::v_rd_base(lane), vbV = (int)(uintptr_t)V_lds + fa::v_rd_base(lane);
    for (int item = vcu; item < 256; item += G) {
        const int b = item >> 6, h = (item >> 3) & 7, dir = (item >> 2) & 1, sl = item & 3;
        const float bi = p.ml_gate_b[dir * 8 + h], bf_ = p.ml_gate_b[(2 + dir) * 8 + h];
        __syncthreads();
        for (int i = tid; i < 16384 / 16; i += 512) ((u32x4*)(V_lds))[i] = (u32x4){0u, 0u, 0u, 0u};
        for (int i = tid; i < 24576 / 16; i += 512) ((u32x4*)(C_lds))[i] = (u32x4){0u, 0u, 0u, 0u};
        __syncthreads();
        if (tid < 64) *(bf16*)(V_lds + fa::v_st(tid, 64)) = (bf16)0x3F80;
        for (int i = tid; i < 49152 / 16; i += 512) ((u32x4*)(lds + CF_OFF))[i] = (u32x4){0u, 0u, 0u, 0u};
        float mprev = 0.f;
        if (wid == 4) { const int row = tokrow(b, dir, 0, lane); mprev = gate_chunk(Gt[(size_t)row * 32 + dir * 8 + h] + bi, Gt[(size_t)row * 32 + 16 + dir * 8 + h] + bf_, 0.f, GA, lane); }
        bf16x8 kr0, kr1, vreg, qr[8];
        { const int r0 = tokrow(b, dir, 0, sr), r1 = tokrow(b, dir, 0, sr + 32), r2 = tokrow(b, dir, 0, vr);
          kr0 = *(const bf16x8*)(Q + (size_t)r0 * MIWM + 1024 + h * 128 + sc); kr1 = *(const bf16x8*)(Q + (size_t)r1 * MIWM + 1024 + h * 128 + sc);
          vreg = *(const bf16x8*)(Q + (size_t)r2 * MIWM + 2048 + h * 256 + sl * 64 + vc); }
#pragma unroll
        for (int d0 = 0; d0 < 8; ++d0) qr[d0] = (bf16x8){0, 0, 0, 0, 0, 0, 0, 0};
        __syncthreads();
        auto chunk_loop = [&](auto role_, auto lat_, const int c_begin, const int c_end) __attribute__((always_inline)) {
            constexpr bool OUT = decltype(role_)::value, LATC = decltype(lat_)::value;
#pragma unroll 1
            for (int c = c_begin; c < c_end; ++c) {
                const bool lat = c >= 4;
                const float* ga = GA + (c & 1) * (GA_STRIDE / 4);
                {
                    *(bf16x8*)(K_lds + KSWZ(sr, sc * 2)) = kr0; *(bf16x8*)(K_lds + KSWZ(32 + sr, sc * 2)) = kr1;
                    const float w0 = ga[sr], w1 = ga[sr + 32];
                    u32x4 a = *(u32x4*)&kr0, bq = *(u32x4*)&kr1, oa, ob;
#define SC2(x, w) fa::cvtpk(__uint_as_float((x) << 16) * (w), __uint_as_float((x) & 0xffff0000u) * (w))
                    oa.x = SC2(a.x, w0); oa.y = SC2(a.y, w0); oa.z = SC2(a.z, w0); oa.w = SC2(a.w, w0);
                    ob.x = SC2(bq.x, w1); ob.y = SC2(bq.y, w1); ob.z = SC2(bq.z, w1); ob.w = SC2(bq.w, w1);
#undef SC2
                    *(u32x4*)(Kp_lds + fa::v_st(sr, sc)) = oa; *(u32x4*)(Kp_lds + fa::v_st(32 + sr, sc)) = ob;
                    *(bf16x8*)(V_lds + fa::v_st(vr, vc)) = vreg;
                }
                float gli, gf;
                {
                    const int cn = c + 1 < 68 ? c + 1 : 67;
                    const int r0 = tokrow(b, dir, cn, sr), r1 = tokrow(b, dir, cn, sr + 32), r2 = tokrow(b, dir, cn, vr);
                    kr0 = *(const bf16x8*)(Q + (size_t)r0 * MIWM + 1024 + h * 128 + sc); kr1 = *(const bf16x8*)(Q + (size_t)r1 * MIWM + 1024 + h * 128 + sc);
                    vreg = *(const bf16x8*)(Q + (size_t)r2 * MIWM + 2048 + h * 256 + sl * 64 + vc);
                    const int row = tokrow(b, dir, cn, lane); gli = Gt[(size_t)row * 32 + dir * 8 + h] + bi; gf = Gt[(size_t)row * 32 + 16 + dir * 8 + h] + bf_;
                }
                __syncthreads();
                const char* Cc = C_lds + (c & 1) * 24576;
                if constexpr (OUT) {
                    if constexpr (LATC) {
                        const int tq = wid >> 1, vq = wid & 1, t = tq * 32 + r32;
                        bf16x8 kf0[8], kf1[8], cfr[8];
#pragma unroll
                        for (int d0 = 0; d0 < 8; ++d0) { const int cb = (d0 * 16 + hi * 8) * 2;
                            kf0[d0] = *reinterpret_cast<const bf16x8*>(K_lds + KSWZ(r32, cb)); kf1[d0] = *reinterpret_cast<const bf16x8*>(K_lds + KSWZ(32 + r32, cb));
                            cfr[d0] = *reinterpret_cast<const bf16x8*>(Cc + KSWZ(vq * 32 + r32, cb)); }
                        asm volatile("s_waitcnt lgkmcnt(0)" ::: "memory"); SBAR();
                        f32x16 p0 = {}, p1 = {}, acc = {};
#pragma unroll
                        for (int d0 = 0; d0 < 8; ++d0) p0 = __builtin_amdgcn_mfma_f32_32x32x16_bf16(kf0[d0], qr[d0], p0, 0, 0, 0);
                        if (tq == 1) {
#pragma unroll
                            for (int d0 = 0; d0 < 8; ++d0) p1 = __builtin_amdgcn_mfma_f32_32x32x16_bf16(kf1[d0], qr[d0], p1, 0, 0, 0); }
#pragma unroll
                        for (int d0 = 0; d0 < 8; ++d0) acc = __builtin_amdgcn_mfma_f32_32x32x16_bf16(qr[d0], cfr[d0], acc, 0, 0, 0);
                        bf16x8 cfn[8];
#pragma unroll
                        for (int d0 = 0; d0 < 8; ++d0) cfn[d0] = *reinterpret_cast<const bf16x8*>(Cc + KSWZ(64 + r32, (d0 * 16 + hi * 8) * 2));
                        asm volatile("s_waitcnt lgkmcnt(0)" ::: "memory"); SBAR();
                        f32x16 qnacc = {};
#pragma unroll
                        for (int d0 = 0; d0 < 8; ++d0) qnacc = __builtin_amdgcn_mfma_f32_32x32x16_bf16(cfn[d0], qr[d0], qnacc, 0, 0, 0);
                        { const int cq = c + 1 < 68 ? c + 1 : 67; const bf16* Qw = Q + (size_t)tokrow(b, dir, cq, (wid >> 1) * 32 + r32) * MIWM + h * 128 + hi * 8;
#pragma unroll
                          for (int d0 = 0; d0 < 8; ++d0) qr[d0] = *(const bf16x8*)(Qw + d0 * 16); }
                        float ct0[16], ct1[16], wi[16];
#pragma unroll
                        for (int r = 0; r < 16; ++r) { const int s0 = fa::crow(r, hi); ct0[r] = ga[64 + s0]; ct1[r] = ga[64 + s0 + 32]; wi[r] = ga[192 + tq * 32 + s0]; }
                        const float rown = ga[128 + t] * 1.4426950408889634f, wint_t = ga[192 + t], emr_t = ga[256 + t];
                        asm volatile("s_waitcnt lgkmcnt(0)" ::: "memory"); SBAR();
                        float ps = 0.f;
#pragma unroll
                        for (int r = 0; r < 16; ++r) {
                            const int s0 = fa::crow(r, hi), s1 = s0 + 32;
                            const float e0 = __builtin_amdgcn_exp2f(fmaf(ct0[r], 1.4426950408889634f, rown)), e1 = __builtin_amdgcn_exp2f(fmaf(ct1[r], 1.4426950408889634f, rown));
                            p0[r] = s0 <= t ? p0[r] * QSCALE * e0 : 0.f; p1[r] = s1 <= t ? p1[r] * QSCALE * e1 : 0.f;
                            ps += p0[r] + p1[r];
                        }
                        { auto rr = __builtin_amdgcn_permlane32_swap(__float_as_uint(ps), __float_as_uint(ps), false, false); ps = __uint_as_float(rr[0]) + __uint_as_float(rr[1]); }
                        bf16x8 pa0, pa1, pa2, pa3;
#define PK4(P, BASE, OUT) do { unsigned a0 = fa::cvtpk(P[BASE + 0], P[BASE + 1]), a1 = fa::cvtpk(P[BASE + 2], P[BASE + 3]);   \
        unsigned b0 = fa::cvtpk(P[BASE + 4], P[BASE + 5]), b1 = fa::cvtpk(P[BASE + 6], P[BASE + 7]);                              \
        auto r0 = __builtin_amdgcn_permlane32_swap(a0, b0, false, false); auto r1 = __builtin_amdgcn_permlane32_swap(a1, b1, false, false); \
        u32x4 w = {r0[0], r1[0], r0[1], r1[1]}; OUT = *reinterpret_cast<bf16x8*>(&w); } while (0)
                        PK4(p0, 0, pa0); PK4(p0, 8, pa1); PK4(p1, 0, pa2); PK4(p1, 8, pa3);
                        float qn_ = qnacc[0];
                        { auto rr = __builtin_amdgcn_permlane32_swap(__float_as_uint(qn_), __float_as_uint(qn_), false, false); qn_ = __uint_as_float(rr[0]); }
                        const float den = wint_t * qn_ + ps;
                        if (hi == 0) den_l[r32] = fmaxf(fabsf(den), emr_t);
#pragma unroll
                        for (int r = 0; r < 16; ++r) acc[r] *= wi[r];
                        fa::pv_one<0>(acc, vbV + vq * 512, pa0, pa1, pa2, pa3);
                        float dl[16];
#pragma unroll
                        for (int r = 0; r < 16; ++r) dl[r] = den_l[fa::crow(r, hi)];
                        asm volatile("s_waitcnt lgkmcnt(0)" ::: "memory"); SBAR();
                        const long stepE = dir ? -(long)D : (long)D;
                        bf16* hb = HD + ((size_t)dir * ML + tokrow(b, dir, c, tq * 32 + 4 * hi)) * D + h * 256 + sl * 64 + vq * 32 + r32;
#pragma unroll
                        for (int r = 0; r < 16; ++r) hb[stepE * ((r & 3) + 8 * (r >> 2))] = f2bf(acc[r] * __builtin_amdgcn_rcpf(dl[r]));
                    }
                    if constexpr (!LATC) if (c == 3) { const bf16* Qw = Q + (size_t)tokrow(b, dir, c + 1, (wid >> 1) * 32 + r32) * MIWM + h * 128 + hi * 8;
#pragma unroll
                        for (int d0 = 0; d0 < 8; ++d0) qr[d0] = *(const bf16x8*)(Qw + d0 * 16); }
                } else {
                    const int kq = wid - 4; const float decay = ga[320];
                    f32x4* CF = (f32x4*)(lds + CF_OFF) + kq * 3 * 4 * 64 + lane;
                    f32x4 cfv[12]; s16x4 kt[8], vt[24];
#pragma unroll
                    for (int i = 0; i < 12; ++i) cfv[i] = CF[i * 64];
                    typedef short v4i16_t __attribute__((ext_vector_type(4)));
#define TRB(base, off) __builtin_bit_cast(s16x4, __builtin_amdgcn_ds_read_tr16_b64_v4i16((LAS v4i16_t*)(size_t)(unsigned)((base) + (off))))
                    const int ak = vbK + kq * 512;
#pragma unroll
                    for (int ks = 0; ks < 4; ++ks) { kt[2 * ks] = TRB(ak, fa::v_rd_off(0, ks, 0)); kt[2 * ks + 1] = TRB(ak, fa::v_rd_off(0, ks, 1)); }
#pragma unroll
                    for (int j = 0; j < 3; ++j)
#pragma unroll
                        for (int ks = 0; ks < 4; ++ks) { vt[8 * j + 2 * ks] = TRB(vbV, fa::v_rd_off(j, ks, 0)); vt[8 * j + 2 * ks + 1] = TRB(vbV, fa::v_rd_off(j, ks, 1)); }
#undef TRB
                    f32x16 cacc[3];
#pragma unroll
                    for (int j = 0; j < 3; ++j)
#pragma unroll
                        for (int r4 = 0; r4 < 4; ++r4) { const f32x4 v4 = cfv[j * 4 + r4] * decay; cacc[j][r4 * 4 + 0] = v4[0]; cacc[j][r4 * 4 + 1] = v4[1]; cacc[j][r4 * 4 + 2] = v4[2]; cacc[j][r4 * 4 + 3] = v4[3]; }
#define PKF(L, H) (bf16x8){L[0], L[1], L[2], L[3], H[0], H[1], H[2], H[3]}
#pragma unroll
                    for (int j = 0; j < 3; ++j)
#pragma unroll
                        for (int ks = 0; ks < 4; ++ks) cacc[j] = __builtin_amdgcn_mfma_f32_32x32x16_bf16(PKF(kt[2 * ks], kt[2 * ks + 1]), PKF(vt[8 * j + 2 * ks], vt[8 * j + 2 * ks + 1]), cacc[j], 0, 0, 0);
#undef PKF
                    char* Cn = C_lds + ((c + 1) & 1) * 24576;
#pragma unroll
                    for (int j = 0; j < 3; ++j) { bf16x8 f0, f1; PK4(cacc[j], 0, f0); PK4(cacc[j], 8, f1);
                        *(bf16x8*)(Cn + KSWZ(j * 32 + r32, (kq * 32 + hi * 8) * 2)) = f0; *(bf16x8*)(Cn + KSWZ(j * 32 + r32, (kq * 32 + 16 + hi * 8) * 2)) = f1; }
#pragma unroll
                    for (int j = 0; j < 3; ++j)
#pragma unroll
                        for (int r4 = 0; r4 < 4; ++r4) CF[(j * 4 + r4) * 64] = (f32x4){cacc[j][r4 * 4 + 0], cacc[j][r4 * 4 + 1], cacc[j][r4 * 4 + 2], cacc[j][r4 * 4 + 3]};
                    if (wid == 4 && c + 1 < 68) mprev = gate_chunk(gli, gf, mprev, GA + ((c + 1) & 1) * (GA_STRIDE / 4), lane);
                }
                __syncthreads();
            }
        };
        if (wid < 4) { chunk_loop(std::true_type{}, std::false_type{}, 0, 4);
            __builtin_amdgcn_s_waitcnt(0);
            chunk_loop(std::true_type{}, std::true_type{}, 4, 68); }
        else chunk_loop(std::false_type{}, std::false_type{}, 0, 68);
#undef PK4
    }
}
}

DEVI void ph_attn0(const Params& p, char* lds, int vcu, int G) {
    const bf16* Q = (const bf16*)(p.ws + WS_QKV); unsigned char* AO = (unsigned char*)(p.ws + WS_AO);
    const int nG = (512 - vcu + G - 1) / G, nC = vcu < 64 ? (64 - vcu + G - 1) / G : 0;
    for (int i = 0; i < 2 * nG + nC; ++i) {
        const bf16 *Qb, *kc, *kl; unsigned char* Ob; int tbase = 0, nwin = 64, vdelta, NT, rq0 = 0; bool na = false; const float* rpb = p.attn_rpb;
        if (i < nG) {
            const int u = vcu + i * G; int b, qh, qb;
            if (G == 256) { const int grp = vcu >> 5, idx = (vcu & 31) + 32 * i; b = grp >> 1; qh = (grp & 1) * 4 + (idx >> 4); qb = idx & 15; } else { b = u >> 7; qh = (u >> 4) & 7; qb = u & 15; }
            const int kvh = qh >> 2;
            kc = Q + (size_t)(ML + b * CTXL) * AIW + 4096 + kvh * 128; kl = Q + (size_t)(b * SEQ) * AIW + 4096 + kvh * 128; vdelta = 256; NT = 68;
            Qb = Q + (size_t)(b * SEQ + qb * 256) * AIW + 3072 + qh * 128; Ob = AO + (size_t)(b * SEQ + qb * 256) * D + 1024 + qh * 128;
        } else if (i < 2 * nG) {
            const int u = vcu + (i - nG) * G; const int b = u >> 7, h = (u >> 4) & 7, qb = u & 15;
            const int krmin = min(max(4 * qb - 4, 0), 56), krmax = min(max(4 * qb - 1, 0), 56) + 7;
            tbase = krmin; nwin = krmax - krmin + 1; NT = (4 + nwin + 1) & ~1; na = true; rq0 = 4 * qb; rpb = p.attn_rpb + h * 465;
            kc = Q + (size_t)(ML + b * CTXL) * AIW + 1024 + h * 128; kl = Q + (size_t)(b * SEQ) * AIW + 1024 + h * 128; vdelta = 1024;
            Qb = Q + (size_t)(b * SEQ + qb * 256) * AIW + h * 128; Ob = AO + (size_t)(b * SEQ + qb * 256) * D + h * 128;
        } else {
            const int u = vcu + (i - 2 * nG) * G; const int b = (u >> 3) & 3, hh = u & 7; const bool gq = u >= 32;
            const int qcol = gq ? 3072 + hh * 128 : hh * 128, kcol = gq ? 4096 + (hh >> 2) * 128 : 1024 + hh * 128, ocol = gq ? 1024 + hh * 128 : hh * 128;
            kc = Q + (size_t)(ML + b * CTXL) * AIW + kcol; kl = kc; vdelta = gq ? 256 : 1024; NT = 4;
            Qb = Q + (size_t)(ML + b * CTXL) * AIW + qcol; Ob = AO + (size_t)(ML + b * CTXL) * D + ocol;
        }
        if (na) fa::attn_unit_na(Qb, kc, kl, tbase, nwin, vdelta, Ob, lds, rq0, rpb); else fa::attn_unit(Qb, kc, kl, vdelta, NT, Ob, lds);
    }
}

DEVI unsigned cvtpk_s(float lo, float hi) { unsigned r; asm volatile("v_cvt_pk_bf16_f32 %0, %1, %2" : "=v"(r) : "v"(lo), "v"(hi)); return r; }
DEVI void ph_router_prep(const Params& p, float* lds, int vcu, int G) {
    const int tid = otid(), lane = tid & 63, wave = tid >> 6;
    bf16* RWP = (bf16*)(p.ws + WS_RWP); float* RC = (float*)(p.ws + WS_RC);
    for (int idx = vcu * 512 + tid; idx < 10 * 256 * 64; idx += G * 512) {
        const int e = idx & 63, kg = (idx >> 6) & 255, lb = idx >> 14, l = lb / 5, bb = lb % 5;
        const float* W = p.router_w + (size_t)l * D * NE + e; const float* gn = p.norm_ffn + l * D + kg * 8; const float* scl = modp(p, l, bb, 4) + kg * 8;
        float v[8]; unsigned hi[4], lo[4];
#pragma unroll
        for (int j = 0; j < 8; ++j) v[j] = gn[j] * (1.f + scl[j]) * W[(size_t)(kg * 8 + j) * NE];
#pragma unroll
        for (int j = 0; j < 4; ++j) { hi[j] = cvtpk_s(v[2 * j], v[2 * j + 1]); lo[j] = cvtpk_s(v[2 * j] - __uint_as_float(hi[j] << 16), v[2 * j + 1] - __uint_as_float(hi[j] & 0xffff0000u)); }
        bf16* dst = RWP + (((size_t)lb * 2 * 128 + (kg >> 1)) * 64 + e) * 16 + (kg & 1) * 8;
        *(u32x4*)dst = (u32x4){hi[0], hi[1], hi[2], hi[3]}; *(u32x4*)(dst + (size_t)128 * 64 * 16) = (u32x4){lo[0], lo[1], lo[2], lo[3]};
    }
    for (int c = vcu; c < 80; c += G) {
        const int lb = c % 10, sl = c / 10, l = lb / 5, bb = lb % 5; const float* W = p.router_w + (size_t)l * D * NE + lane; const float* sh = modp(p, l, bb, 3);
        float a = 0.f;
#pragma unroll 32
        for (int k = sl * 256 + wave * 32; k < sl * 256 + wave * 32 + 32; ++k) a += sh[k] * W[(size_t)k * NE];
        __syncthreads(); lds[wave * 64 + lane] = a; __syncthreads();
        if (wave == 0) { float t = 0.f; for (int w = 0; w < 8; ++w) t += lds[w * 64 + lane]; RC[(lb * 8 + sl) * 64 + lane] = t; }
    }
}
DEVI void ph_normr2(const Params& p, int layer, int nrows, float* lds, int vcu, int G) {
    using fa::f32x16;
    float* part = lds; float* ssq = lds + 8 * 4096; float* rstd_l = ssq + 256; float* sraw = rstd_l + 32; float* ssel = sraw + 2048; float* gsc = ssel + 2048;
    int* gsel = (int*)(gsc + 256); int* esel = gsel + 256; float* wsel = (float*)(esel + 256);
    LAS int* hist = (LAS int*)(wsel + 256); LAS int* hbase = hist + 64;
    const int tid = otid(), lane = tid & 63, wave = __builtin_amdgcn_readfirstlane(tid >> 6), r32 = lane & 31, kgp = lane >> 5;
    bf16* HB = (bf16*)(p.ws + WS_HB);
    int* eidx = (int*)(p.ws + WS_EIDX); float* ew = (float*)(p.ws + WS_EW); int* epos = (int*)(p.ws + WS_EPOS);
    u32* cnt = (u32*)(p.ws + WS_CTL) + CW_CNT + layer * 64 * CNT_PAD;
    const float* RB = p.router_b + layer * NE; const float* gain = p.norm_ffn + layer * D;
    LAS int* tq = hbase + 64;
    unsigned* tcnt = (unsigned*)(p.ws + WS_CTL) + CW_TQ + layer * 64;
    const int ntiles = nrows >> 5;
    if (tid == 0) tq[0] = (int)atomicAdd(tcnt, 1u);
    __syncthreads();
    int tile = __builtin_amdgcn_readfirstlane(tq[0]);
    while (tile < ntiles) {
        int nxt_reg = 0;
        const int m0 = tile * 32, bb = bidx(m0);
        const bf16* xbase = (const bf16*)(p.ws + WS_X) + (size_t)m0 * D;
        {
            LAS unsigned char* xs = (LAS unsigned char*)lds + wave * 16384;
            {
                const int rr_ = lane >> 5, cc = lane & 31;
                const unsigned char* xg = (const unsigned char*)xbase + (size_t)rr_ * (D * 2) + wave * 512 + cc * 16;
                u32x4 xv[16];
#pragma unroll
                for (int i = 0; i < 16; ++i) xv[i] = *(const u32x4*)(xg + (size_t)(2 * i) * (D * 2));
#pragma unroll
                for (int i = 0; i < 16; ++i) { const int row = 2 * i + rr_; *(LAS u32x4*)(xs + row * 512 + ((cc ^ row) & 31) * 16) = xv[i]; }
            }
            const bf16* wb = (const bf16*)(p.ws + WS_RWP) + (((size_t)(layer * 5 + bb) * 2 * 128 + wave * 16) * 64 + r32) * 16 + kgp * 8;
            f32x16 acc0 = {}, acc1 = {}; float ss = 0.f;
            bf16x8 wv[2][4][4];
#pragma unroll
            for (int t = 0; t < 4; ++t) { const bf16* w_ = wb + (size_t)t * 1024;
                wv[0][t][0] = *(const bf16x8*)(w_); wv[0][t][1] = *(const bf16x8*)(w_ + 512); wv[0][t][2] = *(const bf16x8*)(w_ + (size_t)128 * 1024); wv[0][t][3] = *(const bf16x8*)(w_ + (size_t)128 * 1024 + 512); }
            asm volatile("s_waitcnt lgkmcnt(0)" ::: "memory");
#pragma unroll
            for (int sb = 0; sb < 4; ++sb) {
                if (sb < 3) {
#pragma unroll
                    for (int t = 0; t < 4; ++t) { const bf16* w_ = wb + (size_t)((sb + 1) * 4 + t) * 1024;
                        wv[(sb + 1) & 1][t][0] = *(const bf16x8*)(w_); wv[(sb + 1) & 1][t][1] = *(const bf16x8*)(w_ + 512); wv[(sb + 1) & 1][t][2] = *(const bf16x8*)(w_ + (size_t)128 * 1024); wv[(sb + 1) & 1][t][3] = *(const bf16x8*)(w_ + (size_t)128 * 1024 + 512); }
                }
                u32x4 ahv[4];
#pragma unroll
                for (int t = 0; t < 4; ++t) { const int ch = 2 * (sb * 4 + t) + kgp; ahv[t] = *(const LAS u32x4*)(xs + r32 * 512 + ((ch ^ r32) & 31) * 16); }
#pragma unroll
                for (int t = 0; t < 4; ++t) {
                    const u32x4 ah = ahv[t];
#pragma unroll
                    for (int q = 0; q < 4; ++q) { const float a = __uint_as_float(ah[q] << 16), b = __uint_as_float(ah[q] & 0xffff0000u); ss += a * a + b * b; }
                    const bf16x8 Ah = __builtin_bit_cast(bf16x8, ah);
                    acc0 = __builtin_amdgcn_mfma_f32_32x32x16_bf16(Ah, wv[sb & 1][t][0], acc0, 0, 0, 0); acc1 = __builtin_amdgcn_mfma_f32_32x32x16_bf16(Ah, wv[sb & 1][t][1], acc1, 0, 0, 0);
                    acc0 = __builtin_amdgcn_mfma_f32_32x32x16_bf16(Ah, wv[sb & 1][t][2], acc0, 0, 0, 0); acc1 = __builtin_amdgcn_mfma_f32_32x32x16_bf16(Ah, wv[sb & 1][t][3], acc1, 0, 0, 0);
                }
            }
            { auto rr = __builtin_amdgcn_permlane32_swap(__float_as_uint(ss), __float_as_uint(ss), false, false); ss = __uint_as_float(rr[0]) + __uint_as_float(rr[1]); }
            if (kgp == 0) ssq[wave * 32 + r32] = ss;
#pragma unroll
            for (int r = 0; r < 16; ++r) { part[wave * 4096 + (0 * 16 + r) * 64 + lane] = acc0[r]; part[wave * 4096 + (1 * 16 + r) * 64 + lane] = acc1[r]; }
        }
        __syncthreads();
        if (tid == 0) nxt_reg = (int)atomicAdd(tcnt, 1u);
        if (tid < 32) { float t = 0.f; for (int w = 0; w < 8; ++w) t += ssq[w * 32 + tid]; rstd_l[tid] = rsqrtf(t * (1.f / D) + EPS); }
        __syncthreads();
        {
            if (tid < 64) hist[tid] = 0;
            const float* rc = (const float*)(p.ws + WS_RC) + (layer * 5 + bb) * 8 * 64;
            float rcsum = 0.f;
#pragma unroll
            for (int sl = 0; sl < 8; ++sl) rcsum += rc[sl * 64 + lane];
            const float rbe = RB[lane]; const int g = lane >> 3;
#define DPPF(x, ctrl) __int_as_float(__builtin_amdgcn_update_dpp(0, __float_as_int(x), ctrl, 0xf, 0xf, false))
#pragma unroll 1
            for (int q = 0; q < 4; ++q) {
                const int row = wave + 8 * q, rr = (row & 3) + 4 * (row >> 3), ll = (lane & 31) + 32 * ((row >> 2) & 1), eb = lane >> 5;
                float t = 0.f;
#pragma unroll
                for (int w = 0; w < 8; ++w) t += part[w * 4096 + (eb * 16 + rr) * 64 + ll];
                const float lg = t * rstd_l[row] + rcsum; const float sg = 1.f / (1.f + expf(-lg));
                const float v = sg + rbe;
                float m1 = v, m2 = -INFINITY;
                { const float o1 = DPPF(m1, 0xB1); m2 = fminf(m1, o1); m1 = fmaxf(m1, o1); }
                { const float o1 = DPPF(m1, 0x4E), o2 = DPPF(m2, 0x4E); m2 = fmaxf(fminf(m1, o1), fmaxf(m2, o2)); m1 = fmaxf(m1, o1); }
                { const float o1 = DPPF(m1, 0x141), o2 = DPPF(m2, 0x141); m2 = fmaxf(fminf(m1, o1), fmaxf(m2, o2)); m1 = fmaxf(m1, o1); }
                const float gs = m1 + m2;
                int grank = 0;
#pragma unroll
                for (int j = 0; j < 8; ++j) { const float sj = __int_as_float(__builtin_amdgcn_readlane(__float_as_int(gs), 8 * j)); grank += (sj > gs || (sj == gs && j < g)) ? 1 : 0; }
                float vm = grank < 4 ? v : -INFINITY;
#pragma unroll 1
                for (int r = 0; r < 8; ++r) {
                    const float mx = ml::lane63(ml::prefix_max64(vm, 0));
                    const unsigned long long bal = __ballot(vm == mx);
                    const int idx = __ffsll((long long)bal) - 1;
                    if (lane == idx) { esel[row * 8 + r] = lane; wsel[row * 8 + r] = sg; vm = -INFINITY; }
                }
            }
#undef DPPF
        }
        __syncthreads();
        int lrank = 0;
        if (tid < 256) lrank = __hip_atomic_fetch_add(hist + esel[tid], 1, __ATOMIC_RELAXED, __HIP_MEMORY_SCOPE_WORKGROUP);
        __syncthreads();
        if (tid < 64) { const int c_ = hist[tid]; hbase[tid] = c_ > 0 ? (int)atomicAdd(&cnt[tid * CNT_PAD], (u32)c_) : 0; }
        __syncthreads();
        if (tid < 256) {
            const int row = tid >> 3, k = tid & 7; float wsum = 0.f;
#pragma unroll
            for (int j = 0; j < 8; ++j) wsum += wsel[row * 8 + j];
            const int e = esel[tid]; const int mm = m0 + row;
            const int pos = hbase[e] + lrank;
            eidx[mm * 8 + k] = e; epos[mm * 8 + k] = pos;
            ((int*)(p.ws + WS_LTOK))[(size_t)e * MT + pos] = mm; ((float*)(p.ws + WS_LW))[(size_t)e * MT + pos] = wsel[tid] * (2.5f / wsum);
        }
        {
            const float* sh = modp(p, layer, bb, 3); const float* scl = modp(p, layer, bb, 4);
            const float rs0 = rstd_l[wave * 4 + 0], rs1 = rstd_l[wave * 4 + 1], rs2 = rstd_l[wave * 4 + 2], rs3 = rstd_l[wave * 4 + 3];
            const bf16* src = xbase + (size_t)(wave * 4) * D; unsigned char* dstb = (unsigned char*)HB + (size_t)(m0 + wave * 4) * D;
#pragma unroll 2
            for (int j = 0; j < 8; ++j) {
                const int c = 4 * lane + 256 * j;
                uint2 xv[4];
#pragma unroll
                for (int rr = 0; rr < 4; ++rr) xv[rr] = *(const uint2*)(src + (size_t)rr * D + c);
                const float4 g = *(const float4*)(gain + c), s1 = *(const float4*)(scl + c), s0 = *(const float4*)(sh + c);
                const float gx = g.x * (1.f + s1.x), gy = g.y * (1.f + s1.y), gz = g.z * (1.f + s1.z), gw_ = g.w * (1.f + s1.w);
#pragma unroll
                for (int rr = 0; rr < 4; ++rr) { const float rs = rr == 0 ? rs0 : rr == 1 ? rs1 : rr == 2 ? rs2 : rs3;
                    const float vx = __uint_as_float(xv[rr].x << 16), vy = __uint_as_float(xv[rr].x & 0xffff0000u), vz = __uint_as_float(xv[rr].y << 16), vw = __uint_as_float(xv[rr].y & 0xffff0000u);
                    *(u32*)(dstb + (size_t)rr * D + c) = pk4_fp8(vx * rs * gx + s0.x, vy * rs * gy + s0.y, vz * rs * gz + s0.z, vw * rs * gw_ + s0.w); }
            }
        }
        if (tid == 0) tq[1] = nxt_reg;
        __syncthreads();
        tile = __builtin_amdgcn_readfirstlane(tq[1]);
    }
}

enum Phase { PH_MODS = 0, PH_NORM0, PH_INPROJ0, PH_QKNORM, PH_ATTN0, PH_OUTPROJ0, PH_NORMR0, PH_DISP0, PH_G1_0, PH_G2_0, PH_COMB0,
             PH_INPROJ1, PH_MLSTM, PH_READOUT, PH_OUTPROJ1, PH_NORMR1, PH_DISP1, PH_G1_1, PH_G2_1, PH_COMB1, PH_COUNT };

#define XB_TMO      128
#define XB_XCNT(j)  (256  + 64 * (j))
#define XB_XSUB(j)  (1280 + 64 * (j))
#define XB_XGEN(j)  (2304 + 64 * (j))
#define XB_TOP      3328
#define XB_TOPGEN   3392
#define XCD_BAR_WORDS 3456
#define XB_SPIN_CAP (1u << 18)
__device__ __forceinline__ unsigned xb_ld(unsigned* p)              { return __hip_atomic_load(p, __ATOMIC_RELAXED, __HIP_MEMORY_SCOPE_AGENT); }
__device__ __forceinline__ unsigned xb_add(unsigned* p, unsigned v) { return __hip_atomic_fetch_add(p, v, __ATOMIC_RELAXED, __HIP_MEMORY_SCOPE_AGENT); }
__device__ __forceinline__ unsigned xb_xcc_id() { return (unsigned)__builtin_amdgcn_s_getreg((3 << 11) | 20) & 0xFu; }
#define XB_SPIN(cond, bar) do { unsigned _sp = 0; while (cond) { __builtin_amdgcn_s_sleep(1); \
    if ((++_sp & 255u) == 0u) { if (xb_ld(&(bar)[XB_TMO])) break; if (_sp > XB_SPIN_CAP) { atomicAdd(&(bar)[XB_TMO], 1u); break; } } } } while (0)
struct XcdBarrier { unsigned* bar; unsigned x; volatile LAS unsigned* st; };
__device__ __forceinline__ XcdBarrier xcd_barrier_post(unsigned* bar, volatile LAS unsigned* st) {
    XcdBarrier b; b.bar = bar; b.x = xb_xcc_id(); b.st = st;
    if (threadIdx.x == 0) (void)xb_add(&bar[XB_XCNT(b.x)], 1u);
    return b;
}
__device__ __forceinline__ void xcd_barrier_complete(unsigned* bar, unsigned x, unsigned& nloc, unsigned& nx) {
    const unsigned G = gridDim.x * gridDim.y * gridDim.z;
    unsigned sum, cnt, mine, sp = 0u;
    for (;;) {
        sum = 0u; cnt = 0u; mine = 0u;
#pragma unroll 1
        for (unsigned j = 0; j < 16; ++j) { const unsigned c = xb_ld(&bar[XB_XCNT(j)]); sum += c; cnt += (c > 0u) ? 1u : 0u; mine = (j == x) ? c : mine; }
        if (sum == G) break;
        __builtin_amdgcn_s_sleep(1);
        if ((++sp & 255u) == 0u) { if (xb_ld(&bar[XB_TMO])) break; if (sp > XB_SPIN_CAP) { atomicAdd(&bar[XB_TMO], 1u); break; } }
    }
    nloc = mine > 0u ? mine : 1u; nx = cnt > 0u ? cnt : 1u;
}
__device__ __forceinline__ void xcd_barrier(const XcdBarrier& b) {
    asm volatile("s_waitcnt vmcnt(0)" ::: "memory");
    __syncthreads();
    if (threadIdx.x == 0) {
        unsigned* bar = b.bar;
        __builtin_amdgcn_s_waitcnt(0);
        unsigned nloc = b.st[0], nx = b.st[1];
        if (nloc == 0u) { xcd_barrier_complete(bar, b.x, nloc, nx); b.st[0] = nloc; b.st[1] = nx; }
        const unsigned old = xb_add(&bar[XB_XSUB(b.x)], 1u);
        const unsigned gen = old / nloc;
        if (old + 1u == (gen + 1u) * nloc) {
            __builtin_amdgcn_fence(__ATOMIC_RELEASE, "agent");
            asm volatile("s_waitcnt vmcnt(0)" ::: "memory");
            const unsigned og = xb_add(&bar[XB_TOP], 1u);
            const unsigned tg = og / nx;
            if (og + 1u == (tg + 1u) * nx) xb_add(&bar[XB_TOPGEN], 1u);
            else XB_SPIN(xb_ld(&bar[XB_TOPGEN]) == tg, bar);
            __builtin_amdgcn_fence(__ATOMIC_ACQUIRE, "agent");
            xb_add(&bar[XB_XGEN(b.x)], 1u);
            asm volatile("s_waitcnt vmcnt(0)" ::: "memory");
        } else {
            XB_SPIN(xb_ld(&bar[XB_TOPGEN]) == gen, bar);
            __builtin_amdgcn_fence(__ATOMIC_ACQUIRE, "agent");
            asm volatile("s_waitcnt vmcnt(0)" ::: "memory");
        }
    }
    __syncthreads();
}
constexpr int CW_BAR = 4096;
static_assert((CW_BAR + XCD_BAR_WORDS) * 4 <= (int)CTL_BYTES, "barrier words inside the memset region");

typedef const __attribute__((address_space(4))) Params* KArgs;
#if defined(__HIP_DEVICE_COMPILE__)
DEVI Params kargs() { KArgs k = (KArgs)__builtin_amdgcn_kernarg_segment_ptr(); asm volatile("" : "+s"(k)); Params q; q.x = k->x; q.c = k->c; q.ctx = k->ctx; q.c_ctx = k->c_ctx; q.ada_w = k->ada_w; q.ada_b = k->ada_b; q.norm_mix = k->norm_mix; q.norm_ffn = k->norm_ffn; q.attn_w_in = k->attn_w_in; q.attn_w_out = k->attn_w_out; q.attn_rpb = k->attn_rpb; q.attn_q_gain = k->attn_q_gain; q.attn_k_gain = k->attn_k_gain; q.ml_w_in = k->ml_w_in; q.ml_w_out = k->ml_w_out; q.ml_gate_b = k->ml_gate_b; q.ml_head_gain = k->ml_head_gain; q.router_w = k->router_w; q.router_b = k->router_b; q.exp_w1 = k->exp_w1; q.exp_w3 = k->exp_w3; q.exp_w2 = k->exp_w2; q.sh_w1 = k->sh_w1; q.sh_w3 = k->sh_w3; q.sh_w2 = k->sh_w2; q.final_norm = k->final_norm; q.out = k->out; q.ws = k->ws; q.lo = k->lo; q.hi = k->hi; return q; }
#else
DEVI Params kargs() { return Params{}; }
#endif
constexpr int MEGA_LDS = 157 * 1024;
static_assert(pg::LDS_TOTAL <= MEGA_LDS, "LDS map");
__global__ void __launch_bounds__(512, 2) k_mega(Params p) {
    extern __shared__ __attribute__((aligned(16))) unsigned char lds_raw[];
    LAS unsigned char* lds = (LAS unsigned char*)lds_raw;
    float* ldsf = (float*)lds_raw;
    const int G = gridDim.x, bx = blockIdx.x;
    const int vcu = (G % 8 == 0) ? (bx % 8) * (G / 8) + bx / 8 : bx;
    if (threadIdx.x < 16) ((LAS unsigned*)(lds + pg::MISC_OFF))[threadIdx.x] = 0u;
    __syncthreads();
    XcdBarrier bar; bar.bar = (unsigned*)(p.ws + WS_CTL) + CW_BAR; bar.x = 0; bar.st = nullptr;
    if (p.hi - p.lo > 1) bar = xcd_barrier_post((unsigned*)(p.ws + WS_CTL) + CW_BAR, (volatile LAS unsigned*)(lds + pg::MISC_OFF));
#ifndef SITEMASK
#define SITEMASK 0xFFFFFu
#endif
#define INF(k) (p.lo <= (k) && (k) < p.hi)
#define INS(site, k) (((SITEMASK >> (site)) & 1u) && INF(k))
#ifdef PROBE_REP
#define REPF(k) for (int rep_ = 0; rep_ < (((k) == PROBE_REP) ? 2 : 1); ++rep_)
#else
#define REPF(k)
#endif
#define SEAM(k) do { if (INF(k) && INF((k) + 1)) xcd_barrier(bar); } while (0)
    REPF(PH_MODS) if (INS(PH_MODS, PH_MODS)) { const Params q = kargs(); __syncthreads(); ph_mods(q, ldsf, vcu, G); __syncthreads(); ph_cvt(q, lds, vcu, G); }
    SEAM(PH_MODS);
    REPF(PH_NORM0) if (INS(PH_NORM0, PH_NORM0)) { const Params q = kargs(); ph_norm(q, 0, q.x, q.ctx, q.norm_mix, 0, 1, MT, vcu, G); ph_router_prep(q, ldsf, vcu, G); }
    SEAM(PH_NORM0);
    for (int layer = 0; layer < 2; ++layer) {
        const int po = 9 * layer;
        REPF(PH_INPROJ0 + po) if (INS(PH_INPROJ0, PH_INPROJ0 + po)) {
            const Params q = kargs();
            const int nN = layer == 0 ? AIW / 256 : MINP / 256;
            const int nu = pg::fill_dense(lds, MT / 256, nN, G, bx);
            __syncthreads();
            pg::ListOrder S{(const LAS int*)(lds + pg::UD_OFF), nu};
            EpiBf16Store E{(bf16*)(q.ws + WS_QKV), layer == 0 ? AIW : MIWM, (float*)(q.ws + WS_G), layer == 0 ? -1 : MIWM / 256, 1.f / W13_SCALE};
            pg::gemm_phase<EpiBf16Store, false, true>(lds, q.ws + WS_HB, q.ws + (layer == 0 ? WT_AIN : WT_MIN), D, 0, S, E);
        }
        SEAM(PH_INPROJ0 + po);
        if (layer == 0) {
            REPF(PH_QKNORM) if (INS(PH_QKNORM, PH_QKNORM)) { const Params q = kargs(); ph_qknorm(q, vcu, G); }
            SEAM(PH_QKNORM);
            REPF(PH_ATTN0) if (INS(PH_ATTN0, PH_ATTN0)) { const Params q = kargs(); ph_attn0(q, (char*)lds_raw, vcu, G); }
            SEAM(PH_ATTN0);
        } else {
            REPF(PH_MLSTM) if (INS(PH_MLSTM, PH_MLSTM)) { const Params q = kargs(); ml::ph_mlstm(q, (char*)lds_raw, vcu, G); }
            SEAM(PH_MLSTM);
            REPF(PH_READOUT) if (INS(PH_READOUT, PH_READOUT)) { const Params q = kargs(); ph_readout(q, vcu, G); }
            SEAM(PH_READOUT);
        }
        REPF(PH_OUTPROJ0 + po) if (INS(PH_OUTPROJ0, PH_OUTPROJ0 + po)) {
            const Params q = kargs();
            const int nu = pg::fill_dense(lds, (layer == 0 ? MT : ML) / 256, D / 256, G, bx);
            __syncthreads();
            pg::ListOrder S{(const LAS int*)(lds + pg::UD_OFF), nu};
            EpiResid E{(bf16*)(q.ws + WS_X), (const float*)(q.ws + WS_MOD) + (size_t)layer * 5 * 6 * D};
            pg::gemm_phase<EpiResid, false, true>(lds, q.ws + WS_AO, q.ws + (layer == 0 ? WT_AOUT : WT_MOUT), D, 0, S, E);
        }
        SEAM(PH_OUTPROJ0 + po);
        REPF(PH_NORMR0 + po) if (INS(PH_NORMR0, PH_NORMR0 + po)) { const Params q = kargs(); ph_normr2(q, layer, layer == 0 ? MT : ML, ldsf, vcu, G); }
        SEAM(PH_NORMR0 + po);
        REPF(PH_G1_0 + po) if (INS(PH_G1_0, PH_G1_0 + po)) {
            const Params q = kargs();
            const int nu = moe_setup<true>(q, lds, layer, layer == 0 ? MT : ML, vcu, G);
            pg::ListOrder S{(const LAS int*)(lds + pg::UD_OFF), nu};
            EpiSwiGLU E{(bf16*)(q.ws + WS_ACT)};
            pg::gemm_phase<EpiSwiGLU, true, true>(lds, q.ws + WS_HB, q.ws + WT_W13 + (size_t)layer * 65 * 1024 * D, D, (size_t)1024 * D, S, E);
        }
        SEAM(PH_G1_0 + po);
        REPF(PH_G2_0 + po) if (INS(PH_G2_0, PH_G2_0 + po)) {
            const Params q = kargs();
            const int nu = moe_setup<false>(q, lds, layer, layer == 0 ? MT : ML, vcu, G);
            pg::ListOrder S{(const LAS int*)(lds + pg::UD_OFF), nu};
            EpiScale E{(unsigned char*)(q.ws + WS_Y), (const LAS float*)(lds + pg::GT_OFF)};
            pg::gemm_phase<EpiScale, false, true>(lds, q.ws + WS_ACT, q.ws + WT_W2 + (size_t)layer * 65 * D * EDIM, EDIM, (size_t)D * EDIM, S, E);
        }
        SEAM(PH_G2_0 + po);
        REPF(PH_COMB0 + po) if (INS(PH_COMB0, PH_COMB0 + po)) { const Params q = kargs(); ph_combine(q, layer, (int*)ldsf, vcu, G); }
        if (layer == 0) SEAM(PH_COMB0);
    }
#undef INF
#undef INS
#undef SEAM
}

#ifndef N_LAUNCH
#define N_LAUNCH 1
#endif
extern "C" void kernel_launch(void* const* d_in, const int* in_sizes, int n_in, void* d_out, int out_size, void* d_ws, size_t ws_size, hipStream_t stream) {
    static int grid = 0;
    if (grid == 0) {
        if (n_in != 26 || out_size != ML * D || ws_size < WS_END) { fprintf(stderr, "kernel_launch: unexpected shapes n_in %d out %d ws %zu\n", n_in, out_size, ws_size); grid = -1; return; }
        int dev = 0, cus = 0, per_cu = 0;
        if (hipGetDevice(&dev) != hipSuccess || hipDeviceGetAttribute(&cus, hipDeviceAttributeMultiprocessorCount, dev) != hipSuccess) { fprintf(stderr, "kernel_launch: device query failed\n"); grid = -1; return; }
        if (hipFuncSetAttribute((const void*)k_mega, hipFuncAttributeMaxDynamicSharedMemorySize, MEGA_LDS) != hipSuccess) { fprintf(stderr, "kernel_launch: hipFuncSetAttribute failed\n"); grid = -1; return; }
        if (hipOccupancyMaxActiveBlocksPerMultiprocessor(&per_cu, (const void*)k_mega, 512, MEGA_LDS) != hipSuccess || per_cu < 1) fprintf(stderr, "kernel_launch: note: occupancy query reports %d blocks per CU\n", per_cu);
        (void)hipGetLastError();
        grid = cus;
    }
    if (grid < 0) return;
    (void)hipMemsetAsync((char*)d_ws + WS_CTL, 0, CTL_BYTES, stream);
    Params p{};
    const float** pp = (const float**)&p;
    for (int i = 0; i < 26; ++i) pp[i] = (const float*)d_in[i];
    p.out = (float*)d_out; p.ws = (unsigned char*)d_ws;
#if N_LAUNCH == 1
    p.lo = 0; p.hi = PH_COUNT;
    hipLaunchKernelGGL(k_mega, dim3(grid), dim3(512), MEGA_LDS, stream, p);
#else
    for (int ph = 0; ph < PH_COUNT; ++ph) { p.lo = ph; p.hi = ph + 1; hipLaunchKernelGGL(k_mega, dim3(grid), dim3(512), MEGA_LDS, stream, p); }
#endif
    const hipError_t le = hipPeekAtLastError();
    if (le != hipSuccess) fprintf(stderr, "kernel_launch: launch failed: %s\n", hipGetErrorName(le));
}
```

```cpp
#include <hip/hip_runtime.h>
#include <cstdio>
#include <cstdint>
#include <type_traits>

#define DEVI __device__ __forceinline__
#define LAS __attribute__((address_space(3)))
typedef short bf16x8 __attribute__((ext_vector_type(8)));
typedef float f32x4 __attribute__((ext_vector_type(4)));
typedef unsigned u32x4 __attribute__((ext_vector_type(4)));
typedef int v4i32 __attribute__((ext_vector_type(4)));
typedef int v8i32 __attribute__((ext_vector_type(8)));
typedef unsigned short bf16;
typedef unsigned int u32;

constexpr int D = 2048, NB = 4, SEQ = 4096, CTXL = 256, GRIDW = 64;
constexpr int ML = NB * SEQ;
constexpr int MC = NB * CTXL;
constexpr int MT = ML + MC;
constexpr int AIW = 4608;
constexpr int MIW = 6176, MIWM = 6144;
constexpr int NE = 64, TOPK = 8, EDIM = 512;
constexpr int RS = MT * 8 + 64 * 256;
constexpr int SH0 = RS;
constexpr int NSLOT = RS + MT;
constexpr float EPS = 1e-6f;
constexpr float QSCALE = 0.08838834764831845f;

constexpr size_t MiB = (size_t)1 << 20;
constexpr size_t WS_CTL = 0, CTL_BYTES = 1 * MiB;
constexpr size_t WS_MOD = 1 * MiB;
constexpr size_t WS_XC = 2 * MiB;
constexpr size_t WS_G = 10 * MiB;
constexpr size_t WS_EIDX = 13 * MiB, WS_EW = 14 * MiB, WS_EPOS = 15 * MiB, WS_TSLOT = 16 * MiB, WS_STOK = 17 * MiB, WS_SW = 18 * MiB, WS_EOFF = 19 * MiB;
constexpr size_t WS_HB = 20 * MiB;
constexpr size_t WS_ACT = 88 * MiB;
constexpr size_t WS_Y = 257 * MiB;
constexpr size_t WS_QKV = 257 * MiB;
constexpr size_t WS_AO = 461 * MiB;
constexpr size_t WS_HD = 529 * MiB;
constexpr size_t WS_WT = 933 * MiB;
constexpr size_t WS_RWP = 1772 * MiB;
constexpr size_t WS_RC = 1777 * MiB;
constexpr size_t WS_LTOK = 1780 * MiB;
constexpr size_t WS_LW = 1785 * MiB;
constexpr size_t WS_X = 1790 * MiB;
constexpr size_t WS_END = 1858 * MiB;
constexpr int CW_TQ = 24576;
constexpr int CW_CNT = 16384, CNT_PAD = 32;

struct Params {
    const float *x, *c, *ctx, *c_ctx, *ada_w, *ada_b, *norm_mix, *norm_ffn, *attn_w_in, *attn_w_out, *attn_rpb, *attn_q_gain, *attn_k_gain,
        *ml_w_in, *ml_w_out, *ml_gate_b, *ml_head_gain, *router_w, *router_b, *exp_w1, *exp_w3, *exp_w2, *sh_w1, *sh_w3, *sh_w2, *final_norm;
    float* out; unsigned char* ws;
    int lo, hi;
};

DEVI int otid() { int t = threadIdx.x; asm volatile("" : "+v"(t)); return t; }
DEVI float bf2f(bf16 b) { return __uint_as_float(((u32)b) << 16); }
DEVI bf16 f2bf(float f) { u32 u = __float_as_uint(f); u += 0x7fffu + ((u >> 16) & 1u); return (bf16)(u >> 16); }
DEVI u32 pk2(float lo, float hi) { return (u32)f2bf(lo) | ((u32)f2bf(hi) << 16); }
DEVI float wave_sum(float v) {
#pragma unroll
    for (int o = 32; o >= 1; o >>= 1) v += __shfl_xor(v, o);
    return v;
}
DEVI unsigned pg_cvt_pk_bf16(float lo, float hi) { unsigned r; asm volatile("v_cvt_pk_bf16_f32 %0, %1, %2" : "=v"(r) : "v"(lo), "v"(hi)); return r; }
DEVI float wave_prefix_dpp(float x) {
#define WS_DPP(ctrl, rmask) x += __int_as_float(__builtin_amdgcn_update_dpp(0, __float_as_int(x), ctrl, rmask, 0xf, false))
    WS_DPP(0x111, 0xf); WS_DPP(0x112, 0xf); WS_DPP(0x114, 0xf); WS_DPP(0x118, 0xf); WS_DPP(0x142, 0xa); WS_DPP(0x143, 0xc);
#undef WS_DPP
    return x;
}
DEVI float wave_sum_dpp(float x) {
#define WS_DPP(ctrl, rmask) x += __int_as_float(__builtin_amdgcn_update_dpp(0, __float_as_int(x), ctrl, rmask, 0xf, false))
    WS_DPP(0x111, 0xf); WS_DPP(0x112, 0xf); WS_DPP(0x114, 0xf); WS_DPP(0x118, 0xf); WS_DPP(0x142, 0xa); WS_DPP(0x143, 0xc);
#undef WS_DPP
    return __int_as_float(__builtin_amdgcn_readlane(__float_as_int(x), 63));
}
DEVI u32 pk4_fp8(float a, float b, float c, float d) { int w = 0; w = __builtin_amdgcn_cvt_pk_fp8_f32(a, b, w, false); w = __builtin_amdgcn_cvt_pk_fp8_f32(c, d, w, true); return (u32)w; }
DEVI int bidx(int m) { return m < ML ? (m >> 12) : 4; }
DEVI const float* modp(const Params& p, int layer, int bb, int i) { return (const float*)(p.ws + WS_MOD) + ((size_t)((layer * 5 + bb) * 6 + i)) * D; }
DEVI float silu(float x) { return x / (1.f + __expf(-x)); }
DEVI float sigmoidf(float x) { return 1.f / (1.f + __expf(-x)); }

DEVI void ph_mods(const Params& p, float* lds, int vcu, int G) {
    float* sc = lds;
    float* red = lds + 5 * D;
    const int tid = otid();
    for (int i = tid; i < 5 * D; i += 512) { const int bb = i / D, k = i % D; const float v = bb < 4 ? p.c[bb * D + k] : p.c_ctx[k]; sc[i] = silu(v); }
    __syncthreads();
    const int tn = tid & 7, tk = tid >> 3;
    for (int item = vcu; item < 2 * 384; item += G) {
        const int l = item / 384, n0 = (item % 384) * 32;
        const float* W = p.ada_w + (size_t)l * D * 12288 + n0 + tn * 4;
        float4 acc[5];
#pragma unroll
        for (int b = 0; b < 5; ++b) acc[b] = make_float4(0.f, 0.f, 0.f, 0.f);
#pragma unroll 1
        for (int k8 = 0; k8 < 4; ++k8) {
            float4 w[8];
#pragma unroll
            for (int j = 0; j < 8; ++j) w[j] = *(const float4*)(W + (size_t)(tk * 32 + k8 * 8 + j) * 12288);
#pragma unroll
            for (int j = 0; j < 8; ++j) { const int k = tk * 32 + k8 * 8 + j;
#pragma unroll
                for (int b = 0; b < 5; ++b) { const float s_ = sc[b * D + k]; acc[b].x += s_ * w[j].x; acc[b].y += s_ * w[j].y; acc[b].z += s_ * w[j].z; acc[b].w += s_ * w[j].w; } }
        }
#pragma unroll
        for (int b = 0; b < 5; ++b) *(float4*)(red + (tk * 5 + b) * 32 + tn * 4) = acc[b];
        __syncthreads();
        if (tid < 160) {
            const int b = tid / 32, n = tid % 32; float s_ = 0.f;
            for (int g = 0; g < 64; ++g) s_ += red[(g * 5 + b) * 32 + n];
            ((float*)(p.ws + WS_MOD))[(size_t)(l * 5 + b) * 12288 + n0 + n] = s_ + p.ada_b[l * 12288 + n0 + n];
        }
        __syncthreads();
    }
}

DEVI void norm_row_load(const float* src, float4 (&v)[8], float& rstd, int lane) {
    float ss = 0.f;
#pragma unroll
    for (int j = 0; j < 8; ++j) { v[j] = *(const float4*)(src + 4 * lane + 256 * j); ss += v[j].x * v[j].x + v[j].y * v[j].y + v[j].z * v[j].z + v[j].w * v[j].w; }
    ss = wave_sum(ss);
    rstd = rsqrtf(ss * (1.f / D) + EPS);
}
DEVI void ph_norm(const Params& p, int layer, const float* xlat, const float* xctx, const float* gain, int ish, int isc, int nrows, int vcu, int G) {
    const int tid = otid(), lane = tid & 63, wave = tid >> 6;
    bf16* HB = (bf16*)(p.ws + WS_HB); bf16* X = (bf16*)(p.ws + WS_X);
    const int rot = (vcu * 8 + wave) & 7;
    for (int m0 = vcu * 8 + wave; m0 < nrows; m0 += 2 * G * 8) {
        const int mA = m0, mB = m0 + G * 8 < nrows ? m0 + G * 8 : m0;
        const float* srcA = mA < ML ? xlat + (size_t)mA * D : xctx + (size_t)(mA - ML) * D;
        const float* srcB = mB < ML ? xlat + (size_t)mB * D : xctx + (size_t)(mB - ML) * D;
        float4 vA[8], vB[8]; float ssA = 0.f, ssB = 0.f;
#pragma unroll
        for (int j = 0; j < 8; ++j) { vA[j] = *(const float4*)(srcA + 4 * lane + 256 * ((j + rot) & 7)); vB[j] = *(const float4*)(srcB + 4 * lane + 256 * ((j + rot) & 7)); }
#pragma unroll
        for (int j = 0; j < 8; ++j) { ssA += vA[j].x * vA[j].x + vA[j].y * vA[j].y + vA[j].z * vA[j].z + vA[j].w * vA[j].w; ssB += vB[j].x * vB[j].x + vB[j].y * vB[j].y + vB[j].z * vB[j].z + vB[j].w * vB[j].w; }
        const float rstdA = rsqrtf(wave_sum_dpp(ssA) * (1.f / D) + EPS), rstdB = rsqrtf(wave_sum_dpp(ssB) * (1.f / D) + EPS);
        const int bA = bidx(mA), bB = bidx(mB);
        const float* shA = modp(p, layer, bA, ish); const float* sclA = modp(p, layer, bA, isc); const float* shB = modp(p, layer, bB, ish); const float* sclB = modp(p, layer, bB, isc);
#pragma unroll
        for (int j = 0; j < 8; ++j) {
            const int c = 4 * lane + 256 * ((j + rot) & 7);
            const float4 g = *(const float4*)(gain + c), s1 = *(const float4*)(sclA + c), s0 = *(const float4*)(shA + c), t1 = *(const float4*)(sclB + c), t0 = *(const float4*)(shB + c);
            *(u32*)((unsigned char*)HB + (size_t)mA * D + c) = pk4_fp8(vA[j].x * rstdA * g.x * (1.f + s1.x) + s0.x, vA[j].y * rstdA * g.y * (1.f + s1.y) + s0.y, vA[j].z * rstdA * g.z * (1.f + s1.z) + s0.z, vA[j].w * rstdA * g.w * (1.f + s1.w) + s0.w);
            *(u32*)((unsigned char*)HB + (size_t)mB * D + c) = pk4_fp8(vB[j].x * rstdB * g.x * (1.f + t1.x) + t0.x, vB[j].y * rstdB * g.y * (1.f + t1.y) + t0.y, vB[j].z * rstdB * g.z * (1.f + t1.z) + t0.z, vB[j].w * rstdB * g.w * (1.f + t1.w) + t0.w);
            uint2 xw; xw.x = pk2(vA[j].x, vA[j].y); xw.y = pk2(vA[j].z, vA[j].w); *(uint2*)(X + (size_t)mA * D + c) = xw;
            uint2 yw; yw.x = pk2(vB[j].x, vB[j].y); yw.y = pk2(vB[j].z, vB[j].w); *(uint2*)(X + (size_t)mB * D + c) = yw;
        }
    }
}

DEVI void ph_qknorm(const Params& p, int vcu, int G) {
    const int tid = otid(), lane = tid & 63, wave = tid >> 6;
    bf16* Q = (bf16*)(p.ws + WS_QKV);
    const float invf = exp2f(-(float)(lane & 31) * (13.287712379549449f / 32.f));
    const float gq0 = p.attn_q_gain[2 * lane], gq1 = p.attn_q_gain[2 * lane + 1], gk0 = p.attn_k_gain[2 * lane], gk1 = p.attn_k_gain[2 * lane + 1];
    for (int m = vcu * 8 + wave; m < MT; m += G * 8) {
        bf16* ptr = Q + (size_t)m * AIW + 3072 + 2 * lane;
        u32 v[10];
#pragma unroll
        for (int hh = 0; hh < 10; ++hh) v[hh] = *(const u32*)(ptr + hh * 128);
        float sn = 0.f, cs = 1.f;
        if (m < ML) { const int sq = m & 4095; const float pos = lane < 32 ? (float)(sq >> 6) : (float)(sq & 63);
            sn = __sinf(pos * invf); cs = __cosf(pos * invf); }
#pragma unroll
        for (int hh = 0; hh < 10; ++hh) {
            float x0 = __uint_as_float(v[hh] << 16), x1 = __uint_as_float(v[hh] & 0xffff0000u);
            const float ss = wave_sum_dpp(x0 * x0 + x1 * x1); const float rstd = rsqrtf(ss * (1.f / 128.f) + EPS);
            x0 = x0 * rstd * (hh < 8 ? gq0 : gk0); x1 = x1 * rstd * (hh < 8 ? gq1 : gk1);
            const float y0 = x0 * cs - x1 * sn, y1 = x0 * sn + x1 * cs;
            *(u32*)(ptr + hh * 128) = pk2(y0, y1);
        }
    }
}

DEVI void ph_readout(const Params& p, int vcu, int G) {
    const int tid = otid(), lane = tid & 63, wave = tid >> 6;
    const bf16* HD = (const bf16*)(p.ws + WS_HD); const bf16* Q = (const bf16*)(p.ws + WS_QKV); bf16* AO = (bf16*)(p.ws + WS_AO);
    float4 g[8];
#pragma unroll
    for (int h = 0; h < 8; ++h) g[h] = *(const float4*)(p.ml_head_gain + h * 256 + 4 * lane);
    typedef unsigned u32x2_ __attribute__((ext_vector_type(2)));
    for (int m = vcu * 8 + wave; m < ML; m += G * 8) {
        u32x2_ a[8], b2[8], ov[8];
#pragma unroll
        for (int h = 0; h < 8; ++h) { const int c = h * 256 + 4 * lane;
            a[h] = __builtin_nontemporal_load((const u32x2_*)(HD + (size_t)m * D + c)); b2[h] = __builtin_nontemporal_load((const u32x2_*)(HD + ((size_t)ML + m) * D + c));
            ov[h] = __builtin_nontemporal_load((const u32x2_*)(Q + (size_t)m * MIWM + 4096 + c)); }
#pragma unroll
        for (int h = 0; h < 8; ++h) { const int c = h * 256 + 4 * lane;
            const float x[4] = {__uint_as_float(a[h].x << 16) + __uint_as_float(b2[h].x << 16), __uint_as_float(a[h].x & 0xffff0000u) + __uint_as_float(b2[h].x & 0xffff0000u),
                                __uint_as_float(a[h].y << 16) + __uint_as_float(b2[h].y << 16), __uint_as_float(a[h].y & 0xffff0000u) + __uint_as_float(b2[h].y & 0xffff0000u)};
            const float ss = wave_sum_dpp(x[0] * x[0] + x[1] * x[1] + x[2] * x[2] + x[3] * x[3]); const float rstd = rsqrtf(ss * (1.f / 256.f) + EPS);
            const float o0 = __uint_as_float(ov[h].x << 16), o1 = __uint_as_float(ov[h].x & 0xffff0000u), o2 = __uint_as_float(ov[h].y << 16), o3 = __uint_as_float(ov[h].y & 0xffff0000u);
            const float s0 = __builtin_amdgcn_rcpf(1.f + __expf(-o0)), s1 = __builtin_amdgcn_rcpf(1.f + __expf(-o1)), s2 = __builtin_amdgcn_rcpf(1.f + __expf(-o2)), s3 = __builtin_amdgcn_rcpf(1.f + __expf(-o3));
            *(u32*)((unsigned char*)AO + (size_t)m * D + c) = pk4_fp8(x[0] * rstd * g[h].x * s0, x[1] * rstd * g[h].y * s1, x[2] * rstd * g[h].z * s2, x[3] * rstd * g[h].w * s3);
        }
    }
}

DEVI void ph_combine(const Params& p, int layer, int* offl, int vcu, int G) {
    const int tid = otid(), lane = tid & 63, wave = tid >> 6;
    const unsigned char* Y = (const unsigned char*)(p.ws + WS_Y);
    unsigned char* HB = (unsigned char*)(p.ws + WS_HB); bf16* X = (bf16*)(p.ws + WS_X);
    const int nrows = layer == 0 ? MT : ML;
    {
        const u32* cnt = (const u32*)(p.ws + WS_CTL) + CW_CNT + layer * 64 * CNT_PAD;
        if (tid < 64) { const int c_ = (int)cnt[tid * CNT_PAD]; const int pc = (c_ + 255) & ~255; offl[64 + tid] = c_; offl[tid] = (int)wave_prefix_dpp((float)pc) - pc; }
        __syncthreads();
    }
    const int* eidx = (const int*)(p.ws + WS_EIDX); const int* epos = (const int*)(p.ws + WS_EPOS);
    for (int m = vcu * 8 + wave; m < nrows; m += G * 8) {
        bf16* xr = X + (size_t)m * D; float* orow = p.out + (size_t)m * D;
        const int bb = bidx(m); const float* g5 = modp(p, layer, bb, 5);
        int sl[9];
#pragma unroll
        for (int k = 0; k < 8; ++k) sl[k] = offl[eidx[m * 8 + k]] + epos[m * 8 + k];
        sl[8] = SH0 + m;
        u32x4 y[2][9], xv[2][2];
#pragma unroll
        for (int j = 0; j < 2; ++j) {
#pragma unroll
            for (int k = 0; k < 9; ++k) y[j][k] = __builtin_nontemporal_load((const u32x4*)(Y + (size_t)sl[k] * D + j * 1024 + lane * 16));
            xv[j][0] = *(const u32x4*)(xr + j * 1024 + lane * 16); xv[j][1] = *(const u32x4*)(xr + j * 1024 + lane * 16 + 8);
        }
        float o[32]; float ss = 0.f;
#pragma unroll
        for (int j = 0; j < 2; ++j) {
            const int c = j * 1024 + lane * 16;
            float f[16];
#pragma unroll
            for (int i = 0; i < 16; ++i) f[i] = 0.f;
#pragma unroll
            for (int k = 0; k < 9; ++k) {
                const unsigned yy[4] = {y[j][k].x, y[j][k].y, y[j][k].z, y[j][k].w};
#pragma unroll
                for (int q = 0; q < 4; ++q) { const auto lo = __builtin_amdgcn_cvt_pk_f32_fp8((int)yy[q], false), hi = __builtin_amdgcn_cvt_pk_f32_fp8((int)yy[q], true);
                    f[4 * q + 0] += lo[0]; f[4 * q + 1] += lo[1]; f[4 * q + 2] += hi[0]; f[4 * q + 3] += hi[1]; }
            }
            const unsigned xw[8] = {xv[j][0].x, xv[j][0].y, xv[j][0].z, xv[j][0].w, xv[j][1].x, xv[j][1].y, xv[j][1].z, xv[j][1].w};
#pragma unroll
            for (int q = 0; q < 4; ++q) {
                const float4 g0 = *(const float4*)(g5 + c + 4 * q);
                const float o0 = __uint_as_float(xw[2 * q] << 16) + g0.x * f[4 * q + 0] * (1.f / 8.f), o1 = __uint_as_float(xw[2 * q] & 0xffff0000u) + g0.y * f[4 * q + 1] * (1.f / 8.f);
                const float o2 = __uint_as_float(xw[2 * q + 1] << 16) + g0.z * f[4 * q + 2] * (1.f / 8.f), o3 = __uint_as_float(xw[2 * q + 1] & 0xffff0000u) + g0.w * f[4 * q + 3] * (1.f / 8.f);
                ss += o0 * o0 + o1 * o1 + o2 * o2 + o3 * o3;
                o[j * 16 + 4 * q + 0] = o0; o[j * 16 + 4 * q + 1] = o1; o[j * 16 + 4 * q + 2] = o2; o[j * 16 + 4 * q + 3] = o3;
            }
        }
        const float rstd = rsqrtf(wave_sum_dpp(ss) * (1.f / D) + EPS);
        const float* gain = layer == 0 ? p.norm_mix + D : p.final_norm;
        const float* sh = modp(p, 1, bb, 0); const float* scl = modp(p, 1, bb, 1);
#pragma unroll
        for (int j = 0; j < 2; ++j) {
            const int c = j * 1024 + lane * 16;
            if (layer == 0) {
                u32x4 w0, w1, ob;
#pragma unroll
                for (int q = 0; q < 4; ++q) {
                    const float4 g0 = *(const float4*)(gain + c + 4 * q), a0 = *(const float4*)(scl + c + 4 * q), b0 = *(const float4*)(sh + c + 4 * q);
                    const float x0 = o[j * 16 + 4 * q + 0], x1 = o[j * 16 + 4 * q + 1], x2 = o[j * 16 + 4 * q + 2], x3 = o[j * 16 + 4 * q + 3];
                    const unsigned p0 = pg_cvt_pk_bf16(x0, x1), p1 = pg_cvt_pk_bf16(x2, x3);
                    if (q < 2) { w0[2 * q] = p0; w0[2 * q + 1] = p1; } else { w1[2 * (q - 2)] = p0; w1[2 * (q - 2) + 1] = p1; }
                    ob[q] = pk4_fp8(x0 * rstd * g0.x * (1.f + a0.x) + b0.x, x1 * rstd * g0.y * (1.f + a0.y) + b0.y, x2 * rstd * g0.z * (1.f + a0.z) + b0.z, x3 * rstd * g0.w * (1.f + a0.w) + b0.w);
                }
                *(u32x4*)(xr + c) = w0; *(u32x4*)(xr + c + 8) = w1;
                *(u32x4*)(HB + (size_t)m * D + c) = ob;
            } else {
#pragma unroll
                for (int q = 0; q < 4; ++q) {
                    const float4 g0 = *(const float4*)(gain + c + 4 * q);
                    float4 r0; r0.x = o[j * 16 + 4 * q + 0] * rstd * g0.x; r0.y = o[j * 16 + 4 * q + 1] * rstd * g0.y; r0.z = o[j * 16 + 4 * q + 2] * rstd * g0.z; r0.w = o[j * 16 + 4 * q + 3] * rstd * g0.w;
                    *(float4*)(orow + c + 4 * q) = r0;
                }
            }
        }
    }
}

namespace pg {
struct Frag2 { bf16x8 k[2]; };
template <bool F8> struct FragT { typedef Frag2 T; };
template <> struct FragT<true> { typedef v8i32 T; };
constexpr int BM = 256, BK = 64, HALF = 128, HTB = HALF * BK * 2, STAGE_BYTES = 8 * HTB, NXCD = 8, WGM = 8;
__host__ __device__ __forceinline__ int lds_byte(int r, int c) { const int st = (r >> 4) * 2 + (c >> 5), rr = r & 15, cc = c & 31, ob = rr * 64 + cc * 2; return st * 1024 + (ob ^ (((ob >> 9) & 1) << 5)); }
__host__ __device__ __forceinline__ void stage_rc(int b, int& R, int& C) { const int st = b / 1024, sb = b % 1024, swz = sb ^ (((sb >> 9) & 1) << 5); R = (st >> 1) * 16 + swz / 64; C = (st & 1) * 32 + (swz % 64) / 2; }
__host__ __device__ __forceinline__ int perm32(int rho) { const int n = rho >> 4, i = rho & 15; return 8 * (i >> 2) + 4 * n + (i & 3); }
DEVI unsigned cvt_pk_bf16(float lo, float hi) { unsigned r; asm volatile("v_cvt_pk_bf16_f32 %0, %1, %2" : "=v"(r) : "v"(lo), "v"(hi)); return r; }

struct Unit { int pm, pn, e; };
constexpr int GT_OFF = STAGE_BYTES;
constexpr int UD_OFF = GT_OFF + 24 * 256 * 4;
constexpr int EO_OFF = UD_OFF + 32 * 16;
constexpr int MISC_OFF = EO_OFF + 136 * 4;
constexpr int LDS_TOTAL = MISC_OFF + 64;

struct ListOrder {
    const LAS int* ud; int nu;
    DEVI bool next(int i, Unit& u) const {
        if (i >= nu) return false;
        u.pm = __builtin_amdgcn_readfirstlane(ud[i * 4 + 0]); u.pn = __builtin_amdgcn_readfirstlane(ud[i * 4 + 1]); u.e = __builtin_amdgcn_readfirstlane(ud[i * 4 + 2]); return true;
    }
};
DEVI bool dense_unit(int nM, int nN, int G, int c, int i, Unit& u) {
    const int nwg = nM * nN; const long L = (long)i * G + c; if (L >= nwg) return false;
    int wgid = (int)L; { const int q = nwg / NXCD, r = nwg % NXCD, xcd = wgid % NXCD, off = wgid / NXCD; wgid = (xcd < r ? xcd * (q + 1) : r * (q + 1) + (xcd - r) * q) + off; }
    const int nig = WGM * nN, gid = wgid / nig, fm = gid * WGM, gsz = (nM - fm) < WGM ? (nM - fm) : WGM;
    u.pm = fm + ((wgid % nig) % gsz); u.pn = (wgid % nig) / gsz; u.e = 0; return true;
}
DEVI int fill_dense(LAS unsigned char* lds, int nM, int nN, int G, int c) {
    LAS int* ud = (LAS int*)(lds + UD_OFF); int nu = 0;
    for (int i = 0; i < 32; ++i) { Unit u; if (!dense_unit(nM, nN, G, c, i, u)) break; if (otid() == 0) { ud[i * 4 + 0] = u.pm; ud[i * 4 + 1] = u.pn; ud[i * 4 + 2] = 0; } ++nu; }
    return nu;
}

template <class Epi, bool GATHER, bool F8 = false>
DEVI void gemm_phase(LAS unsigned char* lds, const void* A, const void* Bt, int KB, size_t bgroup_bytes, const ListOrder& S, const Epi& E) {
    const int tid = otid();
    const int wid = __builtin_amdgcn_readfirstlane(tid >> 6), lane = tid & 63, wr = wid >> 2, wc = wid & 3, fr = lane & 15, fq = lane >> 4;
    const int nt = KB / 128;
    const LAS int* gtab = (const LAS int*)(lds + GT_OFF);
    unsigned voffA[2], voffB[2];
#pragma unroll
    for (int i = 0; i < 2; ++i) { int R, C; stage_rc(tid * 16 + i * 8192, R, C); const int Rb = Epi::B16 ? (64 * (R >> 5) + 16 * ((R & 15) >> 2) + 4 * ((R >> 4) & 1) + (R & 3)) : (Epi::PERM ? ((R & ~31) + perm32(R & 31)) : R);
        voffA[i] = GATHER ? (unsigned)(C * 2) : (unsigned)(R * KB + C * 2); voffB[i] = (unsigned)(Rb * KB + C * 2); }
    const size_t kstep = (size_t)(BK * 2);
    const size_t hstep = (size_t)HALF * KB;
    const size_t bhs = Epi::B16 ? (size_t)8 * KB : hstep;
    const size_t tstep = 2 * hstep;
    const unsigned ldsw = (unsigned)wid * 1024u;
    const int aoff = lds_byte(wr * 64 + fr, fq * 8); int boff = 4 * HTB + lds_byte(wc * 32 + fr, fq * 8); asm volatile("" : "+v"(boff));
#define PG_SA(b, h) (((b) * 2 + (h)) * HTB)
#define PG_SB(b, h) ((4 + (b) * 2 + (h)) * HTB)
#define PG_STAGE(bufoff, gbase, voff) do { _Pragma("unroll") for (int _i = 0; _i < 2; ++_i) \
        __builtin_amdgcn_global_load_lds((const unsigned*)((const char*)(gbase) + (voff)[_i]), (LAS unsigned*)(lds + (bufoff) + ldsw + _i * 8192), 16, 0, 0); } while (0)
#define PG_STAGE_A(bufoff, abase, h, goff) do { if constexpr (GATHER) { PG_STAGE(bufoff, abase, goff[h]); } else { PG_STAGE(bufoff, (abase) + (h) * hstep, voffA); } } while (0)
#define PG_LD1(dst, addr) do { if constexpr (F8) { const v4i32 lo_ = *(const LAS v4i32*)(lds + (addr)), hi_ = *(const LAS v4i32*)(lds + (addr) + 1024); dst = __builtin_shufflevector(lo_, hi_, 0, 1, 2, 3, 4, 5, 6, 7); } \
        else { dst.k[0] = *(const LAS bf16x8*)(lds + (addr)); dst.k[1] = *(const LAS bf16x8*)(lds + (addr) + 1024); } } while (0)
#define PG_LDA(dst, b, h) do { _Pragma("unroll") for (int m = 0; m < 4; ++m) PG_LD1(dst[m], PG_SA(b, h) + aoff + m * 2048); } while (0)
#define PG_LDB(dst, b, h) do { _Pragma("unroll") for (int n = 0; n < 2; ++n) PG_LD1(dst[n], boff + ((b) * 2 + (h)) * HTB + n * 2048); } while (0)
#define PG_MMA(ai, bj, At, Bt_) do { __builtin_amdgcn_s_setprio(1); _Pragma("unroll") for (int m = 0; m < 4; ++m) _Pragma("unroll") for (int n = 0; n < 2; ++n) { \
        if constexpr (F8) { asm volatile("v_mfma_scale_f32_16x16x128_f8f6f4 %0, %1, %2, %0, %3, %3 op_sel_hi:[0,0,0]" : "+v"(acc[ai][bj][m][n]) : "v"(Bt_[n]), "v"(At[m]), "v"(sc1)); } \
        else { _Pragma("unroll") for (int k = 0; k < 2; ++k) acc[ai][bj][m][n] = __builtin_amdgcn_mfma_f32_16x16x32_bf16(Bt_[n].k[k], At[m].k[k], acc[ai][bj][m][n], 0, 0, 0); } } \
        __builtin_amdgcn_s_setprio(0); } while (0)
#define PG_MMAZ(ai, bj, At, Bt_) do { __builtin_amdgcn_s_setprio(1); _Pragma("unroll") for (int m = 0; m < 4; ++m) _Pragma("unroll") for (int n = 0; n < 2; ++n) \
        asm volatile("v_mfma_scale_f32_16x16x128_f8f6f4 %0, %1, %2, 0, %3, %3 op_sel_hi:[0,0,0]" : "+v"(acc[ai][bj][m][n]) : "v"(Bt_[n]), "v"(At[m]), "v"(sc1)); \
        __builtin_amdgcn_s_setprio(0); } while (0)
#define PG_WAIT_V(n) asm volatile("s_waitcnt vmcnt(" #n ")" ::: "memory")
#define PG_WAIT_L(n) asm volatile("s_waitcnt lgkmcnt(" #n ")" ::: "memory")
#define PG_WAIT_VR(rl) do { if ((rl) == 0) PG_WAIT_V(8); else if ((rl) == 8) PG_WAIT_V(16); else if ((rl) == 16) PG_WAIT_V(24); else PG_WAIT_V(40); } while (0)
#define PG_BAR __builtin_amdgcn_s_barrier()
#define PG_SCHED __builtin_amdgcn_sched_barrier(0)
    Unit cur, nxt; int ui = 0, relax = 0;
    if (!S.next(0, cur)) return;
    int sc1 = 0x7F7F7F7F; asm volatile("" : "+v"(sc1));
    static_assert(F8, "the first-tile C = 0 form below is written for the fp8 MFMA");
    f32x4 acc[2][2][4][2];
#pragma unroll
    for (int a = 0; a < 2; ++a)
#pragma unroll
        for (int b = 0; b < 2; ++b)
#pragma unroll
            for (int m = 0; m < 4; ++m)
#pragma unroll
                for (int n = 0; n < 2; ++n) acc[a][b][m][n] = (f32x4){0.f, 0.f, 0.f, 0.f};
    typename FragT<F8>::T At[4], B0[2], B1[2];
    unsigned gC[2][2];
    auto gload = [&](int uidx, unsigned (&g)[2][2]) {
        const int tt = otid();
#pragma unroll
        for (int i = 0; i < 2; ++i) { int R, C; stage_rc(tt * 16 + i * 8192, R, C);
#pragma unroll
            for (int h = 0; h < 2; ++h) g[h][i] = (unsigned)gtab[uidx * 256 + h * HALF + R] * (unsigned)KB + (unsigned)(C * 2); }
    };
    if constexpr (GATHER) gload(0, gC);
    const char* cA = GATHER ? (const char*)A : (const char*)A + (size_t)cur.pm * tstep;
    const char* cB = (const char*)Bt + (size_t)cur.e * bgroup_bytes + (size_t)cur.pn * tstep;
    PG_STAGE(PG_SB(0, 0), cB, voffB); PG_STAGE(PG_SB(0, 1), cB + bhs, voffB); PG_STAGE_A(PG_SA(0, 0), cA, 0, gC); PG_STAGE_A(PG_SA(0, 1), cA, 1, gC);
    if (wr == 1) PG_BAR;
    PG_WAIT_V(2); PG_BAR;
    PG_STAGE(PG_SB(1, 0), cB + kstep, voffB); PG_STAGE_A(PG_SA(1, 0), cA + kstep, 0, gC); PG_STAGE(PG_SB(1, 1), cB + bhs + kstep, voffB);
    PG_WAIT_V(6); PG_BAR;
    for (;;) {
        const bool has_next = S.next(ui + 1, nxt);
        const char* nA = GATHER ? (const char*)A : (has_next ? (const char*)A + (size_t)nxt.pm * tstep : cA);
        const char* nB = has_next ? (const char*)Bt + (size_t)nxt.e * bgroup_bytes + (size_t)nxt.pn * tstep : cB;
#define PG_KITER(MMAX, WAITX, LASTX) do { \
            const bool last = LASTX; \
            const char* a1 = cA + (size_t)(t + 1) * kstep; \
            const char* a2 = last ? nA : cA + (size_t)(t + 2) * kstep; const char* b2 = last ? nB : cB + (size_t)(t + 2) * kstep; \
            const char* a3 = a2 + kstep; const char* b3 = b2 + kstep; \
            unsigned gS[2][2]; \
            if constexpr (GATHER) { \
                if (last && has_next) gload(ui + 1, gS); \
                else { gS[0][0] = gC[0][0]; gS[0][1] = gC[0][1]; gS[1][0] = gC[1][0]; gS[1][1] = gC[1][1]; } \
            } \
 \
            PG_LDB(B0, 0, 0); PG_LDB(B1, 0, 1); PG_SCHED; PG_LDA(At, 0, 0); PG_STAGE_A(PG_SA(1, 1), a1, 1, gC); \
            WAITX; PG_WAIT_L(0); PG_BAR; MMAX(0, 0, At, B0); MMAX(0, 1, At, B1); PG_BAR; PG_SCHED; \
 \
            PG_LDA(At, 0, 1); PG_STAGE(PG_SB(0, 0), b2, voffB); PG_STAGE(PG_SB(0, 1), b2 + bhs, voffB); PG_STAGE_A(PG_SA(0, 0), a2, 0, gS); \
            WAITX; PG_WAIT_L(0); PG_BAR; MMAX(1, 0, At, B0); MMAX(1, 1, At, B1); PG_BAR; PG_SCHED; \
 \
            PG_LDB(B0, 1, 0); PG_LDB(B1, 1, 1); PG_SCHED; PG_LDA(At, 1, 0); PG_STAGE_A(PG_SA(0, 1), a2, 1, gS); \
            PG_WAIT_V(8); PG_WAIT_L(0); PG_BAR; PG_MMA(0, 0, At, B0); PG_MMA(0, 1, At, B1); PG_BAR; PG_SCHED; \
 \
            PG_LDA(At, 1, 1); PG_STAGE(PG_SB(1, 0), b3, voffB); PG_STAGE(PG_SB(1, 1), b3 + bhs, voffB); PG_STAGE_A(PG_SA(1, 0), a3, 0, gS); \
            PG_WAIT_V(8); PG_WAIT_L(0); PG_BAR; PG_MMA(1, 0, At, B0); PG_MMA(1, 1, At, B1); PG_BAR; PG_SCHED; \
        } while (0)
        { const int t = 0; PG_KITER(PG_MMAZ, PG_WAIT_VR(relax), false); }
#pragma unroll 1
        for (int t = 2; t < nt; t += 2) { PG_KITER(PG_MMA, PG_WAIT_V(8), (t == nt - 2)); }
#undef PG_KITER
        if (wr == 0) PG_BAR;
        if constexpr (F8) asm volatile("s_nop 15\n\ts_nop 15" ::: "memory");
        E(acc, cur, ui, wr, wc, fr, fq); relax = E.nst(cur);
        if (!has_next) break;
        cur = nxt; cA = nA; cB = nB; ++ui;
        if constexpr (GATHER) gload(ui, gC);
        if (wr == 1) PG_BAR;
    }
    PG_WAIT_V(0);
    PG_BAR;
#undef PG_SA
#undef PG_SB
#undef PG_STAGE
#undef PG_STAGE_A
#undef PG_LDA
#undef PG_LDB
#undef PG_MMA
#undef PG_MMAZ
#undef PG_WAIT_V
#undef PG_WAIT_VR
#undef PG_WAIT_L
#undef PG_BAR
#undef PG_SCHED
}
}

constexpr size_t WT_AIN = WS_WT, WT_AOUT = WS_WT + 18 * MiB, WT_MIN = WS_WT + 26 * MiB, WT_MOUT = WS_WT + 51 * MiB, WT_W13 = WS_WT + 59 * MiB, WT_W2 = WS_WT + 579 * MiB;
constexpr int MINP = 6400;
constexpr float W13_SCALE = 64.f, W2_SCALE = 32.f;
static_assert(WT_W2 + (size_t)2 * 65 * 2 * MiB <= WS_END, "weight copies fit");
#define LDS_WAIT() asm volatile("s_waitcnt lgkmcnt(0)" ::: "memory")
struct CvtDesc { const float* W; unsigned char* dst; int ldw, dK; float sc; };
DEVI CvtDesc cvt_decode(const Params& p, int it) {
    constexpr int I_AIN = 16 * 144, I_AOUT = 16 * 64, I_MIN = 16 * 193, I_MOUT = 16 * 64;
    CvtDesc d; int r = it; d.sc = W13_SCALE; d.dK = D;
    const float *w_ain = p.attn_w_in, *w_aout = p.attn_w_out, *w_min = p.ml_w_in, *w_mout = p.ml_w_out, *w_e1 = p.exp_w1, *w_e3 = p.exp_w3, *w_e2 = p.exp_w2, *w_s1 = p.sh_w1, *w_s3 = p.sh_w3, *w_s2 = p.sh_w2;
    asm volatile("" : "+s"(w_ain), "+s"(w_aout), "+s"(w_min), "+s"(w_mout), "+s"(w_e1), "+s"(w_e3), "+s"(w_e2), "+s"(w_s1), "+s"(w_s3), "+s"(w_s2));
    if (r < I_AIN) { const int kb = r / 144, nb = r % 144; d.W = w_ain + (size_t)(128 * kb) * AIW + 32 * nb; d.ldw = AIW; d.dst = (unsigned char*)(p.ws + WT_AIN) + (size_t)(32 * nb) * D + 128 * kb; return d; } r -= I_AIN;
    if (r < I_AOUT) { const int kb = r / 64, nb = r % 64; d.W = w_aout + (size_t)(128 * kb) * D + 32 * nb; d.ldw = D; d.dst = (unsigned char*)(p.ws + WT_AOUT) + (size_t)(32 * nb) * D + 128 * kb; return d; } r -= I_AOUT;
    if (r < I_MIN) { const int kb = r / 193, nb = r % 193; d.W = w_min + (size_t)(128 * kb) * MIW + 32 * nb; d.ldw = MIW; d.dst = (unsigned char*)(p.ws + WT_MIN) + (size_t)(32 * nb) * D + 128 * kb; return d; } r -= I_MIN;
    if (r < I_MOUT) { const int kb = r / 64, nb = r % 64; d.W = w_mout + (size_t)(128 * kb) * D + 32 * nb; d.ldw = D; d.dst = (unsigned char*)(p.ws + WT_MOUT) + (size_t)(32 * nb) * D + 128 * kb; return d; } r -= I_MOUT;
    const int mat = r >> 8, ii = r & 255; const int l = mat / 195, q = mat % 195, e = q / 3, which = q % 3;
    if (which < 2) {
        const float* W = e < 64 ? (which == 0 ? w_e1 : w_e3) + ((size_t)l * 64 + e) * D * EDIM : (which == 0 ? w_s1 : w_s3) + (size_t)l * D * EDIM;
        const int kb = ii / 16, nb = ii % 16, n0 = 32 * nb;
        d.W = W + (size_t)(128 * kb) * EDIM + n0; d.ldw = EDIM;
        d.dst = (unsigned char*)(p.ws + WT_W13) + ((size_t)l * 65 + e) * 1024 * D + (size_t)((n0 >> 7) * 256 + which * 128 + (n0 & 127)) * D + 128 * kb;
    } else {
        const float* W = e < 64 ? w_e2 + ((size_t)l * 64 + e) * EDIM * D : w_s2 + (size_t)l * EDIM * D;
        const int kb = ii / 64, nb = ii % 64;
        d.W = W + (size_t)(128 * kb) * D + 32 * nb; d.ldw = D; d.dK = EDIM; d.sc = W2_SCALE;
        d.dst = (unsigned char*)(p.ws + WT_W2) + ((size_t)l * 65 + e) * D * EDIM + (size_t)(32 * nb) * EDIM + 128 * kb;
    }
    return d;
}
DEVI void ph_cvt(const Params& p, LAS unsigned char* lds, int vcu, int G) {
    const int tid = otid(), lane = tid & 63, wave = __builtin_amdgcn_readfirstlane(tid >> 6);
    LAS float* scr = (LAS float*)(lds + wave * 17408);
    const int gw = vcu * 8 + wave, NGW = G * 8;
    constexpr int NITEMS = 16 * 144 + 16 * 64 + 16 * 193 + 16 * 64 + 2 * 65 * 3 * 256;
    const int lr = lane >> 3, lc = (lane & 7) * 4;
    const int sn = lane >> 3, sc8 = lane & 7;
    if (gw < NITEMS) {
        int it = gw; CvtDesc dc = cvt_decode(p, it);
        typedef const __attribute__((address_space(1))) f32x4* GV4;
        f32x4 cur[16];
#pragma unroll
        for (int i = 0; i < 16; ++i) cur[i] = __builtin_nontemporal_load((GV4)(dc.W + (size_t)(lr + 8 * i) * dc.ldw + lc));
        for (;;) {
            const int nx = it + NGW; const CvtDesc dn = cvt_decode(p, nx < NITEMS ? nx : it);
            f32x4 nxt[16];
#pragma unroll
            for (int i = 0; i < 16; ++i) nxt[i] = __builtin_nontemporal_load((GV4)(dn.W + (size_t)(lr + 8 * i) * dn.ldw + lc));
#pragma unroll
            for (int i = 0; i < 16; ++i) { LAS float* sp = scr + (lr + 8 * i) * 33 + 4 * (i >> 1) + lc; sp[0] = cur[i][0] * dc.sc; sp[1] = cur[i][1] * dc.sc; sp[2] = cur[i][2] * dc.sc; sp[3] = cur[i][3] * dc.sc; }
            LDS_WAIT(); asm volatile("" ::: "memory");
#pragma unroll
            for (int j = 0; j < 4; ++j) { const int n = sn + 8 * j; const LAS float* sp = scr + (16 * sc8) * 33 + 4 * sc8 + n;
                u32x4 o;
#pragma unroll
                for (int q = 0; q < 4; ++q) o[q] = pk4_fp8(sp[(4 * q + 0) * 33], sp[(4 * q + 1) * 33], sp[(4 * q + 2) * 33], sp[(4 * q + 3) * 33]);
                *(u32x4*)(dc.dst + (size_t)n * dc.dK + 16 * sc8) = o; }
            LDS_WAIT(); asm volatile("" ::: "memory");
            if (nx >= NITEMS) break;
#pragma unroll
            for (int i = 0; i < 16; ++i) cur[i] = nxt[i];
            dc = dn; it = nx;
        }
    }
    { u32x4* z = (u32x4*)((unsigned char*)(p.ws + WT_MIN) + (size_t)MIW * D); const int n16 = (MINP - MIW) * D / 16;
      for (int i = vcu * 512 + tid; i < n16; i += G * 512) z[i] = (u32x4){0u, 0u, 0u, 0u}; }
}

typedef float f32x4e __attribute__((ext_vector_type(4)));
struct EpiBf16Store {
    static constexpr bool PERM = true, B16 = false;
    bf16* O; int ld; float* gates; int gate_pn; float sc;
    DEVI int nst(const pg::Unit& u) const { return u.pn == gate_pn ? 0 : 16; }
    DEVI void operator()(const f32x4 (&acc)[2][2][4][2], const pg::Unit& u, int ui, int wr, int wc, int fr, int fq) const {
        const int row0 = u.pm * 256 + wr * 64 + fr;
        if (u.pn == gate_pn) {
            if (wc == 0) {
#pragma unroll
                for (int ai = 0; ai < 2; ++ai)
#pragma unroll
                    for (int m = 0; m < 4; ++m) { float* gp = gates + (size_t)(row0 + ai * 128 + m * 16) * 32 + 8 * fq;
                        *(f32x4*)(gp) = acc[ai][0][m][0] * sc; *(f32x4*)(gp + 4) = acc[ai][0][m][1] * sc; }
            }
            return;
        }
        const int col0 = u.pn * 256 + wc * 32 + 8 * fq;
#pragma unroll
        for (int ai = 0; ai < 2; ++ai)
#pragma unroll
            for (int m = 0; m < 4; ++m) { bf16* rowp = O + (size_t)(row0 + ai * 128 + m * 16) * ld + col0;
#pragma unroll
                for (int bj = 0; bj < 2; ++bj) { const f32x4 v0 = acc[ai][bj][m][0] * sc, v1 = acc[ai][bj][m][1] * sc;
                    u32x4 w; w.x = pg::cvt_pk_bf16(v0[0], v0[1]); w.y = pg::cvt_pk_bf16(v0[2], v0[3]); w.z = pg::cvt_pk_bf16(v1[0], v1[1]); w.w = pg::cvt_pk_bf16(v1[2], v1[3]);
                    *(u32x4*)(rowp + bj * 128) = w; } }
    }
};
struct EpiSwiGLU {
    static constexpr bool PERM = true, B16 = false;
    bf16* ACT;
    DEVI int nst(const pg::Unit&) const { return 8; }
    DEVI void operator()(const f32x4 (&acc)[2][2][4][2], const pg::Unit& u, int ui, int wr, int wc, int fr, int fq) const {
        const int row0 = u.pm * 256 + wr * 64 + fr, col0 = u.pn * 128 + wc * 32 + 8 * fq;
#pragma unroll
        for (int ai = 0; ai < 2; ++ai)
#pragma unroll
            for (int m = 0; m < 4; ++m) {
                f32x4 o[2];
#pragma unroll
                for (int n = 0; n < 2; ++n) { const f32x4 a = acc[ai][0][m][n], b = acc[ai][1][m][n]; const f32x4 t = a * (-1.4426950408889634f / W13_SCALE);
                    f32x4 e; e[0] = __builtin_amdgcn_exp2f(t[0]); e[1] = __builtin_amdgcn_exp2f(t[1]); e[2] = __builtin_amdgcn_exp2f(t[2]); e[3] = __builtin_amdgcn_exp2f(t[3]);
                    const f32x4 d = e * (W13_SCALE * W13_SCALE) + (W13_SCALE * W13_SCALE);
                    f32x4 r; r[0] = __builtin_amdgcn_rcpf(d[0]); r[1] = __builtin_amdgcn_rcpf(d[1]); r[2] = __builtin_amdgcn_rcpf(d[2]); r[3] = __builtin_amdgcn_rcpf(d[3]);
                    o[n] = (a * b) * r; }
                uint2 w; w.x = pk4_fp8(o[0][0], o[0][1], o[0][2], o[0][3]); w.y = pk4_fp8(o[1][0], o[1][1], o[1][2], o[1][3]);
                *(uint2*)((unsigned char*)ACT + (size_t)(row0 + ai * 128 + m * 16) * EDIM + col0) = w; }
    }
};
constexpr float Y_SCALE = 8.f;
struct EpiScale {
    static constexpr bool PERM = true, B16 = true;
    unsigned char* Y; const LAS float* swt;
    DEVI int nst(const pg::Unit&) const { return 8; }
    DEVI void operator()(const f32x4 (&acc)[2][2][4][2], const pg::Unit& u, int ui, int wr, int wc, int fr, int fq) const {
        const int row0 = u.pm * 256 + wr * 64 + fr, col0 = u.pn * 256 + wc * 64 + 16 * fq;
#pragma unroll
        for (int ai = 0; ai < 2; ++ai)
#pragma unroll
            for (int m = 0; m < 4; ++m) { const int slot = row0 + ai * 128 + m * 16; const float w8 = swt[ui * 256 + wr * 64 + fr + ai * 128 + m * 16];
                const f32x4 a = acc[ai][0][m][0] * w8, b = acc[ai][0][m][1] * w8, c = acc[ai][1][m][0] * w8, d = acc[ai][1][m][1] * w8;
                u32x4 w; w.x = pk4_fp8(a[0], a[1], a[2], a[3]); w.y = pk4_fp8(b[0], b[1], b[2], b[3]); w.z = pk4_fp8(c[0], c[1], c[2], c[3]); w.w = pk4_fp8(d[0], d[1], d[2], d[3]);
                __builtin_nontemporal_store(w, (u32x4*)(Y + (size_t)slot * D + col0)); }
    }
};
struct EpiResid {
    static constexpr bool PERM = true, B16 = false;
    bf16* X; const float* modl;
    DEVI int nst(const pg::Unit&) const { return 16; }
    DEVI void operator()(const f32x4 (&acc)[2][2][4][2], const pg::Unit& u, int ui, int wr, int wc, int fr, int fq) const {
        const int bb = u.pm < 64 ? (u.pm >> 4) : 4;
        const float* gate = modl + (size_t)(bb * 6 + 2) * D;
        const int row0 = u.pm * 256 + wr * 64 + fr, col0 = u.pn * 256 + wc * 32 + 8 * fq;
        f32x4 gv[2][2];
#pragma unroll
        for (int bj = 0; bj < 2; ++bj)
#pragma unroll
            for (int n = 0; n < 2; ++n) gv[bj][n] = *(const f32x4*)(gate + col0 + bj * 128 + 4 * n) * (1.f / W13_SCALE);
        u32x4 xa[2], xb[2];
#define RLOAD(Xr, g) do { const size_t off_ = (size_t)(row0 + ((g) >> 2) * 128 + ((g) & 3) * 16) * D + col0; _Pragma("unroll") for (int bj = 0; bj < 2; ++bj) Xr[bj] = *(const u32x4*)(X + off_ + bj * 128); } while (0)
#define RMIX(w, a, b, ga, gb) pg::cvt_pk_bf16(__uint_as_float((w) << 16) + (ga) * (a), __uint_as_float((w) & 0xffff0000u) + (gb) * (b))
#define RSTORE(Xr, g) do { const size_t off_ = (size_t)(row0 + ((g) >> 2) * 128 + ((g) & 3) * 16) * D + col0; _Pragma("unroll") for (int bj = 0; bj < 2; ++bj) { \
            const f32x4 a0 = acc[(g) >> 2][bj][(g) & 3][0], a1 = acc[(g) >> 2][bj][(g) & 3][1]; u32x4 w; \
            w.x = RMIX(Xr[bj].x, a0[0], a0[1], gv[bj][0][0], gv[bj][0][1]); w.y = RMIX(Xr[bj].y, a0[2], a0[3], gv[bj][0][2], gv[bj][0][3]); \
            w.z = RMIX(Xr[bj].z, a1[0], a1[1], gv[bj][1][0], gv[bj][1][1]); w.w = RMIX(Xr[bj].w, a1[2], a1[3], gv[bj][1][2], gv[bj][1][3]); \
            *(u32x4*)(X + off_ + bj * 128) = w; } } while (0)
        RLOAD(xa, 0);
#pragma unroll
        for (int g = 0; g < 8; g += 2) {
            RLOAD(xb, g + 1); asm volatile("" ::: "memory");
            RSTORE(xa, g); asm volatile("" ::: "memory");
            if (g + 2 < 8) { RLOAD(xa, g + 2); asm volatile("" ::: "memory"); }
            RSTORE(xb, g + 1); asm volatile("" ::: "memory");
        }
#undef RLOAD
#undef RMIX
#undef RSTORE
    }
};

template <bool G1>
DEVI int moe_setup(const Params& p, LAS unsigned char* lds, int layer, int nrows, int vcu, int G) {
    LAS int* eo = (LAS int*)(lds + pg::EO_OFF); LAS int* ud = (LAS int*)(lds + pg::UD_OFF); LAS int* gt = (LAS int*)(lds + pg::GT_OFF);
    const int tid = otid(); const u32* cnt = (const u32*)(p.ws + WS_CTL) + CW_CNT + layer * 64 * CNT_PAD;
    LAS int* ec = eo + 68;
    if (tid < 64) { const int c_ = (int)cnt[tid * CNT_PAD]; const int pc = (c_ + 255) & ~255; const int incl = (int)wave_prefix_dpp((float)pc);
        ec[tid] = c_; eo[tid] = incl - pc; if (tid == 63) eo[64] = incl; }
    __syncthreads();
    constexpr int NT = G1 ? 4 : 8, CAP = G1 ? 16 : 24;
    const int PR = eo[64] >> 8, PS = nrows >> 8, total = (PR + PS) * NT;
    int nu = total > vcu ? (total - vcu + G - 1) / G : 0; if (nu > CAP) nu = CAP;
    if (tid < nu) {
        const int L = tid * G + vcu, pp = L / NT, pn = L % NT; int e = 64, pm = SH0 / 256 + (pp - PR);
        if (pp < PR) { pm = pp; e = 0; for (int i = 1; i < 64; ++i) if (eo[i] <= pp * 256) e = i; }
        ud[tid * 4 + 0] = pm; ud[tid * 4 + 1] = pn; ud[tid * 4 + 2] = e;
    }
    __syncthreads();
    if (G1) { const int* ltok = (const int*)(p.ws + WS_LTOK);
        for (int idx = tid; idx < nu * 256; idx += 512) { const int u_ = idx >> 8, slot = ud[u_ * 4] * 256 + (idx & 255), e = ud[u_ * 4 + 2];
            int t = slot - SH0; if (slot < SH0) { const int pos = slot - eo[e]; t = pos < ec[e] ? ltok[(size_t)e * MT + pos] : 0; } gt[idx] = t; } }
    else { const float* lw = (const float*)(p.ws + WS_LW); LAS float* st = (LAS float*)gt;
        for (int idx = tid; idx < nu * 256; idx += 512) { const int u_ = idx >> 8, slot = ud[u_ * 4] * 256 + (idx & 255), e = ud[u_ * 4 + 2];
            float w = 1.f; if (slot < SH0) { const int pos = slot - eo[e]; w = pos < ec[e] ? lw[(size_t)e * MT + pos] : 0.f; } st[idx] = w * (Y_SCALE / W2_SCALE); } }
    __syncthreads();
    return nu;
}

namespace fa {
typedef short s16x4 __attribute__((ext_vector_type(4)));
typedef float f32x16 __attribute__((ext_vector_type(16)));
constexpr int HD = 128, NW = 8, QBLK = 32, KVBLK = 64;
constexpr float SCALE = 0.088388347648318440f, THR = 8.f;
constexpr int SHM_V = KVBLK * HD * 2, SHM_K = KVBLK * HD * 2, SCR_OFF = 2 * SHM_V + 2 * SHM_K, BIAS_OFF = SCR_OFF + NW * 64 * 4, SHM_ATTN = BIAS_OFF + 512 * 4;
#define KSWZ(row, colB) ((row) * 256 + ((colB) ^ (((row) & 7) << 4)))
#define SBAR() __builtin_amdgcn_sched_barrier(0)
DEVI int crow(int r, int hi) { return (r & 3) + 8 * (r >> 2) + 4 * hi; }
DEVI unsigned cvtpk(float lo, float hi) { unsigned r; asm volatile("v_cvt_pk_bf16_f32 %0, %1, %2" : "=v"(r) : "v"(lo), "v"(hi)); return r; }
DEVI void partialSM(f32x16& p0, f32x16& p1, float& m_reg, float& mn, float& alpha) {
    constexpr float C = SCALE * 1.4426950408889634f;
    float pmax = p0[0];
#pragma unroll
    for (int r = 1; r < 16; ++r) pmax = fmaxf(pmax, p0[r]);
#pragma unroll
    for (int r = 0; r < 16; ++r) pmax = fmaxf(pmax, p1[r]);
    { auto rr = __builtin_amdgcn_permlane32_swap(__float_as_uint(pmax), __float_as_uint(pmax), false, false); pmax = fmaxf(__uint_as_float(rr[0]), __uint_as_float(rr[1])); }
    if (__builtin_expect(__all(pmax - m_reg <= THR / SCALE), 1)) { mn = m_reg; alpha = 1.f; }
    else { mn = fmaxf(m_reg, pmax); alpha = __builtin_amdgcn_exp2f((m_reg - mn) * C); m_reg = mn; }
    const float mnC = -mn * C;
#pragma unroll
    for (int r = 0; r < 16; ++r) p0[r] = fmaf(p0[r], C, mnC);
#pragma unroll
    for (int r = 0; r < 16; ++r) p1[r] = fmaf(p1[r], C, mnC);
#pragma unroll
    for (int r = 0; r < 16; ++r) p0[r] = __builtin_amdgcn_exp2f(p0[r]);
}
DEVI void finishSM(f32x16& p0, f32x16& p1, float alpha, float& l_reg, bf16x8& pa0, bf16x8& pa1, bf16x8& pa2, bf16x8& pa3) {
#pragma unroll
    for (int r = 0; r < 16; ++r) p1[r] = __builtin_amdgcn_exp2f(p1[r]);
    float ps = 0;
#pragma unroll
    for (int r = 0; r < 16; ++r) ps += p0[r];
#pragma unroll
    for (int r = 0; r < 16; ++r) ps += p1[r];
    { auto rr = __builtin_amdgcn_permlane32_swap(__float_as_uint(ps), __float_as_uint(ps), false, false); ps = __uint_as_float(rr[0]) + __uint_as_float(rr[1]); }
    l_reg = l_reg * alpha + ps;
#define PK4(P, BASE, OUT) do { unsigned a0 = cvtpk(P[BASE + 0], P[BASE + 1]), a1 = cvtpk(P[BASE + 2], P[BASE + 3]);   \
    unsigned b0 = cvtpk(P[BASE + 4], P[BASE + 5]), b1 = cvtpk(P[BASE + 6], P[BASE + 7]);                              \
    auto r0 = __builtin_amdgcn_permlane32_swap(a0, b0, false, false); auto r1 = __builtin_amdgcn_permlane32_swap(a1, b1, false, false); \
    u32x4 w = {r0[0], r1[0], r0[1], r1[1]}; OUT = *reinterpret_cast<bf16x8*>(&w); } while (0)
    PK4(p0, 0, pa0); PK4(p0, 8, pa1); PK4(p1, 0, pa2); PK4(p1, 8, pa3);
#undef PK4
}
DEVI void qkt(f32x16& p0, f32x16& p1, const char* Ks, const bf16x8* qr, int r32, int hi) {
    p0 = f32x16{}; p1 = f32x16{};
#pragma unroll
    for (int d0 = 0; d0 < 8; ++d0) { const int cb = (d0 * 16 + hi * 8) * 2;
        const bf16x8 b0 = *reinterpret_cast<const bf16x8*>(Ks + KSWZ(r32, cb));
        const bf16x8 b1 = *reinterpret_cast<const bf16x8*>(Ks + KSWZ(32 + r32, cb));
        p0 = __builtin_amdgcn_mfma_f32_32x32x16_bf16(b0, qr[d0], p0, 0, 0, 0);
        p1 = __builtin_amdgcn_mfma_f32_32x32x16_bf16(b1, qr[d0], p1, 0, 0, 0); }
}
DEVI int v_st(int k, int c) { const int kk = (k & ~0xC) | ((k & 4) << 1) | ((k & 8) >> 1); return ((kk >> 3) * 4 + (c >> 5)) * 512 + ((kk & 7) * 32 + (c & 31)) * 2; }
DEVI int v_rd_base(int lane) { return ((lane & 3) << 3) | (((lane >> 2) & 3) << 6) | (((lane >> 4) & 1) << 5) | (((lane >> 5) & 1) << 8); }
constexpr int v_rd_off(int d0, int ks, int half) { return d0 * 512 + ks * 4096 + half * 2048; }
template <int OFF> DEVI s16x4 tr_read(int vb) { s16x4 r; asm volatile("ds_read_b64_tr_b16 %0, %1 offset:%2" : "=&v"(r) : "v"(vb), "i"(OFF) : "memory"); return r; }
template <int D0> DEVI void pv_one(f32x16& od, int vb, bf16x8 pa0, bf16x8 pa1, bf16x8 pa2, bf16x8 pa3) {
    const s16x4 l0 = tr_read<v_rd_off(D0, 0, 0)>(vb), h0 = tr_read<v_rd_off(D0, 0, 1)>(vb), l1 = tr_read<v_rd_off(D0, 1, 0)>(vb), h1 = tr_read<v_rd_off(D0, 1, 1)>(vb);
    const s16x4 l2 = tr_read<v_rd_off(D0, 2, 0)>(vb), h2 = tr_read<v_rd_off(D0, 2, 1)>(vb), l3 = tr_read<v_rd_off(D0, 3, 0)>(vb), h3 = tr_read<v_rd_off(D0, 3, 1)>(vb);
    asm volatile("s_waitcnt lgkmcnt(0)" ::: "memory"); SBAR();
#define PK(L, H) (bf16x8){L[0], L[1], L[2], L[3], H[0], H[1], H[2], H[3]}
    od = __builtin_amdgcn_mfma_f32_32x32x16_bf16(pa0, PK(l0, h0), od, 0, 0, 0);
    od = __builtin_amdgcn_mfma_f32_32x32x16_bf16(pa1, PK(l1, h1), od, 0, 0, 0);
    od = __builtin_amdgcn_mfma_f32_32x32x16_bf16(pa2, PK(l2, h2), od, 0, 0, 0);
    od = __builtin_amdgcn_mfma_f32_32x32x16_bf16(pa3, PK(l3, h3), od, 0, 0, 0);
#undef PK
}
DEVI void pv_d0(f32x16* o, int vb, bf16x8 pa0, bf16x8 pa1, bf16x8 pa2, bf16x8 pa3) {
    pv_one<0>(o[0], vb, pa0, pa1, pa2, pa3); pv_one<1>(o[1], vb, pa0, pa1, pa2, pa3); pv_one<2>(o[2], vb, pa0, pa1, pa2, pa3); pv_one<3>(o[3], vb, pa0, pa1, pa2, pa3);
}
DEVI void na_mask(f32x16& p0, f32x16& p1, const float* brow, int cq, int hi) {
    const int cs = min(max(cq - 8, 0), 48);
    const float* bl = brow + (4 * hi - cq + 15);
    const int d0 = 4 * hi - cs;
#pragma unroll
    for (int r = 0; r < 16; ++r) {
        const int kc0 = (r & 3) + 8 * (r >> 2), kc1 = kc0 + 32;
        const bool ok0 = (unsigned)(kc0 + d0) < 16u, ok1 = (unsigned)(kc1 + d0) < 16u;
        const float b0 = bl[ok0 ? kc0 : 0], b1 = bl[ok1 ? kc1 : 0];
        p0[r] = ok0 ? p0[r] + b0 : -1e30f; p1[r] = ok1 ? p1[r] + b1 : -1e30f;
    }
}
DEVI void attn_unit(const bf16* __restrict__ Qb, const bf16* __restrict__ kc, const bf16* __restrict__ kl, int vdelta, int NT, unsigned char* __restrict__ Ob, char* lds) {
    constexpr int ldq = AIW, ldk = AIW, ldo = D; constexpr bool NA = false; const int tbase = 0, nwin = 64, krmin = 0, rq0 = 0; const float* rpb_h = nullptr;
    auto tile = [&](int t, const bf16*& kp, const bf16*& vp) { kp = t < 4 ? kc + (size_t)t * 64 * ldk : kl + (size_t)(tbase + min(t - 4, nwin - 1)) * 64 * ldk; vp = kp + vdelta; };
    const int tid = otid(), wid = tid >> 6, lane = tid & 63, r32 = lane & 31, hi = lane >> 5;
    char* V_lds = lds; char* K_lds = lds + 2 * SHM_V;
    float* wsc = (float*)(lds + SCR_OFF) + wid * 64; float* li_l = wsc; float* al_l = wsc + 32;
    float* btab = (float*)(lds + BIAS_OFF);
    float m_reg = -1e30f, l_reg = 0; f32x16 o[4] = {}; bf16x8 qr[8];
    const bf16* Qw = Qb + (size_t)(wid * QBLK + r32) * ldq + hi * 8;
#pragma unroll
    for (int d0 = 0; d0 < 8; ++d0) qr[d0] = *reinterpret_cast<const bf16x8*>(Qw + d0 * 16);
    if (NA) { for (int i = tid; i < 465; i += 512) btab[i] = rpb_h[i] * (1.f / SCALE); }
    const int sr = tid >> 4, sc = (tid & 15) * 8, vst0 = v_st(sr, sc), vst1 = v_st(32 + sr, sc);
    const int vb0 = (int)(uintptr_t)V_lds + v_rd_base(lane);
    const int rq = rq0 + (wid >> 1), cq = (wid & 1) * 32 + r32, kr0 = min(max(rq - 4, 0), 56);
    struct { bf16x8 vs0, vs1, ks0, ks1; } st_[2];
#define SLOAD(i, t) do { const bf16* kp_; const bf16* vp_; tile((t), kp_, vp_); \
    st_[i].vs0 = *reinterpret_cast<const bf16x8*>(vp_ + (size_t)sr * ldk + sc); st_[i].vs1 = *reinterpret_cast<const bf16x8*>(vp_ + (size_t)(32 + sr) * ldk + sc); \
    st_[i].ks0 = *reinterpret_cast<const bf16x8*>(kp_ + (size_t)sr * ldk + sc); st_[i].ks1 = *reinterpret_cast<const bf16x8*>(kp_ + (size_t)(32 + sr) * ldk + sc); } while (0)
#define SWRITE(b, i) do { *(bf16x8*)(V_lds + (b) * SHM_V + vst0) = st_[i].vs0; *(bf16x8*)(V_lds + (b) * SHM_V + vst1) = st_[i].vs1; const int kc = sc * 2; \
    *(bf16x8*)(K_lds + (b) * SHM_K + KSWZ(sr, kc)) = st_[i].ks0; *(bf16x8*)(K_lds + (b) * SHM_K + KSWZ(32 + sr, kc)) = st_[i].ks1; } while (0)
#define SWAIT() asm volatile("s_waitcnt vmcnt(4)" ::: "memory")
#define RESC(a) do { if (__any((a) < 1.f)) { if (hi == 0) al_l[r32] = (a); asm volatile("s_waitcnt lgkmcnt(0)" ::: "memory"); \
    _Pragma("unroll") for (int d = 0; d < 4; ++d) _Pragma("unroll") for (int r = 0; r < 16; ++r) o[d][r] *= al_l[crow(r, hi)]; } } while (0)
#define MASK(P0, P1, t) do { if (NA) { if ((t) >= 4) { const int kr_ = krmin + (t) - 4; const bool v_ = ((t) - 4 < nwin) && kr_ >= kr0 && kr_ <= kr0 + 7; (void)v_; } } } while (0)
    f32x16 pA0, pA1, pB0, pB1; float mnA, mnB, alA, alB; bf16x8 pa0, pa1, pa2, pa3;
    constexpr int SE = 0, SO = 1;
    SLOAD(SE, 0); asm volatile("s_waitcnt vmcnt(0)" ::: "memory"); SWRITE(0, SE); __syncthreads();
    qkt(pA0, pA1, K_lds, qr, r32, hi); MASK(pA0, pA1, 0); partialSM(pA0, pA1, m_reg, mnA, alA);
    SLOAD(SO, 1); SLOAD(SE, 2);
    SWAIT(); SWRITE(1, SO); __syncthreads();
    for (int j = 1; j + 1 < NT; j += 2) {
        SBAR(); qkt(pB0, pB1, K_lds + SHM_K, qr, r32, hi); MASK(pB0, pB1, j);
        finishSM(pA0, pA1, alA, l_reg, pa0, pa1, pa2, pa3); SBAR();
        SLOAD(SO, j + 2); SBAR();
        pv_d0(o, vb0, pa0, pa1, pa2, pa3); partialSM(pB0, pB1, m_reg, mnB, alB);
        __syncthreads(); SWAIT(); SWRITE(0, SE);
        RESC(alB); __syncthreads();
        SBAR(); qkt(pA0, pA1, K_lds, qr, r32, hi); MASK(pA0, pA1, j + 1);
        finishSM(pB0, pB1, alB, l_reg, pa0, pa1, pa2, pa3); SBAR();
        SLOAD(SE, min(j + 3, NT - 1)); SBAR();
        pv_d0(o, vb0 + SHM_V, pa0, pa1, pa2, pa3); partialSM(pA0, pA1, m_reg, mnA, alA);
        __syncthreads(); SWAIT(); SWRITE(1, SO);
        RESC(alA); __syncthreads();
    }
    SBAR(); qkt(pB0, pB1, K_lds + SHM_K, qr, r32, hi); MASK(pB0, pB1, NT - 1);
    finishSM(pA0, pA1, alA, l_reg, pa0, pa1, pa2, pa3); SBAR();
    pv_d0(o, vb0, pa0, pa1, pa2, pa3); partialSM(pB0, pB1, m_reg, mnB, alB);
    __syncthreads(); RESC(alB);
    finishSM(pB0, pB1, alB, l_reg, pa0, pa1, pa2, pa3); SBAR();
    pv_d0(o, vb0 + SHM_V, pa0, pa1, pa2, pa3);
    if (hi == 0) li_l[r32] = l_reg; asm volatile("s_waitcnt lgkmcnt(0)" ::: "memory");
#pragma unroll
    for (int r = 0; r < 16; ++r) { const int orow = crow(r, hi); const float rl = __builtin_amdgcn_rcpf(li_l[orow]);
#pragma unroll
        for (int d0 = 0; d0 < 4; ++d0) ((unsigned char*)Ob)[(size_t)(wid * QBLK + orow) * ldo + d0 * 32 + r32] = (unsigned char)(pk4_fp8(o[d0][r] * rl, 0.f, 0.f, 0.f) & 0xffu); }
    __syncthreads();
#undef SLOAD
#undef SWRITE
#undef SWAIT
#undef RESC
#undef MASK
}
DEVI void attn_unit_na(const bf16* __restrict__ Qb, const bf16* __restrict__ kc, const bf16* __restrict__ kl, int krmin, int nwin, int vdelta, unsigned char* __restrict__ Ob, char* lds, int rq0, const float* rpb_h) {
    constexpr int ldq = AIW, ldk = AIW, ldo = D;
    const int tid = otid(), wid = tid >> 6, lane = tid & 63, r32 = lane & 31, hi = lane >> 5;
    char* V_lds = lds; char* K_lds = lds + 2 * SHM_V;
    float* wsc = (float*)(lds + SCR_OFF) + wid * 64; float* li_l = wsc; float* al_l = wsc + 32;
    float* btab = (float*)(lds + BIAS_OFF);
    float m_reg = -1e30f, l_reg = 0; f32x16 o[4] = {}; bf16x8 qr[8];
    const bf16* Qw = Qb + (size_t)(wid * QBLK + r32) * ldq + hi * 8;
#pragma unroll
    for (int d0 = 0; d0 < 8; ++d0) qr[d0] = *reinterpret_cast<const bf16x8*>(Qw + d0 * 16);
    for (int i = tid; i < 465; i += 512) btab[i] = rpb_h[i] * (1.f / SCALE);
    const int sr = tid >> 4, sc = (tid & 15) * 8, vst0 = v_st(sr, sc), vst1 = v_st(32 + sr, sc);
    const int vb0 = (int)(uintptr_t)V_lds + v_rd_base(lane);
    const int rq = rq0 + (wid >> 1), cq = (wid & 1) * 32 + r32, kr0 = min(max(rq - 4, 0), 56);
    bf16x8 vs0, vs1, ks0, ks1;
    const int NT = 4 + nwin;
#define NLOAD(t) do { const bf16* kp_ = (t) < 4 ? kc + (size_t)(t) * 64 * ldk : kl + (size_t)(krmin + (t) - 4) * 64 * ldk; const bf16* vp_ = kp_ + vdelta; \
    vs0 = *reinterpret_cast<const bf16x8*>(vp_ + (size_t)sr * ldk + sc); vs1 = *reinterpret_cast<const bf16x8*>(vp_ + (size_t)(32 + sr) * ldk + sc); \
    ks0 = *reinterpret_cast<const bf16x8*>(kp_ + (size_t)sr * ldk + sc); ks1 = *reinterpret_cast<const bf16x8*>(kp_ + (size_t)(32 + sr) * ldk + sc); } while (0)
    NLOAD(0);
    for (int t = 0; t < NT; ++t) {
        __syncthreads();
        *(bf16x8*)(V_lds + vst0) = vs0; *(bf16x8*)(V_lds + vst1) = vs1;
        *(bf16x8*)(K_lds + KSWZ(sr, sc * 2)) = ks0; *(bf16x8*)(K_lds + KSWZ(32 + sr, sc * 2)) = ks1;
        __syncthreads();
        NLOAD(min(t + 1, NT - 1));
        const int kr = krmin + t - 4;
        if (t < 4 || (kr >= kr0 && kr <= kr0 + 7)) {
            f32x16 p0, p1; float mn, al; bf16x8 pa0, pa1, pa2, pa3;
            qkt(p0, p1, K_lds, qr, r32, hi);
            if (t >= 4) na_mask(p0, p1, btab + (kr - rq + 7) * 31, cq, hi);
            partialSM(p0, p1, m_reg, mn, al);
            if (__any(al < 1.f)) { if (hi == 0) al_l[r32] = al; asm volatile("s_waitcnt lgkmcnt(0)" ::: "memory");
#pragma unroll
                for (int d = 0; d < 4; ++d)
#pragma unroll
                    for (int r = 0; r < 16; ++r) o[d][r] *= al_l[crow(r, hi)]; }
            finishSM(p0, p1, al, l_reg, pa0, pa1, pa2, pa3);
            pv_d0(o, vb0, pa0, pa1, pa2, pa3);
        }
    }
#undef NLOAD
    if (hi == 0) li_l[r32] = l_reg; asm volatile("s_waitcnt lgkmcnt(0)" ::: "memory");
#pragma unroll
    for (int r = 0; r < 16; ++r) { const int orow = crow(r, hi); const float rl = __builtin_amdgcn_rcpf(li_l[orow]);
#pragma unroll
        for (int d0 = 0; d0 < 4; ++d0) ((unsigned char*)Ob)[(size_t)(wid * QBLK + orow) * ldo + d0 * 32 + r32] = (unsigned char)(pk4_fp8(o[d0][r] * rl, 0.f, 0.f, 0.f) & 0xffu); }
    __syncthreads();
}
}

namespace ml {
using fa::f32x16; using fa::s16x4;
constexpr int K_OFF = 0, KP_OFF = 16384, V_OFF = 32768, C2_OFF = 49152, GA_OFF = C2_OFF + 2 * 24576, DEN_OFF = GA_OFF + 3072, CF_OFF = DEN_OFF + 1024, ML_LDS = CF_OFF + 49152;
static_assert(ML_LDS <= 157 * 1024, "mLSTM LDS map");
constexpr int GA_STRIDE = 6 * 64 * 4;
DEVI int tokrow(int b, int dir, int c, int i) {
    return c >= 4 ? (b * SEQ + (dir ? (SEQ - 1 - ((c - 4) * 64 + i)) : ((c - 4) * 64 + i))) : (ML + b * CTXL + (dir ? (CTXL - 1 - (c * 64 + i)) : (c * 64 + i)));
}
template <int CTRL, int ROWMASK> DEVI float dpp_f(float ident, float src) {
    return __int_as_float(__builtin_amdgcn_update_dpp(__float_as_int(ident), __float_as_int(src), CTRL, ROWMASK, 0xf, false));
}
DEVI float prefix_sum64(float x, int) {
    x += dpp_f<0x111, 0xf>(0.f, x); x += dpp_f<0x112, 0xf>(0.f, x); x += dpp_f<0x114, 0xf>(0.f, x); x += dpp_f<0x118, 0xf>(0.f, x);
    x += dpp_f<0x142, 0xa>(0.f, x); x += dpp_f<0x143, 0xc>(0.f, x);
    return x;
}
DEVI float prefix_max64(float x, int) {
    const float ninf = -INFINITY;
    x = fmaxf(x, dpp_f<0x111, 0xf>(ninf, x)); x = fmaxf(x, dpp_f<0x112, 0xf>(ninf, x)); x = fmaxf(x, dpp_f<0x114, 0xf>(ninf, x)); x = fmaxf(x, dpp_f<0x118, 0xf>(ninf, x));
    x = fmaxf(x, dpp_f<0x142, 0xa>(ninf, x)); x = fmaxf(x, dpp_f<0x143, 0xc>(ninf, x));
    return x;
}
DEVI float lane63(float v) { return __int_as_float(__builtin_amdgcn_readlane(__float_as_int(v), 63)); }
DEVI float gate_chunk(float li, float f, float mprev, float* ga, int lane) {
    const float lf = fminf(f, 0.f) - log1pf(__expf(-fabsf(f)));
    const float bc = prefix_sum64(lf, lane), btot = lane63(bc);
    const float colt = li - bc, aend = btot + colt, pm = prefix_max64(colt, lane), amax = btot + lane63(pm), mnew = fmaxf(btot + mprev, amax);
    const float cm = fmaxf(mprev, pm);
    ga[lane] = __expf(aend - mnew) * QSCALE;
    ga[64 + lane] = colt;
    ga[128 + lane] = -cm;
    ga[192 + lane] = __expf(mprev - cm);
    ga[256 + lane] = __expf(-bc - cm);
    if (lane == 0) ga[320] = __expf(btot + mprev - mnew);
    return mnew;
}
DEVI void ph_mlstm(const Params& p, char* lds, int vcu, int G) {
    const int tid = otid(), wid = __builtin_amdgcn_readfirstlane(tid >> 6), lane = tid & 63, r32 = lane & 31, hi = lane >> 5;
    const bf16* Q = (const bf16*)(p.ws + WS_QKV); const float* Gt = (const float*)(p.ws + WS_G); bf16* HD = (bf16*)(p.ws + WS_HD);
    char* K_lds = lds + K_OFF; char* Kp_lds = lds + KP_OFF; char* V_lds = lds + V_OFF; char* C_lds = lds + C2_OFF;
    float* GA = (float*)(lds + GA_OFF); float* den_l = (float*)(lds + DEN_OFF) + (wid & 3) * 64;
    const int sr = tid >> 4, sc = (tid & 15) * 8;
    const int vr = tid >> 3, vc = (tid & 7) * 8;
    const int vbK = (int)(uintptr_t)Kp_lds + fa::v_rd_base(lane), vbV = (int)(uintptr_t)V_lds + fa::v_rd_base(lane);
    for (int item = vcu; item < 256; item += G) {
        const int b = item >> 6, h = (item >> 3) & 7, dir = (item >> 2) & 1, sl = item & 3;
        const float bi = p.ml_gate_b[dir * 8 + h], bf_ = p.ml_gate_b[(2 + dir) * 8 + h];
        __syncthreads();
        for (int i = tid; i < 16384 / 16; i += 512) ((u32x4*)(V_lds))[i] = (u32x4){0u, 0u, 0u, 0u};
        for (int i = tid; i < 24576 / 16; i += 512) ((u32x4*)(C_lds))[i] = (u32x4){0u, 0u, 0u, 0u};
        __syncthreads();
        if (tid < 64) *(bf16*)(V_lds + fa::v_st(tid, 64)) = (bf16)0x3F80;
        for (int i = tid; i < 49152 / 16; i += 512) ((u32x4*)(lds + CF_OFF))[i] = (u32x4){0u, 0u, 0u, 0u};
        float mprev = 0.f;
        if (wid == 4) { const int row = tokrow(b, dir, 0, lane); mprev = gate_chunk(Gt[(size_t)row * 32 + dir * 8 + h] + bi, Gt[(size_t)row * 32 + 16 + dir * 8 + h] + bf_, 0.f, GA, lane); }
        bf16x8 kr0, kr1, vreg, qr[8];
        { const int r0 = tokrow(b, dir, 0, sr), r1 = tokrow(b, dir, 0, sr + 32), r2 = tokrow(b, dir, 0, vr);
          kr0 = *(const bf16x8*)(Q + (size_t)r0 * MIWM + 1024 + h * 128 + sc); kr1 = *(const bf16x8*)(Q + (size_t)r1 * MIWM + 1024 + h * 128 + sc);
          vreg = *(const bf16x8*)(Q + (size_t)r2 * MIWM + 2048 + h * 256 + sl * 64 + vc); }
#pragma unroll
        for (int d0 = 0; d0 < 8; ++d0) qr[d0] = (bf16x8){0, 0, 0, 0, 0, 0, 0, 0};
        __syncthreads();
        auto chunk_loop = [&](auto role_, auto lat_, const int c_begin, const int c_end) __attribute__((always_inline)) {
            constexpr bool OUT = decltype(role_)::value, LATC = decltype(lat_)::value;
#pragma unroll 1
            for (int c = c_begin; c < c_end; ++c) {
                const bool lat = c >= 4;
                const float* ga = GA + (c & 1) * (GA_STRIDE / 4);
                {
                    *(bf16x8*)(K_lds + KSWZ(sr, sc * 2)) = kr0; *(bf16x8*)(K_lds + KSWZ(32 + sr, sc * 2)) = kr1;
                    const float w0 = ga[sr], w1 = ga[sr + 32];
                    u32x4 a = *(u32x4*)&kr0, bq = *(u32x4*)&kr1, oa, ob;
#define SC2(x, w) fa::cvtpk(__uint_as_float((x) << 16) * (w), __uint_as_float((x) & 0xffff0000u) * (w))
                    oa.x = SC2(a.x, w0); oa.y = SC2(a.y, w0); oa.z = SC2(a.z, w0); oa.w = SC2(a.w, w0);
                    ob.x = SC2(bq.x, w1); ob.y = SC2(bq.y, w1); ob.z = SC2(bq.z, w1); ob.w = SC2(bq.w, w1);
#undef SC2
                    *(u32x4*)(Kp_lds + fa::v_st(sr, sc)) = oa; *(u32x4*)(Kp_lds + fa::v_st(32 + sr, sc)) = ob;
                    *(bf16x8*)(V_lds + fa::v_st(vr, vc)) = vreg;
                }
                float gli, gf;
                {
                    const int cn = c + 1 < 68 ? c + 1 : 67;
                    const int r0 = tokrow(b, dir, cn, sr), r1 = tokrow(b, dir, cn, sr + 32), r2 = tokrow(b, dir, cn, vr);
                    kr0 = *(const bf16x8*)(Q + (size_t)r0 * MIWM + 1024 + h * 128 + sc); kr1 = *(const bf16x8*)(Q + (size_t)r1 * MIWM + 1024 + h * 128 + sc);
                    vreg = *(const bf16x8*)(Q + (size_t)r2 * MIWM + 2048 + h * 256 + sl * 64 + vc);
                    const int row = tokrow(b, dir, cn, lane); gli = Gt[(size_t)row * 32 + dir * 8 + h] + bi; gf = Gt[(size_t)row * 32 + 16 + dir * 8 + h] + bf_;
                }
                __syncthreads();
                const char* Cc = C_lds + (c & 1) * 24576;
                if constexpr (OUT) {
                    if constexpr (LATC) {
                        const int tq = wid >> 1, vq = wid & 1, t = tq * 32 + r32;
                        bf16x8 kf0[8], kf1[8], cfr[8];
#pragma unroll
                        for (int d0 = 0; d0 < 8; ++d0) { const int cb = (d0 * 16 + hi * 8) * 2;
                            kf0[d0] = *reinterpret_cast<const bf16x8*>(K_lds + KSWZ(r32, cb)); kf1[d0] = *reinterpret_cast<const bf16x8*>(K_lds + KSWZ(32 + r32, cb));
                            cfr[d0] = *reinterpret_cast<const bf16x8*>(Cc + KSWZ(vq * 32 + r32, cb)); }
                        asm volatile("s_waitcnt lgkmcnt(0)" ::: "memory"); SBAR();
                        f32x16 p0 = {}, p1 = {}, acc = {};
#pragma unroll
                        for (int d0 = 0; d0 < 8; ++d0) p0 = __builtin_amdgcn_mfma_f32_32x32x16_bf16(kf0[d0], qr[d0], p0, 0, 0, 0);
                        if (tq == 1) {
#pragma unroll
                            for (int d0 = 0; d0 < 8; ++d0) p1 = __builtin_amdgcn_mfma_f32_32x32x16_bf16(kf1[d0], qr[d0], p1, 0, 0, 0); }
#pragma unroll
                        for (int d0 = 0; d0 < 8; ++d0) acc = __builtin_amdgcn_mfma_f32_32x32x16_bf16(qr[d0], cfr[d0], acc, 0, 0, 0);
                        bf16x8 cfn[8];
#pragma unroll
                        for (int d0 = 0; d0 < 8; ++d0) cfn[d0] = *reinterpret_cast<const bf16x8*>(Cc + KSWZ(64 + r32, (d0 * 16 + hi * 8) * 2));
                        asm volatile("s_waitcnt lgkmcnt(0)" ::: "memory"); SBAR();
                        f32x16 qnacc = {};
#pragma unroll
                        for (int d0 = 0; d0 < 8; ++d0) qnacc = __builtin_amdgcn_mfma_f32_32x32x16_bf16(cfn[d0], qr[d0], qnacc, 0, 0, 0);
                        { const int cq = c + 1 < 68 ? c + 1 : 67; const bf16* Qw = Q + (size_t)tokrow(b, dir, cq, (wid >> 1) * 32 + r32) * MIWM + h * 128 + hi * 8;
#pragma unroll
                          for (int d0 = 0; d0 < 8; ++d0) qr[d0] = *(const bf16x8*)(Qw + d0 * 16); }
                        float ct0[16], ct1[16], wi[16];
#pragma unroll
                        for (int r = 0; r < 16; ++r) { const int s0 = fa::crow(r, hi); ct0[r] = ga[64 + s0]; ct1[r] = ga[64 + s0 + 32]; wi[r] = ga[192 + tq * 32 + s0]; }
                        const float rown = ga[128 + t] * 1.4426950408889634f, wint_t = ga[192 + t], emr_t = ga[256 + t];
                        asm volatile("s_waitcnt lgkmcnt(0)" ::: "memory"); SBAR();
                        float ps = 0.f;
#pragma unroll
                        for (int r = 0; r < 16; ++r) {
                            const int s0 = fa::crow(r, hi), s1 = s0 + 32;
                            const float e0 = __builtin_amdgcn_exp2f(fmaf(ct0[r], 1.4426950408889634f, rown)), e1 = __builtin_amdgcn_exp2f(fmaf(ct1[r], 1.4426950408889634f, rown));
                            p0[r] = s0 <= t ? p0[r] * QSCALE * e0 : 0.f; p1[r] = s1 <= t ? p1[r] * QSCALE * e1 : 0.f;
                            ps += p0[r] + p1[r];
                        }
                        { auto rr = __builtin_amdgcn_permlane32_swap(__float_as_uint(ps), __float_as_uint(ps), false, false); ps = __uint_as_float(rr[0]) + __uint_as_float(rr[1]); }
                        bf16x8 pa0, pa1, pa2, pa3;
#define PK4(P, BASE, OUT) do { unsigned a0 = fa::cvtpk(P[BASE + 0], P[BASE + 1]), a1 = fa::cvtpk(P[BASE + 2], P[BASE + 3]);   \
        unsigned b0 = fa::cvtpk(P[BASE + 4], P[BASE + 5]), b1 = fa::cvtpk(P[BASE + 6], P[BASE + 7]);                              \
        auto r0 = __builtin_amdgcn_permlane32_swap(a0, b0, false, false); auto r1 = __builtin_amdgcn_permlane32_swap(a1, b1, false, false); \
        u32x4 w = {r0[0], r1[0], r0[1], r1[1]}; OUT = *reinterpret_cast<bf16x8*>(&w); } while (0)
                        PK4(p0, 0, pa0); PK4(p0, 8, pa1); PK4(p1, 0, pa2); PK4(p1, 8, pa3);
                        float qn_ = qnacc[0];
                        { auto rr = __builtin_amdgcn_permlane32_swap(__float_as_uint(qn_), __float_as_uint(qn_), false, false); qn_ = __uint_as_float(rr[0]); }
                        const float den = wint_t * qn_ + ps;
                        if (hi == 0) den_l[r32] = fmaxf(fabsf(den), emr_t);
#pragma unroll
                        for (int r = 0; r < 16; ++r) acc[r] *= wi[r];
                        fa::pv_one<0>(acc, vbV + vq * 512, pa0, pa1, pa2, pa3);
                        float dl[16];
#pragma unroll
                        for (int r = 0; r < 16; ++r) dl[r] = den_l[fa::crow(r, hi)];
                        asm volatile("s_waitcnt lgkmcnt(0)" ::: "memory"); SBAR();
                        const long stepE = dir ? -(long)D : (long)D;
                        bf16* hb = HD + ((size_t)dir * ML + tokrow(b, dir, c, tq * 32 + 4 * hi)) * D + h * 256 + sl * 64 + vq * 32 + r32;
#pragma unroll
                        for (int r = 0; r < 16; ++r) hb[stepE * ((r & 3) + 8 * (r >> 2))] = f2bf(acc[r] * __builtin_amdgcn_rcpf(dl[r]));
                    }
                    if constexpr (!LATC) if (c == 3) { const bf16* Qw = Q + (size_t)tokrow(b, dir, c + 1, (wid >> 1) * 32 + r32) * MIWM + h * 128 + hi * 8;
#pragma unroll
                        for (int d0 = 0; d0 < 8; ++d0) qr[d0] = *(const bf16x8*)(Qw + d0 * 16); }
                } else {
                    const int kq = wid - 4; const float decay = ga[320];
                    f32x4* CF = (f32x4*)(lds + CF_OFF) + kq * 3 * 4 * 64 + lane;
                    f32x4 cfv[12]; s16x4 kt[8], vt[24];
#pragma unroll
                    for (int i = 0; i < 12; ++i) cfv[i] = CF[i * 64];
                    typedef short v4i16_t __attribute__((ext_vector_type(4)));
#define TRB(base, off) __builtin_bit_cast(s16x4, __builtin_amdgcn_ds_read_tr16_b64_v4i16((LAS v4i16_t*)(size_t)(unsigned)((base) + (off))))
                    const int ak = vbK + kq * 512;
#pragma unroll
                    for (int ks = 0; ks < 4; ++ks) { kt[2 * ks] = TRB(ak, fa::v_rd_off(0, ks, 0)); kt[2 * ks + 1] = TRB(ak, fa::v_rd_off(0, ks, 1)); }
#pragma unroll
                    for (int j = 0; j < 3; ++j)
#pragma unroll
                        for (int ks = 0; ks < 4; ++ks) { vt[8 * j + 2 * ks] = TRB(vbV, fa::v_rd_off(j, ks, 0)); vt[8 * j + 2 * ks + 1] = TRB(vbV, fa::v_rd_off(j, ks, 1)); }
#undef TRB
                    f32x16 cacc[3];
#pragma unroll
                    for (int j = 0; j < 3; ++j)
#pragma unroll
                        for (int r4 = 0; r4 < 4; ++r4) { const f32x4 v4 = cfv[j * 4 + r4] * decay; cacc[j][r4 * 4 + 0] = v4[0]; cacc[j][r4 * 4 + 1] = v4[1]; cacc[j][r4 * 4 + 2] = v4[2]; cacc[j][r4 * 4 + 3] = v4[3]; }
#define PKF(L, H) (bf16x8){L[0], L[1], L[2], L[3], H[0], H[1], H[2], H[3]}
#pragma unroll
                    for (int j = 0; j < 3; ++j)
#pragma unroll
                        for (int ks = 0; ks < 4; ++ks) cacc[j] = __builtin_amdgcn_mfma_f32_32x32x16_bf16(PKF(kt[2 * ks], kt[2 * ks + 1]), PKF(vt[8 * j + 2 * ks], vt[8 * j + 2 * ks + 1]), cacc[j], 0, 0, 0);
#undef PKF
                    char* Cn = C_lds + ((c + 1) & 1) * 24576;
#pragma unroll
                    for (int j = 0; j < 3; ++j) { bf16x8 f0, f1; PK4(cacc[j], 0, f0); PK4(cacc[j], 8, f1);
                        *(bf16x8*)(Cn + KSWZ(j * 32 + r32, (kq * 32 + hi * 8) * 2)) = f0; *(bf16x8*)(Cn + KSWZ(j * 32 + r32, (kq * 32 + 16 + hi * 8) * 2)) = f1; }
#pragma unroll
                    for (int j = 0; j < 3; ++j)
#pragma unroll
                        for (int r4 = 0; r4 < 4; ++r4) CF[(j * 4 + r4) * 64] = (f32x4){cacc[j][r4 * 4 + 0], cacc[j][r4 * 4 + 1], cacc[j][r4 * 4 + 2], cacc[j][r4 * 4 + 3]};
                    if (wid == 4 && c + 1 < 68) mprev = gate_chunk(gli, gf, mprev, GA + ((c + 1) & 1) * (GA_STRIDE / 4), lane);
                }
                __syncthreads();
            }
        };
        if (wid < 4) { chunk_loop(std::true_type{}, std::false_type{}, 0, 4);
            __builtin_amdgcn_s_waitcnt(0);
            chunk_loop(std::true_type{}, std::true_type{}, 4, 68); }
        else chunk_loop(std::false_type{}, std::false_type{}, 0, 68);
#undef PK4
    }
}
}

DEVI void ph_attn0(const Params& p, char* lds, int vcu, int G) {
    const bf16* Q = (const bf16*)(p.ws + WS_QKV); unsigned char* AO = (unsigned char*)(p.ws + WS_AO);
    const bool edge = (vcu & 15) == 0 || (vcu & 15) == 15;
    const int nG = (512 - vcu + G - 1) / G, nC = G == 256 ? (edge ? 2 : 0) : (vcu < 64 ? (64 - vcu + G - 1) / G : 0);
    for (int i = 0; i < 2 * nG + nC; ++i) {
        const bf16 *Qb, *kc, *kl; unsigned char* Ob; int tbase = 0, nwin = 64, vdelta, NT, rq0 = 0; bool na = false; const float* rpb = p.attn_rpb;
        if (i < nG) {
            const int u = vcu + i * G; int b, qh, qb;
            if (G == 256) { const int grp = vcu >> 5, idx = (vcu & 31) + 32 * i; b = grp >> 1; qh = (grp & 1) * 4 + (idx >> 4); qb = idx & 15; } else { b = u >> 7; qh = (u >> 4) & 7; qb = u & 15; }
            const int kvh = qh >> 2;
            kc = Q + (size_t)(ML + b * CTXL) * AIW + 4096 + kvh * 128; kl = Q + (size_t)(b * SEQ) * AIW + 4096 + kvh * 128; vdelta = 256; NT = 68;
            Qb = Q + (size_t)(b * SEQ + qb * 256) * AIW + 3072 + qh * 128; Ob = AO + (size_t)(b * SEQ + qb * 256) * D + 1024 + qh * 128;
        } else if (i < 2 * nG) {
            const int u = vcu + (i - nG) * G; const int b = u >> 7, h = (u >> 4) & 7, qb = u & 15;
            const int krmin = min(max(4 * qb - 4, 0), 56), krmax = min(max(4 * qb - 1, 0), 56) + 7;
            tbase = krmin; nwin = krmax - krmin + 1; NT = (4 + nwin + 1) & ~1; na = true; rq0 = 4 * qb; rpb = p.attn_rpb + h * 465;
            kc = Q + (size_t)(ML + b * CTXL) * AIW + 1024 + h * 128; kl = Q + (size_t)(b * SEQ) * AIW + 1024 + h * 128; vdelta = 1024;
            Qb = Q + (size_t)(b * SEQ + qb * 256) * AIW + h * 128; Ob = AO + (size_t)(b * SEQ + qb * 256) * D + h * 128;
        } else {
            const int u = G == 256 ? ((vcu >> 4) * 2 + ((vcu & 15) == 15 ? 1 : 0)) + 32 * (i - 2 * nG) : vcu + (i - 2 * nG) * G; const int b = (u >> 3) & 3, hh = u & 7; const bool gq = u >= 32;
            const int qcol = gq ? 3072 + hh * 128 : hh * 128, kcol = gq ? 4096 + (hh >> 2) * 128 : 1024 + hh * 128, ocol = gq ? 1024 + hh * 128 : hh * 128;
            kc = Q + (size_t)(ML + b * CTXL) * AIW + kcol; kl = kc; vdelta = gq ? 256 : 1024; NT = 4;
            Qb = Q + (size_t)(ML + b * CTXL) * AIW + qcol; Ob = AO + (size_t)(ML + b * CTXL) * D + ocol;
        }
        if (na) fa::attn_unit_na(Qb, kc, kl, tbase, nwin, vdelta, Ob, lds, rq0, rpb); else fa::attn_unit(Qb, kc, kl, vdelta, NT, Ob, lds);
    }
}

DEVI unsigned cvtpk_s(float lo, float hi) { unsigned r; asm volatile("v_cvt_pk_bf16_f32 %0, %1, %2" : "=v"(r) : "v"(lo), "v"(hi)); return r; }
DEVI void ph_router_prep(const Params& p, float* lds, int vcu, int G) {
    const int tid = otid(), lane = tid & 63, wave = tid >> 6;
    bf16* RWP = (bf16*)(p.ws + WS_RWP); float* RC = (float*)(p.ws + WS_RC);
    for (int idx = vcu * 512 + tid; idx < 10 * 256 * 64; idx += G * 512) {
        const int e = idx & 63, kg = (idx >> 6) & 255, lb = idx >> 14, l = lb / 5, bb = lb % 5;
        const float* W = p.router_w + (size_t)l * D * NE + e; const float* gn = p.norm_ffn + l * D + kg * 8; const float* scl = modp(p, l, bb, 4) + kg * 8;
        float v[8]; unsigned hi[4], lo[4];
#pragma unroll
        for (int j = 0; j < 8; ++j) v[j] = gn[j] * (1.f + scl[j]) * W[(size_t)(kg * 8 + j) * NE];
#pragma unroll
        for (int j = 0; j < 4; ++j) { hi[j] = cvtpk_s(v[2 * j], v[2 * j + 1]); lo[j] = cvtpk_s(v[2 * j] - __uint_as_float(hi[j] << 16), v[2 * j + 1] - __uint_as_float(hi[j] & 0xffff0000u)); }
        bf16* dst = RWP + (((size_t)lb * 2 * 128 + (kg >> 1)) * 64 + e) * 16 + (kg & 1) * 8;
        *(u32x4*)dst = (u32x4){hi[0], hi[1], hi[2], hi[3]}; *(u32x4*)(dst + (size_t)128 * 64 * 16) = (u32x4){lo[0], lo[1], lo[2], lo[3]};
    }
    for (int c = vcu; c < 80; c += G) {
        const int lb = c % 10, sl = c / 10, l = lb / 5, bb = lb % 5; const float* W = p.router_w + (size_t)l * D * NE + lane; const float* sh = modp(p, l, bb, 3);
        float a = 0.f;
#pragma unroll 32
        for (int k = sl * 256 + wave * 32; k < sl * 256 + wave * 32 + 32; ++k) a += sh[k] * W[(size_t)k * NE];
        __syncthreads(); lds[wave * 64 + lane] = a; __syncthreads();
        if (wave == 0) { float t = 0.f; for (int w = 0; w < 8; ++w) t += lds[w * 64 + lane]; RC[(lb * 8 + sl) * 64 + lane] = t; }
    }
}
DEVI void ph_normr2(const Params& p, int layer, int nrows, float* lds, int vcu, int G) {
    using fa::f32x16;
    float* part = lds; float* ssq = lds + 8 * 4096; float* rstd_l = ssq + 256; float* sraw = rstd_l + 32; float* ssel = sraw + 2048; float* gsc = ssel + 2048;
    int* gsel = (int*)(gsc + 256); int* esel = gsel + 256; float* wsel = (float*)(esel + 256);
    LAS int* hist = (LAS int*)(wsel + 256); LAS int* hbase = hist + 64;
    const int tid = otid(), lane = tid & 63, wave = __builtin_amdgcn_readfirstlane(tid >> 6), r32 = lane & 31, kgp = lane >> 5;
    bf16* HB = (bf16*)(p.ws + WS_HB);
    int* eidx = (int*)(p.ws + WS_EIDX); float* ew = (float*)(p.ws + WS_EW); int* epos = (int*)(p.ws + WS_EPOS);
    u32* cnt = (u32*)(p.ws + WS_CTL) + CW_CNT + layer * 64 * CNT_PAD;
    const float* RB = p.router_b + layer * NE; const float* gain = p.norm_ffn + layer * D;
    LAS int* tq = hbase + 64;
    unsigned* tcnt = (unsigned*)(p.ws + WS_CTL) + CW_TQ + layer * 64;
    const int ntiles = nrows >> 5;
    if (tid == 0) tq[0] = (int)atomicAdd(tcnt, 1u);
    __syncthreads();
    int tile = __builtin_amdgcn_readfirstlane(tq[0]);
    while (tile < ntiles) {
        int nxt_reg = 0;
        const int m0 = tile * 32, bb = bidx(m0);
        const bf16* xbase = (const bf16*)(p.ws + WS_X) + (size_t)m0 * D;
        {
            LAS unsigned char* xs = (LAS unsigned char*)lds + wave * 16384;
            {
                const int rr_ = lane >> 5, cc = lane & 31;
                const unsigned char* xg = (const unsigned char*)xbase + (size_t)rr_ * (D * 2) + wave * 512 + cc * 16;
                u32x4 xv[16];
#pragma unroll
                for (int i = 0; i < 16; ++i) xv[i] = *(const u32x4*)(xg + (size_t)(2 * i) * (D * 2));
#pragma unroll
                for (int i = 0; i < 16; ++i) { const int row = 2 * i + rr_; *(LAS u32x4*)(xs + row * 512 + ((cc ^ row) & 31) * 16) = xv[i]; }
            }
            const bf16* wb = (const bf16*)(p.ws + WS_RWP) + (((size_t)(layer * 5 + bb) * 2 * 128 + wave * 16) * 64 + r32) * 16 + kgp * 8;
            f32x16 acc0 = {}, acc1 = {}; float ss = 0.f;
            bf16x8 wv[2][4][4];
#pragma unroll
            for (int t = 0; t < 4; ++t) { const bf16* w_ = wb + (size_t)t * 1024;
                wv[0][t][0] = *(const bf16x8*)(w_); wv[0][t][1] = *(const bf16x8*)(w_ + 512); wv[0][t][2] = *(const bf16x8*)(w_ + (size_t)128 * 1024); wv[0][t][3] = *(const bf16x8*)(w_ + (size_t)128 * 1024 + 512); }
            asm volatile("s_waitcnt lgkmcnt(0)" ::: "memory");
#pragma unroll
            for (int sb = 0; sb < 4; ++sb) {
                if (sb < 3) {
#pragma unroll
                    for (int t = 0; t < 4; ++t) { const bf16* w_ = wb + (size_t)((sb + 1) * 4 + t) * 1024;
                        wv[(sb + 1) & 1][t][0] = *(const bf16x8*)(w_); wv[(sb + 1) & 1][t][1] = *(const bf16x8*)(w_ + 512); wv[(sb + 1) & 1][t][2] = *(const bf16x8*)(w_ + (size_t)128 * 1024); wv[(sb + 1) & 1][t][3] = *(const bf16x8*)(w_ + (size_t)128 * 1024 + 512); }
                }
                u32x4 ahv[4];
#pragma unroll
                for (int t = 0; t < 4; ++t) { const int ch = 2 * (sb * 4 + t) + kgp; ahv[t] = *(const LAS u32x4*)(xs + r32 * 512 + ((ch ^ r32) & 31) * 16); }
#pragma unroll
                for (int t = 0; t < 4; ++t) {
                    const u32x4 ah = ahv[t];
#pragma unroll
                    for (int q = 0; q < 4; ++q) { const float a = __uint_as_float(ah[q] << 16), b = __uint_as_float(ah[q] & 0xffff0000u); ss += a * a + b * b; }
                    const bf16x8 Ah = __builtin_bit_cast(bf16x8, ah);
                    acc0 = __builtin_amdgcn_mfma_f32_32x32x16_bf16(Ah, wv[sb & 1][t][0], acc0, 0, 0, 0); acc1 = __builtin_amdgcn_mfma_f32_32x32x16_bf16(Ah, wv[sb & 1][t][1], acc1, 0, 0, 0);
                    acc0 = __builtin_amdgcn_mfma_f32_32x32x16_bf16(Ah, wv[sb & 1][t][2], acc0, 0, 0, 0); acc1 = __builtin_amdgcn_mfma_f32_32x32x16_bf16(Ah, wv[sb & 1][t][3], acc1, 0, 0, 0);
                }
            }
            { auto rr = __builtin_amdgcn_permlane32_swap(__float_as_uint(ss), __float_as_uint(ss), false, false); ss = __uint_as_float(rr[0]) + __uint_as_float(rr[1]); }
            if (kgp == 0) ssq[wave * 32 + r32] = ss;
#pragma unroll
            for (int r = 0; r < 16; ++r) { part[wave * 4096 + (0 * 16 + r) * 64 + lane] = acc0[r]; part[wave * 4096 + (1 * 16 + r) * 64 + lane] = acc1[r]; }
        }
        __syncthreads();
        if (tid == 0) nxt_reg = (int)atomicAdd(tcnt, 1u);
        if (tid < 32) { float t = 0.f; for (int w = 0; w < 8; ++w) t += ssq[w * 32 + tid]; rstd_l[tid] = rsqrtf(t * (1.f / D) + EPS); }
        __syncthreads();
        {
            if (tid < 64) hist[tid] = 0;
            const float* rc = (const float*)(p.ws + WS_RC) + (layer * 5 + bb) * 8 * 64;
            float rcsum = 0.f;
#pragma unroll
            for (int sl = 0; sl < 8; ++sl) rcsum += rc[sl * 64 + lane];
            const float rbe = RB[lane]; const int g = lane >> 3;
#define DPPF(x, ctrl) __int_as_float(__builtin_amdgcn_update_dpp(0, __float_as_int(x), ctrl, 0xf, 0xf, false))
#pragma unroll 1
            for (int q = 0; q < 4; ++q) {
                const int row = wave + 8 * q, rr = (row & 3) + 4 * (row >> 3), ll = (lane & 31) + 32 * ((row >> 2) & 1), eb = lane >> 5;
                float t = 0.f;
#pragma unroll
                for (int w = 0; w < 8; ++w) t += part[w * 4096 + (eb * 16 + rr) * 64 + ll];
                const float lg = t * rstd_l[row] + rcsum; const float sg = 1.f / (1.f + expf(-lg));
                const float v = sg + rbe;
                float m1 = v, m2 = -INFINITY;
                { const float o1 = DPPF(m1, 0xB1); m2 = fminf(m1, o1); m1 = fmaxf(m1, o1); }
                { const float o1 = DPPF(m1, 0x4E), o2 = DPPF(m2, 0x4E); m2 = fmaxf(fminf(m1, o1), fmaxf(m2, o2)); m1 = fmaxf(m1, o1); }
                { const float o1 = DPPF(m1, 0x141), o2 = DPPF(m2, 0x141); m2 = fmaxf(fminf(m1, o1), fmaxf(m2, o2)); m1 = fmaxf(m1, o1); }
                const float gs = m1 + m2;
                int grank = 0;
#pragma unroll
                for (int j = 0; j < 8; ++j) { const float sj = __int_as_float(__builtin_amdgcn_readlane(__float_as_int(gs), 8 * j)); grank += (sj > gs || (sj == gs && j < g)) ? 1 : 0; }
                float vm = grank < 4 ? v : -INFINITY;
#pragma unroll 1
                for (int r = 0; r < 8; ++r) {
                    const float mx = ml::lane63(ml::prefix_max64(vm, 0));
                    const unsigned long long bal = __ballot(vm == mx);
                    const int idx = __ffsll((long long)bal) - 1;
                    if (lane == idx) { esel[row * 8 + r] = lane; wsel[row * 8 + r] = sg; vm = -INFINITY; }
                }
            }
#undef DPPF
        }
        __syncthreads();
        int lrank = 0;
        if (tid < 256) lrank = __hip_atomic_fetch_add(hist + esel[tid], 1, __ATOMIC_RELAXED, __HIP_MEMORY_SCOPE_WORKGROUP);
        __syncthreads();
        if (tid < 64) { const int c_ = hist[tid]; hbase[tid] = c_ > 0 ? (int)atomicAdd(&cnt[tid * CNT_PAD], (u32)c_) : 0; }
        __syncthreads();
        if (tid < 256) {
            const int row = tid >> 3, k = tid & 7; float wsum = 0.f;
#pragma unroll
            for (int j = 0; j < 8; ++j) wsum += wsel[row * 8 + j];
            const int e = esel[tid]; const int mm = m0 + row;
            const int pos = hbase[e] + lrank;
            eidx[mm * 8 + k] = e; epos[mm * 8 + k] = pos;
            ((int*)(p.ws + WS_LTOK))[(size_t)e * MT + pos] = mm; ((float*)(p.ws + WS_LW))[(size_t)e * MT + pos] = wsel[tid] * (2.5f / wsum);
        }
        {
            const float* sh = modp(p, layer, bb, 3); const float* scl = modp(p, layer, bb, 4);
            const float rs0 = rstd_l[wave * 4 + 0], rs1 = rstd_l[wave * 4 + 1], rs2 = rstd_l[wave * 4 + 2], rs3 = rstd_l[wave * 4 + 3];
            const bf16* src = xbase + (size_t)(wave * 4) * D; unsigned char* dstb = (unsigned char*)HB + (size_t)(m0 + wave * 4) * D;
#pragma unroll 2
            for (int j = 0; j < 8; ++j) {
                const int c = 4 * lane + 256 * j;
                uint2 xv[4];
#pragma unroll
                for (int rr = 0; rr < 4; ++rr) xv[rr] = *(const uint2*)(src + (size_t)rr * D + c);
                const float4 g = *(const float4*)(gain + c), s1 = *(const float4*)(scl + c), s0 = *(const float4*)(sh + c);
                const float gx = g.x * (1.f + s1.x), gy = g.y * (1.f + s1.y), gz = g.z * (1.f + s1.z), gw_ = g.w * (1.f + s1.w);
#pragma unroll
                for (int rr = 0; rr < 4; ++rr) { const float rs = rr == 0 ? rs0 : rr == 1 ? rs1 : rr == 2 ? rs2 : rs3;
                    const float vx = __uint_as_float(xv[rr].x << 16), vy = __uint_as_float(xv[rr].x & 0xffff0000u), vz = __uint_as_float(xv[rr].y << 16), vw = __uint_as_float(xv[rr].y & 0xffff0000u);
                    *(u32*)(dstb + (size_t)rr * D + c) = pk4_fp8(vx * rs * gx + s0.x, vy * rs * gy + s0.y, vz * rs * gz + s0.z, vw * rs * gw_ + s0.w); }
            }
        }
        if (tid == 0) tq[1] = nxt_reg;
        __syncthreads();
        tile = __builtin_amdgcn_readfirstlane(tq[1]);
    }
}

enum Phase { PH_MODS = 0, PH_NORM0, PH_INPROJ0, PH_QKNORM, PH_ATTN0, PH_OUTPROJ0, PH_NORMR0, PH_DISP0, PH_G1_0, PH_G2_0, PH_COMB0,
             PH_INPROJ1, PH_MLSTM, PH_READOUT, PH_OUTPROJ1, PH_NORMR1, PH_DISP1, PH_G1_1, PH_G2_1, PH_COMB1, PH_COUNT };

#define XB_TMO      128
#define XB_XCNT(j)  (256  + 64 * (j))
#define XB_XSUB(j)  (1280 + 64 * (j))
#define XB_XGEN(j)  (2304 + 64 * (j))
#define XB_TOP      3328
#define XB_TOPGEN   3392
#define XCD_BAR_WORDS 3456
#define XB_SPIN_CAP (1u << 18)
__device__ __forceinline__ unsigned xb_ld(unsigned* p)              { return __hip_atomic_load(p, __ATOMIC_RELAXED, __HIP_MEMORY_SCOPE_AGENT); }
__device__ __forceinline__ unsigned xb_add(unsigned* p, unsigned v) { return __hip_atomic_fetch_add(p, v, __ATOMIC_RELAXED, __HIP_MEMORY_SCOPE_AGENT); }
__device__ __forceinline__ unsigned xb_xcc_id() { return (unsigned)__builtin_amdgcn_s_getreg((3 << 11) | 20) & 0xFu; }
#define XB_SPIN(cond, bar) do { unsigned _sp = 0; while (cond) { __builtin_amdgcn_s_sleep(1); \
    if ((++_sp & 255u) == 0u) { if (xb_ld(&(bar)[XB_TMO])) break; if (_sp > XB_SPIN_CAP) { atomicAdd(&(bar)[XB_TMO], 1u); break; } } } } while (0)
struct XcdBarrier { unsigned* bar; unsigned x; volatile LAS unsigned* st; };
__device__ __forceinline__ XcdBarrier xcd_barrier_post(unsigned* bar, volatile LAS unsigned* st) {
    XcdBarrier b; b.bar = bar; b.x = xb_xcc_id(); b.st = st;
    if (threadIdx.x == 0) (void)xb_add(&bar[XB_XCNT(b.x)], 1u);
    return b;
}
__device__ __forceinline__ void xcd_barrier_complete(unsigned* bar, unsigned x, unsigned& nloc, unsigned& nx) {
    const unsigned G = gridDim.x * gridDim.y * gridDim.z;
    unsigned sum, cnt, mine, sp = 0u;
    for (;;) {
        sum = 0u; cnt = 0u; mine = 0u;
#pragma unroll 1
        for (unsigned j = 0; j < 16; ++j) { const unsigned c = xb_ld(&bar[XB_XCNT(j)]); sum += c; cnt += (c > 0u) ? 1u : 0u; mine = (j == x) ? c : mine; }
        if (sum == G) break;
        __builtin_amdgcn_s_sleep(1);
        if ((++sp & 255u) == 0u) { if (xb_ld(&bar[XB_TMO])) break; if (sp > XB_SPIN_CAP) { atomicAdd(&bar[XB_TMO], 1u); break; } }
    }
    nloc = mine > 0u ? mine : 1u; nx = cnt > 0u ? cnt : 1u;
}
__device__ __forceinline__ void xcd_barrier(const XcdBarrier& b) {
    asm volatile("s_waitcnt vmcnt(0)" ::: "memory");
    __syncthreads();
    if (threadIdx.x == 0) {
        unsigned* bar = b.bar;
        __builtin_amdgcn_s_waitcnt(0);
        unsigned nloc = b.st[0], nx = b.st[1];
        if (nloc == 0u) { xcd_barrier_complete(bar, b.x, nloc, nx); b.st[0] = nloc; b.st[1] = nx; }
        const unsigned old = xb_add(&bar[XB_XSUB(b.x)], 1u);
        const unsigned gen = old / nloc;
        if (old + 1u == (gen + 1u) * nloc) {
            __builtin_amdgcn_fence(__ATOMIC_RELEASE, "agent");
            asm volatile("s_waitcnt vmcnt(0)" ::: "memory");
            const unsigned og = xb_add(&bar[XB_TOP], 1u);
            const unsigned tg = og / nx;
            if (og + 1u == (tg + 1u) * nx) xb_add(&bar[XB_TOPGEN], 1u);
            else XB_SPIN(xb_ld(&bar[XB_TOPGEN]) == tg, bar);
            __builtin_amdgcn_fence(__ATOMIC_ACQUIRE, "agent");
            xb_add(&bar[XB_XGEN(b.x)], 1u);
            asm volatile("s_waitcnt vmcnt(0)" ::: "memory");
        } else {
            XB_SPIN(xb_ld(&bar[XB_XGEN(b.x)]) == gen, bar);
            __builtin_amdgcn_fence(__ATOMIC_ACQUIRE, "agent");
            asm volatile("s_waitcnt vmcnt(0)" ::: "memory");
        }
    }
    __syncthreads();
}
constexpr int CW_BAR = 4096;
static_assert((CW_BAR + XCD_BAR_WORDS) * 4 <= (int)CTL_BYTES, "barrier words inside the memset region");

typedef const __attribute__((address_space(4))) Params* KArgs;
#if defined(__HIP_DEVICE_COMPILE__)
DEVI Params kargs() { KArgs k = (KArgs)__builtin_amdgcn_kernarg_segment_ptr(); asm volatile("" : "+s"(k)); Params q; q.x = k->x; q.c = k->c; q.ctx = k->ctx; q.c_ctx = k->c_ctx; q.ada_w = k->ada_w; q.ada_b = k->ada_b; q.norm_mix = k->norm_mix; q.norm_ffn = k->norm_ffn; q.attn_w_in = k->attn_w_in; q.attn_w_out = k->attn_w_out; q.attn_rpb = k->attn_rpb; q.attn_q_gain = k->attn_q_gain; q.attn_k_gain = k->attn_k_gain; q.ml_w_in = k->ml_w_in; q.ml_w_out = k->ml_w_out; q.ml_gate_b = k->ml_gate_b; q.ml_head_gain = k->ml_head_gain; q.router_w = k->router_w; q.router_b = k->router_b; q.exp_w1 = k->exp_w1; q.exp_w3 = k->exp_w3; q.exp_w2 = k->exp_w2; q.sh_w1 = k->sh_w1; q.sh_w3 = k->sh_w3; q.sh_w2 = k->sh_w2; q.final_norm = k->final_norm; q.out = k->out; q.ws = k->ws; q.lo = k->lo; q.hi = k->hi; return q; }
#else
DEVI Params kargs() { return Params{}; }
#endif
constexpr int MEGA_LDS = 157 * 1024;
static_assert(pg::LDS_TOTAL <= MEGA_LDS, "LDS map");
__global__ void __launch_bounds__(512, 2) k_mega(Params p) {
    extern __shared__ __attribute__((aligned(16))) unsigned char lds_raw[];
    LAS unsigned char* lds = (LAS unsigned char*)lds_raw;
    float* ldsf = (float*)lds_raw;
    const int G = gridDim.x, bx = blockIdx.x;
    const int vcu = (G % 8 == 0) ? (bx % 8) * (G / 8) + bx / 8 : bx;
    if (threadIdx.x < 16) ((LAS unsigned*)(lds + pg::MISC_OFF))[threadIdx.x] = 0u;
    __syncthreads();
    XcdBarrier bar; bar.bar = (unsigned*)(p.ws + WS_CTL) + CW_BAR; bar.x = 0; bar.st = nullptr;
    if (p.hi - p.lo > 1) bar = xcd_barrier_post((unsigned*)(p.ws + WS_CTL) + CW_BAR, (volatile LAS unsigned*)(lds + pg::MISC_OFF));
#ifndef SITEMASK
#define SITEMASK 0xFFFFFu
#endif
#define INF(k) (p.lo <= (k) && (k) < p.hi)
#define INS(site, k) (((SITEMASK >> (site)) & 1u) && INF(k))
#ifdef PROBE_REP
#define REPF(k) for (int rep_ = 0; rep_ < (((k) == PROBE_REP) ? 2 : 1); ++rep_)
#else
#define REPF(k)
#endif
#define SEAM(k) do { if (INF(k) && INF((k) + 1)) xcd_barrier(bar); } while (0)
    REPF(PH_MODS) if (INS(PH_MODS, PH_MODS)) { const Params q = kargs(); __syncthreads(); ph_mods(q, ldsf, vcu, G); __syncthreads(); ph_cvt(q, lds, vcu, G); }
    SEAM(PH_MODS);
    REPF(PH_NORM0) if (INS(PH_NORM0, PH_NORM0)) { const Params q = kargs(); ph_norm(q, 0, q.x, q.ctx, q.norm_mix, 0, 1, MT, vcu, G); ph_router_prep(q, ldsf, vcu, G); }
    SEAM(PH_NORM0);
    for (int layer = 0; layer < 2; ++layer) {
        const int po = 9 * layer;
        REPF(PH_INPROJ0 + po) if (INS(PH_INPROJ0, PH_INPROJ0 + po)) {
            const Params q = kargs();
            const int nN = layer == 0 ? AIW / 256 : MINP / 256;
            const int nu = pg::fill_dense(lds, MT / 256, nN, G, bx);
            __syncthreads();
            pg::ListOrder S{(const LAS int*)(lds + pg::UD_OFF), nu};
            EpiBf16Store E{(bf16*)(q.ws + WS_QKV), layer == 0 ? AIW : MIWM, (float*)(q.ws + WS_G), layer == 0 ? -1 : MIWM / 256, 1.f / W13_SCALE};
            pg::gemm_phase<EpiBf16Store, false, true>(lds, q.ws + WS_HB, q.ws + (layer == 0 ? WT_AIN : WT_MIN), D, 0, S, E);
        }
        SEAM(PH_INPROJ0 + po);
        if (layer == 0) {
            REPF(PH_QKNORM) if (INS(PH_QKNORM, PH_QKNORM)) { const Params q = kargs(); ph_qknorm(q, vcu, G); }
            SEAM(PH_QKNORM);
            REPF(PH_ATTN0) if (INS(PH_ATTN0, PH_ATTN0)) { const Params q = kargs(); ph_attn0(q, (char*)lds_raw, vcu, G); }
            SEAM(PH_ATTN0);
        } else {
            REPF(PH_MLSTM) if (INS(PH_MLSTM, PH_MLSTM)) { const Params q = kargs(); ml::ph_mlstm(q, (char*)lds_raw, vcu, G); }
            SEAM(PH_MLSTM);
            REPF(PH_READOUT) if (INS(PH_READOUT, PH_READOUT)) { const Params q = kargs(); ph_readout(q, vcu, G); }
            SEAM(PH_READOUT);
        }
        REPF(PH_OUTPROJ0 + po) if (INS(PH_OUTPROJ0, PH_OUTPROJ0 + po)) {
            const Params q = kargs();
            const int nu = pg::fill_dense(lds, (layer == 0 ? MT : ML) / 256, D / 256, G, bx);
            __syncthreads();
            pg::ListOrder S{(const LAS int*)(lds + pg::UD_OFF), nu};
            EpiResid E{(bf16*)(q.ws + WS_X), (const float*)(q.ws + WS_MOD) + (size_t)layer * 5 * 6 * D};
            pg::gemm_phase<EpiResid, false, true>(lds, q.ws + WS_AO, q.ws + (layer == 0 ? WT_AOUT : WT_MOUT), D, 0, S, E);
        }
        SEAM(PH_OUTPROJ0 + po);
        REPF(PH_NORMR0 + po) if (INS(PH_NORMR0, PH_NORMR0 + po)) { const Params q = kargs(); ph_normr2(q, layer, layer == 0 ? MT : ML, ldsf, vcu, G); }
        SEAM(PH_NORMR0 + po);
        REPF(PH_G1_0 + po) if (INS(PH_G1_0, PH_G1_0 + po)) {
            const Params q = kargs();
            const int nu = moe_setup<true>(q, lds, layer, layer == 0 ? MT : ML, vcu, G);
            pg::ListOrder S{(const LAS int*)(lds + pg::UD_OFF), nu};
            EpiSwiGLU E{(bf16*)(q.ws + WS_ACT)};
            pg::gemm_phase<EpiSwiGLU, true, true>(lds, q.ws + WS_HB, q.ws + WT_W13 + (size_t)layer * 65 * 1024 * D, D, (size_t)1024 * D, S, E);
        }
        SEAM(PH_G1_0 + po);
        REPF(PH_G2_0 + po) if (INS(PH_G2_0, PH_G2_0 + po)) {
            const Params q = kargs();
            const int nu = moe_setup<false>(q, lds, layer, layer == 0 ? MT : ML, vcu, G);
            pg::ListOrder S{(const LAS int*)(lds + pg::UD_OFF), nu};
            EpiScale E{(unsigned char*)(q.ws + WS_Y), (const LAS float*)(lds + pg::GT_OFF)};
            pg::gemm_phase<EpiScale, false, true>(lds, q.ws + WS_ACT, q.ws + WT_W2 + (size_t)layer * 65 * D * EDIM, EDIM, (size_t)D * EDIM, S, E);
        }
        SEAM(PH_G2_0 + po);
        REPF(PH_COMB0 + po) if (INS(PH_COMB0, PH_COMB0 + po)) { const Params q = kargs(); ph_combine(q, layer, (int*)ldsf, vcu, G); }
        if (layer == 0) SEAM(PH_COMB0);
    }
#undef INF
#undef INS
#undef SEAM
}

#ifndef N_LAUNCH
#define N_LAUNCH 1
#endif
extern "C" void kernel_launch(void* const* d_in, const int* in_sizes, int n_in, void* d_out, int out_size, void* d_ws, size_t ws_size, hipStream_t stream) {
    static int grid = 0;
    if (grid == 0) {
        if (n_in != 26 || out_size != ML * D || ws_size < WS_END) { fprintf(stderr, "kernel_launch: unexpected shapes n_in %d out %d ws %zu\n", n_in, out_size, ws_size); grid = -1; return; }
        int dev = 0, cus = 0, per_cu = 0;
        if (hipGetDevice(&dev) != hipSuccess || hipDeviceGetAttribute(&cus, hipDeviceAttributeMultiprocessorCount, dev) != hipSuccess) { fprintf(stderr, "kernel_launch: device query failed\n"); grid = -1; return; }
        if (hipFuncSetAttribute((const void*)k_mega, hipFuncAttributeMaxDynamicSharedMemorySize, MEGA_LDS) != hipSuccess) { fprintf(stderr, "kernel_launch: hipFuncSetAttribute failed\n"); grid = -1; return; }
        if (hipOccupancyMaxActiveBlocksPerMultiprocessor(&per_cu, (const void*)k_mega, 512, MEGA_LDS) != hipSuccess || per_cu < 1) fprintf(stderr, "kernel_launch: note: occupancy query reports %d blocks per CU\n", per_cu);
        (void)hipGetLastError();
        grid = cus;
    }
    if (grid < 0) return;
    (void)hipMemsetAsync((char*)d_ws + WS_CTL, 0, CTL_BYTES, stream);
    Params p{};
    const float** pp = (const float**)&p;
    for (int i = 0; i < 26; ++i) pp[i] = (const float*)d_in[i];
    p.out = (float*)d_out; p.ws = (unsigned char*)d_ws;
#if N_LAUNCH == 1
    p.lo = 0; p.hi = PH_COUNT;
    hipLaunchKernelGGL(k_mega, dim3(grid), dim3(512), MEGA_LDS, stream, p);
#else
    for (int ph = 0; ph < PH_COUNT; ++ph) { p.lo = ph; p.hi = ph + 1; hipLaunchKernelGGL(k_mega, dim3(grid), dim3(512), MEGA_LDS, stream, p); }
#endif
    const hipError_t le = hipPeekAtLastError();
    if (le != hipSuccess) fprintf(stderr, "kernel_launch: launch failed: %s\n", hipGetErrorName(le));
}
```

```cpp
#include <hip/hip_runtime.h>
#include <cstdio>
#include <cstdint>
#include <type_traits>

#define DEVI __device__ __forceinline__
#define LAS __attribute__((address_space(3)))
typedef short bf16x8 __attribute__((ext_vector_type(8)));
typedef float f32x4 __attribute__((ext_vector_type(4)));
typedef unsigned u32x4 __attribute__((ext_vector_type(4)));
typedef int v4i32 __attribute__((ext_vector_type(4)));
typedef int v8i32 __attribute__((ext_vector_type(8)));
typedef unsigned short bf16;
typedef unsigned int u32;

constexpr int D = 2048, NB = 4, SEQ = 4096, CTXL = 256, GRIDW = 64;
constexpr int ML = NB * SEQ;
constexpr int MC = NB * CTXL;
constexpr int MT = ML + MC;
constexpr int AIW = 4608;
constexpr int MIW = 6176, MIWM = 6144;
constexpr int NE = 64, TOPK = 8, EDIM = 512;
constexpr int RS = MT * 8 + 64 * 256;
constexpr int SH0 = RS;
constexpr int NSLOT = RS + MT;
constexpr float EPS = 1e-6f;
constexpr float QSCALE = 0.08838834764831845f;

constexpr size_t MiB = (size_t)1 << 20;
constexpr size_t WS_CTL = 0, CTL_BYTES = 1 * MiB;
constexpr size_t WS_MOD = 1 * MiB;
constexpr size_t WS_XC = 2 * MiB;
constexpr size_t WS_G = 10 * MiB;
constexpr size_t WS_EIDX = 13 * MiB, WS_EW = 14 * MiB, WS_EPOS = 15 * MiB, WS_TSLOT = 16 * MiB, WS_STOK = 17 * MiB, WS_SW = 18 * MiB, WS_EOFF = 19 * MiB;
constexpr size_t WS_HB = 20 * MiB;
constexpr size_t WS_ACT = 88 * MiB;
constexpr size_t WS_Y = 257 * MiB;
constexpr size_t WS_QKV = 257 * MiB;
constexpr size_t WS_AO = 461 * MiB;
constexpr size_t WS_HD = 529 * MiB;
constexpr size_t WS_WT = 933 * MiB;
constexpr size_t WS_RWP = 1772 * MiB;
constexpr size_t WS_RC = 1777 * MiB;
constexpr size_t WS_LTOK = 1780 * MiB;
constexpr size_t WS_LW = 1785 * MiB;
constexpr size_t WS_X = 1790 * MiB;
constexpr size_t WS_END = 1858 * MiB;
constexpr int CW_TQ = 24576;
constexpr int CW_CNT = 16384, CNT_PAD = 32;

struct Params {
    const float *x, *c, *ctx, *c_ctx, *ada_w, *ada_b, *norm_mix, *norm_ffn, *attn_w_in, *attn_w_out, *attn_rpb, *attn_q_gain, *attn_k_gain,
        *ml_w_in, *ml_w_out, *ml_gate_b, *ml_head_gain, *router_w, *router_b, *exp_w1, *exp_w3, *exp_w2, *sh_w1, *sh_w3, *sh_w2, *final_norm;
    float* out; unsigned char* ws;
    int lo, hi;
};

DEVI int otid() { int t = threadIdx.x; asm volatile("" : "+v"(t)); return t; }
DEVI float bf2f(bf16 b) { return __uint_as_float(((u32)b) << 16); }
DEVI bf16 f2bf(float f) { u32 u = __float_as_uint(f); u += 0x7fffu + ((u >> 16) & 1u); return (bf16)(u >> 16); }
DEVI u32 pk2(float lo, float hi) { return (u32)f2bf(lo) | ((u32)f2bf(hi) << 16); }
DEVI float wave_sum(float v) {
#pragma unroll
    for (int o = 32; o >= 1; o >>= 1) v += __shfl_xor(v, o);
    return v;
}
DEVI unsigned pg_cvt_pk_bf16(float lo, float hi) { unsigned r; asm volatile("v_cvt_pk_bf16_f32 %0, %1, %2" : "=v"(r) : "v"(lo), "v"(hi)); return r; }
DEVI float wave_prefix_dpp(float x) {
#define WS_DPP(ctrl, rmask) x += __int_as_float(__builtin_amdgcn_update_dpp(0, __float_as_int(x), ctrl, rmask, 0xf, false))
    WS_DPP(0x111, 0xf); WS_DPP(0x112, 0xf); WS_DPP(0x114, 0xf); WS_DPP(0x118, 0xf); WS_DPP(0x142, 0xa); WS_DPP(0x143, 0xc);
#undef WS_DPP
    return x;
}
DEVI float wave_sum_dpp(float x) {
#define WS_DPP(ctrl, rmask) x += __int_as_float(__builtin_amdgcn_update_dpp(0, __float_as_int(x), ctrl, rmask, 0xf, false))
    WS_DPP(0x111, 0xf); WS_DPP(0x112, 0xf); WS_DPP(0x114, 0xf); WS_DPP(0x118, 0xf); WS_DPP(0x142, 0xa); WS_DPP(0x143, 0xc);
#undef WS_DPP
    return __int_as_float(__builtin_amdgcn_readlane(__float_as_int(x), 63));
}
DEVI u32 pk4_fp8(float a, float b, float c, float d) { int w = 0; w = __builtin_amdgcn_cvt_pk_fp8_f32(a, b, w, false); w = __builtin_amdgcn_cvt_pk_fp8_f32(c, d, w, true); return (u32)w; }
DEVI int bidx(int m) { return m < ML ? (m >> 12) : 4; }
DEVI const float* modp(const Params& p, int layer, int bb, int i) { return (const float*)(p.ws + WS_MOD) + ((size_t)((layer * 5 + bb) * 6 + i)) * D; }
DEVI float silu(float x) { return x / (1.f + __expf(-x)); }
DEVI float sigmoidf(float x) { return 1.f / (1.f + __expf(-x)); }

DEVI void ph_mods(const Params& p, float* lds, int vcu, int G) {
    float* sc = lds;
    float* red = lds + 5 * D;
    const int tid = otid();
    for (int i = tid; i < 5 * D; i += 512) { const int bb = i / D, k = i % D; const float v = bb < 4 ? p.c[bb * D + k] : p.c_ctx[k]; sc[i] = silu(v); }
    __syncthreads();
    const int tn = tid & 7, tk = tid >> 3;
    for (int item = vcu; item < 2 * 384; item += G) {
        const int l = item / 384, n0 = (item % 384) * 32;
        const float* W = p.ada_w + (size_t)l * D * 12288 + n0 + tn * 4;
        float4 acc[5];
#pragma unroll
        for (int b = 0; b < 5; ++b) acc[b] = make_float4(0.f, 0.f, 0.f, 0.f);
#pragma unroll 1
        for (int k8 = 0; k8 < 4; ++k8) {
            float4 w[8];
#pragma unroll
            for (int j = 0; j < 8; ++j) w[j] = *(const float4*)(W + (size_t)(tk * 32 + k8 * 8 + j) * 12288);
#pragma unroll
            for (int j = 0; j < 8; ++j) { const int k = tk * 32 + k8 * 8 + j;
#pragma unroll
                for (int b = 0; b < 5; ++b) { const float s_ = sc[b * D + k]; acc[b].x += s_ * w[j].x; acc[b].y += s_ * w[j].y; acc[b].z += s_ * w[j].z; acc[b].w += s_ * w[j].w; } }
        }
#pragma unroll
        for (int b = 0; b < 5; ++b) *(float4*)(red + (tk * 5 + b) * 32 + tn * 4) = acc[b];
        __syncthreads();
        if (tid < 160) {
            const int b = tid / 32, n = tid % 32; float s_ = 0.f;
            for (int g = 0; g < 64; ++g) s_ += red[(g * 5 + b) * 32 + n];
            ((float*)(p.ws + WS_MOD))[(size_t)(l * 5 + b) * 12288 + n0 + n] = s_ + p.ada_b[l * 12288 + n0 + n];
        }
        __syncthreads();
    }
}

DEVI void norm_row_load(const float* src, float4 (&v)[8], float& rstd, int lane) {
    float ss = 0.f;
#pragma unroll
    for (int j = 0; j < 8; ++j) { v[j] = *(const float4*)(src + 4 * lane + 256 * j); ss += v[j].x * v[j].x + v[j].y * v[j].y + v[j].z * v[j].z + v[j].w * v[j].w; }
    ss = wave_sum(ss);
    rstd = rsqrtf(ss * (1.f / D) + EPS);
}
DEVI void ph_norm(const Params& p, int layer, const float* xlat, const float* xctx, const float* gain, int ish, int isc, int nrows, int vcu, int G) {
    const int tid = otid(), lane = tid & 63, wave = tid >> 6;
    bf16* HB = (bf16*)(p.ws + WS_HB); bf16* X = (bf16*)(p.ws + WS_X);
    const int rot = (vcu * 8 + wave) & 7;
    for (int m0 = vcu * 8 + wave; m0 < nrows; m0 += 2 * G * 8) {
        const int mA = m0, mB = m0 + G * 8 < nrows ? m0 + G * 8 : m0;
        const float* srcA = mA < ML ? xlat + (size_t)mA * D : xctx + (size_t)(mA - ML) * D;
        const float* srcB = mB < ML ? xlat + (size_t)mB * D : xctx + (size_t)(mB - ML) * D;
        float4 vA[8], vB[8]; float ssA = 0.f, ssB = 0.f;
#pragma unroll
        for (int j = 0; j < 8; ++j) { vA[j] = *(const float4*)(srcA + 4 * lane + 256 * ((j + rot) & 7)); vB[j] = *(const float4*)(srcB + 4 * lane + 256 * ((j + rot) & 7)); }
#pragma unroll
        for (int j = 0; j < 8; ++j) { ssA += vA[j].x * vA[j].x + vA[j].y * vA[j].y + vA[j].z * vA[j].z + vA[j].w * vA[j].w; ssB += vB[j].x * vB[j].x + vB[j].y * vB[j].y + vB[j].z * vB[j].z + vB[j].w * vB[j].w; }
        const float rstdA = rsqrtf(wave_sum_dpp(ssA) * (1.f / D) + EPS), rstdB = rsqrtf(wave_sum_dpp(ssB) * (1.f / D) + EPS);
        const int bA = bidx(mA), bB = bidx(mB);
        const float* shA = modp(p, layer, bA, ish); const float* sclA = modp(p, layer, bA, isc); const float* shB = modp(p, layer, bB, ish); const float* sclB = modp(p, layer, bB, isc);
#pragma unroll
        for (int j = 0; j < 8; ++j) {
            const int c = 4 * lane + 256 * ((j + rot) & 7);
            const float4 g = *(const float4*)(gain + c), s1 = *(const float4*)(sclA + c), s0 = *(const float4*)(shA + c), t1 = *(const float4*)(sclB + c), t0 = *(const float4*)(shB + c);
            *(u32*)((unsigned char*)HB + (size_t)mA * D + c) = pk4_fp8(vA[j].x * rstdA * g.x * (1.f + s1.x) + s0.x, vA[j].y * rstdA * g.y * (1.f + s1.y) + s0.y, vA[j].z * rstdA * g.z * (1.f + s1.z) + s0.z, vA[j].w * rstdA * g.w * (1.f + s1.w) + s0.w);
            *(u32*)((unsigned char*)HB + (size_t)mB * D + c) = pk4_fp8(vB[j].x * rstdB * g.x * (1.f + t1.x) + t0.x, vB[j].y * rstdB * g.y * (1.f + t1.y) + t0.y, vB[j].z * rstdB * g.z * (1.f + t1.z) + t0.z, vB[j].w * rstdB * g.w * (1.f + t1.w) + t0.w);
            uint2 xw; xw.x = pk2(vA[j].x, vA[j].y); xw.y = pk2(vA[j].z, vA[j].w); *(uint2*)(X + (size_t)mA * D + c) = xw;
            uint2 yw; yw.x = pk2(vB[j].x, vB[j].y); yw.y = pk2(vB[j].z, vB[j].w); *(uint2*)(X + (size_t)mB * D + c) = yw;
        }
    }
}

DEVI void ph_qknorm(const Params& p, int vcu, int G) {
    const int tid = otid(), lane = tid & 63, wave = tid >> 6;
    bf16* Q = (bf16*)(p.ws + WS_QKV);
    const float invf = exp2f(-(float)(lane & 31) * (13.287712379549449f / 32.f));
    const float gq0 = p.attn_q_gain[2 * lane], gq1 = p.attn_q_gain[2 * lane + 1], gk0 = p.attn_k_gain[2 * lane], gk1 = p.attn_k_gain[2 * lane + 1];
    for (int m = vcu * 8 + wave; m < MT; m += G * 8) {
        bf16* ptr = Q + (size_t)m * AIW + 3072 + 2 * lane;
        u32 v[10];
#pragma unroll
        for (int hh = 0; hh < 10; ++hh) v[hh] = *(const u32*)(ptr + hh * 128);
        float sn = 0.f, cs = 1.f;
        if (m < ML) { const int sq = m & 4095; const float pos = lane < 32 ? (float)(sq >> 6) : (float)(sq & 63);
            sn = __sinf(pos * invf); cs = __cosf(pos * invf); }
#pragma unroll
        for (int hh = 0; hh < 10; ++hh) {
            float x0 = __uint_as_float(v[hh] << 16), x1 = __uint_as_float(v[hh] & 0xffff0000u);
            const float ss = wave_sum_dpp(x0 * x0 + x1 * x1); const float rstd = rsqrtf(ss * (1.f / 128.f) + EPS);
            x0 = x0 * rstd * (hh < 8 ? gq0 : gk0); x1 = x1 * rstd * (hh < 8 ? gq1 : gk1);
            const float y0 = x0 * cs - x1 * sn, y1 = x0 * sn + x1 * cs;
            *(u32*)(ptr + hh * 128) = pk2(y0, y1);
        }
    }
}

DEVI void ph_readout(const Params& p, int vcu, int G) {
    const int tid = otid(), lane = tid & 63, wave = tid >> 6;
    const bf16* HD = (const bf16*)(p.ws + WS_HD); const bf16* Q = (const bf16*)(p.ws + WS_QKV); bf16* AO = (bf16*)(p.ws + WS_AO);
    float4 g[8];
#pragma unroll
    for (int h = 0; h < 8; ++h) g[h] = *(const float4*)(p.ml_head_gain + h * 256 + 4 * lane);
    typedef unsigned u32x2_ __attribute__((ext_vector_type(2)));
    for (int m = vcu * 8 + wave; m < ML; m += G * 8) {
        u32x2_ a[8], b2[8], ov[8];
#pragma unroll
        for (int h = 0; h < 8; ++h) { const int c = h * 256 + 4 * lane;
            a[h] = __builtin_nontemporal_load((const u32x2_*)(HD + (size_t)m * D + c)); b2[h] = __builtin_nontemporal_load((const u32x2_*)(HD + ((size_t)ML + m) * D + c));
            ov[h] = __builtin_nontemporal_load((const u32x2_*)(Q + (size_t)m * MIWM + 4096 + c)); }
#pragma unroll
        for (int h = 0; h < 8; ++h) { const int c = h * 256 + 4 * lane;
            const float x[4] = {__uint_as_float(a[h].x << 16) + __uint_as_float(b2[h].x << 16), __uint_as_float(a[h].x & 0xffff0000u) + __uint_as_float(b2[h].x & 0xffff0000u),
                                __uint_as_float(a[h].y << 16) + __uint_as_float(b2[h].y << 16), __uint_as_float(a[h].y & 0xffff0000u) + __uint_as_float(b2[h].y & 0xffff0000u)};
            const float ss = wave_sum_dpp(x[0] * x[0] + x[1] * x[1] + x[2] * x[2] + x[3] * x[3]); const float rstd = rsqrtf(ss * (1.f / 256.f) + EPS);
            const float o0 = __uint_as_float(ov[h].x << 16), o1 = __uint_as_float(ov[h].x & 0xffff0000u), o2 = __uint_as_float(ov[h].y << 16), o3 = __uint_as_float(ov[h].y & 0xffff0000u);
            const float s0 = __builtin_amdgcn_rcpf(1.f + __expf(-o0)), s1 = __builtin_amdgcn_rcpf(1.f + __expf(-o1)), s2 = __builtin_amdgcn_rcpf(1.f + __expf(-o2)), s3 = __builtin_amdgcn_rcpf(1.f + __expf(-o3));
            *(u32*)((unsigned char*)AO + (size_t)m * D + c) = pk4_fp8(x[0] * rstd * g[h].x * s0, x[1] * rstd * g[h].y * s1, x[2] * rstd * g[h].z * s2, x[3] * rstd * g[h].w * s3);
        }
    }
}

DEVI void ph_combine(const Params& p, int layer, int* offl, int vcu, int G) {
    const int tid = otid(), lane = tid & 63, wave = tid >> 6;
    const unsigned char* Y = (const unsigned char*)(p.ws + WS_Y);
    unsigned char* HB = (unsigned char*)(p.ws + WS_HB); bf16* X = (bf16*)(p.ws + WS_X);
    const int nrows = layer == 0 ? MT : ML;
    {
        const u32* cnt = (const u32*)(p.ws + WS_CTL) + CW_CNT + layer * 64 * CNT_PAD;
        if (tid < 64) { const int c_ = (int)cnt[tid * CNT_PAD]; const int pc = (c_ + 255) & ~255; offl[64 + tid] = c_; offl[tid] = (int)wave_prefix_dpp((float)pc) - pc; }
        __syncthreads();
    }
    const int* eidx = (const int*)(p.ws + WS_EIDX); const int* epos = (const int*)(p.ws + WS_EPOS);
    for (int m = vcu * 8 + wave; m < nrows; m += G * 8) {
        bf16* xr = X + (size_t)m * D; float* orow = p.out + (size_t)m * D;
        const int bb = bidx(m); const float* g5 = modp(p, layer, bb, 5);
        int sl[9];
#pragma unroll
        for (int k = 0; k < 8; ++k) sl[k] = offl[eidx[m * 8 + k]] + epos[m * 8 + k];
        sl[8] = SH0 + m;
        u32x4 y[2][9], xv[2][2];
#pragma unroll
        for (int j = 0; j < 2; ++j) {
#pragma unroll
            for (int k = 0; k < 9; ++k) y[j][k] = __builtin_nontemporal_load((const u32x4*)(Y + (size_t)sl[k] * D + j * 1024 + lane * 16));
            xv[j][0] = *(const u32x4*)(xr + j * 1024 + lane * 16); xv[j][1] = *(const u32x4*)(xr + j * 1024 + lane * 16 + 8);
        }
        float o[32]; float ss = 0.f;
#pragma unroll
        for (int j = 0; j < 2; ++j) {
            const int c = j * 1024 + lane * 16;
            float f[16];
#pragma unroll
            for (int i = 0; i < 16; ++i) f[i] = 0.f;
#pragma unroll
            for (int k = 0; k < 9; ++k) {
                const unsigned yy[4] = {y[j][k].x, y[j][k].y, y[j][k].z, y[j][k].w};
#pragma unroll
                for (int q = 0; q < 4; ++q) { const auto lo = __builtin_amdgcn_cvt_pk_f32_fp8((int)yy[q], false), hi = __builtin_amdgcn_cvt_pk_f32_fp8((int)yy[q], true);
                    f[4 * q + 0] += lo[0]; f[4 * q + 1] += lo[1]; f[4 * q + 2] += hi[0]; f[4 * q + 3] += hi[1]; }
            }
            const unsigned xw[8] = {xv[j][0].x, xv[j][0].y, xv[j][0].z, xv[j][0].w, xv[j][1].x, xv[j][1].y, xv[j][1].z, xv[j][1].w};
#pragma unroll
            for (int q = 0; q < 4; ++q) {
                const float4 g0 = *(const float4*)(g5 + c + 4 * q);
                const float o0 = __uint_as_float(xw[2 * q] << 16) + g0.x * f[4 * q + 0] * (1.f / 8.f), o1 = __uint_as_float(xw[2 * q] & 0xffff0000u) + g0.y * f[4 * q + 1] * (1.f / 8.f);
                const float o2 = __uint_as_float(xw[2 * q + 1] << 16) + g0.z * f[4 * q + 2] * (1.f / 8.f), o3 = __uint_as_float(xw[2 * q + 1] & 0xffff0000u) + g0.w * f[4 * q + 3] * (1.f / 8.f);
                ss += o0 * o0 + o1 * o1 + o2 * o2 + o3 * o3;
                o[j * 16 + 4 * q + 0] = o0; o[j * 16 + 4 * q + 1] = o1; o[j * 16 + 4 * q + 2] = o2; o[j * 16 + 4 * q + 3] = o3;
            }
        }
        const float rstd = rsqrtf(wave_sum_dpp(ss) * (1.f / D) + EPS);
        const float* gain = layer == 0 ? p.norm_mix + D : p.final_norm;
        const float* sh = modp(p, 1, bb, 0); const float* scl = modp(p, 1, bb, 1);
#pragma unroll
        for (int j = 0; j < 2; ++j) {
            const int c = j * 1024 + lane * 16;
            if (layer == 0) {
                u32x4 w0, w1, ob;
#pragma unroll
                for (int q = 0; q < 4; ++q) {
                    const float4 g0 = *(const float4*)(gain + c + 4 * q), a0 = *(const float4*)(scl + c + 4 * q), b0 = *(const float4*)(sh + c + 4 * q);
                    const float x0 = o[j * 16 + 4 * q + 0], x1 = o[j * 16 + 4 * q + 1], x2 = o[j * 16 + 4 * q + 2], x3 = o[j * 16 + 4 * q + 3];
                    const unsigned p0 = pg_cvt_pk_bf16(x0, x1), p1 = pg_cvt_pk_bf16(x2, x3);
                    if (q < 2) { w0[2 * q] = p0; w0[2 * q + 1] = p1; } else { w1[2 * (q - 2)] = p0; w1[2 * (q - 2) + 1] = p1; }
                    ob[q] = pk4_fp8(x0 * rstd * g0.x * (1.f + a0.x) + b0.x, x1 * rstd * g0.y * (1.f + a0.y) + b0.y, x2 * rstd * g0.z * (1.f + a0.z) + b0.z, x3 * rstd * g0.w * (1.f + a0.w) + b0.w);
                }
                *(u32x4*)(xr + c) = w0; *(u32x4*)(xr + c + 8) = w1;
                *(u32x4*)(HB + (size_t)m * D + c) = ob;
            } else {
#pragma unroll
                for (int q = 0; q < 4; ++q) {
                    const float4 g0 = *(const float4*)(gain + c + 4 * q);
                    float4 r0; r0.x = o[j * 16 + 4 * q + 0] * rstd * g0.x; r0.y = o[j * 16 + 4 * q + 1] * rstd * g0.y; r0.z = o[j * 16 + 4 * q + 2] * rstd * g0.z; r0.w = o[j * 16 + 4 * q + 3] * rstd * g0.w;
                    *(float4*)(orow + c + 4 * q) = r0;
                }
            }
        }
    }
}

namespace pg {
struct Frag2 { bf16x8 k[2]; };
template <bool F8> struct FragT { typedef Frag2 T; };
template <> struct FragT<true> { typedef v8i32 T; };
constexpr int BM = 256, BK = 64, HALF = 128, HTB = HALF * BK * 2, STAGE_BYTES = 8 * HTB, NXCD = 8, WGM = 8;
__host__ __device__ __forceinline__ int lds_byte(int r, int c) { const int st = (r >> 4) * 2 + (c >> 5), rr = r & 15, cc = c & 31, ob = rr * 64 + cc * 2; return st * 1024 + (ob ^ (((ob >> 9) & 1) << 5)); }
__host__ __device__ __forceinline__ void stage_rc(int b, int& R, int& C) { const int st = b / 1024, sb = b % 1024, swz = sb ^ (((sb >> 9) & 1) << 5); R = (st >> 1) * 16 + swz / 64; C = (st & 1) * 32 + (swz % 64) / 2; }
__host__ __device__ __forceinline__ int perm32(int rho) { const int n = rho >> 4, i = rho & 15; return 8 * (i >> 2) + 4 * n + (i & 3); }
DEVI unsigned cvt_pk_bf16(float lo, float hi) { unsigned r; asm volatile("v_cvt_pk_bf16_f32 %0, %1, %2" : "=v"(r) : "v"(lo), "v"(hi)); return r; }

struct Unit { int pm, pn, e; };
constexpr int GT_OFF = STAGE_BYTES;
constexpr int UD_OFF = GT_OFF + 24 * 256 * 4;
constexpr int EO_OFF = UD_OFF + 32 * 16;
constexpr int MISC_OFF = EO_OFF + 136 * 4;
constexpr int LDS_TOTAL = MISC_OFF + 64;

struct ListOrder {
    const LAS int* ud; int nu;
    DEVI bool next(int i, Unit& u) const {
        if (i >= nu) return false;
        u.pm = __builtin_amdgcn_readfirstlane(ud[i * 4 + 0]); u.pn = __builtin_amdgcn_readfirstlane(ud[i * 4 + 1]); u.e = __builtin_amdgcn_readfirstlane(ud[i * 4 + 2]); return true;
    }
};
DEVI bool dense_unit(int nM, int nN, int G, int c, int i, Unit& u) {
    const int nwg = nM * nN; const long L = (long)i * G + c; if (L >= nwg) return false;
    int wgid = (int)L; { const int q = nwg / NXCD, r = nwg % NXCD, xcd = wgid % NXCD, off = wgid / NXCD; wgid = (xcd < r ? xcd * (q + 1) : r * (q + 1) + (xcd - r) * q) + off; }
    const int nig = WGM * nN, gid = wgid / nig, fm = gid * WGM, gsz = (nM - fm) < WGM ? (nM - fm) : WGM;
    u.pm = fm + ((wgid % nig) % gsz); u.pn = (wgid % nig) / gsz; u.e = 0; return true;
}
DEVI int fill_dense(LAS unsigned char* lds, int nM, int nN, int G, int c) {
    LAS int* ud = (LAS int*)(lds + UD_OFF); int nu = 0;
    for (int i = 0; i < 32; ++i) { Unit u; if (!dense_unit(nM, nN, G, c, i, u)) break; if (otid() == 0) { ud[i * 4 + 0] = u.pm; ud[i * 4 + 1] = u.pn; ud[i * 4 + 2] = 0; } ++nu; }
    return nu;
}

template <class Epi, bool GATHER, bool F8 = false>
DEVI void gemm_phase(LAS unsigned char* lds, const void* A, const void* Bt, int KB, size_t bgroup_bytes, const ListOrder& S, const Epi& E) {
    const int tid = otid();
    const int wid = __builtin_amdgcn_readfirstlane(tid >> 6), lane = tid & 63, wr = wid >> 2, wc = wid & 3, fr = lane & 15, fq = lane >> 4;
    const int nt = KB / 128;
    const LAS int* gtab = (const LAS int*)(lds + GT_OFF);
    unsigned voffA[2], voffB[2];
#pragma unroll
    for (int i = 0; i < 2; ++i) { int R, C; stage_rc(tid * 16 + i * 8192, R, C); const int Rb = Epi::B16 ? (64 * (R >> 5) + 16 * ((R & 15) >> 2) + 4 * ((R >> 4) & 1) + (R & 3)) : (Epi::PERM ? ((R & ~31) + perm32(R & 31)) : R);
        voffA[i] = GATHER ? (unsigned)(C * 2) : (unsigned)(R * KB + C * 2); voffB[i] = (unsigned)(Rb * KB + C * 2); }
    const size_t kstep = (size_t)(BK * 2);
    const size_t hstep = (size_t)HALF * KB;
    const size_t bhs = Epi::B16 ? (size_t)8 * KB : hstep;
    const size_t tstep = 2 * hstep;
    const unsigned ldsw = (unsigned)wid * 1024u;
    const int aoff = lds_byte(wr * 64 + fr, fq * 8); int boff = 4 * HTB + lds_byte(wc * 32 + fr, fq * 8); asm volatile("" : "+v"(boff));
#define PG_SA(b, h) (((b) * 2 + (h)) * HTB)
#define PG_SB(b, h) ((4 + (b) * 2 + (h)) * HTB)
#define PG_STAGE(bufoff, gbase, voff) do { _Pragma("unroll") for (int _i = 0; _i < 2; ++_i) \
        __builtin_amdgcn_global_load_lds((const unsigned*)((const char*)(gbase) + (voff)[_i]), (LAS unsigned*)(lds + (bufoff) + ldsw + _i * 8192), 16, 0, 0); } while (0)
#define PG_STAGE_A(bufoff, abase, h, goff) do { if constexpr (GATHER) { PG_STAGE(bufoff, abase, goff[h]); } else { PG_STAGE(bufoff, (abase) + (h) * hstep, voffA); } } while (0)
#define PG_LD1(dst, addr) do { if constexpr (F8) { const v4i32 lo_ = *(const LAS v4i32*)(lds + (addr)), hi_ = *(const LAS v4i32*)(lds + (addr) + 1024); dst = __builtin_shufflevector(lo_, hi_, 0, 1, 2, 3, 4, 5, 6, 7); } \
        else { dst.k[0] = *(const LAS bf16x8*)(lds + (addr)); dst.k[1] = *(const LAS bf16x8*)(lds + (addr) + 1024); } } while (0)
#define PG_LDA(dst, b, h) do { _Pragma("unroll") for (int m = 0; m < 4; ++m) PG_LD1(dst[m], PG_SA(b, h) + aoff + m * 2048); } while (0)
#define PG_LDB(dst, b, h) do { _Pragma("unroll") for (int n = 0; n < 2; ++n) PG_LD1(dst[n], boff + ((b) * 2 + (h)) * HTB + n * 2048); } while (0)
#define PG_MMA(ai, bj, At, Bt_) do { __builtin_amdgcn_s_setprio(1); _Pragma("unroll") for (int m = 0; m < 4; ++m) _Pragma("unroll") for (int n = 0; n < 2; ++n) { \
        if constexpr (F8) { asm volatile("v_mfma_scale_f32_16x16x128_f8f6f4 %0, %1, %2, %0, %3, %3 op_sel_hi:[0,0,0]" : "+v"(acc[ai][bj][m][n]) : "v"(Bt_[n]), "v"(At[m]), "v"(sc1)); } \
        else { _Pragma("unroll") for (int k = 0; k < 2; ++k) acc[ai][bj][m][n] = __builtin_amdgcn_mfma_f32_16x16x32_bf16(Bt_[n].k[k], At[m].k[k], acc[ai][bj][m][n], 0, 0, 0); } } \
        __builtin_amdgcn_s_setprio(0); } while (0)
#define PG_MMAZ(ai, bj, At, Bt_) do { __builtin_amdgcn_s_setprio(1); _Pragma("unroll") for (int m = 0; m < 4; ++m) _Pragma("unroll") for (int n = 0; n < 2; ++n) \
        asm volatile("v_mfma_scale_f32_16x16x128_f8f6f4 %0, %1, %2, 0, %3, %3 op_sel_hi:[0,0,0]" : "+v"(acc[ai][bj][m][n]) : "v"(Bt_[n]), "v"(At[m]), "v"(sc1)); \
        __builtin_amdgcn_s_setprio(0); } while (0)
#define PG_WAIT_V(n) asm volatile("s_waitcnt vmcnt(" #n ")" ::: "memory")
#define PG_WAIT_L(n) asm volatile("s_waitcnt lgkmcnt(" #n ")" ::: "memory")
#define PG_WAIT_VR(rl) do { if ((rl) == 0) PG_WAIT_V(8); else if ((rl) == 8) PG_WAIT_V(16); else if ((rl) == 16) PG_WAIT_V(24); else PG_WAIT_V(40); } while (0)
#define PG_BAR __builtin_amdgcn_s_barrier()
#define PG_SCHED __builtin_amdgcn_sched_barrier(0)
    Unit cur, nxt; int ui = 0, relax = 0;
    if (!S.next(0, cur)) return;
    int sc1 = 0x7F7F7F7F; asm volatile("" : "+v"(sc1));
    static_assert(F8, "the first-tile C = 0 form below is written for the fp8 MFMA");
    f32x4 acc[2][2][4][2];
#pragma unroll
    for (int a = 0; a < 2; ++a)
#pragma unroll
        for (int b = 0; b < 2; ++b)
#pragma unroll
            for (int m = 0; m < 4; ++m)
#pragma unroll
                for (int n = 0; n < 2; ++n) acc[a][b][m][n] = (f32x4){0.f, 0.f, 0.f, 0.f};
    typename FragT<F8>::T At[4], B0[2], B1[2];
    unsigned gC[2][2];
    auto gload = [&](int uidx, unsigned (&g)[2][2]) {
        const int tt = otid();
#pragma unroll
        for (int i = 0; i < 2; ++i) { int R, C; stage_rc(tt * 16 + i * 8192, R, C);
#pragma unroll
            for (int h = 0; h < 2; ++h) g[h][i] = (unsigned)gtab[uidx * 256 + h * HALF + R] * (unsigned)KB + (unsigned)(C * 2); }
    };
    if constexpr (GATHER) gload(0, gC);
    const char* cA = GATHER ? (const char*)A : (const char*)A + (size_t)cur.pm * tstep;
    const char* cB = (const char*)Bt + (size_t)cur.e * bgroup_bytes + (size_t)cur.pn * tstep;
    PG_STAGE(PG_SB(0, 0), cB, voffB); PG_STAGE(PG_SB(0, 1), cB + bhs, voffB); PG_STAGE_A(PG_SA(0, 0), cA, 0, gC); PG_STAGE_A(PG_SA(0, 1), cA, 1, gC);
    if (wr == 1) PG_BAR;
    PG_WAIT_V(2); PG_BAR;
    PG_STAGE(PG_SB(1, 0), cB + kstep, voffB); PG_STAGE_A(PG_SA(1, 0), cA + kstep, 0, gC); PG_STAGE(PG_SB(1, 1), cB + bhs + kstep, voffB);
    PG_WAIT_V(6); PG_BAR;
    for (;;) {
        const bool has_next = S.next(ui + 1, nxt);
        const char* nA = GATHER ? (const char*)A : (has_next ? (const char*)A + (size_t)nxt.pm * tstep : cA);
        const char* nB = has_next ? (const char*)Bt + (size_t)nxt.e * bgroup_bytes + (size_t)nxt.pn * tstep : cB;
#define PG_KITER(MMAX, WAITX, LASTX) do { \
            const bool last = LASTX; \
            const char* a1 = cA + (size_t)(t + 1) * kstep; \
            const char* a2 = last ? nA : cA + (size_t)(t + 2) * kstep; const char* b2 = last ? nB : cB + (size_t)(t + 2) * kstep; \
            const char* a3 = a2 + kstep; const char* b3 = b2 + kstep; \
            unsigned gS[2][2]; \
            if constexpr (GATHER) { \
                if (last && has_next) gload(ui + 1, gS); \
                else { gS[0][0] = gC[0][0]; gS[0][1] = gC[0][1]; gS[1][0] = gC[1][0]; gS[1][1] = gC[1][1]; } \
            } \
 \
            PG_LDB(B0, 0, 0); PG_LDB(B1, 0, 1); PG_SCHED; PG_LDA(At, 0, 0); PG_STAGE_A(PG_SA(1, 1), a1, 1, gC); \
            WAITX; PG_WAIT_L(0); PG_BAR; MMAX(0, 0, At, B0); MMAX(0, 1, At, B1); PG_BAR; PG_SCHED; \
 \
            PG_LDA(At, 0, 1); PG_STAGE(PG_SB(0, 0), b2, voffB); PG_STAGE(PG_SB(0, 1), b2 + bhs, voffB); PG_STAGE_A(PG_SA(0, 0), a2, 0, gS); \
            WAITX; PG_WAIT_L(0); PG_BAR; MMAX(1, 0, At, B0); MMAX(1, 1, At, B1); PG_BAR; PG_SCHED; \
 \
            PG_LDB(B0, 1, 0); PG_LDB(B1, 1, 1); PG_SCHED; PG_LDA(At, 1, 0); PG_STAGE_A(PG_SA(0, 1), a2, 1, gS); \
            PG_WAIT_V(8); PG_WAIT_L(0); PG_BAR; PG_MMA(0, 0, At, B0); PG_MMA(0, 1, At, B1); PG_BAR; PG_SCHED; \
 \
            PG_LDA(At, 1, 1); PG_STAGE(PG_SB(1, 0), b3, voffB); PG_STAGE(PG_SB(1, 1), b3 + bhs, voffB); PG_STAGE_A(PG_SA(1, 0), a3, 0, gS); \
            PG_WAIT_V(8); PG_WAIT_L(0); PG_BAR; PG_MMA(1, 0, At, B0); PG_MMA(1, 1, At, B1); PG_BAR; PG_SCHED; \
        } while (0)
        { const int t = 0; PG_KITER(PG_MMAZ, PG_WAIT_VR(relax), false); }
#pragma unroll 1
        for (int t = 2; t < nt; t += 2) { PG_KITER(PG_MMA, PG_WAIT_V(8), (t == nt - 2)); }
#undef PG_KITER
        if (wr == 0) PG_BAR;
        if constexpr (F8) asm volatile("s_nop 15\n\ts_nop 15" ::: "memory");
        E(acc, cur, ui, wr, wc, fr, fq); relax = E.nst(cur);
        if (!has_next) break;
        cur = nxt; cA = nA; cB = nB; ++ui;
        if constexpr (GATHER) gload(ui, gC);
        if (wr == 1) PG_BAR;
    }
    PG_WAIT_V(0);
    PG_BAR;
#undef PG_SA
#undef PG_SB
#undef PG_STAGE
#undef PG_STAGE_A
#undef PG_LDA
#undef PG_LDB
#undef PG_MMA
#undef PG_MMAZ
#undef PG_WAIT_V
#undef PG_WAIT_VR
#undef PG_WAIT_L
#undef PG_BAR
#undef PG_SCHED
}
}

constexpr size_t WT_AIN = WS_WT, WT_AOUT = WS_WT + 18 * MiB, WT_MIN = WS_WT + 26 * MiB, WT_MOUT = WS_WT + 51 * MiB, WT_W13 = WS_WT + 59 * MiB, WT_W2 = WS_WT + 579 * MiB;
constexpr int MINP = 6400;
constexpr float W13_SCALE = 64.f, W2_SCALE = 32.f;
static_assert(WT_W2 + (size_t)2 * 65 * 2 * MiB <= WS_END, "weight copies fit");
#define LDS_WAIT() asm volatile("s_waitcnt lgkmcnt(0)" ::: "memory")
struct CvtDesc { const float* W; unsigned char* dst; int ldw, dK; float sc; };
DEVI CvtDesc cvt_decode(const Params& p, int it) {
    constexpr int I_AIN = 16 * 144, I_AOUT = 16 * 64, I_MIN = 16 * 193, I_MOUT = 16 * 64;
    CvtDesc d; int r = it; d.sc = W13_SCALE; d.dK = D;
    const float *w_ain = p.attn_w_in, *w_aout = p.attn_w_out, *w_min = p.ml_w_in, *w_mout = p.ml_w_out, *w_e1 = p.exp_w1, *w_e3 = p.exp_w3, *w_e2 = p.exp_w2, *w_s1 = p.sh_w1, *w_s3 = p.sh_w3, *w_s2 = p.sh_w2;
    asm volatile("" : "+s"(w_ain), "+s"(w_aout), "+s"(w_min), "+s"(w_mout), "+s"(w_e1), "+s"(w_e3), "+s"(w_e2), "+s"(w_s1), "+s"(w_s3), "+s"(w_s2));
    if (r < I_AIN) { const int kb = r / 144, nb = r % 144; d.W = w_ain + (size_t)(128 * kb) * AIW + 32 * nb; d.ldw = AIW; d.dst = (unsigned char*)(p.ws + WT_AIN) + (size_t)(32 * nb) * D + 128 * kb; return d; } r -= I_AIN;
    if (r < I_AOUT) { const int kb = r / 64, nb = r % 64; d.W = w_aout + (size_t)(128 * kb) * D + 32 * nb; d.ldw = D; d.dst = (unsigned char*)(p.ws + WT_AOUT) + (size_t)(32 * nb) * D + 128 * kb; return d; } r -= I_AOUT;
    if (r < I_MIN) { const int kb = r / 193, nb = r % 193; d.W = w_min + (size_t)(128 * kb) * MIW + 32 * nb; d.ldw = MIW; d.dst = (unsigned char*)(p.ws + WT_MIN) + (size_t)(32 * nb) * D + 128 * kb; return d; } r -= I_MIN;
    if (r < I_MOUT) { const int kb = r / 64, nb = r % 64; d.W = w_mout + (size_t)(128 * kb) * D + 32 * nb; d.ldw = D; d.dst = (unsigned char*)(p.ws + WT_MOUT) + (size_t)(32 * nb) * D + 128 * kb; return d; } r -= I_MOUT;
    const int mat = r >> 8, ii = r & 255; const int l = mat / 195, q = mat % 195, e = q / 3, which = q % 3;
    if (which < 2) {
        const float* W = e < 64 ? (which == 0 ? w_e1 : w_e3) + ((size_t)l * 64 + e) * D * EDIM : (which == 0 ? w_s1 : w_s3) + (size_t)l * D * EDIM;
        const int kb = ii / 16, nb = ii % 16, n0 = 32 * nb;
        d.W = W + (size_t)(128 * kb) * EDIM + n0; d.ldw = EDIM;
        d.dst = (unsigned char*)(p.ws + WT_W13) + ((size_t)l * 65 + e) * 1024 * D + (size_t)((n0 >> 7) * 256 + which * 128 + (n0 & 127)) * D + 128 * kb;
    } else {
        const float* W = e < 64 ? w_e2 + ((size_t)l * 64 + e) * EDIM * D : w_s2 + (size_t)l * EDIM * D;
        const int kb = ii / 64, nb = ii % 64;
        d.W = W + (size_t)(128 * kb) * D + 32 * nb; d.ldw = D; d.dK = EDIM; d.sc = W2_SCALE;
        d.dst = (unsigned char*)(p.ws + WT_W2) + ((size_t)l * 65 + e) * D * EDIM + (size_t)(32 * nb) * EDIM + 128 * kb;
    }
    return d;
}
DEVI void ph_cvt(const Params& p, LAS unsigned char* lds, int vcu, int G) {
    const int tid = otid(), lane = tid & 63, wave = __builtin_amdgcn_readfirstlane(tid >> 6);
    LAS float* scr = (LAS float*)(lds + wave * 17408);
    const int gw = vcu * 8 + wave, NGW = G * 8;
    constexpr int NITEMS = 16 * 144 + 16 * 64 + 16 * 193 + 16 * 64 + 2 * 65 * 3 * 256;
    const int lr = lane >> 3, lc = (lane & 7) * 4;
    const int sn = lane >> 3, sc8 = lane & 7;
    if (gw < NITEMS) {
        int it = gw; CvtDesc dc = cvt_decode(p, it);
        typedef const __attribute__((address_space(1))) f32x4* GV4;
        f32x4 cur[16];
#pragma unroll
        for (int i = 0; i < 16; ++i) cur[i] = __builtin_nontemporal_load((GV4)(dc.W + (size_t)(lr + 8 * i) * dc.ldw + lc));
        for (;;) {
            const int nx = it + NGW; const CvtDesc dn = cvt_decode(p, nx < NITEMS ? nx : it);
            f32x4 nxt[16];
#pragma unroll
            for (int i = 0; i < 16; ++i) nxt[i] = __builtin_nontemporal_load((GV4)(dn.W + (size_t)(lr + 8 * i) * dn.ldw + lc));
#pragma unroll
            for (int i = 0; i < 16; ++i) { LAS float* sp = scr + (lr + 8 * i) * 33 + 4 * (i >> 1) + lc; sp[0] = cur[i][0] * dc.sc; sp[1] = cur[i][1] * dc.sc; sp[2] = cur[i][2] * dc.sc; sp[3] = cur[i][3] * dc.sc; }
            LDS_WAIT(); asm volatile("" ::: "memory");
#pragma unroll
            for (int j = 0; j < 4; ++j) { const int n = sn + 8 * j; const LAS float* sp = scr + (16 * sc8) * 33 + 4 * sc8 + n;
                u32x4 o;
#pragma unroll
                for (int q = 0; q < 4; ++q) o[q] = pk4_fp8(sp[(4 * q + 0) * 33], sp[(4 * q + 1) * 33], sp[(4 * q + 2) * 33], sp[(4 * q + 3) * 33]);
                *(u32x4*)(dc.dst + (size_t)n * dc.dK + 16 * sc8) = o; }
            LDS_WAIT(); asm volatile("" ::: "memory");
            if (nx >= NITEMS) break;
#pragma unroll
            for (int i = 0; i < 16; ++i) cur[i] = nxt[i];
            dc = dn; it = nx;
        }
    }
    { u32x4* z = (u32x4*)((unsigned char*)(p.ws + WT_MIN) + (size_t)MIW * D); const int n16 = (MINP - MIW) * D / 16;
      for (int i = vcu * 512 + tid; i < n16; i += G * 512) z[i] = (u32x4){0u, 0u, 0u, 0u}; }
}

typedef float f32x4e __attribute__((ext_vector_type(4)));
struct EpiBf16Store {
    static constexpr bool PERM = true, B16 = false;
    bf16* O; int ld; float* gates; int gate_pn; float sc;
    DEVI int nst(const pg::Unit& u) const { return u.pn == gate_pn ? 0 : 16; }
    DEVI void operator()(const f32x4 (&acc)[2][2][4][2], const pg::Unit& u, int ui, int wr, int wc, int fr, int fq) const {
        const int row0 = u.pm * 256 + wr * 64 + fr;
        if (u.pn == gate_pn) {
            if (wc == 0) {
#pragma unroll
                for (int ai = 0; ai < 2; ++ai)
#pragma unroll
                    for (int m = 0; m < 4; ++m) { float* gp = gates + (size_t)(row0 + ai * 128 + m * 16) * 32 + 8 * fq;
                        *(f32x4*)(gp) = acc[ai][0][m][0] * sc; *(f32x4*)(gp + 4) = acc[ai][0][m][1] * sc; }
            }
            return;
        }
        const int col0 = u.pn * 256 + wc * 32 + 8 * fq;
#pragma unroll
        for (int ai = 0; ai < 2; ++ai)
#pragma unroll
            for (int m = 0; m < 4; ++m) { bf16* rowp = O + (size_t)(row0 + ai * 128 + m * 16) * ld + col0;
#pragma unroll
                for (int bj = 0; bj < 2; ++bj) { const f32x4 v0 = acc[ai][bj][m][0] * sc, v1 = acc[ai][bj][m][1] * sc;
                    u32x4 w; w.x = pg::cvt_pk_bf16(v0[0], v0[1]); w.y = pg::cvt_pk_bf16(v0[2], v0[3]); w.z = pg::cvt_pk_bf16(v1[0], v1[1]); w.w = pg::cvt_pk_bf16(v1[2], v1[3]);
                    *(u32x4*)(rowp + bj * 128) = w; } }
    }
};
struct EpiSwiGLU {
    static constexpr bool PERM = true, B16 = false;
    bf16* ACT;
    DEVI int nst(const pg::Unit&) const { return 8; }
    DEVI void operator()(const f32x4 (&acc)[2][2][4][2], const pg::Unit& u, int ui, int wr, int wc, int fr, int fq) const {
        const int row0 = u.pm * 256 + wr * 64 + fr, col0 = u.pn * 128 + wc * 32 + 8 * fq;
#pragma unroll
        for (int ai = 0; ai < 2; ++ai)
#pragma unroll
            for (int m = 0; m < 4; ++m) {
                f32x4 o[2];
#pragma unroll
                for (int n = 0; n < 2; ++n) { const f32x4 a = acc[ai][0][m][n], b = acc[ai][1][m][n]; const f32x4 t = a * (-1.4426950408889634f / W13_SCALE);
                    f32x4 e; e[0] = __builtin_amdgcn_exp2f(t[0]); e[1] = __builtin_amdgcn_exp2f(t[1]); e[2] = __builtin_amdgcn_exp2f(t[2]); e[3] = __builtin_amdgcn_exp2f(t[3]);
                    const f32x4 d = e * (W13_SCALE * W13_SCALE) + (W13_SCALE * W13_SCALE);
                    f32x4 r; r[0] = __builtin_amdgcn_rcpf(d[0]); r[1] = __builtin_amdgcn_rcpf(d[1]); r[2] = __builtin_amdgcn_rcpf(d[2]); r[3] = __builtin_amdgcn_rcpf(d[3]);
                    o[n] = (a * b) * r; }
                uint2 w; w.x = pk4_fp8(o[0][0], o[0][1], o[0][2], o[0][3]); w.y = pk4_fp8(o[1][0], o[1][1], o[1][2], o[1][3]);
                *(uint2*)((unsigned char*)ACT + (size_t)(row0 + ai * 128 + m * 16) * EDIM + col0) = w; }
    }
};
constexpr float Y_SCALE = 8.f;
struct EpiScale {
    static constexpr bool PERM = true, B16 = true;
    unsigned char* Y; const LAS float* swt;
    DEVI int nst(const pg::Unit&) const { return 8; }
    DEVI void operator()(const f32x4 (&acc)[2][2][4][2], const pg::Unit& u, int ui, int wr, int wc, int fr, int fq) const {
        const int row0 = u.pm * 256 + wr * 64 + fr, col0 = u.pn * 256 + wc * 64 + 16 * fq;
#pragma unroll
        for (int ai = 0; ai < 2; ++ai)
#pragma unroll
            for (int m = 0; m < 4; ++m) { const int slot = row0 + ai * 128 + m * 16; const float w8 = swt[ui * 256 + wr * 64 + fr + ai * 128 + m * 16];
                const f32x4 a = acc[ai][0][m][0] * w8, b = acc[ai][0][m][1] * w8, c = acc[ai][1][m][0] * w8, d = acc[ai][1][m][1] * w8;
                u32x4 w; w.x = pk4_fp8(a[0], a[1], a[2], a[3]); w.y = pk4_fp8(b[0], b[1], b[2], b[3]); w.z = pk4_fp8(c[0], c[1], c[2], c[3]); w.w = pk4_fp8(d[0], d[1], d[2], d[3]);
                __builtin_nontemporal_store(w, (u32x4*)(Y + (size_t)slot * D + col0)); }
    }
};
struct EpiResid {
    static constexpr bool PERM = true, B16 = false;
    bf16* X; const float* modl;
    DEVI int nst(const pg::Unit&) const { return 16; }
    DEVI void operator()(const f32x4 (&acc)[2][2][4][2], const pg::Unit& u, int ui, int wr, int wc, int fr, int fq) const {
        const int bb = u.pm < 64 ? (u.pm >> 4) : 4;
        const float* gate = modl + (size_t)(bb * 6 + 2) * D;
        const int row0 = u.pm * 256 + wr * 64 + fr, col0 = u.pn * 256 + wc * 32 + 8 * fq;
        f32x4 gv[2][2];
#pragma unroll
        for (int bj = 0; bj < 2; ++bj)
#pragma unroll
            for (int n = 0; n < 2; ++n) gv[bj][n] = *(const f32x4*)(gate + col0 + bj * 128 + 4 * n) * (1.f / W13_SCALE);
        u32x4 xa[2], xb[2];
#define RLOAD(Xr, g) do { const size_t off_ = (size_t)(row0 + ((g) >> 2) * 128 + ((g) & 3) * 16) * D + col0; _Pragma("unroll") for (int bj = 0; bj < 2; ++bj) Xr[bj] = *(const u32x4*)(X + off_ + bj * 128); } while (0)
#define RMIX(w, a, b, ga, gb) pg::cvt_pk_bf16(__uint_as_float((w) << 16) + (ga) * (a), __uint_as_float((w) & 0xffff0000u) + (gb) * (b))
#define RSTORE(Xr, g) do { const size_t off_ = (size_t)(row0 + ((g) >> 2) * 128 + ((g) & 3) * 16) * D + col0; _Pragma("unroll") for (int bj = 0; bj < 2; ++bj) { \
            const f32x4 a0 = acc[(g) >> 2][bj][(g) & 3][0], a1 = acc[(g) >> 2][bj][(g) & 3][1]; u32x4 w; \
            w.x = RMIX(Xr[bj].x, a0[0], a0[1], gv[bj][0][0], gv[bj][0][1]); w.y = RMIX(Xr[bj].y, a0[2], a0[3], gv[bj][0][2], gv[bj][0][3]); \
            w.z = RMIX(Xr[bj].z, a1[0], a1[1], gv[bj][1][0], gv[bj][1][1]); w.w = RMIX(Xr[bj].w, a1[2], a1[3], gv[bj][1][2], gv[bj][1][3]); \
            *(u32x4*)(X + off_ + bj * 128) = w; } } while (0)
        RLOAD(xa, 0);
#pragma unroll
        for (int g = 0; g < 8; g += 2) {
            RLOAD(xb, g + 1); asm volatile("" ::: "memory");
            RSTORE(xa, g); asm volatile("" ::: "memory");
            if (g + 2 < 8) { RLOAD(xa, g + 2); asm volatile("" ::: "memory"); }
            RSTORE(xb, g + 1); asm volatile("" ::: "memory");
        }
#undef RLOAD
#undef RMIX
#undef RSTORE
    }
};

template <bool G1>
DEVI int moe_setup(const Params& p, LAS unsigned char* lds, int layer, int nrows, int vcu, int G) {
    LAS int* eo = (LAS int*)(lds + pg::EO_OFF); LAS int* ud = (LAS int*)(lds + pg::UD_OFF); LAS int* gt = (LAS int*)(lds + pg::GT_OFF);
    const int tid = otid(); const u32* cnt = (const u32*)(p.ws + WS_CTL) + CW_CNT + layer * 64 * CNT_PAD;
    LAS int* ec = eo + 68;
    if (tid < 64) { const int c_ = (int)cnt[tid * CNT_PAD]; const int pc = (c_ + 255) & ~255; const int incl = (int)wave_prefix_dpp((float)pc);
        ec[tid] = c_; eo[tid] = incl - pc; if (tid == 63) eo[64] = incl; }
    __syncthreads();
    constexpr int NT = G1 ? 4 : 8, CAP = G1 ? 16 : 24;
    const int PR = eo[64] >> 8, PS = nrows >> 8, total = (PR + PS) * NT;
    int nu = total > vcu ? (total - vcu + G - 1) / G : 0; if (nu > CAP) nu = CAP;
    if (tid < nu) {
        const int L = tid * G + vcu, pp = L / NT, pn = L % NT; int e = 64, pm = SH0 / 256 + (pp - PR);
        if (pp < PR) { pm = pp; e = 0; for (int i = 1; i < 64; ++i) if (eo[i] <= pp * 256) e = i; }
        ud[tid * 4 + 0] = pm; ud[tid * 4 + 1] = pn; ud[tid * 4 + 2] = e;
    }
    __syncthreads();
    if (G1) { const int* ltok = (const int*)(p.ws + WS_LTOK);
        for (int idx = tid; idx < nu * 256; idx += 512) { const int u_ = idx >> 8, slot = ud[u_ * 4] * 256 + (idx & 255), e = ud[u_ * 4 + 2];
            int t = slot - SH0; if (slot < SH0) { const int pos = slot - eo[e]; t = pos < ec[e] ? ltok[(size_t)e * MT + pos] : 0; } gt[idx] = t; } }
    else { const float* lw = (const float*)(p.ws + WS_LW); LAS float* st = (LAS float*)gt;
        for (int idx = tid; idx < nu * 256; idx += 512) { const int u_ = idx >> 8, slot = ud[u_ * 4] * 256 + (idx & 255), e = ud[u_ * 4 + 2];
            float w = 1.f; if (slot < SH0) { const int pos = slot - eo[e]; w = pos < ec[e] ? lw[(size_t)e * MT + pos] : 0.f; } st[idx] = w * (Y_SCALE / W2_SCALE); } }
    __syncthreads();
    return nu;
}

namespace fa {
typedef short s16x4 __attribute__((ext_vector_type(4)));
typedef float f32x16 __attribute__((ext_vector_type(16)));
constexpr int HD = 128, NW = 8, QBLK = 32, KVBLK = 64;
constexpr float SCALE = 0.088388347648318440f, THR = 8.f;
constexpr int SHM_V = KVBLK * HD * 2, SHM_K = KVBLK * HD * 2, SCR_OFF = 2 * SHM_V + 2 * SHM_K, BIAS_OFF = SCR_OFF + NW * 64 * 4, SHM_ATTN = BIAS_OFF + 512 * 4;
#define KSWZ(row, colB) ((row) * 256 + ((colB) ^ (((row) & 7) << 4)))
#define SBAR() __builtin_amdgcn_sched_barrier(0)
DEVI int crow(int r, int hi) { return (r & 3) + 8 * (r >> 2) + 4 * hi; }
DEVI unsigned cvtpk(float lo, float hi) { unsigned r; asm volatile("v_cvt_pk_bf16_f32 %0, %1, %2" : "=v"(r) : "v"(lo), "v"(hi)); return r; }
DEVI void partialSM(f32x16& p0, f32x16& p1, float& m_reg, float& mn, float& alpha) {
    constexpr float C = SCALE * 1.4426950408889634f;
    float pmax = p0[0];
#pragma unroll
    for (int r = 1; r < 16; ++r) pmax = fmaxf(pmax, p0[r]);
#pragma unroll
    for (int r = 0; r < 16; ++r) pmax = fmaxf(pmax, p1[r]);
    { auto rr = __builtin_amdgcn_permlane32_swap(__float_as_uint(pmax), __float_as_uint(pmax), false, false); pmax = fmaxf(__uint_as_float(rr[0]), __uint_as_float(rr[1])); }
    if (__builtin_expect(__all(pmax - m_reg <= THR / SCALE), 1)) { mn = m_reg; alpha = 1.f; }
    else { mn = fmaxf(m_reg, pmax); alpha = __builtin_amdgcn_exp2f((m_reg - mn) * C); m_reg = mn; }
    const float mnC = -mn * C;
#pragma unroll
    for (int r = 0; r < 16; ++r) p0[r] = fmaf(p0[r], C, mnC);
#pragma unroll
    for (int r = 0; r < 16; ++r) p1[r] = fmaf(p1[r], C, mnC);
#pragma unroll
    for (int r = 0; r < 16; ++r) p0[r] = __builtin_amdgcn_exp2f(p0[r]);
}
DEVI void finishSM(f32x16& p0, f32x16& p1, float alpha, float& l_reg, bf16x8& pa0, bf16x8& pa1, bf16x8& pa2, bf16x8& pa3) {
#pragma unroll
    for (int r = 0; r < 16; ++r) p1[r] = __builtin_amdgcn_exp2f(p1[r]);
    float ps = 0;
#pragma unroll
    for (int r = 0; r < 16; ++r) ps += p0[r];
#pragma unroll
    for (int r = 0; r < 16; ++r) ps += p1[r];
    { auto rr = __builtin_amdgcn_permlane32_swap(__float_as_uint(ps), __float_as_uint(ps), false, false); ps = __uint_as_float(rr[0]) + __uint_as_float(rr[1]); }
    l_reg = l_reg * alpha + ps;
#define PK4(P, BASE, OUT) do { unsigned a0 = cvtpk(P[BASE + 0], P[BASE + 1]), a1 = cvtpk(P[BASE + 2], P[BASE + 3]);   \
    unsigned b0 = cvtpk(P[BASE + 4], P[BASE + 5]), b1 = cvtpk(P[BASE + 6], P[BASE + 7]);                              \
    auto r0 = __builtin_amdgcn_permlane32_swap(a0, b0, false, false); auto r1 = __builtin_amdgcn_permlane32_swap(a1, b1, false, false); \
    u32x4 w = {r0[0], r1[0], r0[1], r1[1]}; OUT = *reinterpret_cast<bf16x8*>(&w); } while (0)
    PK4(p0, 0, pa0); PK4(p0, 8, pa1); PK4(p1, 0, pa2); PK4(p1, 8, pa3);
#undef PK4
}
DEVI void qkt(f32x16& p0, f32x16& p1, const char* Ks, const bf16x8* qr, int r32, int hi) {
    p0 = f32x16{}; p1 = f32x16{};
#pragma unroll
    for (int d0 = 0; d0 < 8; ++d0) { const int cb = (d0 * 16 + hi * 8) * 2;
        const bf16x8 b0 = *reinterpret_cast<const bf16x8*>(Ks + KSWZ(r32, cb));
        const bf16x8 b1 = *reinterpret_cast<const bf16x8*>(Ks + KSWZ(32 + r32, cb));
        p0 = __builtin_amdgcn_mfma_f32_32x32x16_bf16(b0, qr[d0], p0, 0, 0, 0);
        p1 = __builtin_amdgcn_mfma_f32_32x32x16_bf16(b1, qr[d0], p1, 0, 0, 0); }
}
DEVI int v_st(int k, int c) { const int kk = (k & ~0xC) | ((k & 4) << 1) | ((k & 8) >> 1); return ((kk >> 3) * 4 + (c >> 5)) * 512 + ((kk & 7) * 32 + (c & 31)) * 2; }
DEVI int v_rd_base(int lane) { return ((lane & 3) << 3) | (((lane >> 2) & 3) << 6) | (((lane >> 4) & 1) << 5) | (((lane >> 5) & 1) << 8); }
constexpr int v_rd_off(int d0, int ks, int half) { return d0 * 512 + ks * 4096 + half * 2048; }
template <int OFF> DEVI s16x4 tr_read(int vb) { s16x4 r; asm volatile("ds_read_b64_tr_b16 %0, %1 offset:%2" : "=&v"(r) : "v"(vb), "i"(OFF) : "memory"); return r; }
template <int D0> DEVI void pv_one(f32x16& od, int vb, bf16x8 pa0, bf16x8 pa1, bf16x8 pa2, bf16x8 pa3) {
    const s16x4 l0 = tr_read<v_rd_off(D0, 0, 0)>(vb), h0 = tr_read<v_rd_off(D0, 0, 1)>(vb), l1 = tr_read<v_rd_off(D0, 1, 0)>(vb), h1 = tr_read<v_rd_off(D0, 1, 1)>(vb);
    const s16x4 l2 = tr_read<v_rd_off(D0, 2, 0)>(vb), h2 = tr_read<v_rd_off(D0, 2, 1)>(vb), l3 = tr_read<v_rd_off(D0, 3, 0)>(vb), h3 = tr_read<v_rd_off(D0, 3, 1)>(vb);
    asm volatile("s_waitcnt lgkmcnt(0)" ::: "memory"); SBAR();
#define PK(L, H) (bf16x8){L[0], L[1], L[2], L[3], H[0], H[1], H[2], H[3]}
    od = __builtin_amdgcn_mfma_f32_32x32x16_bf16(pa0, PK(l0, h0), od, 0, 0, 0);
    od = __builtin_amdgcn_mfma_f32_32x32x16_bf16(pa1, PK(l1, h1), od, 0, 0, 0);
    od = __builtin_amdgcn_mfma_f32_32x32x16_bf16(pa2, PK(l2, h2), od, 0, 0, 0);
    od = __builtin_amdgcn_mfma_f32_32x32x16_bf16(pa3, PK(l3, h3), od, 0, 0, 0);
#undef PK
}
DEVI void pv_d0(f32x16* o, int vb, bf16x8 pa0, bf16x8 pa1, bf16x8 pa2, bf16x8 pa3) {
    pv_one<0>(o[0], vb, pa0, pa1, pa2, pa3); pv_one<1>(o[1], vb, pa0, pa1, pa2, pa3); pv_one<2>(o[2], vb, pa0, pa1, pa2, pa3); pv_one<3>(o[3], vb, pa0, pa1, pa2, pa3);
}
DEVI void na_mask(f32x16& p0, f32x16& p1, const float* brow, int cq, int hi) {
    const int cs = min(max(cq - 8, 0), 48);
    const float* bl = brow + (4 * hi - cq + 15);
    const int d0 = 4 * hi - cs;
#pragma unroll
    for (int r = 0; r < 16; ++r) {
        const int kc0 = (r & 3) + 8 * (r >> 2), kc1 = kc0 + 32;
        const bool ok0 = (unsigned)(kc0 + d0) < 16u, ok1 = (unsigned)(kc1 + d0) < 16u;
        const float b0 = bl[ok0 ? kc0 : 0], b1 = bl[ok1 ? kc1 : 0];
        p0[r] = ok0 ? p0[r] + b0 : -1e30f; p1[r] = ok1 ? p1[r] + b1 : -1e30f;
    }
}
DEVI void attn_unit(const bf16* __restrict__ Qb, const bf16* __restrict__ kc, const bf16* __restrict__ kl, int vdelta, int NT, unsigned char* __restrict__ Ob, char* lds) {
    constexpr int ldq = AIW, ldk = AIW, ldo = D; constexpr bool NA = false; const int tbase = 0, nwin = 64, krmin = 0, rq0 = 0; const float* rpb_h = nullptr;
    auto tile = [&](int t, const bf16*& kp, const bf16*& vp) { kp = t < 4 ? kc + (size_t)t * 64 * ldk : kl + (size_t)(tbase + min(t - 4, nwin - 1)) * 64 * ldk; vp = kp + vdelta; };
    const int tid = otid(), wid = tid >> 6, lane = tid & 63, r32 = lane & 31, hi = lane >> 5;
    char* V_lds = lds; char* K_lds = lds + 2 * SHM_V;
    float* wsc = (float*)(lds + SCR_OFF) + wid * 64; float* li_l = wsc; float* al_l = wsc + 32;
    float* btab = (float*)(lds + BIAS_OFF);
    float m_reg = -1e30f, l_reg = 0; f32x16 o[4] = {}; bf16x8 qr[8];
    const bf16* Qw = Qb + (size_t)(wid * QBLK + r32) * ldq + hi * 8;
#pragma unroll
    for (int d0 = 0; d0 < 8; ++d0) qr[d0] = *reinterpret_cast<const bf16x8*>(Qw + d0 * 16);
    if (NA) { for (int i = tid; i < 465; i += 512) btab[i] = rpb_h[i] * (1.f / SCALE); }
    const int sr = tid >> 4, sc = (tid & 15) * 8, vst0 = v_st(sr, sc), vst1 = v_st(32 + sr, sc);
    const int vb0 = (int)(uintptr_t)V_lds + v_rd_base(lane);
    const int rq = rq0 + (wid >> 1), cq = (wid & 1) * 32 + r32, kr0 = min(max(rq - 4, 0), 56);
    struct { bf16x8 vs0, vs1, ks0, ks1; } st_[2];
#define SLOAD(i, t) do { const bf16* kp_; const bf16* vp_; tile((t), kp_, vp_); \
    st_[i].vs0 = *reinterpret_cast<const bf16x8*>(vp_ + (size_t)sr * ldk + sc); st_[i].vs1 = *reinterpret_cast<const bf16x8*>(vp_ + (size_t)(32 + sr) * ldk + sc); \
    st_[i].ks0 = *reinterpret_cast<const bf16x8*>(kp_ + (size_t)sr * ldk + sc); st_[i].ks1 = *reinterpret_cast<const bf16x8*>(kp_ + (size_t)(32 + sr) * ldk + sc); } while (0)
#define SWRITE(b, i) do { *(bf16x8*)(V_lds + (b) * SHM_V + vst0) = st_[i].vs0; *(bf16x8*)(V_lds + (b) * SHM_V + vst1) = st_[i].vs1; const int kc = sc * 2; \
    *(bf16x8*)(K_lds + (b) * SHM_K + KSWZ(sr, kc)) = st_[i].ks0; *(bf16x8*)(K_lds + (b) * SHM_K + KSWZ(32 + sr, kc)) = st_[i].ks1; } while (0)
#define SWAIT() asm volatile("s_waitcnt vmcnt(4)" ::: "memory")
#define RESC(a) do { if (__any((a) < 1.f)) { if (hi == 0) al_l[r32] = (a); asm volatile("s_waitcnt lgkmcnt(0)" ::: "memory"); \
    _Pragma("unroll") for (int d = 0; d < 4; ++d) _Pragma("unroll") for (int r = 0; r < 16; ++r) o[d][r] *= al_l[crow(r, hi)]; } } while (0)
#define MASK(P0, P1, t) do { if (NA) { if ((t) >= 4) { const int kr_ = krmin + (t) - 4; const bool v_ = ((t) - 4 < nwin) && kr_ >= kr0 && kr_ <= kr0 + 7; (void)v_; } } } while (0)
    f32x16 pA0, pA1, pB0, pB1; float mnA, mnB, alA, alB; bf16x8 pa0, pa1, pa2, pa3;
    constexpr int SE = 0, SO = 1;
    SLOAD(SE, 0); asm volatile("s_waitcnt vmcnt(0)" ::: "memory"); SWRITE(0, SE); __syncthreads();
    qkt(pA0, pA1, K_lds, qr, r32, hi); MASK(pA0, pA1, 0); partialSM(pA0, pA1, m_reg, mnA, alA);
    SLOAD(SO, 1); SLOAD(SE, 2);
    SWAIT(); SWRITE(1, SO); __syncthreads();
    for (int j = 1; j + 1 < NT; j += 2) {
        SBAR(); qkt(pB0, pB1, K_lds + SHM_K, qr, r32, hi); MASK(pB0, pB1, j);
        finishSM(pA0, pA1, alA, l_reg, pa0, pa1, pa2, pa3); SBAR();
        SLOAD(SO, j + 2); SBAR();
        pv_d0(o, vb0, pa0, pa1, pa2, pa3); partialSM(pB0, pB1, m_reg, mnB, alB);
        __syncthreads(); SWAIT(); SWRITE(0, SE);
        RESC(alB); __syncthreads();
        SBAR(); qkt(pA0, pA1, K_lds, qr, r32, hi); MASK(pA0, pA1, j + 1);
        finishSM(pB0, pB1, alB, l_reg, pa0, pa1, pa2, pa3); SBAR();
        SLOAD(SE, min(j + 3, NT - 1)); SBAR();
        pv_d0(o, vb0 + SHM_V, pa0, pa1, pa2, pa3); partialSM(pA0, pA1, m_reg, mnA, alA);
        __syncthreads(); SWAIT(); SWRITE(1, SO);
        RESC(alA); __syncthreads();
    }
    SBAR(); qkt(pB0, pB1, K_lds + SHM_K, qr, r32, hi); MASK(pB0, pB1, NT - 1);
    finishSM(pA0, pA1, alA, l_reg, pa0, pa1, pa2, pa3); SBAR();
    pv_d0(o, vb0, pa0, pa1, pa2, pa3); partialSM(pB0, pB1, m_reg, mnB, alB);
    __syncthreads(); RESC(alB);
    finishSM(pB0, pB1, alB, l_reg, pa0, pa1, pa2, pa3); SBAR();
    pv_d0(o, vb0 + SHM_V, pa0, pa1, pa2, pa3);
    if (hi == 0) li_l[r32] = l_reg; asm volatile("s_waitcnt lgkmcnt(0)" ::: "memory");
#pragma unroll
    for (int r = 0; r < 16; ++r) { const int orow = crow(r, hi); const float rl = __builtin_amdgcn_rcpf(li_l[orow]);
#pragma unroll
        for (int d0 = 0; d0 < 4; ++d0) ((unsigned char*)Ob)[(size_t)(wid * QBLK + orow) * ldo + d0 * 32 + r32] = (unsigned char)(pk4_fp8(o[d0][r] * rl, 0.f, 0.f, 0.f) & 0xffu); }
    __syncthreads();
#undef SLOAD
#undef SWRITE
#undef SWAIT
#undef RESC
#undef MASK
}
DEVI void attn_unit_na(const bf16* __restrict__ Qb, const bf16* __restrict__ kc, const bf16* __restrict__ kl, int krmin, int nwin, int vdelta, unsigned char* __restrict__ Ob, char* lds, int rq0, const float* rpb_h) {
    constexpr int ldq = AIW, ldk = AIW, ldo = D;
    const int tid = otid(), wid = tid >> 6, lane = tid & 63, r32 = lane & 31, hi = lane >> 5;
    char* V_lds = lds; char* K_lds = lds + 2 * SHM_V;
    float* wsc = (float*)(lds + SCR_OFF) + wid * 64; float* li_l = wsc; float* al_l = wsc + 32;
    float* btab = (float*)(lds + BIAS_OFF);
    float m_reg = -1e30f, l_reg = 0; f32x16 o[4] = {}; bf16x8 qr[8];
    const bf16* Qw = Qb + (size_t)(wid * QBLK + r32) * ldq + hi * 8;
#pragma unroll
    for (int d0 = 0; d0 < 8; ++d0) qr[d0] = *reinterpret_cast<const bf16x8*>(Qw + d0 * 16);
    for (int i = tid; i < 465; i += 512) btab[i] = rpb_h[i] * (1.f / SCALE);
    const int sr = tid >> 4, sc = (tid & 15) * 8, vst0 = v_st(sr, sc), vst1 = v_st(32 + sr, sc);
    const int vb0 = (int)(uintptr_t)V_lds + v_rd_base(lane);
    const int rq = rq0 + (wid >> 1), cq = (wid & 1) * 32 + r32, kr0 = min(max(rq - 4, 0), 56);
    bf16x8 vs0, vs1, ks0, ks1;
    const int NT = 4 + nwin;
#define NLOAD(t) do { const bf16* kp_ = (t) < 4 ? kc + (size_t)(t) * 64 * ldk : kl + (size_t)(krmin + (t) - 4) * 64 * ldk; const bf16* vp_ = kp_ + vdelta; \
    vs0 = *reinterpret_cast<const bf16x8*>(vp_ + (size_t)sr * ldk + sc); vs1 = *reinterpret_cast<const bf16x8*>(vp_ + (size_t)(32 + sr) * ldk + sc); \
    ks0 = *reinterpret_cast<const bf16x8*>(kp_ + (size_t)sr * ldk + sc); ks1 = *reinterpret_cast<const bf16x8*>(kp_ + (size_t)(32 + sr) * ldk + sc); } while (0)
    NLOAD(0);
    for (int t = 0; t < NT; ++t) {
        __syncthreads();
        *(bf16x8*)(V_lds + vst0) = vs0; *(bf16x8*)(V_lds + vst1) = vs1;
        *(bf16x8*)(K_lds + KSWZ(sr, sc * 2)) = ks0; *(bf16x8*)(K_lds + KSWZ(32 + sr, sc * 2)) = ks1;
        __syncthreads();
        NLOAD(min(t + 1, NT - 1));
        const int kr = krmin + t - 4;
        if (t < 4 || (kr >= kr0 && kr <= kr0 + 7)) {
            f32x16 p0, p1; float mn, al; bf16x8 pa0, pa1, pa2, pa3;
            qkt(p0, p1, K_lds, qr, r32, hi);
            if (t >= 4) na_mask(p0, p1, btab + (kr - rq + 7) * 31, cq, hi);
            partialSM(p0, p1, m_reg, mn, al);
            if (__any(al < 1.f)) { if (hi == 0) al_l[r32] = al; asm volatile("s_waitcnt lgkmcnt(0)" ::: "memory");
#pragma unroll
                for (int d = 0; d < 4; ++d)
#pragma unroll
                    for (int r = 0; r < 16; ++r) o[d][r] *= al_l[crow(r, hi)]; }
            finishSM(p0, p1, al, l_reg, pa0, pa1, pa2, pa3);
            pv_d0(o, vb0, pa0, pa1, pa2, pa3);
        }
    }
#undef NLOAD
    if (hi == 0) li_l[r32] = l_reg; asm volatile("s_waitcnt lgkmcnt(0)" ::: "memory");
#pragma unroll
    for (int r = 0; r < 16; ++r) { const int orow = crow(r, hi); const float rl = __builtin_amdgcn_rcpf(li_l[orow]);
#pragma unroll
        for (int d0 = 0; d0 < 4; ++d0) ((unsigned char*)Ob)[(size_t)(wid * QBLK + orow) * ldo + d0 * 32 + r32] = (unsigned char)(pk4_fp8(o[d0][r] * rl, 0.f, 0.f, 0.f) & 0xffu); }
    __syncthreads();
}
}

namespace ml {
using fa::f32x16; using fa::s16x4;
constexpr int K_OFF = 0, KP_OFF = 16384, V_OFF = 32768, C2_OFF = 49152, GA_OFF = C2_OFF + 2 * 24576, DEN_OFF = GA_OFF + 3072, CF_OFF = DEN_OFF + 1024, ML_LDS = CF_OFF + 49152;
static_assert(ML_LDS <= 157 * 1024, "mLSTM LDS map");
constexpr int GA_STRIDE = 6 * 64 * 4;
DEVI int tokrow(int b, int dir, int c, int i) {
    return c >= 4 ? (b * SEQ + (dir ? (SEQ - 1 - ((c - 4) * 64 + i)) : ((c - 4) * 64 + i))) : (ML + b * CTXL + (dir ? (CTXL - 1 - (c * 64 + i)) : (c * 64 + i)));
}
template <int CTRL, int ROWMASK> DEVI float dpp_f(float ident, float src) {
    return __int_as_float(__builtin_amdgcn_update_dpp(__float_as_int(ident), __float_as_int(src), CTRL, ROWMASK, 0xf, false));
}
DEVI float prefix_sum64(float x, int) {
    x += dpp_f<0x111, 0xf>(0.f, x); x += dpp_f<0x112, 0xf>(0.f, x); x += dpp_f<0x114, 0xf>(0.f, x); x += dpp_f<0x118, 0xf>(0.f, x);
    x += dpp_f<0x142, 0xa>(0.f, x); x += dpp_f<0x143, 0xc>(0.f, x);
    return x;
}
DEVI float prefix_max64(float x, int) {
    const float ninf = -INFINITY;
    x = fmaxf(x, dpp_f<0x111, 0xf>(ninf, x)); x = fmaxf(x, dpp_f<0x112, 0xf>(ninf, x)); x = fmaxf(x, dpp_f<0x114, 0xf>(ninf, x)); x = fmaxf(x, dpp_f<0x118, 0xf>(ninf, x));
    x = fmaxf(x, dpp_f<0x142, 0xa>(ninf, x)); x = fmaxf(x, dpp_f<0x143, 0xc>(ninf, x));
    return x;
}
DEVI float lane63(float v) { return __int_as_float(__builtin_amdgcn_readlane(__float_as_int(v), 63)); }
DEVI float gate_chunk(float li, float f, float mprev, float* ga, int lane) {
    const float lf = fminf(f, 0.f) - log1pf(__expf(-fabsf(f)));
    const float bc = prefix_sum64(lf, lane), btot = lane63(bc);
    const float colt = li - bc, aend = btot + colt, pm = prefix_max64(colt, lane), amax = btot + lane63(pm), mnew = fmaxf(btot + mprev, amax);
    const float cm = fmaxf(mprev, pm);
    ga[lane] = __expf(aend - mnew) * QSCALE;
    ga[64 + lane] = colt;
    ga[128 + lane] = -cm;
    ga[192 + lane] = __expf(mprev - cm);
    ga[256 + lane] = __expf(-bc - cm);
    if (lane == 0) ga[320] = __expf(btot + mprev - mnew);
    return mnew;
}
DEVI void ph_mlstm(const Params& p, char* lds, int vcu, int G) {
    const int tid = otid(), wid = __builtin_amdgcn_readfirstlane(tid >> 6), lane = tid & 63, r32 = lane & 31, hi = lane >> 5;
    const bf16* Q = (const bf16*)(p.ws + WS_QKV); const float* Gt = (const float*)(p.ws + WS_G); bf16* HD = (bf16*)(p.ws + WS_HD);
    char* K_lds = lds + K_OFF; char* Kp_lds = lds + KP_OFF; char* V_lds = lds + V_OFF; char* C_lds = lds + C2_OFF;
    float* GA = (float*)(lds + GA_OFF); float* den_l = (float*)(lds + DEN_OFF) + (wid & 3) * 64;
    const int sr = tid >> 4, sc = (tid & 15) * 8;
    const int vr = tid >> 3, vc = (tid & 7) * 8;
    const int vbK = (int)(uintptr_t)Kp_lds + fa::v_rd_base(lane), vbV = (int)(uintptr_t)V_lds + fa::v_rd_base(lane);
    for (int item = vcu; item < 256; item += G) {
        const int b = item >> 6, h = (item >> 3) & 7, dir = (item >> 2) & 1, sl = item & 3;
        const float bi = p.ml_gate_b[dir * 8 + h], bf_ = p.ml_gate_b[(2 + dir) * 8 + h];
        __syncthreads();
        for (int i = tid; i < 16384 / 16; i += 512) ((u32x4*)(V_lds))[i] = (u32x4){0u, 0u, 0u, 0u};
        for (int i = tid; i < 24576 / 16; i += 512) ((u32x4*)(C_lds))[i] = (u32x4){0u, 0u, 0u, 0u};
        __syncthreads();
        if (tid < 64) *(bf16*)(V_lds + fa::v_st(tid, 64)) = (bf16)0x3F80;
        for (int i = tid; i < 49152 / 16; i += 512) ((u32x4*)(lds + CF_OFF))[i] = (u32x4){0u, 0u, 0u, 0u};
        float mprev = 0.f;
        if (wid == 4) { const int row = tokrow(b, dir, 0, lane); mprev = gate_chunk(Gt[(size_t)row * 32 + dir * 8 + h] + bi, Gt[(size_t)row * 32 + 16 + dir * 8 + h] + bf_, 0.f, GA, lane); }
        bf16x8 kr0, kr1, vreg, qr[8];
        { const int r0 = tokrow(b, dir, 0, sr), r1 = tokrow(b, dir, 0, sr + 32), r2 = tokrow(b, dir, 0, vr);
          kr0 = *(const bf16x8*)(Q + (size_t)r0 * MIWM + 1024 + h * 128 + sc); kr1 = *(const bf16x8*)(Q + (size_t)r1 * MIWM + 1024 + h * 128 + sc);
          vreg = *(const bf16x8*)(Q + (size_t)r2 * MIWM + 2048 + h * 256 + sl * 64 + vc); }
#pragma unroll
        for (int d0 = 0; d0 < 8; ++d0) qr[d0] = (bf16x8){0, 0, 0, 0, 0, 0, 0, 0};
        __syncthreads();
        auto chunk_loop = [&](auto role_, auto lat_, const int c_begin, const int c_end) __attribute__((always_inline)) {
            constexpr bool OUT = decltype(role_)::value, LATC = decltype(lat_)::value;
#pragma unroll 1
            for (int c = c_begin; c < c_end; ++c) {
                const bool lat = c >= 4;
                const float* ga = GA + (c & 1) * (GA_STRIDE / 4);
                {
                    *(bf16x8*)(K_lds + KSWZ(sr, sc * 2)) = kr0; *(bf16x8*)(K_lds + KSWZ(32 + sr, sc * 2)) = kr1;
                    const float w0 = ga[sr], w1 = ga[sr + 32];
                    u32x4 a = *(u32x4*)&kr0, bq = *(u32x4*)&kr1, oa, ob;
#define SC2(x, w) fa::cvtpk(__uint_as_float((x) << 16) * (w), __uint_as_float((x) & 0xffff0000u) * (w))
                    oa.x = SC2(a.x, w0); oa.y = SC2(a.y, w0); oa.z = SC2(a.z, w0); oa.w = SC2(a.w, w0);
                    ob.x = SC2(bq.x, w1); ob.y = SC2(bq.y, w1); ob.z = SC2(bq.z, w1); ob.w = SC2(bq.w, w1);
#undef SC2
                    *(u32x4*)(Kp_lds + fa::v_st(sr, sc)) = oa; *(u32x4*)(Kp_lds + fa::v_st(32 + sr, sc)) = ob;
                    *(bf16x8*)(V_lds + fa::v_st(vr, vc)) = vreg;
                }
                float gli, gf;
                {
                    const int cn = c + 1 < 68 ? c + 1 : 67;
                    const int r0 = tokrow(b, dir, cn, sr), r1 = tokrow(b, dir, cn, sr + 32), r2 = tokrow(b, dir, cn, vr);
                    kr0 = *(const bf16x8*)(Q + (size_t)r0 * MIWM + 1024 + h * 128 + sc); kr1 = *(const bf16x8*)(Q + (size_t)r1 * MIWM + 1024 + h * 128 + sc);
                    vreg = *(const bf16x8*)(Q + (size_t)r2 * MIWM + 2048 + h * 256 + sl * 64 + vc);
                    const int row = tokrow(b, dir, cn, lane); gli = Gt[(size_t)row * 32 + dir * 8 + h] + bi; gf = Gt[(size_t)row * 32 + 16 + dir * 8 + h] + bf_;
                }
                __syncthreads();
                const char* Cc = C_lds + (c & 1) * 24576;
                if constexpr (OUT) {
                    if constexpr (LATC) {
                        const int tq = wid >> 1, vq = wid & 1, t = tq * 32 + r32;
                        bf16x8 kf0[8], kf1[8], cfr[8];
#pragma unroll
                        for (int d0 = 0; d0 < 8; ++d0) { const int cb = (d0 * 16 + hi * 8) * 2;
                            kf0[d0] = *reinterpret_cast<const bf16x8*>(K_lds + KSWZ(r32, cb)); kf1[d0] = *reinterpret_cast<const bf16x8*>(K_lds + KSWZ(32 + r32, cb));
                            cfr[d0] = *reinterpret_cast<const bf16x8*>(Cc + KSWZ(vq * 32 + r32, cb)); }
                        asm volatile("s_waitcnt lgkmcnt(0)" ::: "memory"); SBAR();
                        f32x16 p0 = {}, p1 = {}, acc = {};
#pragma unroll
                        for (int d0 = 0; d0 < 8; ++d0) p0 = __builtin_amdgcn_mfma_f32_32x32x16_bf16(kf0[d0], qr[d0], p0, 0, 0, 0);
                        if (tq == 1) {
#pragma unroll
                            for (int d0 = 0; d0 < 8; ++d0) p1 = __builtin_amdgcn_mfma_f32_32x32x16_bf16(kf1[d0], qr[d0], p1, 0, 0, 0); }
#pragma unroll
                        for (int d0 = 0; d0 < 8; ++d0) acc = __builtin_amdgcn_mfma_f32_32x32x16_bf16(qr[d0], cfr[d0], acc, 0, 0, 0);
                        bf16x8 cfn[8];
#pragma unroll
                        for (int d0 = 0; d0 < 8; ++d0) cfn[d0] = *reinterpret_cast<const bf16x8*>(Cc + KSWZ(64 + r32, (d0 * 16 + hi * 8) * 2));
                        asm volatile("s_waitcnt lgkmcnt(0)" ::: "memory"); SBAR();
                        f32x16 qnacc = {};
#pragma unroll
                        for (int d0 = 0; d0 < 8; ++d0) qnacc = __builtin_amdgcn_mfma_f32_32x32x16_bf16(cfn[d0], qr[d0], qnacc, 0, 0, 0);
                        { const int cq = c + 1 < 68 ? c + 1 : 67; const bf16* Qw = Q + (size_t)tokrow(b, dir, cq, (wid >> 1) * 32 + r32) * MIWM + h * 128 + hi * 8;
#pragma unroll
                          for (int d0 = 0; d0 < 8; ++d0) qr[d0] = *(const bf16x8*)(Qw + d0 * 16); }
                        float ct0[16], ct1[16], wi[16];
#pragma unroll
                        for (int r = 0; r < 16; ++r) { const int s0 = fa::crow(r, hi); ct0[r] = ga[64 + s0]; ct1[r] = ga[64 + s0 + 32]; wi[r] = ga[192 + tq * 32 + s0]; }
                        const float rown = ga[128 + t] * 1.4426950408889634f, wint_t = ga[192 + t], emr_t = ga[256 + t];
                        asm volatile("s_waitcnt lgkmcnt(0)" ::: "memory"); SBAR();
                        float ps = 0.f;
#pragma unroll
                        for (int r = 0; r < 16; ++r) {
                            const int s0 = fa::crow(r, hi), s1 = s0 + 32;
                            const float e0 = __builtin_amdgcn_exp2f(fmaf(ct0[r], 1.4426950408889634f, rown)), e1 = __builtin_amdgcn_exp2f(fmaf(ct1[r], 1.4426950408889634f, rown));
                            p0[r] = s0 <= t ? p0[r] * QSCALE * e0 : 0.f; p1[r] = s1 <= t ? p1[r] * QSCALE * e1 : 0.f;
                            ps += p0[r] + p1[r];
                        }
                        { auto rr = __builtin_amdgcn_permlane32_swap(__float_as_uint(ps), __float_as_uint(ps), false, false); ps = __uint_as_float(rr[0]) + __uint_as_float(rr[1]); }
                        bf16x8 pa0, pa1, pa2, pa3;
#define PK4(P, BASE, OUT) do { unsigned a0 = fa::cvtpk(P[BASE + 0], P[BASE + 1]), a1 = fa::cvtpk(P[BASE + 2], P[BASE + 3]);   \
        unsigned b0 = fa::cvtpk(P[BASE + 4], P[BASE + 5]), b1 = fa::cvtpk(P[BASE + 6], P[BASE + 7]);                              \
        auto r0 = __builtin_amdgcn_permlane32_swap(a0, b0, false, false); auto r1 = __builtin_amdgcn_permlane32_swap(a1, b1, false, false); \
        u32x4 w = {r0[0], r1[0], r0[1], r1[1]}; OUT = *reinterpret_cast<bf16x8*>(&w); } while (0)
                        PK4(p0, 0, pa0); PK4(p0, 8, pa1); PK4(p1, 0, pa2); PK4(p1, 8, pa3);
                        float qn_ = qnacc[0];
                        { auto rr = __builtin_amdgcn_permlane32_swap(__float_as_uint(qn_), __float_as_uint(qn_), false, false); qn_ = __uint_as_float(rr[0]); }
                        const float den = wint_t * qn_ + ps;
                        if (hi == 0) den_l[r32] = fmaxf(fabsf(den), emr_t);
#pragma unroll
                        for (int r = 0; r < 16; ++r) acc[r] *= wi[r];
                        fa::pv_one<0>(acc, vbV + vq * 512, pa0, pa1, pa2, pa3);
                        float dl[16];
#pragma unroll
                        for (int r = 0; r < 16; ++r) dl[r] = den_l[fa::crow(r, hi)];
                        asm volatile("s_waitcnt lgkmcnt(0)" ::: "memory"); SBAR();
                        const long stepE = dir ? -(long)D : (long)D;
                        bf16* hb = HD + ((size_t)dir * ML + tokrow(b, dir, c, tq * 32 + 4 * hi)) * D + h * 256 + sl * 64 + vq * 32 + r32;
#pragma unroll
                        for (int r = 0; r < 16; ++r) hb[stepE * ((r & 3) + 8 * (r >> 2))] = f2bf(acc[r] * __builtin_amdgcn_rcpf(dl[r]));
                    }
                    if constexpr (!LATC) if (c == 3) { const bf16* Qw = Q + (size_t)tokrow(b, dir, c + 1, (wid >> 1) * 32 + r32) * MIWM + h * 128 + hi * 8;
#pragma unroll
                        for (int d0 = 0; d0 < 8; ++d0) qr[d0] = *(const bf16x8*)(Qw + d0 * 16); }
                } else {
                    const int kq = wid - 4; const float decay = ga[320];
                    f32x4* CF = (f32x4*)(lds + CF_OFF) + kq * 3 * 4 * 64 + lane;
                    f32x4 cfv[12]; s16x4 kt[8], vt[24];
#pragma unroll
                    for (int i = 0; i < 12; ++i) cfv[i] = CF[i * 64];
                    typedef short v4i16_t __attribute__((ext_vector_type(4)));
#define TRB(base, off) __builtin_bit_cast(s16x4, __builtin_amdgcn_ds_read_tr16_b64_v4i16((LAS v4i16_t*)(size_t)(unsigned)((base) + (off))))
                    const int ak = vbK + kq * 512;
#pragma unroll
                    for (int ks = 0; ks < 4; ++ks) { kt[2 * ks] = TRB(ak, fa::v_rd_off(0, ks, 0)); kt[2 * ks + 1] = TRB(ak, fa::v_rd_off(0, ks, 1)); }
#pragma unroll
                    for (int j = 0; j < 3; ++j)
#pragma unroll
                        for (int ks = 0; ks < 4; ++ks) { vt[8 * j + 2 * ks] = TRB(vbV, fa::v_rd_off(j, ks, 0)); vt[8 * j + 2 * ks + 1] = TRB(vbV, fa::v_rd_off(j, ks, 1)); }
#undef TRB
                    f32x16 cacc[3];
#pragma unroll
                    for (int j = 0; j < 3; ++j)
#pragma unroll
                        for (int r4 = 0; r4 < 4; ++r4) { const f32x4 v4 = cfv[j * 4 + r4] * decay; cacc[j][r4 * 4 + 0] = v4[0]; cacc[j][r4 * 4 + 1] = v4[1]; cacc[j][r4 * 4 + 2] = v4[2]; cacc[j][r4 * 4 + 3] = v4[3]; }
#define PKF(L, H) (bf16x8){L[0], L[1], L[2], L[3], H[0], H[1], H[2], H[3]}
#pragma unroll
                    for (int j = 0; j < 3; ++j)
#pragma unroll
                        for (int ks = 0; ks < 4; ++ks) cacc[j] = __builtin_amdgcn_mfma_f32_32x32x16_bf16(PKF(kt[2 * ks], kt[2 * ks + 1]), PKF(vt[8 * j + 2 * ks], vt[8 * j + 2 * ks + 1]), cacc[j], 0, 0, 0);
#undef PKF
                    char* Cn = C_lds + ((c + 1) & 1) * 24576;
#pragma unroll
                    for (int j = 0; j < 3; ++j) { bf16x8 f0, f1; PK4(cacc[j], 0, f0); PK4(cacc[j], 8, f1);
                        *(bf16x8*)(Cn + KSWZ(j * 32 + r32, (kq * 32 + hi * 8) * 2)) = f0; *(bf16x8*)(Cn + KSWZ(j * 32 + r32, (kq * 32 + 16 + hi * 8) * 2)) = f1; }
#pragma unroll
                    for (int j = 0; j < 3; ++j)
#pragma unroll
                        for (int r4 = 0; r4 < 4; ++r4) CF[(j * 4 + r4) * 64] = (f32x4){cacc[j][r4 * 4 + 0], cacc[j][r4 * 4 + 1], cacc[j][r4 * 4 + 2], cacc[j][r4 * 4 + 3]};
                    if (wid == 4 && c + 1 < 68) mprev = gate_chunk(gli, gf, mprev, GA + ((c + 1) & 1) * (GA_STRIDE / 4), lane);
                }
                __syncthreads();
            }
        };
        if (wid < 4) { chunk_loop(std::true_type{}, std::false_type{}, 0, 4);
            __builtin_amdgcn_s_waitcnt(0);
            chunk_loop(std::true_type{}, std::true_type{}, 4, 68); }
        else chunk_loop(std::false_type{}, std::false_type{}, 0, 68);
#undef PK4
    }
}
}

DEVI void ph_attn0(const Params& p, char* lds, int vcu, int G) {
    const bf16* Q = (const bf16*)(p.ws + WS_QKV); unsigned char* AO = (unsigned char*)(p.ws + WS_AO);
    const bool edge = (vcu & 15) == 0 || (vcu & 15) == 15;
    const int nG = (512 - vcu + G - 1) / G, nC = G == 256 ? (edge ? 2 : 0) : (vcu < 64 ? (64 - vcu + G - 1) / G : 0);
    for (int i = 0; i < 2 * nG + nC; ++i) {
        const bf16 *Qb, *kc, *kl; unsigned char* Ob; int tbase = 0, nwin = 64, vdelta, NT, rq0 = 0; bool na = false; const float* rpb = p.attn_rpb;
        if (i < nG) {
            const int u = vcu + i * G; int b, qh, qb;
            if (G == 256) { const int grp = vcu >> 5, idx = (vcu & 31) + 32 * i; b = grp >> 1; qh = (grp & 1) * 4 + (idx >> 4); qb = idx & 15; } else { b = u >> 7; qh = (u >> 4) & 7; qb = u & 15; }
            const int kvh = qh >> 2;
            kc = Q + (size_t)(ML + b * CTXL) * AIW + 4096 + kvh * 128; kl = Q + (size_t)(b * SEQ) * AIW + 4096 + kvh * 128; vdelta = 256; NT = 68;
            Qb = Q + (size_t)(b * SEQ + qb * 256) * AIW + 3072 + qh * 128; Ob = AO + (size_t)(b * SEQ + qb * 256) * D + 1024 + qh * 128;
        } else if (i < 2 * nG) {
            const int u = vcu + (i - nG) * G; const int b = u >> 7, h = (u >> 4) & 7, qb = u & 15;
            const int krmin = min(max(4 * qb - 4, 0), 56), krmax = min(max(4 * qb - 1, 0), 56) + 7;
            tbase = krmin; nwin = krmax - krmin + 1; NT = (4 + nwin + 1) & ~1; na = true; rq0 = 4 * qb; rpb = p.attn_rpb + h * 465;
            kc = Q + (size_t)(ML + b * CTXL) * AIW + 1024 + h * 128; kl = Q + (size_t)(b * SEQ) * AIW + 1024 + h * 128; vdelta = 1024;
            Qb = Q + (size_t)(b * SEQ + qb * 256) * AIW + h * 128; Ob = AO + (size_t)(b * SEQ + qb * 256) * D + h * 128;
        } else {
            const int u = G == 256 ? ((vcu >> 4) * 2 + ((vcu & 15) == 15 ? 1 : 0)) + 32 * (i - 2 * nG) : vcu + (i - 2 * nG) * G; const int b = (u >> 3) & 3, hh = u & 7; const bool gq = u >= 32;
            const int qcol = gq ? 3072 + hh * 128 : hh * 128, kcol = gq ? 4096 + (hh >> 2) * 128 : 1024 + hh * 128, ocol = gq ? 1024 + hh * 128 : hh * 128;
            kc = Q + (size_t)(ML + b * CTXL) * AIW + kcol; kl = kc; vdelta = gq ? 256 : 1024; NT = 4;
            Qb = Q + (size_t)(ML + b * CTXL) * AIW + qcol; Ob = AO + (size_t)(ML + b * CTXL) * D + ocol;
        }
        if (na) fa::attn_unit_na(Qb, kc, kl, tbase, nwin, vdelta, Ob, lds, rq0, rpb); else fa::attn_unit(Qb, kc, kl, vdelta, NT, Ob, lds);
    }
}

DEVI unsigned cvtpk_s(float lo, float hi) { unsigned r; asm volatile("v_cvt_pk_bf16_f32 %0, %1, %2" : "=v"(r) : "v"(lo), "v"(hi)); return r; }
DEVI void ph_router_prep(const Params& p, float* lds, int vcu, int G) {
    const int tid = otid(), lane = tid & 63, wave = tid >> 6;
    bf16* RWP = (bf16*)(p.ws + WS_RWP); float* RC = (float*)(p.ws + WS_RC);
    const int vr = G - 1 - vcu;
    for (int idx = vr * 512 + tid; idx < 10 * 256 * 64; idx += G * 512) {
        const int e = idx & 63, kg = (idx >> 6) & 255, lb = idx >> 14, l = lb / 5, bb = lb % 5;
        const float* W = p.router_w + (size_t)l * D * NE + e; const float* gn = p.norm_ffn + l * D + kg * 8; const float* scl = modp(p, l, bb, 4) + kg * 8;
        float v[8]; unsigned hi[4], lo[4];
#pragma unroll
        for (int j = 0; j < 8; ++j) v[j] = gn[j] * (1.f + scl[j]) * W[(size_t)(kg * 8 + j) * NE];
#pragma unroll
        for (int j = 0; j < 4; ++j) { hi[j] = cvtpk_s(v[2 * j], v[2 * j + 1]); lo[j] = cvtpk_s(v[2 * j] - __uint_as_float(hi[j] << 16), v[2 * j + 1] - __uint_as_float(hi[j] & 0xffff0000u)); }
        bf16* dst = RWP + (((size_t)lb * 2 * 128 + (kg >> 1)) * 64 + e) * 16 + (kg & 1) * 8;
        *(u32x4*)dst = (u32x4){hi[0], hi[1], hi[2], hi[3]}; *(u32x4*)(dst + (size_t)128 * 64 * 16) = (u32x4){lo[0], lo[1], lo[2], lo[3]};
    }
    for (int c = vr; c < 80; c += G) {
        const int lb = c % 10, sl = c / 10, l = lb / 5, bb = lb % 5; const float* W = p.router_w + (size_t)l * D * NE + lane; const float* sh = modp(p, l, bb, 3);
        float a = 0.f;
#pragma unroll 32
        for (int k = sl * 256 + wave * 32; k < sl * 256 + wave * 32 + 32; ++k) a += sh[k] * W[(size_t)k * NE];
        __syncthreads(); lds[wave * 64 + lane] = a; __syncthreads();
        if (wave == 0) { float t = 0.f; for (int w = 0; w < 8; ++w) t += lds[w * 64 + lane]; RC[(lb * 8 + sl) * 64 + lane] = t; }
    }
}
DEVI void ph_normr2(const Params& p, int layer, int nrows, float* lds, int vcu, int G) {
    using fa::f32x16;
    float* part = lds; float* ssq = lds + 8 * 4096; float* rstd_l = ssq + 256; float* sraw = rstd_l + 32; float* ssel = sraw + 2048; float* gsc = ssel + 2048;
    int* gsel = (int*)(gsc + 256); int* esel = gsel + 256; float* wsel = (float*)(esel + 256);
    LAS int* hist = (LAS int*)(wsel + 256); LAS int* hbase = hist + 64;
    const int tid = otid(), lane = tid & 63, wave = __builtin_amdgcn_readfirstlane(tid >> 6), r32 = lane & 31, kgp = lane >> 5;
    bf16* HB = (bf16*)(p.ws + WS_HB);
    int* eidx = (int*)(p.ws + WS_EIDX); float* ew = (float*)(p.ws + WS_EW); int* epos = (int*)(p.ws + WS_EPOS);
    u32* cnt = (u32*)(p.ws + WS_CTL) + CW_CNT + layer * 64 * CNT_PAD;
    const float* RB = p.router_b + layer * NE; const float* gain = p.norm_ffn + layer * D;
    LAS int* tq = hbase + 64;
    unsigned* tcnt = (unsigned*)(p.ws + WS_CTL) + CW_TQ + layer * 64;
    const int ntiles = nrows >> 5;
    if (tid == 0) tq[0] = (int)atomicAdd(tcnt, 1u);
    __syncthreads();
    int tile = __builtin_amdgcn_readfirstlane(tq[0]);
    while (tile < ntiles) {
        int nxt_reg = 0;
        const int m0 = tile * 32, bb = bidx(m0);
        const bf16* xbase = (const bf16*)(p.ws + WS_X) + (size_t)m0 * D;
        {
            LAS unsigned char* xs = (LAS unsigned char*)lds + wave * 16384;
            {
                const int rr_ = lane >> 5, cc = lane & 31;
                const unsigned char* xg = (const unsigned char*)xbase + (size_t)rr_ * (D * 2) + wave * 512 + cc * 16;
                u32x4 xv[16];
#pragma unroll
                for (int i = 0; i < 16; ++i) xv[i] = *(const u32x4*)(xg + (size_t)(2 * i) * (D * 2));
#pragma unroll
                for (int i = 0; i < 16; ++i) { const int row = 2 * i + rr_; *(LAS u32x4*)(xs + row * 512 + ((cc ^ row) & 31) * 16) = xv[i]; }
            }
            const bf16* wb = (const bf16*)(p.ws + WS_RWP) + (((size_t)(layer * 5 + bb) * 2 * 128 + wave * 16) * 64 + r32) * 16 + kgp * 8;
            f32x16 acc0 = {}, acc1 = {}; float ss = 0.f;
            bf16x8 wv[2][4][4];
#pragma unroll
            for (int t = 0; t < 4; ++t) { const bf16* w_ = wb + (size_t)t * 1024;
                wv[0][t][0] = *(const bf16x8*)(w_); wv[0][t][1] = *(const bf16x8*)(w_ + 512); wv[0][t][2] = *(const bf16x8*)(w_ + (size_t)128 * 1024); wv[0][t][3] = *(const bf16x8*)(w_ + (size_t)128 * 1024 + 512); }
            asm volatile("s_waitcnt lgkmcnt(0)" ::: "memory");
#pragma unroll
            for (int sb = 0; sb < 4; ++sb) {
                if (sb < 3) {
#pragma unroll
                    for (int t = 0; t < 4; ++t) { const bf16* w_ = wb + (size_t)((sb + 1) * 4 + t) * 1024;
                        wv[(sb + 1) & 1][t][0] = *(const bf16x8*)(w_); wv[(sb + 1) & 1][t][1] = *(const bf16x8*)(w_ + 512); wv[(sb + 1) & 1][t][2] = *(const bf16x8*)(w_ + (size_t)128 * 1024); wv[(sb + 1) & 1][t][3] = *(const bf16x8*)(w_ + (size_t)128 * 1024 + 512); }
                }
                u32x4 ahv[4];
#pragma unroll
                for (int t = 0; t < 4; ++t) { const int ch = 2 * (sb * 4 + t) + kgp; ahv[t] = *(const LAS u32x4*)(xs + r32 * 512 + ((ch ^ r32) & 31) * 16); }
#pragma unroll
                for (int t = 0; t < 4; ++t) {
                    const u32x4 ah = ahv[t];
#pragma unroll
                    for (int q = 0; q < 4; ++q) { const float a = __uint_as_float(ah[q] << 16), b = __uint_as_float(ah[q] & 0xffff0000u); ss += a * a + b * b; }
                    const bf16x8 Ah = __builtin_bit_cast(bf16x8, ah);
                    acc0 = __builtin_amdgcn_mfma_f32_32x32x16_bf16(Ah, wv[sb & 1][t][0], acc0, 0, 0, 0); acc1 = __builtin_amdgcn_mfma_f32_32x32x16_bf16(Ah, wv[sb & 1][t][1], acc1, 0, 0, 0);
                    acc0 = __builtin_amdgcn_mfma_f32_32x32x16_bf16(Ah, wv[sb & 1][t][2], acc0, 0, 0, 0); acc1 = __builtin_amdgcn_mfma_f32_32x32x16_bf16(Ah, wv[sb & 1][t][3], acc1, 0, 0, 0);
                }
            }
            { auto rr = __builtin_amdgcn_permlane32_swap(__float_as_uint(ss), __float_as_uint(ss), false, false); ss = __uint_as_float(rr[0]) + __uint_as_float(rr[1]); }
            if (kgp == 0) ssq[wave * 32 + r32] = ss;
#pragma unroll
            for (int r = 0; r < 16; ++r) { part[wave * 4096 + (0 * 16 + r) * 64 + lane] = acc0[r]; part[wave * 4096 + (1 * 16 + r) * 64 + lane] = acc1[r]; }
        }
        __syncthreads();
        if (tid == 0) nxt_reg = (int)atomicAdd(tcnt, 1u);
        if (tid < 32) { float t = 0.f; for (int w = 0; w < 8; ++w) t += ssq[w * 32 + tid]; rstd_l[tid] = rsqrtf(t * (1.f / D) + EPS); }
        __syncthreads();
        {
            if (tid < 64) hist[tid] = 0;
            const float* rc = (const float*)(p.ws + WS_RC) + (layer * 5 + bb) * 8 * 64;
            float rcsum = 0.f;
#pragma unroll
            for (int sl = 0; sl < 8; ++sl) rcsum += rc[sl * 64 + lane];
            const float rbe = RB[lane]; const int g = lane >> 3;
#define DPPF(x, ctrl) __int_as_float(__builtin_amdgcn_update_dpp(0, __float_as_int(x), ctrl, 0xf, 0xf, false))
#pragma unroll 1
            for (int q = 0; q < 4; ++q) {
                const int row = wave + 8 * q, rr = (row & 3) + 4 * (row >> 3), ll = (lane & 31) + 32 * ((row >> 2) & 1), eb = lane >> 5;
                float t = 0.f;
#pragma unroll
                for (int w = 0; w < 8; ++w) t += part[w * 4096 + (eb * 16 + rr) * 64 + ll];
                const float lg = t * rstd_l[row] + rcsum; const float sg = 1.f / (1.f + expf(-lg));
                const float v = sg + rbe;
                float m1 = v, m2 = -INFINITY;
                { const float o1 = DPPF(m1, 0xB1); m2 = fminf(m1, o1); m1 = fmaxf(m1, o1); }
                { const float o1 = DPPF(m1, 0x4E), o2 = DPPF(m2, 0x4E); m2 = fmaxf(fminf(m1, o1), fmaxf(m2, o2)); m1 = fmaxf(m1, o1); }
                { const float o1 = DPPF(m1, 0x141), o2 = DPPF(m2, 0x141); m2 = fmaxf(fminf(m1, o1), fmaxf(m2, o2)); m1 = fmaxf(m1, o1); }
                const float gs = m1 + m2;
                int grank = 0;
#pragma unroll
                for (int j = 0; j < 8; ++j) { const float sj = __int_as_float(__builtin_amdgcn_readlane(__float_as_int(gs), 8 * j)); grank += (sj > gs || (sj == gs && j < g)) ? 1 : 0; }
                float vm = grank < 4 ? v : -INFINITY;
#pragma unroll 1
                for (int r = 0; r < 8; ++r) {
                    const float mx = ml::lane63(ml::prefix_max64(vm, 0));
                    const unsigned long long bal = __ballot(vm == mx);
                    const int idx = __ffsll((long long)bal) - 1;
                    if (lane == idx) { esel[row * 8 + r] = lane; wsel[row * 8 + r] = sg; vm = -INFINITY; }
                }
            }
#undef DPPF
        }
        __syncthreads();
        int lrank = 0;
        if (tid < 256) lrank = __hip_atomic_fetch_add(hist + esel[tid], 1, __ATOMIC_RELAXED, __HIP_MEMORY_SCOPE_WORKGROUP);
        __syncthreads();
        if (tid < 64) { const int c_ = hist[tid]; hbase[tid] = c_ > 0 ? (int)atomicAdd(&cnt[tid * CNT_PAD], (u32)c_) : 0; }
        __syncthreads();
        if (tid < 256) {
            const int row = tid >> 3, k = tid & 7; float wsum = 0.f;
#pragma unroll
            for (int j = 0; j < 8; ++j) wsum += wsel[row * 8 + j];
            const int e = esel[tid]; const int mm = m0 + row;
            const int pos = hbase[e] + lrank;
            eidx[mm * 8 + k] = e; epos[mm * 8 + k] = pos;
            ((int*)(p.ws + WS_LTOK))[(size_t)e * MT + pos] = mm; ((float*)(p.ws + WS_LW))[(size_t)e * MT + pos] = wsel[tid] * (2.5f / wsum);
        }
        {
            const float* sh = modp(p, layer, bb, 3); const float* scl = modp(p, layer, bb, 4);
            const float rs0 = rstd_l[wave * 4 + 0], rs1 = rstd_l[wave * 4 + 1], rs2 = rstd_l[wave * 4 + 2], rs3 = rstd_l[wave * 4 + 3];
            const bf16* src = xbase + (size_t)(wave * 4) * D; unsigned char* dstb = (unsigned char*)HB + (size_t)(m0 + wave * 4) * D;
#pragma unroll 2
            for (int j = 0; j < 8; ++j) {
                const int c = 4 * lane + 256 * j;
                uint2 xv[4];
#pragma unroll
                for (int rr = 0; rr < 4; ++rr) xv[rr] = *(const uint2*)(src + (size_t)rr * D + c);
                const float4 g = *(const float4*)(gain + c), s1 = *(const float4*)(scl + c), s0 = *(const float4*)(sh + c);
                const float gx = g.x * (1.f + s1.x), gy = g.y * (1.f + s1.y), gz = g.z * (1.f + s1.z), gw_ = g.w * (1.f + s1.w);
#pragma unroll
                for (int rr = 0; rr < 4; ++rr) { const float rs = rr == 0 ? rs0 : rr == 1 ? rs1 : rr == 2 ? rs2 : rs3;
                    const float vx = __uint_as_float(xv[rr].x << 16), vy = __uint_as_float(xv[rr].x & 0xffff0000u), vz = __uint_as_float(xv[rr].y << 16), vw = __uint_as_float(xv[rr].y & 0xffff0000u);
                    *(u32*)(dstb + (size_t)rr * D + c) = pk4_fp8(vx * rs * gx + s0.x, vy * rs * gy + s0.y, vz * rs * gz + s0.z, vw * rs * gw_ + s0.w); }
            }
        }
        if (tid == 0) tq[1] = nxt_reg;
        __syncthreads();
        tile = __builtin_amdgcn_readfirstlane(tq[1]);
    }
}

enum Phase { PH_MODS = 0, PH_NORM0, PH_INPROJ0, PH_QKNORM, PH_ATTN0, PH_OUTPROJ0, PH_NORMR0, PH_DISP0, PH_G1_0, PH_G2_0, PH_COMB0,
             PH_INPROJ1, PH_MLSTM, PH_READOUT, PH_OUTPROJ1, PH_NORMR1, PH_DISP1, PH_G1_1, PH_G2_1, PH_COMB1, PH_COUNT };

#define XB_TMO      128
#define XB_XCNT(j)  (256  + 64 * (j))
#define XB_XSUB(j)  (1280 + 64 * (j))
#define XB_XGEN(j)  (2304 + 64 * (j))
#define XB_TOP      3328
#define XB_TOPGEN   3392
#define XCD_BAR_WORDS 3456
#define XB_SPIN_CAP (1u << 18)
__device__ __forceinline__ unsigned xb_ld(unsigned* p)              { return __hip_atomic_load(p, __ATOMIC_RELAXED, __HIP_MEMORY_SCOPE_AGENT); }
__device__ __forceinline__ unsigned xb_add(unsigned* p, unsigned v) { return __hip_atomic_fetch_add(p, v, __ATOMIC_RELAXED, __HIP_MEMORY_SCOPE_AGENT); }
__device__ __forceinline__ unsigned xb_xcc_id() { return (unsigned)__builtin_amdgcn_s_getreg((3 << 11) | 20) & 0xFu; }
#define XB_SPIN(cond, bar) do { unsigned _sp = 0; while (cond) { __builtin_amdgcn_s_sleep(1); \
    if ((++_sp & 255u) == 0u) { if (xb_ld(&(bar)[XB_TMO])) break; if (_sp > XB_SPIN_CAP) { atomicAdd(&(bar)[XB_TMO], 1u); break; } } } } while (0)
struct XcdBarrier { unsigned* bar; unsigned x; volatile LAS unsigned* st; };
__device__ __forceinline__ XcdBarrier xcd_barrier_post(unsigned* bar, volatile LAS unsigned* st) {
    XcdBarrier b; b.bar = bar; b.x = xb_xcc_id(); b.st = st;
    if (threadIdx.x == 0) (void)xb_add(&bar[XB_XCNT(b.x)], 1u);
    return b;
}
__device__ __forceinline__ void xcd_barrier_complete(unsigned* bar, unsigned x, unsigned& nloc, unsigned& nx) {
    const unsigned G = gridDim.x * gridDim.y * gridDim.z;
    unsigned sum, cnt, mine, sp = 0u;
    for (;;) {
        sum = 0u; cnt = 0u; mine = 0u;
#pragma unroll 1
        for (unsigned j = 0; j < 16; ++j) { const unsigned c = xb_ld(&bar[XB_XCNT(j)]); sum += c; cnt += (c > 0u) ? 1u : 0u; mine = (j == x) ? c : mine; }
        if (sum == G) break;
        __builtin_amdgcn_s_sleep(1);
        if ((++sp & 255u) == 0u) { if (xb_ld(&bar[XB_TMO])) break; if (sp > XB_SPIN_CAP) { atomicAdd(&bar[XB_TMO], 1u); break; } }
    }
    nloc = mine > 0u ? mine : 1u; nx = cnt > 0u ? cnt : 1u;
}
__device__ __forceinline__ void xcd_barrier(const XcdBarrier& b) {
    asm volatile("s_waitcnt vmcnt(0)" ::: "memory");
    __syncthreads();
    if (threadIdx.x == 0) {
        unsigned* bar = b.bar;
        __builtin_amdgcn_s_waitcnt(0);
        unsigned nloc = b.st[0], nx = b.st[1];
        if (nloc == 0u) { xcd_barrier_complete(bar, b.x, nloc, nx); b.st[0] = nloc; b.st[1] = nx; }
        const unsigned old = xb_add(&bar[XB_XSUB(b.x)], 1u);
        const unsigned gen = old / nloc;
        if (old + 1u == (gen + 1u) * nloc) {
            __builtin_amdgcn_fence(__ATOMIC_RELEASE, "agent");
            asm volatile("s_waitcnt vmcnt(0)" ::: "memory");
            const unsigned og = xb_add(&bar[XB_TOP], 1u);
            const unsigned tg = og / nx;
            if (og + 1u == (tg + 1u) * nx) xb_add(&bar[XB_TOPGEN], 1u);
            else XB_SPIN(xb_ld(&bar[XB_TOPGEN]) == tg, bar);
            __builtin_amdgcn_fence(__ATOMIC_ACQUIRE, "agent");
            xb_add(&bar[XB_XGEN(b.x)], 1u);
            asm volatile("s_waitcnt vmcnt(0)" ::: "memory");
        } else {
            XB_SPIN(xb_ld(&bar[XB_XGEN(b.x)]) == gen, bar);
            __builtin_amdgcn_fence(__ATOMIC_ACQUIRE, "agent");
            asm volatile("s_waitcnt vmcnt(0)" ::: "memory");
        }
    }
    __syncthreads();
}
constexpr int CW_BAR = 4096;
static_assert((CW_BAR + XCD_BAR_WORDS) * 4 <= (int)CTL_BYTES, "barrier words inside the memset region");

typedef const __attribute__((address_space(4))) Params* KArgs;
#if defined(__HIP_DEVICE_COMPILE__)
DEVI Params kargs() { KArgs k = (KArgs)__builtin_amdgcn_kernarg_segment_ptr(); asm volatile("" : "+s"(k)); Params q; q.x = k->x; q.c = k->c; q.ctx = k->ctx; q.c_ctx = k->c_ctx; q.ada_w = k->ada_w; q.ada_b = k->ada_b; q.norm_mix = k->norm_mix; q.norm_ffn = k->norm_ffn; q.attn_w_in = k->attn_w_in; q.attn_w_out = k->attn_w_out; q.attn_rpb = k->attn_rpb; q.attn_q_gain = k->attn_q_gain; q.attn_k_gain = k->attn_k_gain; q.ml_w_in = k->ml_w_in; q.ml_w_out = k->ml_w_out; q.ml_gate_b = k->ml_gate_b; q.ml_head_gain = k->ml_head_gain; q.router_w = k->router_w; q.router_b = k->router_b; q.exp_w1 = k->exp_w1; q.exp_w3 = k->exp_w3; q.exp_w2 = k->exp_w2; q.sh_w1 = k->sh_w1; q.sh_w3 = k->sh_w3; q.sh_w2 = k->sh_w2; q.final_norm = k->final_norm; q.out = k->out; q.ws = k->ws; q.lo = k->lo; q.hi = k->hi; return q; }
#else
DEVI Params kargs() { return Params{}; }
#endif
constexpr int MEGA_LDS = 157 * 1024;
static_assert(pg::LDS_TOTAL <= MEGA_LDS, "LDS map");
__global__ void __launch_bounds__(512, 2) k_mega(Params p) {
    extern __shared__ __attribute__((aligned(16))) unsigned char lds_raw[];
    LAS unsigned char* lds = (LAS unsigned char*)lds_raw;
    float* ldsf = (float*)lds_raw;
    const int G = gridDim.x, bx = blockIdx.x;
    const int vcu = (G % 8 == 0) ? (bx % 8) * (G / 8) + bx / 8 : bx;
    if (threadIdx.x < 16) ((LAS unsigned*)(lds + pg::MISC_OFF))[threadIdx.x] = 0u;
    __syncthreads();
    XcdBarrier bar; bar.bar = (unsigned*)(p.ws + WS_CTL) + CW_BAR; bar.x = 0; bar.st = nullptr;
    if (p.hi - p.lo > 1) bar = xcd_barrier_post((unsigned*)(p.ws + WS_CTL) + CW_BAR, (volatile LAS unsigned*)(lds + pg::MISC_OFF));
#ifndef SITEMASK
#define SITEMASK 0xFFFFFu
#endif
#define INF(k) (p.lo <= (k) && (k) < p.hi)
#define INS(site, k) (((SITEMASK >> (site)) & 1u) && INF(k))
#ifdef PROBE_REP
#define REPF(k) for (int rep_ = 0; rep_ < (((k) == PROBE_REP) ? 2 : 1); ++rep_)
#else
#define REPF(k)
#endif
#define SEAM(k) do { if (INF(k) && INF((k) + 1)) xcd_barrier(bar); } while (0)
    REPF(PH_MODS) if (INS(PH_MODS, PH_MODS)) { const Params q = kargs(); __syncthreads(); ph_mods(q, ldsf, vcu, G); __syncthreads(); ph_cvt(q, lds, vcu, G); }
    SEAM(PH_MODS);
    REPF(PH_NORM0) if (INS(PH_NORM0, PH_NORM0)) { const Params q = kargs(); ph_norm(q, 0, q.x, q.ctx, q.norm_mix, 0, 1, MT, vcu, G); ph_router_prep(q, ldsf, vcu, G); }
    SEAM(PH_NORM0);
    for (int layer = 0; layer < 2; ++layer) {
        const int po = 9 * layer;
        REPF(PH_INPROJ0 + po) if (INS(PH_INPROJ0, PH_INPROJ0 + po)) {
            const Params q = kargs();
            const int nN = layer == 0 ? AIW / 256 : MINP / 256;
            const int nu = pg::fill_dense(lds, MT / 256, nN, G, bx);
            __syncthreads();
            pg::ListOrder S{(const LAS int*)(lds + pg::UD_OFF), nu};
            EpiBf16Store E{(bf16*)(q.ws + WS_QKV), layer == 0 ? AIW : MIWM, (float*)(q.ws + WS_G), layer == 0 ? -1 : MIWM / 256, 1.f / W13_SCALE};
            pg::gemm_phase<EpiBf16Store, false, true>(lds, q.ws + WS_HB, q.ws + (layer == 0 ? WT_AIN : WT_MIN), D, 0, S, E);
        }
        SEAM(PH_INPROJ0 + po);
        if (layer == 0) {
            REPF(PH_QKNORM) if (INS(PH_QKNORM, PH_QKNORM)) { const Params q = kargs(); ph_qknorm(q, vcu, G); }
            SEAM(PH_QKNORM);
            REPF(PH_ATTN0) if (INS(PH_ATTN0, PH_ATTN0)) { const Params q = kargs(); ph_attn0(q, (char*)lds_raw, vcu, G); }
            SEAM(PH_ATTN0);
        } else {
            REPF(PH_MLSTM) if (INS(PH_MLSTM, PH_MLSTM)) { const Params q = kargs(); ml::ph_mlstm(q, (char*)lds_raw, vcu, G); }
            SEAM(PH_MLSTM);
            REPF(PH_READOUT) if (INS(PH_READOUT, PH_READOUT)) { const Params q = kargs(); ph_readout(q, vcu, G); }
            SEAM(PH_READOUT);
        }
        REPF(PH_OUTPROJ0 + po) if (INS(PH_OUTPROJ0, PH_OUTPROJ0 + po)) {
            const Params q = kargs();
            const int nu = pg::fill_dense(lds, (layer == 0 ? MT : ML) / 256, D / 256, G, bx);
            __syncthreads();
            pg::ListOrder S{(const LAS int*)(lds + pg::UD_OFF), nu};
            EpiResid E{(bf16*)(q.ws + WS_X), (const float*)(q.ws + WS_MOD) + (size_t)layer * 5 * 6 * D};
            pg::gemm_phase<EpiResid, false, true>(lds, q.ws + WS_AO, q.ws + (layer == 0 ? WT_AOUT : WT_MOUT), D, 0, S, E);
        }
        SEAM(PH_OUTPROJ0 + po);
        REPF(PH_NORMR0 + po) if (INS(PH_NORMR0, PH_NORMR0 + po)) { const Params q = kargs(); ph_normr2(q, layer, layer == 0 ? MT : ML, ldsf, vcu, G); }
        SEAM(PH_NORMR0 + po);
        REPF(PH_G1_0 + po) if (INS(PH_G1_0, PH_G1_0 + po)) {
            const Params q = kargs();
            const int nu = moe_setup<true>(q, lds, layer, layer == 0 ? MT : ML, vcu, G);
            pg::ListOrder S{(const LAS int*)(lds + pg::UD_OFF), nu};
            EpiSwiGLU E{(bf16*)(q.ws + WS_ACT)};
            pg::gemm_phase<EpiSwiGLU, true, true>(lds, q.ws + WS_HB, q.ws + WT_W13 + (size_t)layer * 65 * 1024 * D, D, (size_t)1024 * D, S, E);
        }
        SEAM(PH_G1_0 + po);
        REPF(PH_G2_0 + po) if (INS(PH_G2_0, PH_G2_0 + po)) {
            const Params q = kargs();
            const int nu = moe_setup<false>(q, lds, layer, layer == 0 ? MT : ML, vcu, G);
            pg::ListOrder S{(const LAS int*)(lds + pg::UD_OFF), nu};
            EpiScale E{(unsigned char*)(q.ws + WS_Y), (const LAS float*)(lds + pg::GT_OFF)};
            pg::gemm_phase<EpiScale, false, true>(lds, q.ws + WS_ACT, q.ws + WT_W2 + (size_t)layer * 65 * D * EDIM, EDIM, (size_t)D * EDIM, S, E);
        }
        SEAM(PH_G2_0 + po);
        REPF(PH_COMB0 + po) if (INS(PH_COMB0, PH_COMB0 + po)) { const Params q = kargs(); ph_combine(q, layer, (int*)ldsf, vcu, G); }
        if (layer == 0) SEAM(PH_COMB0);
    }
#undef INF
#undef INS
#undef SEAM
}

#ifndef N_LAUNCH
#define N_LAUNCH 1
#endif
extern "C" void kernel_launch(void* const* d_in, const int* in_sizes, int n_in, void* d_out, int out_size, void* d_ws, size_t ws_size, hipStream_t stream) {
    static int grid = 0;
    if (grid == 0) {
        if (n_in != 26 || out_size != ML * D || ws_size < WS_END) { fprintf(stderr, "kernel_launch: unexpected shapes n_in %d out %d ws %zu\n", n_in, out_size, ws_size); grid = -1; return; }
        int dev = 0, cus = 0, per_cu = 0;
        if (hipGetDevice(&dev) != hipSuccess || hipDeviceGetAttribute(&cus, hipDeviceAttributeMultiprocessorCount, dev) != hipSuccess) { fprintf(stderr, "kernel_launch: device query failed\n"); grid = -1; return; }
        if (hipFuncSetAttribute((const void*)k_mega, hipFuncAttributeMaxDynamicSharedMemorySize, MEGA_LDS) != hipSuccess) { fprintf(stderr, "kernel_launch: hipFuncSetAttribute failed\n"); grid = -1; return; }
        if (hipOccupancyMaxActiveBlocksPerMultiprocessor(&per_cu, (const void*)k_mega, 512, MEGA_LDS) != hipSuccess || per_cu < 1) fprintf(stderr, "kernel_launch: note: occupancy query reports %d blocks per CU\n", per_cu);
        (void)hipGetLastError();
        grid = cus;
    }
    if (grid < 0) return;
    (void)hipMemsetAsync((char*)d_ws + WS_CTL, 0, CTL_BYTES, stream);
    Params p{};
    const float** pp = (const float**)&p;
    for (int i = 0; i < 26; ++i) pp[i] = (const float*)d_in[i];
    p.out = (float*)d_out; p.ws = (unsigned char*)d_ws;
#if N_LAUNCH == 1
    p.lo = 0; p.hi = PH_COUNT;
    hipLaunchKernelGGL(k_mega, dim3(grid), dim3(512), MEGA_LDS, stream, p);
#else
    for (int ph = 0; ph < PH_COUNT; ++ph) { p.lo = ph; p.hi = ph + 1; hipLaunchKernelGGL(k_mega, dim3(grid), dim3(512), MEGA_LDS, stream, p); }
#endif
    const hipError_t le = hipPeekAtLastError();
    if (le != hipSuccess) fprintf(stderr, "kernel_launch: launch failed: %s\n", hipGetErrorName(le));
}
```

```cpp
#include <hip/hip_runtime.h>
#include <cstdio>
#include <cstdint>
#include <type_traits>

#define DEVI __device__ __forceinline__
#define LAS __attribute__((address_space(3)))
typedef short bf16x8 __attribute__((ext_vector_type(8)));
typedef float f32x4 __attribute__((ext_vector_type(4)));
typedef unsigned u32x4 __attribute__((ext_vector_type(4)));
typedef int v4i32 __attribute__((ext_vector_type(4)));
typedef int v8i32 __attribute__((ext_vector_type(8)));
typedef unsigned short bf16;
typedef unsigned int u32;

constexpr int D = 2048, NB = 4, SEQ = 4096, CTXL = 256, GRIDW = 64;
constexpr int ML = NB * SEQ;
constexpr int MC = NB * CTXL;
constexpr int MT = ML + MC;
constexpr int AIW = 4608;
constexpr int MIW = 6176, MIWM = 6144;
constexpr int NE = 64, TOPK = 8, EDIM = 512;
constexpr int RS = MT * 8 + 64 * 256;
constexpr int SH0 = RS;
constexpr int NSLOT = RS + MT;
constexpr float EPS = 1e-6f;
constexpr float QSCALE = 0.08838834764831845f;

constexpr size_t MiB = (size_t)1 << 20;
constexpr size_t WS_CTL = 0, CTL_BYTES = 1 * MiB;
constexpr size_t WS_MOD = 1 * MiB;
constexpr size_t WS_XC = 2 * MiB;
constexpr size_t WS_G = 10 * MiB;
constexpr size_t WS_EIDX = 13 * MiB, WS_EW = 14 * MiB, WS_EPOS = 15 * MiB, WS_TSLOT = 16 * MiB, WS_STOK = 17 * MiB, WS_SW = 18 * MiB, WS_EOFF = 19 * MiB;
constexpr size_t WS_HB = 20 * MiB;
constexpr size_t WS_ACT = 88 * MiB;
constexpr size_t WS_Y = 257 * MiB;
constexpr size_t WS_QKV = 257 * MiB;
constexpr size_t WS_AO = 461 * MiB;
constexpr size_t WS_HD = 529 * MiB;
constexpr size_t WS_WT = 933 * MiB;
constexpr size_t WS_RWP = 1772 * MiB;
constexpr size_t WS_RC = 1777 * MiB;
constexpr size_t WS_LTOK = 1780 * MiB;
constexpr size_t WS_LW = 1785 * MiB;
constexpr size_t WS_X = 1790 * MiB;
constexpr size_t WS_END = 1858 * MiB;
constexpr int CW_TQ = 24576;
constexpr int CW_CNT = 16384, CNT_PAD = 32;

struct Params {
    const float *x, *c, *ctx, *c_ctx, *ada_w, *ada_b, *norm_mix, *norm_ffn, *attn_w_in, *attn_w_out, *attn_rpb, *attn_q_gain, *attn_k_gain,
        *ml_w_in, *ml_w_out, *ml_gate_b, *ml_head_gain, *router_w, *router_b, *exp_w1, *exp_w3, *exp_w2, *sh_w1, *sh_w3, *sh_w2, *final_norm;
    float* out; unsigned char* ws;
    int lo, hi;
};

DEVI int otid() { int t = threadIdx.x; asm volatile("" : "+v"(t)); return t; }
DEVI float bf2f(bf16 b) { return __uint_as_float(((u32)b) << 16); }
DEVI bf16 f2bf(float f) { u32 u = __float_as_uint(f); u += 0x7fffu + ((u >> 16) & 1u); return (bf16)(u >> 16); }
DEVI u32 pk2(float lo, float hi) { return (u32)f2bf(lo) | ((u32)f2bf(hi) << 16); }
DEVI float wave_sum(float v) {
#pragma unroll
    for (int o = 32; o >= 1; o >>= 1) v += __shfl_xor(v, o);
    return v;
}
DEVI unsigned pg_cvt_pk_bf16(float lo, float hi) { unsigned r; asm volatile("v_cvt_pk_bf16_f32 %0, %1, %2" : "=v"(r) : "v"(lo), "v"(hi)); return r; }
DEVI float wave_prefix_dpp(float x) {
#define WS_DPP(ctrl, rmask) x += __int_as_float(__builtin_amdgcn_update_dpp(0, __float_as_int(x), ctrl, rmask, 0xf, false))
    WS_DPP(0x111, 0xf); WS_DPP(0x112, 0xf); WS_DPP(0x114, 0xf); WS_DPP(0x118, 0xf); WS_DPP(0x142, 0xa); WS_DPP(0x143, 0xc);
#undef WS_DPP
    return x;
}
DEVI float wave_sum_dpp(float x) {
#define WS_DPP(ctrl, rmask) x += __int_as_float(__builtin_amdgcn_update_dpp(0, __float_as_int(x), ctrl, rmask, 0xf, false))
    WS_DPP(0x111, 0xf); WS_DPP(0x112, 0xf); WS_DPP(0x114, 0xf); WS_DPP(0x118, 0xf); WS_DPP(0x142, 0xa); WS_DPP(0x143, 0xc);
#undef WS_DPP
    return __int_as_float(__builtin_amdgcn_readlane(__float_as_int(x), 63));
}
DEVI u32 pk4_fp8(float a, float b, float c, float d) { int w = 0; w = __builtin_amdgcn_cvt_pk_fp8_f32(a, b, w, false); w = __builtin_amdgcn_cvt_pk_fp8_f32(c, d, w, true); return (u32)w; }
DEVI int bidx(int m) { return m < ML ? (m >> 12) : 4; }
DEVI int row_of_trip(int vcu, int wave, int k, int nrows, int G) {
    if (G == 256) { if (k < 8) return vcu * 8 + wave + k * 2048; return (k == 8 && nrows > ML && wave < 4) ? ML + vcu * 4 + wave : -1; }
    const int m = vcu * 8 + wave + k * G * 8; return m < nrows ? m : -1;
}
DEVI const float* modp(const Params& p, int layer, int bb, int i) { return (const float*)(p.ws + WS_MOD) + ((size_t)((layer * 5 + bb) * 6 + i)) * D; }
DEVI float silu(float x) { return x / (1.f + __expf(-x)); }
DEVI float sigmoidf(float x) { return 1.f / (1.f + __expf(-x)); }

DEVI void ph_mods(const Params& p, float* lds, int vcu, int G) {
    float* sc = lds;
    float* red = lds + 5 * D;
    const int tid = otid();
    for (int i = tid; i < 5 * D; i += 512) { const int bb = i / D, k = i % D; const float v = bb < 4 ? p.c[bb * D + k] : p.c_ctx[k]; sc[i] = silu(v); }
    __syncthreads();
    const int tn = tid & 7, tk = tid >> 3;
    for (int item = vcu; item < 2 * 384; item += G) {
        const int l = item / 384, n0 = (item % 384) * 32;
        const float* W = p.ada_w + (size_t)l * D * 12288 + n0 + tn * 4;
        float4 acc[5];
#pragma unroll
        for (int b = 0; b < 5; ++b) acc[b] = make_float4(0.f, 0.f, 0.f, 0.f);
#pragma unroll 1
        for (int k8 = 0; k8 < 4; ++k8) {
            float4 w[8];
#pragma unroll
            for (int j = 0; j < 8; ++j) w[j] = *(const float4*)(W + (size_t)(tk * 32 + k8 * 8 + j) * 12288);
#pragma unroll
            for (int j = 0; j < 8; ++j) { const int k = tk * 32 + k8 * 8 + j;
#pragma unroll
                for (int b = 0; b < 5; ++b) { const float s_ = sc[b * D + k]; acc[b].x += s_ * w[j].x; acc[b].y += s_ * w[j].y; acc[b].z += s_ * w[j].z; acc[b].w += s_ * w[j].w; } }
        }
#pragma unroll
        for (int b = 0; b < 5; ++b) *(float4*)(red + (tk * 5 + b) * 32 + tn * 4) = acc[b];
        __syncthreads();
        if (tid < 160) {
            const int b = tid / 32, n = tid % 32; float s_ = 0.f;
            for (int g = 0; g < 64; ++g) s_ += red[(g * 5 + b) * 32 + n];
            ((float*)(p.ws + WS_MOD))[(size_t)(l * 5 + b) * 12288 + n0 + n] = s_ + p.ada_b[l * 12288 + n0 + n];
        }
        __syncthreads();
    }
}

DEVI void norm_row_load(const float* src, float4 (&v)[8], float& rstd, int lane) {
    float ss = 0.f;
#pragma unroll
    for (int j = 0; j < 8; ++j) { v[j] = *(const float4*)(src + 4 * lane + 256 * j); ss += v[j].x * v[j].x + v[j].y * v[j].y + v[j].z * v[j].z + v[j].w * v[j].w; }
    ss = wave_sum(ss);
    rstd = rsqrtf(ss * (1.f / D) + EPS);
}
DEVI void ph_norm(const Params& p, int layer, const float* xlat, const float* xctx, const float* gain, int ish, int isc, int nrows, int vcu, int G) {
    const int tid = otid(), lane = tid & 63, wave = tid >> 6;
    bf16* HB = (bf16*)(p.ws + WS_HB); bf16* X = (bf16*)(p.ws + WS_X);
    const int rot = (vcu * 8 + wave) & 7;
    for (int m0 = vcu * 8 + wave; m0 < nrows; m0 += 2 * G * 8) {
        const int mA = m0, mB = m0 + G * 8 < nrows ? m0 + G * 8 : m0;
        const float* srcA = mA < ML ? xlat + (size_t)mA * D : xctx + (size_t)(mA - ML) * D;
        const float* srcB = mB < ML ? xlat + (size_t)mB * D : xctx + (size_t)(mB - ML) * D;
        float4 vA[8], vB[8]; float ssA = 0.f, ssB = 0.f;
#pragma unroll
        for (int j = 0; j < 8; ++j) { vA[j] = *(const float4*)(srcA + 4 * lane + 256 * ((j + rot) & 7)); vB[j] = *(const float4*)(srcB + 4 * lane + 256 * ((j + rot) & 7)); }
#pragma unroll
        for (int j = 0; j < 8; ++j) { ssA += vA[j].x * vA[j].x + vA[j].y * vA[j].y + vA[j].z * vA[j].z + vA[j].w * vA[j].w; ssB += vB[j].x * vB[j].x + vB[j].y * vB[j].y + vB[j].z * vB[j].z + vB[j].w * vB[j].w; }
        const float rstdA = rsqrtf(wave_sum_dpp(ssA) * (1.f / D) + EPS), rstdB = rsqrtf(wave_sum_dpp(ssB) * (1.f / D) + EPS);
        const int bA = bidx(mA), bB = bidx(mB);
        const float* shA = modp(p, layer, bA, ish); const float* sclA = modp(p, layer, bA, isc); const float* shB = modp(p, layer, bB, ish); const float* sclB = modp(p, layer, bB, isc);
#pragma unroll
        for (int j = 0; j < 8; ++j) {
            const int c = 4 * lane + 256 * ((j + rot) & 7);
            const float4 g = *(const float4*)(gain + c), s1 = *(const float4*)(sclA + c), s0 = *(const float4*)(shA + c), t1 = *(const float4*)(sclB + c), t0 = *(const float4*)(shB + c);
            *(u32*)((unsigned char*)HB + (size_t)mA * D + c) = pk4_fp8(vA[j].x * rstdA * g.x * (1.f + s1.x) + s0.x, vA[j].y * rstdA * g.y * (1.f + s1.y) + s0.y, vA[j].z * rstdA * g.z * (1.f + s1.z) + s0.z, vA[j].w * rstdA * g.w * (1.f + s1.w) + s0.w);
            *(u32*)((unsigned char*)HB + (size_t)mB * D + c) = pk4_fp8(vB[j].x * rstdB * g.x * (1.f + t1.x) + t0.x, vB[j].y * rstdB * g.y * (1.f + t1.y) + t0.y, vB[j].z * rstdB * g.z * (1.f + t1.z) + t0.z, vB[j].w * rstdB * g.w * (1.f + t1.w) + t0.w);
            uint2 xw; xw.x = pk2(vA[j].x, vA[j].y); xw.y = pk2(vA[j].z, vA[j].w); *(uint2*)(X + (size_t)mA * D + c) = xw;
            uint2 yw; yw.x = pk2(vB[j].x, vB[j].y); yw.y = pk2(vB[j].z, vB[j].w); *(uint2*)(X + (size_t)mB * D + c) = yw;
        }
    }
}

DEVI void ph_qknorm(const Params& p, int vcu, int G) {
    const int tid = otid(), lane = tid & 63, wave = tid >> 6;
    bf16* Q = (bf16*)(p.ws + WS_QKV);
    const float invf = exp2f(-(float)(lane & 31) * (13.287712379549449f / 32.f));
    const float gq0 = p.attn_q_gain[2 * lane], gq1 = p.attn_q_gain[2 * lane + 1], gk0 = p.attn_k_gain[2 * lane], gk1 = p.attn_k_gain[2 * lane + 1];
    for (int k_ = 0;; ++k_) { const int m = row_of_trip(vcu, wave, k_, MT, G); if (m < 0) break;
        bf16* ptr = Q + (size_t)m * AIW + 3072 + 2 * lane;
        u32 v[10];
#pragma unroll
        for (int hh = 0; hh < 10; ++hh) v[hh] = *(const u32*)(ptr + hh * 128);
        float sn = 0.f, cs = 1.f;
        if (m < ML) { const int sq = m & 4095; const float pos = lane < 32 ? (float)(sq >> 6) : (float)(sq & 63);
            sn = __sinf(pos * invf); cs = __cosf(pos * invf); }
#pragma unroll
        for (int hh = 0; hh < 10; ++hh) {
            float x0 = __uint_as_float(v[hh] << 16), x1 = __uint_as_float(v[hh] & 0xffff0000u);
            const float ss = wave_sum_dpp(x0 * x0 + x1 * x1); const float rstd = rsqrtf(ss * (1.f / 128.f) + EPS);
            x0 = x0 * rstd * (hh < 8 ? gq0 : gk0); x1 = x1 * rstd * (hh < 8 ? gq1 : gk1);
            const float y0 = x0 * cs - x1 * sn, y1 = x0 * sn + x1 * cs;
            *(u32*)(ptr + hh * 128) = pk2(y0, y1);
        }
    }
}

DEVI void ph_readout(const Params& p, int vcu, int G) {
    const int tid = otid(), lane = tid & 63, wave = tid >> 6;
    const bf16* HD = (const bf16*)(p.ws + WS_HD); const bf16* Q = (const bf16*)(p.ws + WS_QKV); bf16* AO = (bf16*)(p.ws + WS_AO);
    float4 g[8];
#pragma unroll
    for (int h = 0; h < 8; ++h) g[h] = *(const float4*)(p.ml_head_gain + h * 256 + 4 * lane);
    typedef unsigned u32x2_ __attribute__((ext_vector_type(2)));
    for (int m = vcu * 8 + wave; m < ML; m += G * 8) {
        u32x2_ a[8], b2[8], ov[8];
#pragma unroll
        for (int h = 0; h < 8; ++h) { const int c = h * 256 + 4 * lane;
            a[h] = __builtin_nontemporal_load((const u32x2_*)(HD + (size_t)m * D + c)); b2[h] = __builtin_nontemporal_load((const u32x2_*)(HD + ((size_t)ML + m) * D + c));
            ov[h] = __builtin_nontemporal_load((const u32x2_*)(Q + (size_t)m * MIWM + 4096 + c)); }
#pragma unroll
        for (int h = 0; h < 8; ++h) { const int c = h * 256 + 4 * lane;
            const float x[4] = {__uint_as_float(a[h].x << 16) + __uint_as_float(b2[h].x << 16), __uint_as_float(a[h].x & 0xffff0000u) + __uint_as_float(b2[h].x & 0xffff0000u),
                                __uint_as_float(a[h].y << 16) + __uint_as_float(b2[h].y << 16), __uint_as_float(a[h].y & 0xffff0000u) + __uint_as_float(b2[h].y & 0xffff0000u)};
            const float ss = wave_sum_dpp(x[0] * x[0] + x[1] * x[1] + x[2] * x[2] + x[3] * x[3]); const float rstd = rsqrtf(ss * (1.f / 256.f) + EPS);
            const float o0 = __uint_as_float(ov[h].x << 16), o1 = __uint_as_float(ov[h].x & 0xffff0000u), o2 = __uint_as_float(ov[h].y << 16), o3 = __uint_as_float(ov[h].y & 0xffff0000u);
            const float s0 = __builtin_amdgcn_rcpf(1.f + __expf(-o0)), s1 = __builtin_amdgcn_rcpf(1.f + __expf(-o1)), s2 = __builtin_amdgcn_rcpf(1.f + __expf(-o2)), s3 = __builtin_amdgcn_rcpf(1.f + __expf(-o3));
            *(u32*)((unsigned char*)AO + (size_t)m * D + c) = pk4_fp8(x[0] * rstd * g[h].x * s0, x[1] * rstd * g[h].y * s1, x[2] * rstd * g[h].z * s2, x[3] * rstd * g[h].w * s3);
        }
    }
}

DEVI void ph_combine(const Params& p, int layer, int* offl, int vcu, int G) {
    const int tid = otid(), lane = tid & 63, wave = tid >> 6;
    const unsigned char* Y = (const unsigned char*)(p.ws + WS_Y);
    unsigned char* HB = (unsigned char*)(p.ws + WS_HB); bf16* X = (bf16*)(p.ws + WS_X);
    const int nrows = layer == 0 ? MT : ML;
    {
        const u32* cnt = (const u32*)(p.ws + WS_CTL) + CW_CNT + layer * 64 * CNT_PAD;
        if (tid < 64) { const int c_ = (int)cnt[tid * CNT_PAD]; const int pc = (c_ + 255) & ~255; offl[64 + tid] = c_; offl[tid] = (int)wave_prefix_dpp((float)pc) - pc; }
        __syncthreads();
    }
    const int* eidx = (const int*)(p.ws + WS_EIDX); const int* epos = (const int*)(p.ws + WS_EPOS);
    for (int k_ = 0;; ++k_) {
        const int m = row_of_trip(vcu, wave, k_, nrows, G); if (m < 0) break;
        bf16* xr = X + (size_t)m * D; float* orow = p.out + (size_t)m * D;
        const int bb = bidx(m); const float* g5 = modp(p, layer, bb, 5);
        int sl[9];
#pragma unroll
        for (int k = 0; k < 8; ++k) sl[k] = offl[eidx[m * 8 + k]] + epos[m * 8 + k];
        sl[8] = SH0 + m;
        u32x4 y[2][9], xv[2][2];
#pragma unroll
        for (int j = 0; j < 2; ++j) {
#pragma unroll
            for (int k = 0; k < 9; ++k) y[j][k] = __builtin_nontemporal_load((const u32x4*)(Y + (size_t)sl[k] * D + j * 1024 + lane * 16));
            xv[j][0] = *(const u32x4*)(xr + j * 1024 + lane * 16); xv[j][1] = *(const u32x4*)(xr + j * 1024 + lane * 16 + 8);
        }
        float o[32]; float ss = 0.f;
#pragma unroll
        for (int j = 0; j < 2; ++j) {
            const int c = j * 1024 + lane * 16;
            float f[16];
#pragma unroll
            for (int i = 0; i < 16; ++i) f[i] = 0.f;
#pragma unroll
            for (int k = 0; k < 9; ++k) {
                const unsigned yy[4] = {y[j][k].x, y[j][k].y, y[j][k].z, y[j][k].w};
#pragma unroll
                for (int q = 0; q < 4; ++q) { const auto lo = __builtin_amdgcn_cvt_pk_f32_fp8((int)yy[q], false), hi = __builtin_amdgcn_cvt_pk_f32_fp8((int)yy[q], true);
                    f[4 * q + 0] += lo[0]; f[4 * q + 1] += lo[1]; f[4 * q + 2] += hi[0]; f[4 * q + 3] += hi[1]; }
            }
            const unsigned xw[8] = {xv[j][0].x, xv[j][0].y, xv[j][0].z, xv[j][0].w, xv[j][1].x, xv[j][1].y, xv[j][1].z, xv[j][1].w};
#pragma unroll
            for (int q = 0; q < 4; ++q) {
                const float4 g0 = *(const float4*)(g5 + c + 4 * q);
                const float o0 = __uint_as_float(xw[2 * q] << 16) + g0.x * f[4 * q + 0] * (1.f / 8.f), o1 = __uint_as_float(xw[2 * q] & 0xffff0000u) + g0.y * f[4 * q + 1] * (1.f / 8.f);
                const float o2 = __uint_as_float(xw[2 * q + 1] << 16) + g0.z * f[4 * q + 2] * (1.f / 8.f), o3 = __uint_as_float(xw[2 * q + 1] & 0xffff0000u) + g0.w * f[4 * q + 3] * (1.f / 8.f);
                ss += o0 * o0 + o1 * o1 + o2 * o2 + o3 * o3;
                o[j * 16 + 4 * q + 0] = o0; o[j * 16 + 4 * q + 1] = o1; o[j * 16 + 4 * q + 2] = o2; o[j * 16 + 4 * q + 3] = o3;
            }
        }
        const float rstd = rsqrtf(wave_sum_dpp(ss) * (1.f / D) + EPS);
        const float* gain = layer == 0 ? p.norm_mix + D : p.final_norm;
        const float* sh = modp(p, 1, bb, 0); const float* scl = modp(p, 1, bb, 1);
#pragma unroll
        for (int j = 0; j < 2; ++j) {
            const int c = j * 1024 + lane * 16;
            if (layer == 0) {
                u32x4 w0, w1, ob;
#pragma unroll
                for (int q = 0; q < 4; ++q) {
                    const float4 g0 = *(const float4*)(gain + c + 4 * q), a0 = *(const float4*)(scl + c + 4 * q), b0 = *(const float4*)(sh + c + 4 * q);
                    const float x0 = o[j * 16 + 4 * q + 0], x1 = o[j * 16 + 4 * q + 1], x2 = o[j * 16 + 4 * q + 2], x3 = o[j * 16 + 4 * q + 3];
                    const unsigned p0 = pg_cvt_pk_bf16(x0, x1), p1 = pg_cvt_pk_bf16(x2, x3);
                    if (q < 2) { w0[2 * q] = p0; w0[2 * q + 1] = p1; } else { w1[2 * (q - 2)] = p0; w1[2 * (q - 2) + 1] = p1; }
                    ob[q] = pk4_fp8(x0 * rstd * g0.x * (1.f + a0.x) + b0.x, x1 * rstd * g0.y * (1.f + a0.y) + b0.y, x2 * rstd * g0.z * (1.f + a0.z) + b0.z, x3 * rstd * g0.w * (1.f + a0.w) + b0.w);
                }
                *(u32x4*)(xr + c) = w0; *(u32x4*)(xr + c + 8) = w1;
                *(u32x4*)(HB + (size_t)m * D + c) = ob;
            } else {
#pragma unroll
                for (int q = 0; q < 4; ++q) {
                    const float4 g0 = *(const float4*)(gain + c + 4 * q);
                    float4 r0; r0.x = o[j * 16 + 4 * q + 0] * rstd * g0.x; r0.y = o[j * 16 + 4 * q + 1] * rstd * g0.y; r0.z = o[j * 16 + 4 * q + 2] * rstd * g0.z; r0.w = o[j * 16 + 4 * q + 3] * rstd * g0.w;
                    *(float4*)(orow + c + 4 * q) = r0;
                }
            }
        }
    }
}

namespace pg {
struct Frag2 { bf16x8 k[2]; };
template <bool F8> struct FragT { typedef Frag2 T; };
template <> struct FragT<true> { typedef v8i32 T; };
constexpr int BM = 256, BK = 64, HALF = 128, HTB = HALF * BK * 2, STAGE_BYTES = 8 * HTB, NXCD = 8, WGM = 8;
__host__ __device__ __forceinline__ int lds_byte(int r, int c) { const int st = (r >> 4) * 2 + (c >> 5), rr = r & 15, cc = c & 31, ob = rr * 64 + cc * 2; return st * 1024 + (ob ^ (((ob >> 9) & 1) << 5)); }
__host__ __device__ __forceinline__ void stage_rc(int b, int& R, int& C) { const int st = b / 1024, sb = b % 1024, swz = sb ^ (((sb >> 9) & 1) << 5); R = (st >> 1) * 16 + swz / 64; C = (st & 1) * 32 + (swz % 64) / 2; }
__host__ __device__ __forceinline__ int perm32(int rho) { const int n = rho >> 4, i = rho & 15; return 8 * (i >> 2) + 4 * n + (i & 3); }
DEVI unsigned cvt_pk_bf16(float lo, float hi) { unsigned r; asm volatile("v_cvt_pk_bf16_f32 %0, %1, %2" : "=v"(r) : "v"(lo), "v"(hi)); return r; }

struct Unit { int pm, pn, e; };
constexpr int GT_OFF = STAGE_BYTES;
constexpr int UD_OFF = GT_OFF + 24 * 256 * 4;
constexpr int EO_OFF = UD_OFF + 32 * 16;
constexpr int MISC_OFF = EO_OFF + 136 * 4;
constexpr int LDS_TOTAL = MISC_OFF + 64;

struct ListOrder {
    const LAS int* ud; int nu;
    DEVI bool next(int i, Unit& u) const {
        if (i >= nu) return false;
        u.pm = __builtin_amdgcn_readfirstlane(ud[i * 4 + 0]); u.pn = __builtin_amdgcn_readfirstlane(ud[i * 4 + 1]); u.e = __builtin_amdgcn_readfirstlane(ud[i * 4 + 2]); return true;
    }
};
DEVI bool dense_unit(int nM, int nN, int G, int c, int i, Unit& u) {
    const int nwg = nM * nN; const long L = (long)i * G + c; if (L >= nwg) return false;
    int wgid = (int)L; { const int q = nwg / NXCD, r = nwg % NXCD, xcd = wgid % NXCD, off = wgid / NXCD; wgid = (xcd < r ? xcd * (q + 1) : r * (q + 1) + (xcd - r) * q) + off; }
    const int nig = WGM * nN, gid = wgid / nig, fm = gid * WGM, gsz = (nM - fm) < WGM ? (nM - fm) : WGM;
    u.pm = fm + ((wgid % nig) % gsz); u.pn = (wgid % nig) / gsz; u.e = 0; return true;
}
DEVI int fill_dense(LAS unsigned char* lds, int nM, int nN, int G, int c) {
    LAS int* ud = (LAS int*)(lds + UD_OFF); int nu = 0;
    for (int i = 0; i < 32; ++i) { Unit u; if (!dense_unit(nM, nN, G, c, i, u)) break; if (otid() == 0) { ud[i * 4 + 0] = u.pm; ud[i * 4 + 1] = u.pn; ud[i * 4 + 2] = 0; } ++nu; }
    return nu;
}

template <class Epi, bool GATHER, bool F8 = false>
DEVI void gemm_phase(LAS unsigned char* lds, const void* A, const void* Bt, int KB, size_t bgroup_bytes, const ListOrder& S, const Epi& E) {
    const int tid = otid();
    const int wid = __builtin_amdgcn_readfirstlane(tid >> 6), lane = tid & 63, wr = wid >> 2, wc = wid & 3, fr = lane & 15, fq = lane >> 4;
    const int nt = KB / 128;
    const LAS int* gtab = (const LAS int*)(lds + GT_OFF);
    unsigned voffA[2], voffB[2];
#pragma unroll
    for (int i = 0; i < 2; ++i) { int R, C; stage_rc(tid * 16 + i * 8192, R, C); const int Rb = Epi::B16 ? (64 * (R >> 5) + 16 * ((R & 15) >> 2) + 4 * ((R >> 4) & 1) + (R & 3)) : (Epi::PERM ? ((R & ~31) + perm32(R & 31)) : R);
        voffA[i] = GATHER ? (unsigned)(C * 2) : (unsigned)(R * KB + C * 2); voffB[i] = (unsigned)(Rb * KB + C * 2); }
    const size_t kstep = (size_t)(BK * 2);
    const size_t hstep = (size_t)HALF * KB;
    const size_t bhs = Epi::B16 ? (size_t)8 * KB : hstep;
    const size_t tstep = 2 * hstep;
    const unsigned ldsw = (unsigned)wid * 1024u;
    const int aoff = lds_byte(wr * 64 + fr, fq * 8); int boff = 4 * HTB + lds_byte(wc * 32 + fr, fq * 8); asm volatile("" : "+v"(boff));
#define PG_SA(b, h) (((b) * 2 + (h)) * HTB)
#define PG_SB(b, h) ((4 + (b) * 2 + (h)) * HTB)
#define PG_STAGE(bufoff, gbase, voff) do { _Pragma("unroll") for (int _i = 0; _i < 2; ++_i) \
        __builtin_amdgcn_global_load_lds((const unsigned*)((const char*)(gbase) + (voff)[_i]), (LAS unsigned*)(lds + (bufoff) + ldsw + _i * 8192), 16, 0, 0); } while (0)
#define PG_STAGE_A(bufoff, abase, h, goff) do { if constexpr (GATHER) { PG_STAGE(bufoff, abase, goff[h]); } else { PG_STAGE(bufoff, (abase) + (h) * hstep, voffA); } } while (0)
#define PG_LD1(dst, addr) do { if constexpr (F8) { const v4i32 lo_ = *(const LAS v4i32*)(lds + (addr)), hi_ = *(const LAS v4i32*)(lds + (addr) + 1024); dst = __builtin_shufflevector(lo_, hi_, 0, 1, 2, 3, 4, 5, 6, 7); } \
        else { dst.k[0] = *(const LAS bf16x8*)(lds + (addr)); dst.k[1] = *(const LAS bf16x8*)(lds + (addr) + 1024); } } while (0)
#define PG_LDA(dst, b, h) do { _Pragma("unroll") for (int m = 0; m < 4; ++m) PG_LD1(dst[m], PG_SA(b, h) + aoff + m * 2048); } while (0)
#define PG_LDB(dst, b, h) do { _Pragma("unroll") for (int n = 0; n < 2; ++n) PG_LD1(dst[n], boff + ((b) * 2 + (h)) * HTB + n * 2048); } while (0)
#define PG_MMA(ai, bj, At, Bt_) do { __builtin_amdgcn_s_setprio(1); _Pragma("unroll") for (int m = 0; m < 4; ++m) _Pragma("unroll") for (int n = 0; n < 2; ++n) { \
        if constexpr (F8) { asm volatile("v_mfma_scale_f32_16x16x128_f8f6f4 %0, %1, %2, %0, %3, %3 op_sel_hi:[0,0,0]" : "+v"(acc[ai][bj][m][n]) : "v"(Bt_[n]), "v"(At[m]), "v"(sc1)); } \
        else { _Pragma("unroll") for (int k = 0; k < 2; ++k) acc[ai][bj][m][n] = __builtin_amdgcn_mfma_f32_16x16x32_bf16(Bt_[n].k[k], At[m].k[k], acc[ai][bj][m][n], 0, 0, 0); } } \
        __builtin_amdgcn_s_setprio(0); } while (0)
#define PG_MMAZ(ai, bj, At, Bt_) do { __builtin_amdgcn_s_setprio(1); _Pragma("unroll") for (int m = 0; m < 4; ++m) _Pragma("unroll") for (int n = 0; n < 2; ++n) \
        asm volatile("v_mfma_scale_f32_16x16x128_f8f6f4 %0, %1, %2, 0, %3, %3 op_sel_hi:[0,0,0]" : "+v"(acc[ai][bj][m][n]) : "v"(Bt_[n]), "v"(At[m]), "v"(sc1)); \
        __builtin_amdgcn_s_setprio(0); } while (0)
#define PG_WAIT_V(n) asm volatile("s_waitcnt vmcnt(" #n ")" ::: "memory")
#define PG_WAIT_L(n) asm volatile("s_waitcnt lgkmcnt(" #n ")" ::: "memory")
#define PG_WAIT_VR(rl) do { if ((rl) == 0) PG_WAIT_V(8); else if ((rl) == 8) PG_WAIT_V(16); else if ((rl) == 16) PG_WAIT_V(24); else PG_WAIT_V(40); } while (0)
#define PG_BAR __builtin_amdgcn_s_barrier()
#define PG_SCHED __builtin_amdgcn_sched_barrier(0)
    Unit cur, nxt; int ui = 0, relax = 0;
    if (!S.next(0, cur)) return;
    int sc1 = 0x7F7F7F7F; asm volatile("" : "+v"(sc1));
    static_assert(F8, "the first-tile C = 0 form below is written for the fp8 MFMA");
    f32x4 acc[2][2][4][2];
#pragma unroll
    for (int a = 0; a < 2; ++a)
#pragma unroll
        for (int b = 0; b < 2; ++b)
#pragma unroll
            for (int m = 0; m < 4; ++m)
#pragma unroll
                for (int n = 0; n < 2; ++n) acc[a][b][m][n] = (f32x4){0.f, 0.f, 0.f, 0.f};
    typename FragT<F8>::T At[4], B0[2], B1[2];
    unsigned gC[2][2];
    auto gload = [&](int uidx, unsigned (&g)[2][2]) {
        const int tt = otid();
#pragma unroll
        for (int i = 0; i < 2; ++i) { int R, C; stage_rc(tt * 16 + i * 8192, R, C);
#pragma unroll
            for (int h = 0; h < 2; ++h) g[h][i] = (unsigned)gtab[uidx * 256 + h * HALF + R] * (unsigned)KB + (unsigned)(C * 2); }
    };
    if constexpr (GATHER) gload(0, gC);
    const char* cA = GATHER ? (const char*)A : (const char*)A + (size_t)cur.pm * tstep;
    const char* cB = (const char*)Bt + (size_t)cur.e * bgroup_bytes + (size_t)cur.pn * tstep;
    PG_STAGE(PG_SB(0, 0), cB, voffB); PG_STAGE(PG_SB(0, 1), cB + bhs, voffB); PG_STAGE_A(PG_SA(0, 0), cA, 0, gC); PG_STAGE_A(PG_SA(0, 1), cA, 1, gC);
    if (wr == 1) PG_BAR;
    PG_WAIT_V(2); PG_BAR;
    PG_STAGE(PG_SB(1, 0), cB + kstep, voffB); PG_STAGE_A(PG_SA(1, 0), cA + kstep, 0, gC); PG_STAGE(PG_SB(1, 1), cB + bhs + kstep, voffB);
    PG_WAIT_V(6); PG_BAR;
    for (;;) {
        const bool has_next = S.next(ui + 1, nxt);
        const char* nA = GATHER ? (const char*)A : (has_next ? (const char*)A + (size_t)nxt.pm * tstep : cA);
        const char* nB = has_next ? (const char*)Bt + (size_t)nxt.e * bgroup_bytes + (size_t)nxt.pn * tstep : cB;
#define PG_KITER(MMAX, WAITX, LASTX) do { \
            const bool last = LASTX; \
            const char* a1 = cA + (size_t)(t + 1) * kstep; \
            const char* a2 = last ? nA : cA + (size_t)(t + 2) * kstep; const char* b2 = last ? nB : cB + (size_t)(t + 2) * kstep; \
            const char* a3 = a2 + kstep; const char* b3 = b2 + kstep; \
            unsigned gS[2][2]; \
            if constexpr (GATHER) { \
                if (last && has_next) gload(ui + 1, gS); \
                else { gS[0][0] = gC[0][0]; gS[0][1] = gC[0][1]; gS[1][0] = gC[1][0]; gS[1][1] = gC[1][1]; } \
            } \
 \
            PG_LDB(B0, 0, 0); PG_LDB(B1, 0, 1); PG_SCHED; PG_LDA(At, 0, 0); PG_STAGE_A(PG_SA(1, 1), a1, 1, gC); \
            WAITX; PG_WAIT_L(0); PG_BAR; MMAX(0, 0, At, B0); MMAX(0, 1, At, B1); PG_BAR; PG_SCHED; \
 \
            PG_LDA(At, 0, 1); PG_STAGE(PG_SB(0, 0), b2, voffB); PG_STAGE(PG_SB(0, 1), b2 + bhs, voffB); PG_STAGE_A(PG_SA(0, 0), a2, 0, gS); \
            WAITX; PG_WAIT_L(0); PG_BAR; MMAX(1, 0, At, B0); MMAX(1, 1, At, B1); PG_BAR; PG_SCHED; \
 \
            PG_LDB(B0, 1, 0); PG_LDB(B1, 1, 1); PG_SCHED; PG_LDA(At, 1, 0); PG_STAGE_A(PG_SA(0, 1), a2, 1, gS); \
            PG_WAIT_V(8); PG_WAIT_L(0); PG_BAR; PG_MMA(0, 0, At, B0); PG_MMA(0, 1, At, B1); PG_BAR; PG_SCHED; \
 \
            PG_LDA(At, 1, 1); PG_STAGE(PG_SB(1, 0), b3, voffB); PG_STAGE(PG_SB(1, 1), b3 + bhs, voffB); PG_STAGE_A(PG_SA(1, 0), a3, 0, gS); \
            PG_WAIT_V(8); PG_WAIT_L(0); PG_BAR; PG_MMA(1, 0, At, B0); PG_MMA(1, 1, At, B1); PG_BAR; PG_SCHED; \
        } while (0)
        { const int t = 0; PG_KITER(PG_MMAZ, PG_WAIT_VR(relax), false); }
#pragma unroll 1
        for (int t = 2; t < nt; t += 2) { PG_KITER(PG_MMA, PG_WAIT_V(8), (t == nt - 2)); }
#undef PG_KITER
        if (wr == 0) PG_BAR;
        if constexpr (F8) asm volatile("s_nop 15\n\ts_nop 15" ::: "memory");
        E(acc, cur, ui, wr, wc, fr, fq); relax = E.nst(cur);
        if (!has_next) break;
        cur = nxt; cA = nA; cB = nB; ++ui;
        if constexpr (GATHER) gload(ui, gC);
        if (wr == 1) PG_BAR;
    }
    PG_WAIT_V(0);
    PG_BAR;
#undef PG_SA
#undef PG_SB
#undef PG_STAGE
#undef PG_STAGE_A
#undef PG_LDA
#undef PG_LDB
#undef PG_MMA
#undef PG_MMAZ
#undef PG_WAIT_V
#undef PG_WAIT_VR
#undef PG_WAIT_L
#undef PG_BAR
#undef PG_SCHED
}
}

constexpr size_t WT_AIN = WS_WT, WT_AOUT = WS_WT + 18 * MiB, WT_MIN = WS_WT + 26 * MiB, WT_MOUT = WS_WT + 51 * MiB, WT_W13 = WS_WT + 59 * MiB, WT_W2 = WS_WT + 579 * MiB;
constexpr int MINP = 6400;
constexpr float W13_SCALE = 64.f, W2_SCALE = 32.f;
static_assert(WT_W2 + (size_t)2 * 65 * 2 * MiB <= WS_END, "weight copies fit");
#define LDS_WAIT() asm volatile("s_waitcnt lgkmcnt(0)" ::: "memory")
struct CvtDesc { const float* W; unsigned char* dst; int ldw, dK; float sc; };
DEVI CvtDesc cvt_decode(const Params& p, int it) {
    constexpr int I_AIN = 16 * 144, I_AOUT = 16 * 64, I_MIN = 16 * 193, I_MOUT = 16 * 64;
    CvtDesc d; int r = it; d.sc = W13_SCALE; d.dK = D;
    const float *w_ain = p.attn_w_in, *w_aout = p.attn_w_out, *w_min = p.ml_w_in, *w_mout = p.ml_w_out, *w_e1 = p.exp_w1, *w_e3 = p.exp_w3, *w_e2 = p.exp_w2, *w_s1 = p.sh_w1, *w_s3 = p.sh_w3, *w_s2 = p.sh_w2;
    asm volatile("" : "+s"(w_ain), "+s"(w_aout), "+s"(w_min), "+s"(w_mout), "+s"(w_e1), "+s"(w_e3), "+s"(w_e2), "+s"(w_s1), "+s"(w_s3), "+s"(w_s2));
    if (r < I_AIN) { const int kb = r / 144, nb = r % 144; d.W = w_ain + (size_t)(128 * kb) * AIW + 32 * nb; d.ldw = AIW; d.dst = (unsigned char*)(p.ws + WT_AIN) + (size_t)(32 * nb) * D + 128 * kb; return d; } r -= I_AIN;
    if (r < I_AOUT) { const int kb = r / 64, nb = r % 64; d.W = w_aout + (size_t)(128 * kb) * D + 32 * nb; d.ldw = D; d.dst = (unsigned char*)(p.ws + WT_AOUT) + (size_t)(32 * nb) * D + 128 * kb; return d; } r -= I_AOUT;
    if (r < I_MIN) { const int kb = r / 193, nb = r % 193; d.W = w_min + (size_t)(128 * kb) * MIW + 32 * nb; d.ldw = MIW; d.dst = (unsigned char*)(p.ws + WT_MIN) + (size_t)(32 * nb) * D + 128 * kb; return d; } r -= I_MIN;
    if (r < I_MOUT) { const int kb = r / 64, nb = r % 64; d.W = w_mout + (size_t)(128 * kb) * D + 32 * nb; d.ldw = D; d.dst = (unsigned char*)(p.ws + WT_MOUT) + (size_t)(32 * nb) * D + 128 * kb; return d; } r -= I_MOUT;
    const int mat = r >> 8, ii = r & 255; const int l = mat / 195, q = mat % 195, e = q / 3, which = q % 3;
    if (which < 2) {
        const float* W = e < 64 ? (which == 0 ? w_e1 : w_e3) + ((size_t)l * 64 + e) * D * EDIM : (which == 0 ? w_s1 : w_s3) + (size_t)l * D * EDIM;
        const int kb = ii / 16, nb = ii % 16, n0 = 32 * nb;
        d.W = W + (size_t)(128 * kb) * EDIM + n0; d.ldw = EDIM;
        d.dst = (unsigned char*)(p.ws + WT_W13) + ((size_t)l * 65 + e) * 1024 * D + (size_t)((n0 >> 7) * 256 + which * 128 + (n0 & 127)) * D + 128 * kb;
    } else {
        const float* W = e < 64 ? w_e2 + ((size_t)l * 64 + e) * EDIM * D : w_s2 + (size_t)l * EDIM * D;
        const int kb = ii / 64, nb = ii % 64;
        d.W = W + (size_t)(128 * kb) * D + 32 * nb; d.ldw = D; d.dK = EDIM; d.sc = W2_SCALE;
        d.dst = (unsigned char*)(p.ws + WT_W2) + ((size_t)l * 65 + e) * D * EDIM + (size_t)(32 * nb) * EDIM + 128 * kb;
    }
    return d;
}
DEVI void ph_cvt(const Params& p, LAS unsigned char* lds, int vcu, int G) {
    const int tid = otid(), lane = tid & 63, wave = __builtin_amdgcn_readfirstlane(tid >> 6);
    LAS float* scr = (LAS float*)(lds + wave * 17408);
    const int gw = vcu * 8 + wave, NGW = G * 8;
    constexpr int NITEMS = 16 * 144 + 16 * 64 + 16 * 193 + 16 * 64 + 2 * 65 * 3 * 256;
    const int lr = lane >> 3, lc = (lane & 7) * 4;
    const int sn = lane >> 3, sc8 = lane & 7;
    if (gw < NITEMS) {
        int it = gw; CvtDesc dc = cvt_decode(p, it);
        typedef const __attribute__((address_space(1))) f32x4* GV4;
        f32x4 cur[16];
#pragma unroll
        for (int i = 0; i < 16; ++i) cur[i] = __builtin_nontemporal_load((GV4)(dc.W + (size_t)(lr + 8 * i) * dc.ldw + lc));
        for (;;) {
            const int nx = it + NGW; const CvtDesc dn = cvt_decode(p, nx < NITEMS ? nx : it);
            f32x4 nxt[16];
#pragma unroll
            for (int i = 0; i < 16; ++i) nxt[i] = __builtin_nontemporal_load((GV4)(dn.W + (size_t)(lr + 8 * i) * dn.ldw + lc));
#pragma unroll
            for (int i = 0; i < 16; ++i) { LAS float* sp = scr + (lr + 8 * i) * 33 + 4 * (i >> 1) + lc; sp[0] = cur[i][0] * dc.sc; sp[1] = cur[i][1] * dc.sc; sp[2] = cur[i][2] * dc.sc; sp[3] = cur[i][3] * dc.sc; }
            LDS_WAIT(); asm volatile("" ::: "memory");
#pragma unroll
            for (int j = 0; j < 4; ++j) { const int n = sn + 8 * j; const LAS float* sp = scr + (16 * sc8) * 33 + 4 * sc8 + n;
                u32x4 o;
#pragma unroll
                for (int q = 0; q < 4; ++q) o[q] = pk4_fp8(sp[(4 * q + 0) * 33], sp[(4 * q + 1) * 33], sp[(4 * q + 2) * 33], sp[(4 * q + 3) * 33]);
                *(u32x4*)(dc.dst + (size_t)n * dc.dK + 16 * sc8) = o; }
            LDS_WAIT(); asm volatile("" ::: "memory");
            if (nx >= NITEMS) break;
#pragma unroll
            for (int i = 0; i < 16; ++i) cur[i] = nxt[i];
            dc = dn; it = nx;
        }
    }
    { u32x4* z = (u32x4*)((unsigned char*)(p.ws + WT_MIN) + (size_t)MIW * D); const int n16 = (MINP - MIW) * D / 16;
      for (int i = vcu * 512 + tid; i < n16; i += G * 512) z[i] = (u32x4){0u, 0u, 0u, 0u}; }
}

typedef float f32x4e __attribute__((ext_vector_type(4)));
struct EpiBf16Store {
    static constexpr bool PERM = true, B16 = false;
    bf16* O; int ld; float* gates; int gate_pn; float sc;
    DEVI int nst(const pg::Unit& u) const { return u.pn == gate_pn ? 0 : 16; }
    DEVI void operator()(const f32x4 (&acc)[2][2][4][2], const pg::Unit& u, int ui, int wr, int wc, int fr, int fq) const {
        const int row0 = u.pm * 256 + wr * 64 + fr;
        if (u.pn == gate_pn) {
            if (wc == 0) {
#pragma unroll
                for (int ai = 0; ai < 2; ++ai)
#pragma unroll
                    for (int m = 0; m < 4; ++m) { float* gp = gates + (size_t)(row0 + ai * 128 + m * 16) * 32 + 8 * fq;
                        *(f32x4*)(gp) = acc[ai][0][m][0] * sc; *(f32x4*)(gp + 4) = acc[ai][0][m][1] * sc; }
            }
            return;
        }
        const int col0 = u.pn * 256 + wc * 32 + 8 * fq;
#pragma unroll
        for (int ai = 0; ai < 2; ++ai)
#pragma unroll
            for (int m = 0; m < 4; ++m) { bf16* rowp = O + (size_t)(row0 + ai * 128 + m * 16) * ld + col0;
#pragma unroll
                for (int bj = 0; bj < 2; ++bj) { const f32x4 v0 = acc[ai][bj][m][0] * sc, v1 = acc[ai][bj][m][1] * sc;
                    u32x4 w; w.x = pg::cvt_pk_bf16(v0[0], v0[1]); w.y = pg::cvt_pk_bf16(v0[2], v0[3]); w.z = pg::cvt_pk_bf16(v1[0], v1[1]); w.w = pg::cvt_pk_bf16(v1[2], v1[3]);
                    *(u32x4*)(rowp + bj * 128) = w; } }
    }
};
struct EpiSwiGLU {
    static constexpr bool PERM = true, B16 = false;
    bf16* ACT;
    DEVI int nst(const pg::Unit&) const { return 8; }
    DEVI void operator()(const f32x4 (&acc)[2][2][4][2], const pg::Unit& u, int ui, int wr, int wc, int fr, int fq) const {
        const int row0 = u.pm * 256 + wr * 64 + fr, col0 = u.pn * 128 + wc * 32 + 8 * fq;
#pragma unroll
        for (int ai = 0; ai < 2; ++ai)
#pragma unroll
            for (int m = 0; m < 4; ++m) {
                f32x4 o[2];
#pragma unroll
                for (int n = 0; n < 2; ++n) { const f32x4 a = acc[ai][0][m][n], b = acc[ai][1][m][n]; const f32x4 t = a * (-1.4426950408889634f / W13_SCALE);
                    f32x4 e; e[0] = __builtin_amdgcn_exp2f(t[0]); e[1] = __builtin_amdgcn_exp2f(t[1]); e[2] = __builtin_amdgcn_exp2f(t[2]); e[3] = __builtin_amdgcn_exp2f(t[3]);
                    const f32x4 d = e * (W13_SCALE * W13_SCALE) + (W13_SCALE * W13_SCALE);
                    f32x4 r; r[0] = __builtin_amdgcn_rcpf(d[0]); r[1] = __builtin_amdgcn_rcpf(d[1]); r[2] = __builtin_amdgcn_rcpf(d[2]); r[3] = __builtin_amdgcn_rcpf(d[3]);
                    o[n] = (a * b) * r; }
                uint2 w; w.x = pk4_fp8(o[0][0], o[0][1], o[0][2], o[0][3]); w.y = pk4_fp8(o[1][0], o[1][1], o[1][2], o[1][3]);
                *(uint2*)((unsigned char*)ACT + (size_t)(row0 + ai * 128 + m * 16) * EDIM + col0) = w; }
    }
};
constexpr float Y_SCALE = 8.f;
struct EpiScale {
    static constexpr bool PERM = true, B16 = true;
    unsigned char* Y; const LAS float* swt;
    DEVI int nst(const pg::Unit&) const { return 8; }
    DEVI void operator()(const f32x4 (&acc)[2][2][4][2], const pg::Unit& u, int ui, int wr, int wc, int fr, int fq) const {
        const int row0 = u.pm * 256 + wr * 64 + fr, col0 = u.pn * 256 + wc * 64 + 16 * fq;
#pragma unroll
        for (int ai = 0; ai < 2; ++ai)
#pragma unroll
            for (int m = 0; m < 4; ++m) { const int slot = row0 + ai * 128 + m * 16; const float w8 = swt[ui * 256 + wr * 64 + fr + ai * 128 + m * 16];
                const f32x4 a = acc[ai][0][m][0] * w8, b = acc[ai][0][m][1] * w8, c = acc[ai][1][m][0] * w8, d = acc[ai][1][m][1] * w8;
                u32x4 w; w.x = pk4_fp8(a[0], a[1], a[2], a[3]); w.y = pk4_fp8(b[0], b[1], b[2], b[3]); w.z = pk4_fp8(c[0], c[1], c[2], c[3]); w.w = pk4_fp8(d[0], d[1], d[2], d[3]);
                __builtin_nontemporal_store(w, (u32x4*)(Y + (size_t)slot * D + col0)); }
    }
};
struct EpiResid {
    static constexpr bool PERM = true, B16 = false;
    bf16* X; const float* modl;
    DEVI int nst(const pg::Unit&) const { return 16; }
    DEVI void operator()(const f32x4 (&acc)[2][2][4][2], const pg::Unit& u, int ui, int wr, int wc, int fr, int fq) const {
        const int bb = u.pm < 64 ? (u.pm >> 4) : 4;
        const float* gate = modl + (size_t)(bb * 6 + 2) * D;
        const int row0 = u.pm * 256 + wr * 64 + fr, col0 = u.pn * 256 + wc * 32 + 8 * fq;
        f32x4 gv[2][2];
#pragma unroll
        for (int bj = 0; bj < 2; ++bj)
#pragma unroll
            for (int n = 0; n < 2; ++n) gv[bj][n] = *(const f32x4*)(gate + col0 + bj * 128 + 4 * n) * (1.f / W13_SCALE);
        u32x4 xa[2], xb[2];
#define RLOAD(Xr, g) do { const size_t off_ = (size_t)(row0 + ((g) >> 2) * 128 + ((g) & 3) * 16) * D + col0; _Pragma("unroll") for (int bj = 0; bj < 2; ++bj) Xr[bj] = *(const u32x4*)(X + off_ + bj * 128); } while (0)
#define RMIX(w, a, b, ga, gb) pg::cvt_pk_bf16(__uint_as_float((w) << 16) + (ga) * (a), __uint_as_float((w) & 0xffff0000u) + (gb) * (b))
#define RSTORE(Xr, g) do { const size_t off_ = (size_t)(row0 + ((g) >> 2) * 128 + ((g) & 3) * 16) * D + col0; _Pragma("unroll") for (int bj = 0; bj < 2; ++bj) { \
            const f32x4 a0 = acc[(g) >> 2][bj][(g) & 3][0], a1 = acc[(g) >> 2][bj][(g) & 3][1]; u32x4 w; \
            w.x = RMIX(Xr[bj].x, a0[0], a0[1], gv[bj][0][0], gv[bj][0][1]); w.y = RMIX(Xr[bj].y, a0[2], a0[3], gv[bj][0][2], gv[bj][0][3]); \
            w.z = RMIX(Xr[bj].z, a1[0], a1[1], gv[bj][1][0], gv[bj][1][1]); w.w = RMIX(Xr[bj].w, a1[2], a1[3], gv[bj][1][2], gv[bj][1][3]); \
            *(u32x4*)(X + off_ + bj * 128) = w; } } while (0)
        RLOAD(xa, 0);
#pragma unroll
        for (int g = 0; g < 8; g += 2) {
            RLOAD(xb, g + 1); asm volatile("" ::: "memory");
            RSTORE(xa, g); asm volatile("" ::: "memory");
            if (g + 2 < 8) { RLOAD(xa, g + 2); asm volatile("" ::: "memory"); }
            RSTORE(xb, g + 1); asm volatile("" ::: "memory");
        }
#undef RLOAD
#undef RMIX
#undef RSTORE
    }
};

template <bool G1>
DEVI int moe_setup(const Params& p, LAS unsigned char* lds, int layer, int nrows, int vcu, int G) {
    LAS int* eo = (LAS int*)(lds + pg::EO_OFF); LAS int* ud = (LAS int*)(lds + pg::UD_OFF); LAS int* gt = (LAS int*)(lds + pg::GT_OFF);
    const int tid = otid(); const u32* cnt = (const u32*)(p.ws + WS_CTL) + CW_CNT + layer * 64 * CNT_PAD;
    LAS int* ec = eo + 68;
    if (tid < 64) { const int c_ = (int)cnt[tid * CNT_PAD]; const int pc = (c_ + 255) & ~255; const int incl = (int)wave_prefix_dpp((float)pc);
        ec[tid] = c_; eo[tid] = incl - pc; if (tid == 63) eo[64] = incl; }
    __syncthreads();
    constexpr int NT = G1 ? 4 : 8, CAP = G1 ? 16 : 24;
    const int PR = eo[64] >> 8, PS = nrows >> 8, total = (PR + PS) * NT;
    int nu = total > vcu ? (total - vcu + G - 1) / G : 0; if (nu > CAP) nu = CAP;
    if (tid < nu) {
        const int L = tid * G + vcu, pp = L / NT, pn = L % NT; int e = 64, pm = SH0 / 256 + (pp - PR);
        if (pp < PR) { pm = pp; e = 0; for (int i = 1; i < 64; ++i) if (eo[i] <= pp * 256) e = i; }
        ud[tid * 4 + 0] = pm; ud[tid * 4 + 1] = pn; ud[tid * 4 + 2] = e;
    }
    __syncthreads();
    if (G1) { const int* ltok = (const int*)(p.ws + WS_LTOK);
        for (int idx = tid; idx < nu * 256; idx += 512) { const int u_ = idx >> 8, slot = ud[u_ * 4] * 256 + (idx & 255), e = ud[u_ * 4 + 2];
            int t = slot - SH0; if (slot < SH0) { const int pos = slot - eo[e]; t = pos < ec[e] ? ltok[(size_t)e * MT + pos] : 0; } gt[idx] = t; } }
    else { const float* lw = (const float*)(p.ws + WS_LW); LAS float* st = (LAS float*)gt;
        for (int idx = tid; idx < nu * 256; idx += 512) { const int u_ = idx >> 8, slot = ud[u_ * 4] * 256 + (idx & 255), e = ud[u_ * 4 + 2];
            float w = 1.f; if (slot < SH0) { const int pos = slot - eo[e]; w = pos < ec[e] ? lw[(size_t)e * MT + pos] : 0.f; } st[idx] = w * (Y_SCALE / W2_SCALE); } }
    __syncthreads();
    return nu;
}

namespace fa {
typedef short s16x4 __attribute__((ext_vector_type(4)));
typedef float f32x16 __attribute__((ext_vector_type(16)));
constexpr int HD = 128, NW = 8, QBLK = 32, KVBLK = 64;
constexpr float SCALE = 0.088388347648318440f, THR = 8.f;
constexpr int SHM_V = KVBLK * HD * 2, SHM_K = KVBLK * HD * 2, SCR_OFF = 2 * SHM_V + 2 * SHM_K, BIAS_OFF = SCR_OFF + NW * 64 * 4, SHM_ATTN = BIAS_OFF + 512 * 4;
#define KSWZ(row, colB) ((row) * 256 + ((colB) ^ (((row) & 7) << 4)))
#define SBAR() __builtin_amdgcn_sched_barrier(0)
DEVI int crow(int r, int hi) { return (r & 3) + 8 * (r >> 2) + 4 * hi; }
DEVI unsigned cvtpk(float lo, float hi) { unsigned r; asm volatile("v_cvt_pk_bf16_f32 %0, %1, %2" : "=v"(r) : "v"(lo), "v"(hi)); return r; }
DEVI void partialSM(f32x16& p0, f32x16& p1, float& m_reg, float& mn, float& alpha) {
    constexpr float C = SCALE * 1.4426950408889634f;
    float pmax = p0[0];
#pragma unroll
    for (int r = 1; r < 16; ++r) pmax = fmaxf(pmax, p0[r]);
#pragma unroll
    for (int r = 0; r < 16; ++r) pmax = fmaxf(pmax, p1[r]);
    { auto rr = __builtin_amdgcn_permlane32_swap(__float_as_uint(pmax), __float_as_uint(pmax), false, false); pmax = fmaxf(__uint_as_float(rr[0]), __uint_as_float(rr[1])); }
    if (__builtin_expect(__all(pmax - m_reg <= THR / SCALE), 1)) { mn = m_reg; alpha = 1.f; }
    else { mn = fmaxf(m_reg, pmax); alpha = __builtin_amdgcn_exp2f((m_reg - mn) * C); m_reg = mn; }
    const float mnC = -mn * C;
#pragma unroll
    for (int r = 0; r < 16; ++r) p0[r] = fmaf(p0[r], C, mnC);
#pragma unroll
    for (int r = 0; r < 16; ++r) p1[r] = fmaf(p1[r], C, mnC);
#pragma unroll
    for (int r = 0; r < 16; ++r) p0[r] = __builtin_amdgcn_exp2f(p0[r]);
}
DEVI void finishSM(f32x16& p0, f32x16& p1, float alpha, float& l_reg, bf16x8& pa0, bf16x8& pa1, bf16x8& pa2, bf16x8& pa3) {
#pragma unroll
    for (int r = 0; r < 16; ++r) p1[r] = __builtin_amdgcn_exp2f(p1[r]);
    float ps = 0;
#pragma unroll
    for (int r = 0; r < 16; ++r) ps += p0[r];
#pragma unroll
    for (int r = 0; r < 16; ++r) ps += p1[r];
    { auto rr = __builtin_amdgcn_permlane32_swap(__float_as_uint(ps), __float_as_uint(ps), false, false); ps = __uint_as_float(rr[0]) + __uint_as_float(rr[1]); }
    l_reg = l_reg * alpha + ps;
#define PK4(P, BASE, OUT) do { unsigned a0 = cvtpk(P[BASE + 0], P[BASE + 1]), a1 = cvtpk(P[BASE + 2], P[BASE + 3]);   \
    unsigned b0 = cvtpk(P[BASE + 4], P[BASE + 5]), b1 = cvtpk(P[BASE + 6], P[BASE + 7]);                              \
    auto r0 = __builtin_amdgcn_permlane32_swap(a0, b0, false, false); auto r1 = __builtin_amdgcn_permlane32_swap(a1, b1, false, false); \
    u32x4 w = {r0[0], r1[0], r0[1], r1[1]}; OUT = *reinterpret_cast<bf16x8*>(&w); } while (0)
    PK4(p0, 0, pa0); PK4(p0, 8, pa1); PK4(p1, 0, pa2); PK4(p1, 8, pa3);
#undef PK4
}
DEVI void qkt(f32x16& p0, f32x16& p1, const char* Ks, const bf16x8* qr, int r32, int hi) {
    p0 = f32x16{}; p1 = f32x16{};
#pragma unroll
    for (int d0 = 0; d0 < 8; ++d0) { const int cb = (d0 * 16 + hi * 8) * 2;
        const bf16x8 b0 = *reinterpret_cast<const bf16x8*>(Ks + KSWZ(r32, cb));
        const bf16x8 b1 = *reinterpret_cast<const bf16x8*>(Ks + KSWZ(32 + r32, cb));
        p0 = __builtin_amdgcn_mfma_f32_32x32x16_bf16(b0, qr[d0], p0, 0, 0, 0);
        p1 = __builtin_amdgcn_mfma_f32_32x32x16_bf16(b1, qr[d0], p1, 0, 0, 0); }
}
DEVI int v_st(int k, int c) { const int kk = (k & ~0xC) | ((k & 4) << 1) | ((k & 8) >> 1); return ((kk >> 3) * 4 + (c >> 5)) * 512 + ((kk & 7) * 32 + (c & 31)) * 2; }
DEVI int v_rd_base(int lane) { return ((lane & 3) << 3) | (((lane >> 2) & 3) << 6) | (((lane >> 4) & 1) << 5) | (((lane >> 5) & 1) << 8); }
constexpr int v_rd_off(int d0, int ks, int half) { return d0 * 512 + ks * 4096 + half * 2048; }
template <int OFF> DEVI s16x4 tr_read(int vb) { s16x4 r; asm volatile("ds_read_b64_tr_b16 %0, %1 offset:%2" : "=&v"(r) : "v"(vb), "i"(OFF) : "memory"); return r; }
template <int D0> DEVI void pv_one(f32x16& od, int vb, bf16x8 pa0, bf16x8 pa1, bf16x8 pa2, bf16x8 pa3) {
    const s16x4 l0 = tr_read<v_rd_off(D0, 0, 0)>(vb), h0 = tr_read<v_rd_off(D0, 0, 1)>(vb), l1 = tr_read<v_rd_off(D0, 1, 0)>(vb), h1 = tr_read<v_rd_off(D0, 1, 1)>(vb);
    const s16x4 l2 = tr_read<v_rd_off(D0, 2, 0)>(vb), h2 = tr_read<v_rd_off(D0, 2, 1)>(vb), l3 = tr_read<v_rd_off(D0, 3, 0)>(vb), h3 = tr_read<v_rd_off(D0, 3, 1)>(vb);
    asm volatile("s_waitcnt lgkmcnt(0)" ::: "memory"); SBAR();
#define PK(L, H) (bf16x8){L[0], L[1], L[2], L[3], H[0], H[1], H[2], H[3]}
    od = __builtin_amdgcn_mfma_f32_32x32x16_bf16(pa0, PK(l0, h0), od, 0, 0, 0);
    od = __builtin_amdgcn_mfma_f32_32x32x16_bf16(pa1, PK(l1, h1), od, 0, 0, 0);
    od = __builtin_amdgcn_mfma_f32_32x32x16_bf16(pa2, PK(l2, h2), od, 0, 0, 0);
    od = __builtin_amdgcn_mfma_f32_32x32x16_bf16(pa3, PK(l3, h3), od, 0, 0, 0);
#undef PK
}
DEVI void pv_d0(f32x16* o, int vb, bf16x8 pa0, bf16x8 pa1, bf16x8 pa2, bf16x8 pa3) {
    pv_one<0>(o[0], vb, pa0, pa1, pa2, pa3); pv_one<1>(o[1], vb, pa0, pa1, pa2, pa3); pv_one<2>(o[2], vb, pa0, pa1, pa2, pa3); pv_one<3>(o[3], vb, pa0, pa1, pa2, pa3);
}
DEVI void na_mask(f32x16& p0, f32x16& p1, const float* brow, int cq, int hi) {
    const int cs = min(max(cq - 8, 0), 48);
    const float* bl = brow + (4 * hi - cq + 15);
    const int d0 = 4 * hi - cs;
#pragma unroll
    for (int r = 0; r < 16; ++r) {
        const int kc0 = (r & 3) + 8 * (r >> 2), kc1 = kc0 + 32;
        const bool ok0 = (unsigned)(kc0 + d0) < 16u, ok1 = (unsigned)(kc1 + d0) < 16u;
        const float b0 = bl[ok0 ? kc0 : 0], b1 = bl[ok1 ? kc1 : 0];
        p0[r] = ok0 ? p0[r] + b0 : -1e30f; p1[r] = ok1 ? p1[r] + b1 : -1e30f;
    }
}
DEVI void attn_unit(const bf16* __restrict__ Qb, const bf16* __restrict__ kc, const bf16* __restrict__ kl, int vdelta, int NT, unsigned char* __restrict__ Ob, char* lds) {
    constexpr int ldq = AIW, ldk = AIW, ldo = D; constexpr bool NA = false; const int tbase = 0, nwin = 64, krmin = 0, rq0 = 0; const float* rpb_h = nullptr;
    auto tile = [&](int t, const bf16*& kp, const bf16*& vp) { kp = t < 4 ? kc + (size_t)t * 64 * ldk : kl + (size_t)(tbase + min(t - 4, nwin - 1)) * 64 * ldk; vp = kp + vdelta; };
    const int tid = otid(), wid = tid >> 6, lane = tid & 63, r32 = lane & 31, hi = lane >> 5;
    char* V_lds = lds; char* K_lds = lds + 2 * SHM_V;
    float* wsc = (float*)(lds + SCR_OFF) + wid * 64; float* li_l = wsc; float* al_l = wsc + 32;
    float* btab = (float*)(lds + BIAS_OFF);
    float m_reg = -1e30f, l_reg = 0; f32x16 o[4] = {}; bf16x8 qr[8];
    const bf16* Qw = Qb + (size_t)(wid * QBLK + r32) * ldq + hi * 8;
#pragma unroll
    for (int d0 = 0; d0 < 8; ++d0) qr[d0] = *reinterpret_cast<const bf16x8*>(Qw + d0 * 16);
    if (NA) { for (int i = tid; i < 465; i += 512) btab[i] = rpb_h[i] * (1.f / SCALE); }
    const int sr = tid >> 4, sc = (tid & 15) * 8, vst0 = v_st(sr, sc), vst1 = v_st(32 + sr, sc);
    const int vb0 = (int)(uintptr_t)V_lds + v_rd_base(lane);
    const int rq = rq0 + (wid >> 1), cq = (wid & 1) * 32 + r32, kr0 = min(max(rq - 4, 0), 56);
    struct { bf16x8 vs0, vs1, ks0, ks1; } st_[2];
#define SLOAD(i, t) do { const bf16* kp_; const bf16* vp_; tile((t), kp_, vp_); \
    st_[i].vs0 = *reinterpret_cast<const bf16x8*>(vp_ + (size_t)sr * ldk + sc); st_[i].vs1 = *reinterpret_cast<const bf16x8*>(vp_ + (size_t)(32 + sr) * ldk + sc); \
    st_[i].ks0 = *reinterpret_cast<const bf16x8*>(kp_ + (size_t)sr * ldk + sc); st_[i].ks1 = *reinterpret_cast<const bf16x8*>(kp_ + (size_t)(32 + sr) * ldk + sc); } while (0)
#define SWRITE(b, i) do { *(bf16x8*)(V_lds + (b) * SHM_V + vst0) = st_[i].vs0; *(bf16x8*)(V_lds + (b) * SHM_V + vst1) = st_[i].vs1; const int kc = sc * 2; \
    *(bf16x8*)(K_lds + (b) * SHM_K + KSWZ(sr, kc)) = st_[i].ks0; *(bf16x8*)(K_lds + (b) * SHM_K + KSWZ(32 + sr, kc)) = st_[i].ks1; } while (0)
#define SWAIT() asm volatile("s_waitcnt vmcnt(4)" ::: "memory")
#define RESC(a) do { if (__any((a) < 1.f)) { if (hi == 0) al_l[r32] = (a); asm volatile("s_waitcnt lgkmcnt(0)" ::: "memory"); \
    _Pragma("unroll") for (int d = 0; d < 4; ++d) _Pragma("unroll") for (int r = 0; r < 16; ++r) o[d][r] *= al_l[crow(r, hi)]; } } while (0)
#define MASK(P0, P1, t) do { if (NA) { if ((t) >= 4) { const int kr_ = krmin + (t) - 4; const bool v_ = ((t) - 4 < nwin) && kr_ >= kr0 && kr_ <= kr0 + 7; (void)v_; } } } while (0)
    f32x16 pA0, pA1, pB0, pB1; float mnA, mnB, alA, alB; bf16x8 pa0, pa1, pa2, pa3;
    constexpr int SE = 0, SO = 1;
    SLOAD(SE, 0); asm volatile("s_waitcnt vmcnt(0)" ::: "memory"); SWRITE(0, SE); __syncthreads();
    qkt(pA0, pA1, K_lds, qr, r32, hi); MASK(pA0, pA1, 0); partialSM(pA0, pA1, m_reg, mnA, alA);
    SLOAD(SO, 1); SLOAD(SE, 2);
    SWAIT(); SWRITE(1, SO); __syncthreads();
    for (int j = 1; j + 1 < NT; j += 2) {
        SBAR(); qkt(pB0, pB1, K_lds + SHM_K, qr, r32, hi); MASK(pB0, pB1, j);
        finishSM(pA0, pA1, alA, l_reg, pa0, pa1, pa2, pa3); SBAR();
        SLOAD(SO, j + 2); SBAR();
        pv_d0(o, vb0, pa0, pa1, pa2, pa3); partialSM(pB0, pB1, m_reg, mnB, alB);
        __syncthreads(); SWAIT(); SWRITE(0, SE);
        RESC(alB); __syncthreads();
        SBAR(); qkt(pA0, pA1, K_lds, qr, r32, hi); MASK(pA0, pA1, j + 1);
        finishSM(pB0, pB1, alB, l_reg, pa0, pa1, pa2, pa3); SBAR();
        SLOAD(SE, min(j + 3, NT - 1)); SBAR();
        pv_d0(o, vb0 + SHM_V, pa0, pa1, pa2, pa3); partialSM(pA0, pA1, m_reg, mnA, alA);
        __syncthreads(); SWAIT(); SWRITE(1, SO);
        RESC(alA); __syncthreads();
    }
    SBAR(); qkt(pB0, pB1, K_lds + SHM_K, qr, r32, hi); MASK(pB0, pB1, NT - 1);
    finishSM(pA0, pA1, alA, l_reg, pa0, pa1, pa2, pa3); SBAR();
    pv_d0(o, vb0, pa0, pa1, pa2, pa3); partialSM(pB0, pB1, m_reg, mnB, alB);
    __syncthreads(); RESC(alB);
    finishSM(pB0, pB1, alB, l_reg, pa0, pa1, pa2, pa3); SBAR();
    pv_d0(o, vb0 + SHM_V, pa0, pa1, pa2, pa3);
    if (hi == 0) li_l[r32] = l_reg; asm volatile("s_waitcnt lgkmcnt(0)" ::: "memory");
#pragma unroll
    for (int r = 0; r < 16; ++r) { const int orow = crow(r, hi); const float rl = __builtin_amdgcn_rcpf(li_l[orow]);
#pragma unroll
        for (int d0 = 0; d0 < 4; ++d0) ((unsigned char*)Ob)[(size_t)(wid * QBLK + orow) * ldo + d0 * 32 + r32] = (unsigned char)(pk4_fp8(o[d0][r] * rl, 0.f, 0.f, 0.f) & 0xffu); }
    __syncthreads();
#undef SLOAD
#undef SWRITE
#undef SWAIT
#undef RESC
#undef MASK
}
DEVI void attn_unit_na(const bf16* __restrict__ Qb, const bf16* __restrict__ kc, const bf16* __restrict__ kl, int krmin, int nwin, int vdelta, unsigned char* __restrict__ Ob, char* lds, int rq0, const float* rpb_h) {
    constexpr int ldq = AIW, ldk = AIW, ldo = D;
    const int tid = otid(), wid = tid >> 6, lane = tid & 63, r32 = lane & 31, hi = lane >> 5;
    char* V_lds = lds; char* K_lds = lds + 2 * SHM_V;
    float* wsc = (float*)(lds + SCR_OFF) + wid * 64; float* li_l = wsc; float* al_l = wsc + 32;
    float* btab = (float*)(lds + BIAS_OFF);
    float m_reg = -1e30f, l_reg = 0; f32x16 o[4] = {}; bf16x8 qr[8];
    const bf16* Qw = Qb + (size_t)(wid * QBLK + r32) * ldq + hi * 8;
#pragma unroll
    for (int d0 = 0; d0 < 8; ++d0) qr[d0] = *reinterpret_cast<const bf16x8*>(Qw + d0 * 16);
    for (int i = tid; i < 465; i += 512) btab[i] = rpb_h[i] * (1.f / SCALE);
    const int sr = tid >> 4, sc = (tid & 15) * 8, vst0 = v_st(sr, sc), vst1 = v_st(32 + sr, sc);
    const int vb0 = (int)(uintptr_t)V_lds + v_rd_base(lane);
    const int rq = rq0 + (wid >> 1), cq = (wid & 1) * 32 + r32, kr0 = min(max(rq - 4, 0), 56);
    bf16x8 vs0, vs1, ks0, ks1;
    const int NT = 4 + nwin;
#define NLOAD(t) do { const bf16* kp_ = (t) < 4 ? kc + (size_t)(t) * 64 * ldk : kl + (size_t)(krmin + (t) - 4) * 64 * ldk; const bf16* vp_ = kp_ + vdelta; \
    vs0 = *reinterpret_cast<const bf16x8*>(vp_ + (size_t)sr * ldk + sc); vs1 = *reinterpret_cast<const bf16x8*>(vp_ + (size_t)(32 + sr) * ldk + sc); \
    ks0 = *reinterpret_cast<const bf16x8*>(kp_ + (size_t)sr * ldk + sc); ks1 = *reinterpret_cast<const bf16x8*>(kp_ + (size_t)(32 + sr) * ldk + sc); } while (0)
    NLOAD(0);
    for (int t = 0; t < NT; ++t) {
        __syncthreads();
        *(bf16x8*)(V_lds + vst0) = vs0; *(bf16x8*)(V_lds + vst1) = vs1;
        *(bf16x8*)(K_lds + KSWZ(sr, sc * 2)) = ks0; *(bf16x8*)(K_lds + KSWZ(32 + sr, sc * 2)) = ks1;
        __syncthreads();
        NLOAD(min(t + 1, NT - 1));
        const int kr = krmin + t - 4;
        if (t < 4 || (kr >= kr0 && kr <= kr0 + 7)) {
            f32x16 p0, p1; float mn, al; bf16x8 pa0, pa1, pa2, pa3;
            qkt(p0, p1, K_lds, qr, r32, hi);
            if (t >= 4) na_mask(p0, p1, btab + (kr - rq + 7) * 31, cq, hi);
            partialSM(p0, p1, m_reg, mn, al);
            if (__any(al < 1.f)) { if (hi == 0) al_l[r32] = al; asm volatile("s_waitcnt lgkmcnt(0)" ::: "memory");
#pragma unroll
                for (int d = 0; d < 4; ++d)
#pragma unroll
                    for (int r = 0; r < 16; ++r) o[d][r] *= al_l[crow(r, hi)]; }
            finishSM(p0, p1, al, l_reg, pa0, pa1, pa2, pa3);
            pv_d0(o, vb0, pa0, pa1, pa2, pa3);
        }
    }
#undef NLOAD
    if (hi == 0) li_l[r32] = l_reg; asm volatile("s_waitcnt lgkmcnt(0)" ::: "memory");
#pragma unroll
    for (int r = 0; r < 16; ++r) { const int orow = crow(r, hi); const float rl = __builtin_amdgcn_rcpf(li_l[orow]);
#pragma unroll
        for (int d0 = 0; d0 < 4; ++d0) ((unsigned char*)Ob)[(size_t)(wid * QBLK + orow) * ldo + d0 * 32 + r32] = (unsigned char)(pk4_fp8(o[d0][r] * rl, 0.f, 0.f, 0.f) & 0xffu); }
    __syncthreads();
}
}

namespace ml {
using fa::f32x16; using fa::s16x4;
constexpr int K_OFF = 0, KP_OFF = 16384, V_OFF = 32768, C2_OFF = 49152, GA_OFF = C2_OFF + 2 * 24576, DEN_OFF = GA_OFF + 3072, CF_OFF = DEN_OFF + 1024, ML_LDS = CF_OFF + 49152;
static_assert(ML_LDS <= 157 * 1024, "mLSTM LDS map");
constexpr int GA_STRIDE = 6 * 64 * 4;
DEVI int tokrow(int b, int dir, int c, int i) {
    return c >= 4 ? (b * SEQ + (dir ? (SEQ - 1 - ((c - 4) * 64 + i)) : ((c - 4) * 64 + i))) : (ML + b * CTXL + (dir ? (CTXL - 1 - (c * 64 + i)) : (c * 64 + i)));
}
template <int CTRL, int ROWMASK> DEVI float dpp_f(float ident, float src) {
    return __int_as_float(__builtin_amdgcn_update_dpp(__float_as_int(ident), __float_as_int(src), CTRL, ROWMASK, 0xf, false));
}
DEVI float prefix_sum64(float x, int) {
    x += dpp_f<0x111, 0xf>(0.f, x); x += dpp_f<0x112, 0xf>(0.f, x); x += dpp_f<0x114, 0xf>(0.f, x); x += dpp_f<0x118, 0xf>(0.f, x);
    x += dpp_f<0x142, 0xa>(0.f, x); x += dpp_f<0x143, 0xc>(0.f, x);
    return x;
}
DEVI float prefix_max64(float x, int) {
    const float ninf = -INFINITY;
    x = fmaxf(x, dpp_f<0x111, 0xf>(ninf, x)); x = fmaxf(x, dpp_f<0x112, 0xf>(ninf, x)); x = fmaxf(x, dpp_f<0x114, 0xf>(ninf, x)); x = fmaxf(x, dpp_f<0x118, 0xf>(ninf, x));
    x = fmaxf(x, dpp_f<0x142, 0xa>(ninf, x)); x = fmaxf(x, dpp_f<0x143, 0xc>(ninf, x));
    return x;
}
DEVI float lane63(float v) { return __int_as_float(__builtin_amdgcn_readlane(__float_as_int(v), 63)); }
DEVI float gate_chunk(float li, float f, float mprev, float* ga, int lane) {
    const float lf = fminf(f, 0.f) - log1pf(__expf(-fabsf(f)));
    const float bc = prefix_sum64(lf, lane), btot = lane63(bc);
    const float colt = li - bc, aend = btot + colt, pm = prefix_max64(colt, lane), amax = btot + lane63(pm), mnew = fmaxf(btot + mprev, amax);
    const float cm = fmaxf(mprev, pm);
    ga[lane] = __expf(aend - mnew) * QSCALE;
    ga[64 + lane] = colt;
    ga[128 + lane] = -cm;
    ga[192 + lane] = __expf(mprev - cm);
    ga[256 + lane] = __expf(-bc - cm);
    if (lane == 0) ga[320] = __expf(btot + mprev - mnew);
    return mnew;
}
DEVI void ph_mlstm(const Params& p, char* lds, int vcu, int G) {
    const int tid = otid(), wid = __builtin_amdgcn_readfirstlane(tid >> 6), lane = tid & 63, r32 = lane & 31, hi = lane >> 5;
    const bf16* Q = (const bf16*)(p.ws + WS_QKV); const float* Gt = (const float*)(p.ws + WS_G); bf16* HD = (bf16*)(p.ws + WS_HD);
    char* K_lds = lds + K_OFF; char* Kp_lds = lds + KP_OFF; char* V_lds = lds + V_OFF; char* C_lds = lds + C2_OFF;
    float* GA = (float*)(lds + GA_OFF); float* den_l = (float*)(lds + DEN_OFF) + (wid & 3) * 64;
    const int sr = tid >> 4, sc = (tid & 15) * 8;
    const int vr = tid >> 3, vc = (tid & 7) * 8;
    const int vbK = (int)(uintptr_t)Kp_lds + fa::v_rd_base(lane), vbV = (int)(uintptr_t)V_lds + fa::v_rd_base(lane);
    for (int item = vcu; item < 256; item += G) {
        const int b = item >> 6, h = (item >> 3) & 7, dir = (item >> 2) & 1, sl = item & 3;
        const float bi = p.ml_gate_b[dir * 8 + h], bf_ = p.ml_gate_b[(2 + dir) * 8 + h];
        __syncthreads();
        for (int i = tid; i < 16384 / 16; i += 512) ((u32x4*)(V_lds))[i] = (u32x4){0u, 0u, 0u, 0u};
        for (int i = tid; i < 24576 / 16; i += 512) ((u32x4*)(C_lds))[i] = (u32x4){0u, 0u, 0u, 0u};
        __syncthreads();
        if (tid < 64) *(bf16*)(V_lds + fa::v_st(tid, 64)) = (bf16)0x3F80;
        for (int i = tid; i < 49152 / 16; i += 512) ((u32x4*)(lds + CF_OFF))[i] = (u32x4){0u, 0u, 0u, 0u};
        float mprev = 0.f;
        if (wid == 4) { const int row = tokrow(b, dir, 0, lane); mprev = gate_chunk(Gt[(size_t)row * 32 + dir * 8 + h] + bi, Gt[(size_t)row * 32 + 16 + dir * 8 + h] + bf_, 0.f, GA, lane); }
        bf16x8 kr0, kr1, vreg, qr[8];
        { const int r0 = tokrow(b, dir, 0, sr), r1 = tokrow(b, dir, 0, sr + 32), r2 = tokrow(b, dir, 0, vr);
          kr0 = *(const bf16x8*)(Q + (size_t)r0 * MIWM + 1024 + h * 128 + sc); kr1 = *(const bf16x8*)(Q + (size_t)r1 * MIWM + 1024 + h * 128 + sc);
          vreg = *(const bf16x8*)(Q + (size_t)r2 * MIWM + 2048 + h * 256 + sl * 64 + vc); }
#pragma unroll
        for (int d0 = 0; d0 < 8; ++d0) qr[d0] = (bf16x8){0, 0, 0, 0, 0, 0, 0, 0};
        __syncthreads();
        auto chunk_loop = [&](auto role_, auto lat_, const int c_begin, const int c_end) __attribute__((always_inline)) {
            constexpr bool OUT = decltype(role_)::value, LATC = decltype(lat_)::value;
#pragma unroll 1
            for (int c = c_begin; c < c_end; ++c) {
                const bool lat = c >= 4;
                const float* ga = GA + (c & 1) * (GA_STRIDE / 4);
                {
                    *(bf16x8*)(K_lds + KSWZ(sr, sc * 2)) = kr0; *(bf16x8*)(K_lds + KSWZ(32 + sr, sc * 2)) = kr1;
                    const float w0 = ga[sr], w1 = ga[sr + 32];
                    u32x4 a = *(u32x4*)&kr0, bq = *(u32x4*)&kr1, oa, ob;
#define SC2(x, w) fa::cvtpk(__uint_as_float((x) << 16) * (w), __uint_as_float((x) & 0xffff0000u) * (w))
                    oa.x = SC2(a.x, w0); oa.y = SC2(a.y, w0); oa.z = SC2(a.z, w0); oa.w = SC2(a.w, w0);
                    ob.x = SC2(bq.x, w1); ob.y = SC2(bq.y, w1); ob.z = SC2(bq.z, w1); ob.w = SC2(bq.w, w1);
#undef SC2
                    *(u32x4*)(Kp_lds + fa::v_st(sr, sc)) = oa; *(u32x4*)(Kp_lds + fa::v_st(32 + sr, sc)) = ob;
                    *(bf16x8*)(V_lds + fa::v_st(vr, vc)) = vreg;
                }
                float gli, gf;
                {
                    const int cn = c + 1 < 68 ? c + 1 : 67;
                    const int r0 = tokrow(b, dir, cn, sr), r1 = tokrow(b, dir, cn, sr + 32), r2 = tokrow(b, dir, cn, vr);
                    kr0 = *(const bf16x8*)(Q + (size_t)r0 * MIWM + 1024 + h * 128 + sc); kr1 = *(const bf16x8*)(Q + (size_t)r1 * MIWM + 1024 + h * 128 + sc);
                    vreg = *(const bf16x8*)(Q + (size_t)r2 * MIWM + 2048 + h * 256 + sl * 64 + vc);
                    const int row = tokrow(b, dir, cn, lane); gli = Gt[(size_t)row * 32 + dir * 8 + h] + bi; gf = Gt[(size_t)row * 32 + 16 + dir * 8 + h] + bf_;
                }
                __syncthreads();
                const char* Cc = C_lds + (c & 1) * 24576;
                if constexpr (OUT) {
                    if constexpr (LATC) {
                        const int tq = wid >> 1, vq = wid & 1, t = tq * 32 + r32;
                        bf16x8 kf0[8], kf1[8], cfr[8];
#pragma unroll
                        for (int d0 = 0; d0 < 8; ++d0) { const int cb = (d0 * 16 + hi * 8) * 2;
                            kf0[d0] = *reinterpret_cast<const bf16x8*>(K_lds + KSWZ(r32, cb)); kf1[d0] = *reinterpret_cast<const bf16x8*>(K_lds + KSWZ(32 + r32, cb));
                            cfr[d0] = *reinterpret_cast<const bf16x8*>(Cc + KSWZ(vq * 32 + r32, cb)); }
                        asm volatile("s_waitcnt lgkmcnt(0)" ::: "memory"); SBAR();
                        f32x16 p0 = {}, p1 = {}, acc = {};
#pragma unroll
                        for (int d0 = 0; d0 < 8; ++d0) p0 = __builtin_amdgcn_mfma_f32_32x32x16_bf16(kf0[d0], qr[d0], p0, 0, 0, 0);
                        if (tq == 1) {
#pragma unroll
                            for (int d0 = 0; d0 < 8; ++d0) p1 = __builtin_amdgcn_mfma_f32_32x32x16_bf16(kf1[d0], qr[d0], p1, 0, 0, 0); }
#pragma unroll
                        for (int d0 = 0; d0 < 8; ++d0) acc = __builtin_amdgcn_mfma_f32_32x32x16_bf16(qr[d0], cfr[d0], acc, 0, 0, 0);
                        bf16x8 cfn[8];
#pragma unroll
                        for (int d0 = 0; d0 < 8; ++d0) cfn[d0] = *reinterpret_cast<const bf16x8*>(Cc + KSWZ(64 + r32, (d0 * 16 + hi * 8) * 2));
                        asm volatile("s_waitcnt lgkmcnt(0)" ::: "memory"); SBAR();
                        f32x16 qnacc = {};
#pragma unroll
                        for (int d0 = 0; d0 < 8; ++d0) qnacc = __builtin_amdgcn_mfma_f32_32x32x16_bf16(cfn[d0], qr[d0], qnacc, 0, 0, 0);
                        { const int cq = c + 1 < 68 ? c + 1 : 67; const bf16* Qw = Q + (size_t)tokrow(b, dir, cq, (wid >> 1) * 32 + r32) * MIWM + h * 128 + hi * 8;
#pragma unroll
                          for (int d0 = 0; d0 < 8; ++d0) qr[d0] = *(const bf16x8*)(Qw + d0 * 16); }
                        float ct0[16], ct1[16], wi[16];
#pragma unroll
                        for (int r = 0; r < 16; ++r) { const int s0 = fa::crow(r, hi); ct0[r] = ga[64 + s0]; ct1[r] = ga[64 + s0 + 32]; wi[r] = ga[192 + tq * 32 + s0]; }
                        const float rown = ga[128 + t] * 1.4426950408889634f, wint_t = ga[192 + t], emr_t = ga[256 + t];
                        asm volatile("s_waitcnt lgkmcnt(0)" ::: "memory"); SBAR();
                        float ps = 0.f;
#pragma unroll
                        for (int r = 0; r < 16; ++r) {
                            const int s0 = fa::crow(r, hi), s1 = s0 + 32;
                            const float e0 = __builtin_amdgcn_exp2f(fmaf(ct0[r], 1.4426950408889634f, rown)), e1 = __builtin_amdgcn_exp2f(fmaf(ct1[r], 1.4426950408889634f, rown));
                            p0[r] = s0 <= t ? p0[r] * QSCALE * e0 : 0.f; p1[r] = s1 <= t ? p1[r] * QSCALE * e1 : 0.f;
                            ps += p0[r] + p1[r];
                        }
                        { auto rr = __builtin_amdgcn_permlane32_swap(__float_as_uint(ps), __float_as_uint(ps), false, false); ps = __uint_as_float(rr[0]) + __uint_as_float(rr[1]); }
                        bf16x8 pa0, pa1, pa2, pa3;
#define PK4(P, BASE, OUT) do { unsigned a0 = fa::cvtpk(P[BASE + 0], P[BASE + 1]), a1 = fa::cvtpk(P[BASE + 2], P[BASE + 3]);   \
        unsigned b0 = fa::cvtpk(P[BASE + 4], P[BASE + 5]), b1 = fa::cvtpk(P[BASE + 6], P[BASE + 7]);                              \
        auto r0 = __builtin_amdgcn_permlane32_swap(a0, b0, false, false); auto r1 = __builtin_amdgcn_permlane32_swap(a1, b1, false, false); \
        u32x4 w = {r0[0], r1[0], r0[1], r1[1]}; OUT = *reinterpret_cast<bf16x8*>(&w); } while (0)
                        PK4(p0, 0, pa0); PK4(p0, 8, pa1); PK4(p1, 0, pa2); PK4(p1, 8, pa3);
                        float qn_ = qnacc[0];
                        { auto rr = __builtin_amdgcn_permlane32_swap(__float_as_uint(qn_), __float_as_uint(qn_), false, false); qn_ = __uint_as_float(rr[0]); }
                        const float den = wint_t * qn_ + ps;
                        if (hi == 0) den_l[r32] = fmaxf(fabsf(den), emr_t);
#pragma unroll
                        for (int r = 0; r < 16; ++r) acc[r] *= wi[r];
                        fa::pv_one<0>(acc, vbV + vq * 512, pa0, pa1, pa2, pa3);
                        float dl[16];
#pragma unroll
                        for (int r = 0; r < 16; ++r) dl[r] = den_l[fa::crow(r, hi)];
                        asm volatile("s_waitcnt lgkmcnt(0)" ::: "memory"); SBAR();
                        const long stepE = dir ? -(long)D : (long)D;
                        bf16* hb = HD + ((size_t)dir * ML + tokrow(b, dir, c, tq * 32 + 4 * hi)) * D + h * 256 + sl * 64 + vq * 32 + r32;
#pragma unroll
                        for (int r = 0; r < 16; ++r) hb[stepE * ((r & 3) + 8 * (r >> 2))] = f2bf(acc[r] * __builtin_amdgcn_rcpf(dl[r]));
                    }
                    if constexpr (!LATC) if (c == 3) { const bf16* Qw = Q + (size_t)tokrow(b, dir, c + 1, (wid >> 1) * 32 + r32) * MIWM + h * 128 + hi * 8;
#pragma unroll
                        for (int d0 = 0; d0 < 8; ++d0) qr[d0] = *(const bf16x8*)(Qw + d0 * 16); }
                } else {
                    const int kq = wid - 4; const float decay = ga[320];
                    f32x4* CF = (f32x4*)(lds + CF_OFF) + kq * 3 * 4 * 64 + lane;
                    f32x4 cfv[12]; s16x4 kt[8], vt[24];
#pragma unroll
                    for (int i = 0; i < 12; ++i) cfv[i] = CF[i * 64];
                    typedef short v4i16_t __attribute__((ext_vector_type(4)));
#define TRB(base, off) __builtin_bit_cast(s16x4, __builtin_amdgcn_ds_read_tr16_b64_v4i16((LAS v4i16_t*)(size_t)(unsigned)((base) + (off))))
                    const int ak = vbK + kq * 512;
#pragma unroll
                    for (int ks = 0; ks < 4; ++ks) { kt[2 * ks] = TRB(ak, fa::v_rd_off(0, ks, 0)); kt[2 * ks + 1] = TRB(ak, fa::v_rd_off(0, ks, 1)); }
#pragma unroll
                    for (int j = 0; j < 3; ++j)
#pragma unroll
                        for (int ks = 0; ks < 4; ++ks) { vt[8 * j + 2 * ks] = TRB(vbV, fa::v_rd_off(j, ks, 0)); vt[8 * j + 2 * ks + 1] = TRB(vbV, fa::v_rd_off(j, ks, 1)); }
#undef TRB
                    f32x16 cacc[3];
#pragma unroll
                    for (int j = 0; j < 3; ++j)
#pragma unroll
                        for (int r4 = 0; r4 < 4; ++r4) { const f32x4 v4 = cfv[j * 4 + r4] * decay; cacc[j][r4 * 4 + 0] = v4[0]; cacc[j][r4 * 4 + 1] = v4[1]; cacc[j][r4 * 4 + 2] = v4[2]; cacc[j][r4 * 4 + 3] = v4[3]; }
#define PKF(L, H) (bf16x8){L[0], L[1], L[2], L[3], H[0], H[1], H[2], H[3]}
#pragma unroll
                    for (int j = 0; j < 3; ++j)
#pragma unroll
                        for (int ks = 0; ks < 4; ++ks) cacc[j] = __builtin_amdgcn_mfma_f32_32x32x16_bf16(PKF(kt[2 * ks], kt[2 * ks + 1]), PKF(vt[8 * j + 2 * ks], vt[8 * j + 2 * ks + 1]), cacc[j], 0, 0, 0);
#undef PKF
                    char* Cn = C_lds + ((c + 1) & 1) * 24576;
#pragma unroll
                    for (int j = 0; j < 3; ++j) { bf16x8 f0, f1; PK4(cacc[j], 0, f0); PK4(cacc[j], 8, f1);
                        *(bf16x8*)(Cn + KSWZ(j * 32 + r32, (kq * 32 + hi * 8) * 2)) = f0; *(bf16x8*)(Cn + KSWZ(j * 32 + r32, (kq * 32 + 16 + hi * 8) * 2)) = f1; }
#pragma unroll
                    for (int j = 0; j < 3; ++j)
#pragma unroll
                        for (int r4 = 0; r4 < 4; ++r4) CF[(j * 4 + r4) * 64] = (f32x4){cacc[j][r4 * 4 + 0], cacc[j][r4 * 4 + 1], cacc[j][r4 * 4 + 2], cacc[j][r4 * 4 + 3]};
                    if (wid == 4 && c + 1 < 68) mprev = gate_chunk(gli, gf, mprev, GA + ((c + 1) & 1) * (GA_STRIDE / 4), lane);
                }
                __syncthreads();
            }
        };
        if (wid < 4) { chunk_loop(std::true_type{}, std::false_type{}, 0, 4);
            __builtin_amdgcn_s_waitcnt(0);
            chunk_loop(std::true_type{}, std::true_type{}, 4, 68); }
        else chunk_loop(std::false_type{}, std::false_type{}, 0, 68);
#undef PK4
    }
}
}

DEVI void ph_attn0(const Params& p, char* lds, int vcu, int G) {
    const bf16* Q = (const bf16*)(p.ws + WS_QKV); unsigned char* AO = (unsigned char*)(p.ws + WS_AO);
    const bool edge = (vcu & 15) == 0 || (vcu & 15) == 15;
    const int nG = (512 - vcu + G - 1) / G, nC = G == 256 ? (edge ? 2 : 0) : (vcu < 64 ? (64 - vcu + G - 1) / G : 0);
    for (int i = 0; i < 2 * nG + nC; ++i) {
        const bf16 *Qb, *kc, *kl; unsigned char* Ob; int tbase = 0, nwin = 64, vdelta, NT, rq0 = 0; bool na = false; const float* rpb = p.attn_rpb;
        if (i < nG) {
            const int u = vcu + i * G; int b, qh, qb;
            if (G == 256) { const int grp = vcu >> 5, idx = (vcu & 31) + 32 * i; b = grp >> 1; qh = (grp & 1) * 4 + (idx >> 4); qb = idx & 15; } else { b = u >> 7; qh = (u >> 4) & 7; qb = u & 15; }
            const int kvh = qh >> 2;
            kc = Q + (size_t)(ML + b * CTXL) * AIW + 4096 + kvh * 128; kl = Q + (size_t)(b * SEQ) * AIW + 4096 + kvh * 128; vdelta = 256; NT = 68;
            Qb = Q + (size_t)(b * SEQ + qb * 256) * AIW + 3072 + qh * 128; Ob = AO + (size_t)(b * SEQ + qb * 256) * D + 1024 + qh * 128;
        } else if (i < 2 * nG) {
            const int u = vcu + (i - nG) * G; const int b = u >> 7, h = (u >> 4) & 7, qb = u & 15;
            const int krmin = min(max(4 * qb - 4, 0), 56), krmax = min(max(4 * qb - 1, 0), 56) + 7;
            tbase = krmin; nwin = krmax - krmin + 1; NT = (4 + nwin + 1) & ~1; na = true; rq0 = 4 * qb; rpb = p.attn_rpb + h * 465;
            kc = Q + (size_t)(ML + b * CTXL) * AIW + 1024 + h * 128; kl = Q + (size_t)(b * SEQ) * AIW + 1024 + h * 128; vdelta = 1024;
            Qb = Q + (size_t)(b * SEQ + qb * 256) * AIW + h * 128; Ob = AO + (size_t)(b * SEQ + qb * 256) * D + h * 128;
        } else {
            const int u = G == 256 ? ((vcu >> 4) * 2 + ((vcu & 15) == 15 ? 1 : 0)) + 32 * (i - 2 * nG) : vcu + (i - 2 * nG) * G; const int b = (u >> 3) & 3, hh = u & 7; const bool gq = u >= 32;
            const int qcol = gq ? 3072 + hh * 128 : hh * 128, kcol = gq ? 4096 + (hh >> 2) * 128 : 1024 + hh * 128, ocol = gq ? 1024 + hh * 128 : hh * 128;
            kc = Q + (size_t)(ML + b * CTXL) * AIW + kcol; kl = kc; vdelta = gq ? 256 : 1024; NT = 4;
            Qb = Q + (size_t)(ML + b * CTXL) * AIW + qcol; Ob = AO + (size_t)(ML + b * CTXL) * D + ocol;
        }
        if (na) fa::attn_unit_na(Qb, kc, kl, tbase, nwin, vdelta, Ob, lds, rq0, rpb); else fa::attn_unit(Qb, kc, kl, vdelta, NT, Ob, lds);
    }
}

DEVI unsigned cvtpk_s(float lo, float hi) { unsigned r; asm volatile("v_cvt_pk_bf16_f32 %0, %1, %2" : "=v"(r) : "v"(lo), "v"(hi)); return r; }
DEVI void ph_router_prep(const Params& p, float* lds, int vcu, int G) {
    const int tid = otid(), lane = tid & 63, wave = tid >> 6;
    bf16* RWP = (bf16*)(p.ws + WS_RWP); float* RC = (float*)(p.ws + WS_RC);
    const int vr = G - 1 - vcu;
    for (int idx = vr * 512 + tid; idx < 10 * 256 * 64; idx += G * 512) {
        const int e = idx & 63, kg = (idx >> 6) & 255, lb = idx >> 14, l = lb / 5, bb = lb % 5;
        const float* W = p.router_w + (size_t)l * D * NE + e; const float* gn = p.norm_ffn + l * D + kg * 8; const float* scl = modp(p, l, bb, 4) + kg * 8;
        float v[8]; unsigned hi[4], lo[4];
#pragma unroll
        for (int j = 0; j < 8; ++j) v[j] = gn[j] * (1.f + scl[j]) * W[(size_t)(kg * 8 + j) * NE];
#pragma unroll
        for (int j = 0; j < 4; ++j) { hi[j] = cvtpk_s(v[2 * j], v[2 * j + 1]); lo[j] = cvtpk_s(v[2 * j] - __uint_as_float(hi[j] << 16), v[2 * j + 1] - __uint_as_float(hi[j] & 0xffff0000u)); }
        bf16* dst = RWP + (((size_t)lb * 2 * 128 + (kg >> 1)) * 64 + e) * 16 + (kg & 1) * 8;
        *(u32x4*)dst = (u32x4){hi[0], hi[1], hi[2], hi[3]}; *(u32x4*)(dst + (size_t)128 * 64 * 16) = (u32x4){lo[0], lo[1], lo[2], lo[3]};
    }
    for (int c = vr; c < 80; c += G) {
        const int lb = c % 10, sl = c / 10, l = lb / 5, bb = lb % 5; const float* W = p.router_w + (size_t)l * D * NE + lane; const float* sh = modp(p, l, bb, 3);
        float a = 0.f;
#pragma unroll 32
        for (int k = sl * 256 + wave * 32; k < sl * 256 + wave * 32 + 32; ++k) a += sh[k] * W[(size_t)k * NE];
        __syncthreads(); lds[wave * 64 + lane] = a; __syncthreads();
        if (wave == 0) { float t = 0.f; for (int w = 0; w < 8; ++w) t += lds[w * 64 + lane]; RC[(lb * 8 + sl) * 64 + lane] = t; }
    }
}
DEVI void ph_normr2(const Params& p, int layer, int nrows, float* lds, int vcu, int G) {
    using fa::f32x16;
    float* part = lds; float* ssq = lds + 8 * 4096; float* rstd_l = ssq + 256; float* sraw = rstd_l + 32; float* ssel = sraw + 2048; float* gsc = ssel + 2048;
    int* gsel = (int*)(gsc + 256); int* esel = gsel + 256; float* wsel = (float*)(esel + 256);
    LAS int* hist = (LAS int*)(wsel + 256); LAS int* hbase = hist + 64;
    const int tid = otid(), lane = tid & 63, wave = __builtin_amdgcn_readfirstlane(tid >> 6), r32 = lane & 31, kgp = lane >> 5;
    bf16* HB = (bf16*)(p.ws + WS_HB);
    int* eidx = (int*)(p.ws + WS_EIDX); float* ew = (float*)(p.ws + WS_EW); int* epos = (int*)(p.ws + WS_EPOS);
    u32* cnt = (u32*)(p.ws + WS_CTL) + CW_CNT + layer * 64 * CNT_PAD;
    const float* RB = p.router_b + layer * NE; const float* gain = p.norm_ffn + layer * D;
    LAS int* tq = hbase + 64;
    unsigned* tcnt = (unsigned*)(p.ws + WS_CTL) + CW_TQ + layer * 64;
    const int ntiles = nrows >> 5;
    if (tid == 0) tq[0] = (int)atomicAdd(tcnt, 1u);
    __syncthreads();
    int tile = __builtin_amdgcn_readfirstlane(tq[0]);
    while (tile < ntiles) {
        int nxt_reg = 0;
        const int m0 = tile * 32, bb = bidx(m0);
        const bf16* xbase = (const bf16*)(p.ws + WS_X) + (size_t)m0 * D;
        {
            LAS unsigned char* xs = (LAS unsigned char*)lds + wave * 16384;
            {
                const int rr_ = lane >> 5, cc = lane & 31;
                const unsigned char* xg = (const unsigned char*)xbase + (size_t)rr_ * (D * 2) + wave * 512 + cc * 16;
                u32x4 xv[16];
#pragma unroll
                for (int i = 0; i < 16; ++i) xv[i] = *(const u32x4*)(xg + (size_t)(2 * i) * (D * 2));
#pragma unroll
                for (int i = 0; i < 16; ++i) { const int row = 2 * i + rr_; *(LAS u32x4*)(xs + row * 512 + ((cc ^ row) & 31) * 16) = xv[i]; }
            }
            const bf16* wb = (const bf16*)(p.ws + WS_RWP) + (((size_t)(layer * 5 + bb) * 2 * 128 + wave * 16) * 64 + r32) * 16 + kgp * 8;
            f32x16 acc0 = {}, acc1 = {}; float ss = 0.f;
            bf16x8 wv[2][4][4];
#pragma unroll
            for (int t = 0; t < 4; ++t) { const bf16* w_ = wb + (size_t)t * 1024;
                wv[0][t][0] = *(const bf16x8*)(w_); wv[0][t][1] = *(const bf16x8*)(w_ + 512); wv[0][t][2] = *(const bf16x8*)(w_ + (size_t)128 * 1024); wv[0][t][3] = *(const bf16x8*)(w_ + (size_t)128 * 1024 + 512); }
            asm volatile("s_waitcnt lgkmcnt(0)" ::: "memory");
#pragma unroll
            for (int sb = 0; sb < 4; ++sb) {
                if (sb < 3) {
#pragma unroll
                    for (int t = 0; t < 4; ++t) { const bf16* w_ = wb + (size_t)((sb + 1) * 4 + t) * 1024;
                        wv[(sb + 1) & 1][t][0] = *(const bf16x8*)(w_); wv[(sb + 1) & 1][t][1] = *(const bf16x8*)(w_ + 512); wv[(sb + 1) & 1][t][2] = *(const bf16x8*)(w_ + (size_t)128 * 1024); wv[(sb + 1) & 1][t][3] = *(const bf16x8*)(w_ + (size_t)128 * 1024 + 512); }
                }
                u32x4 ahv[4];
#pragma unroll
                for (int t = 0; t < 4; ++t) { const int ch = 2 * (sb * 4 + t) + kgp; ahv[t] = *(const LAS u32x4*)(xs + r32 * 512 + ((ch ^ r32) & 31) * 16); }
#pragma unroll
                for (int t = 0; t < 4; ++t) {
                    const u32x4 ah = ahv[t];
#pragma unroll
                    for (int q = 0; q < 4; ++q) { const float a = __uint_as_float(ah[q] << 16), b = __uint_as_float(ah[q] & 0xffff0000u); ss += a * a + b * b; }
                    const bf16x8 Ah = __builtin_bit_cast(bf16x8, ah);
                    acc0 = __builtin_amdgcn_mfma_f32_32x32x16_bf16(Ah, wv[sb & 1][t][0], acc0, 0, 0, 0); acc1 = __builtin_amdgcn_mfma_f32_32x32x16_bf16(Ah, wv[sb & 1][t][1], acc1, 0, 0, 0);
                    acc0 = __builtin_amdgcn_mfma_f32_32x32x16_bf16(Ah, wv[sb & 1][t][2], acc0, 0, 0, 0); acc1 = __builtin_amdgcn_mfma_f32_32x32x16_bf16(Ah, wv[sb & 1][t][3], acc1, 0, 0, 0);
                }
            }
            { auto rr = __builtin_amdgcn_permlane32_swap(__float_as_uint(ss), __float_as_uint(ss), false, false); ss = __uint_as_float(rr[0]) + __uint_as_float(rr[1]); }
            if (kgp == 0) ssq[wave * 32 + r32] = ss;
#pragma unroll
            for (int r = 0; r < 16; ++r) { part[wave * 4096 + (0 * 16 + r) * 64 + lane] = acc0[r]; part[wave * 4096 + (1 * 16 + r) * 64 + lane] = acc1[r]; }
        }
        __syncthreads();
        if (tid == 0) nxt_reg = (int)atomicAdd(tcnt, 1u);
        if (tid < 32) { float t = 0.f; for (int w = 0; w < 8; ++w) t += ssq[w * 32 + tid]; rstd_l[tid] = rsqrtf(t * (1.f / D) + EPS); }
        __syncthreads();
        {
            if (tid < 64) hist[tid] = 0;
            const float* rc = (const float*)(p.ws + WS_RC) + (layer * 5 + bb) * 8 * 64;
            float rcsum = 0.f;
#pragma unroll
            for (int sl = 0; sl < 8; ++sl) rcsum += rc[sl * 64 + lane];
            const float rbe = RB[lane]; const int g = lane >> 3;
#define DPPF(x, ctrl) __int_as_float(__builtin_amdgcn_update_dpp(0, __float_as_int(x), ctrl, 0xf, 0xf, false))
#pragma unroll 1
            for (int q = 0; q < 4; ++q) {
                const int row = wave + 8 * q, rr = (row & 3) + 4 * (row >> 3), ll = (lane & 31) + 32 * ((row >> 2) & 1), eb = lane >> 5;
                float t = 0.f;
#pragma unroll
                for (int w = 0; w < 8; ++w) t += part[w * 4096 + (eb * 16 + rr) * 64 + ll];
                const float lg = t * rstd_l[row] + rcsum; const float sg = 1.f / (1.f + expf(-lg));
                const float v = sg + rbe;
                float m1 = v, m2 = -INFINITY;
                { const float o1 = DPPF(m1, 0xB1); m2 = fminf(m1, o1); m1 = fmaxf(m1, o1); }
                { const float o1 = DPPF(m1, 0x4E), o2 = DPPF(m2, 0x4E); m2 = fmaxf(fminf(m1, o1), fmaxf(m2, o2)); m1 = fmaxf(m1, o1); }
                { const float o1 = DPPF(m1, 0x141), o2 = DPPF(m2, 0x141); m2 = fmaxf(fminf(m1, o1), fmaxf(m2, o2)); m1 = fmaxf(m1, o1); }
                const float gs = m1 + m2;
                int grank = 0;
#pragma unroll
                for (int j = 0; j < 8; ++j) { const float sj = __int_as_float(__builtin_amdgcn_readlane(__float_as_int(gs), 8 * j)); grank += (sj > gs || (sj == gs && j < g)) ? 1 : 0; }
                float vm = grank < 4 ? v : -INFINITY;
#pragma unroll 1
                for (int r = 0; r < 8; ++r) {
                    const float mx = ml::lane63(ml::prefix_max64(vm, 0));
                    const unsigned long long bal = __ballot(vm == mx);
                    const int idx = __ffsll((long long)bal) - 1;
                    if (lane == idx) { esel[row * 8 + r] = lane; wsel[row * 8 + r] = sg; vm = -INFINITY; }
                }
            }
#undef DPPF
        }
        __syncthreads();
        int lrank = 0;
        if (tid < 256) lrank = __hip_atomic_fetch_add(hist + esel[tid], 1, __ATOMIC_RELAXED, __HIP_MEMORY_SCOPE_WORKGROUP);
        __syncthreads();
        if (tid < 64) { const int c_ = hist[tid]; hbase[tid] = c_ > 0 ? (int)atomicAdd(&cnt[tid * CNT_PAD], (u32)c_) : 0; }
        __syncthreads();
        if (tid < 256) {
            const int row = tid >> 3, k = tid & 7; float wsum = 0.f;
#pragma unroll
            for (int j = 0; j < 8; ++j) wsum += wsel[row * 8 + j];
            const int e = esel[tid]; const int mm = m0 + row;
            const int pos = hbase[e] + lrank;
            eidx[mm * 8 + k] = e; epos[mm * 8 + k] = pos;
            ((int*)(p.ws + WS_LTOK))[(size_t)e * MT + pos] = mm; ((float*)(p.ws + WS_LW))[(size_t)e * MT + pos] = wsel[tid] * (2.5f / wsum);
        }
        {
            const float* sh = modp(p, layer, bb, 3); const float* scl = modp(p, layer, bb, 4);
            const float rs0 = rstd_l[wave * 4 + 0], rs1 = rstd_l[wave * 4 + 1], rs2 = rstd_l[wave * 4 + 2], rs3 = rstd_l[wave * 4 + 3];
            const bf16* src = xbase + (size_t)(wave * 4) * D; unsigned char* dstb = (unsigned char*)HB + (size_t)(m0 + wave * 4) * D;
#pragma unroll 2
            for (int j = 0; j < 8; ++j) {
                const int c = 4 * lane + 256 * j;
                uint2 xv[4];
#pragma unroll
                for (int rr = 0; rr < 4; ++rr) xv[rr] = *(const uint2*)(src + (size_t)rr * D + c);
                const float4 g = *(const float4*)(gain + c), s1 = *(const float4*)(scl + c), s0 = *(const float4*)(sh + c);
                const float gx = g.x * (1.f + s1.x), gy = g.y * (1.f + s1.y), gz = g.z * (1.f + s1.z), gw_ = g.w * (1.f + s1.w);
#pragma unroll
                for (int rr = 0; rr < 4; ++rr) { const float rs = rr == 0 ? rs0 : rr == 1 ? rs1 : rr == 2 ? rs2 : rs3;
                    const float vx = __uint_as_float(xv[rr].x << 16), vy = __uint_as_float(xv[rr].x & 0xffff0000u), vz = __uint_as_float(xv[rr].y << 16), vw = __uint_as_float(xv[rr].y & 0xffff0000u);
                    *(u32*)(dstb + (size_t)rr * D + c) = pk4_fp8(vx * rs * gx + s0.x, vy * rs * gy + s0.y, vz * rs * gz + s0.z, vw * rs * gw_ + s0.w); }
            }
        }
        if (tid == 0) tq[1] = nxt_reg;
        __syncthreads();
        tile = __builtin_amdgcn_readfirstlane(tq[1]);
    }
}

enum Phase { PH_MODS = 0, PH_NORM0, PH_INPROJ0, PH_QKNORM, PH_ATTN0, PH_OUTPROJ0, PH_NORMR0, PH_DISP0, PH_G1_0, PH_G2_0, PH_COMB0,
             PH_INPROJ1, PH_MLSTM, PH_READOUT, PH_OUTPROJ1, PH_NORMR1, PH_DISP1, PH_G1_1, PH_G2_1, PH_COMB1, PH_COUNT };

#define XB_TMO      128
#define XB_XCNT(j)  (256  + 64 * (j))
#define XB_XSUB(j)  (1280 + 64 * (j))
#define XB_XGEN(j)  (2304 + 64 * (j))
#define XB_TOP      3328
#define XB_TOPGEN   3392
#define XCD_BAR_WORDS 3456
#define XB_SPIN_CAP (1u << 18)
__device__ __forceinline__ unsigned xb_ld(unsigned* p)              { return __hip_atomic_load(p, __ATOMIC_RELAXED, __HIP_MEMORY_SCOPE_AGENT); }
__device__ __forceinline__ unsigned xb_add(unsigned* p, unsigned v) { return __hip_atomic_fetch_add(p, v, __ATOMIC_RELAXED, __HIP_MEMORY_SCOPE_AGENT); }
__device__ __forceinline__ unsigned xb_xcc_id() { return (unsigned)__builtin_amdgcn_s_getreg((3 << 11) | 20) & 0xFu; }
#define XB_SPIN(cond, bar) do { unsigned _sp = 0; while (cond) { __builtin_amdgcn_s_sleep(1); \
    if ((++_sp & 255u) == 0u) { if (xb_ld(&(bar)[XB_TMO])) break; if (_sp > XB_SPIN_CAP) { atomicAdd(&(bar)[XB_TMO], 1u); break; } } } } while (0)
struct XcdBarrier { unsigned* bar; unsigned x; volatile LAS unsigned* st; };
__device__ __forceinline__ XcdBarrier xcd_barrier_post(unsigned* bar, volatile LAS unsigned* st) {
    XcdBarrier b; b.bar = bar; b.x = xb_xcc_id(); b.st = st;
    if (threadIdx.x == 0) (void)xb_add(&bar[XB_XCNT(b.x)], 1u);
    return b;
}
__device__ __forceinline__ void xcd_barrier_complete(unsigned* bar, unsigned x, unsigned& nloc, unsigned& nx) {
    const unsigned G = gridDim.x * gridDim.y * gridDim.z;
    unsigned sum, cnt, mine, sp = 0u;
    for (;;) {
        sum = 0u; cnt = 0u; mine = 0u;
#pragma unroll 1
        for (unsigned j = 0; j < 16; ++j) { const unsigned c = xb_ld(&bar[XB_XCNT(j)]); sum += c; cnt += (c > 0u) ? 1u : 0u; mine = (j == x) ? c : mine; }
        if (sum == G) break;
        __builtin_amdgcn_s_sleep(1);
        if ((++sp & 255u) == 0u) { if (xb_ld(&bar[XB_TMO])) break; if (sp > XB_SPIN_CAP) { atomicAdd(&bar[XB_TMO], 1u); break; } }
    }
    nloc = mine > 0u ? mine : 1u; nx = cnt > 0u ? cnt : 1u;
}
__device__ __forceinline__ void xcd_barrier(const XcdBarrier& b) {
    asm volatile("s_waitcnt vmcnt(0)" ::: "memory");
    __syncthreads();
    if (threadIdx.x == 0) {
        unsigned* bar = b.bar;
        __builtin_amdgcn_s_waitcnt(0);
        unsigned nloc = b.st[0], nx = b.st[1];
        if (nloc == 0u) { xcd_barrier_complete(bar, b.x, nloc, nx); b.st[0] = nloc; b.st[1] = nx; }
        const unsigned old = xb_add(&bar[XB_XSUB(b.x)], 1u);
        const unsigned gen = old / nloc;
        if (old + 1u == (gen + 1u) * nloc) {
            __builtin_amdgcn_fence(__ATOMIC_RELEASE, "agent");
            asm volatile("s_waitcnt vmcnt(0)" ::: "memory");
            const unsigned og = xb_add(&bar[XB_TOP], 1u);
            const unsigned tg = og / nx;
            if (og + 1u == (tg + 1u) * nx) xb_add(&bar[XB_TOPGEN], 1u);
            else XB_SPIN(xb_ld(&bar[XB_TOPGEN]) == tg, bar);
            __builtin_amdgcn_fence(__ATOMIC_ACQUIRE, "agent");
            xb_add(&bar[XB_XGEN(b.x)], 1u);
            asm volatile("s_waitcnt vmcnt(0)" ::: "memory");
        } else {
            XB_SPIN(xb_ld(&bar[XB_XGEN(b.x)]) == gen, bar);
            __builtin_amdgcn_fence(__ATOMIC_ACQUIRE, "agent");
            asm volatile("s_waitcnt vmcnt(0)" ::: "memory");
        }
    }
    __syncthreads();
}
constexpr int CW_BAR = 4096;
static_assert((CW_BAR + XCD_BAR_WORDS) * 4 <= (int)CTL_BYTES, "barrier words inside the memset region");

typedef const __attribute__((address_space(4))) Params* KArgs;
#if defined(__HIP_DEVICE_COMPILE__)
DEVI Params kargs() { KArgs k = (KArgs)__builtin_amdgcn_kernarg_segment_ptr(); asm volatile("" : "+s"(k)); Params q; q.x = k->x; q.c = k->c; q.ctx = k->ctx; q.c_ctx = k->c_ctx; q.ada_w = k->ada_w; q.ada_b = k->ada_b; q.norm_mix = k->norm_mix; q.norm_ffn = k->norm_ffn; q.attn_w_in = k->attn_w_in; q.attn_w_out = k->attn_w_out; q.attn_rpb = k->attn_rpb; q.attn_q_gain = k->attn_q_gain; q.attn_k_gain = k->attn_k_gain; q.ml_w_in = k->ml_w_in; q.ml_w_out = k->ml_w_out; q.ml_gate_b = k->ml_gate_b; q.ml_head_gain = k->ml_head_gain; q.router_w = k->router_w; q.router_b = k->router_b; q.exp_w1 = k->exp_w1; q.exp_w3 = k->exp_w3; q.exp_w2 = k->exp_w2; q.sh_w1 = k->sh_w1; q.sh_w3 = k->sh_w3; q.sh_w2 = k->sh_w2; q.final_norm = k->final_norm; q.out = k->out; q.ws = k->ws; q.lo = k->lo; q.hi = k->hi; return q; }
#else
DEVI Params kargs() { return Params{}; }
#endif
constexpr int MEGA_LDS = 157 * 1024;
static_assert(pg::LDS_TOTAL <= MEGA_LDS, "LDS map");
__global__ void __launch_bounds__(512, 2) k_mega(Params p) {
    extern __shared__ __attribute__((aligned(16))) unsigned char lds_raw[];
    LAS unsigned char* lds = (LAS unsigned char*)lds_raw;
    float* ldsf = (float*)lds_raw;
    const int G = gridDim.x, bx = blockIdx.x;
    const int vcu = (G % 8 == 0) ? (bx % 8) * (G / 8) + bx / 8 : bx;
    if (threadIdx.x < 16) ((LAS unsigned*)(lds + pg::MISC_OFF))[threadIdx.x] = 0u;
    __syncthreads();
    XcdBarrier bar; bar.bar = (unsigned*)(p.ws + WS_CTL) + CW_BAR; bar.x = 0; bar.st = nullptr;
    if (p.hi - p.lo > 1) bar = xcd_barrier_post((unsigned*)(p.ws + WS_CTL) + CW_BAR, (volatile LAS unsigned*)(lds + pg::MISC_OFF));
#ifndef SITEMASK
#define SITEMASK 0xFFFFFu
#endif
#define INF(k) (p.lo <= (k) && (k) < p.hi)
#define INS(site, k) (((SITEMASK >> (site)) & 1u) && INF(k))
#ifdef PROBE_REP
#define REPF(k) for (int rep_ = 0; rep_ < (((k) == PROBE_REP) ? 2 : 1); ++rep_)
#else
#define REPF(k)
#endif
#define SEAM(k) do { if (INF(k) && INF((k) + 1)) xcd_barrier(bar); } while (0)
    REPF(PH_MODS) if (INS(PH_MODS, PH_MODS)) { const Params q = kargs(); __syncthreads(); ph_mods(q, ldsf, vcu, G); __syncthreads(); ph_cvt(q, lds, vcu, G); }
    SEAM(PH_MODS);
    REPF(PH_NORM0) if (INS(PH_NORM0, PH_NORM0)) { const Params q = kargs(); ph_norm(q, 0, q.x, q.ctx, q.norm_mix, 0, 1, MT, vcu, G); ph_router_prep(q, ldsf, vcu, G); }
    SEAM(PH_NORM0);
    for (int layer = 0; layer < 2; ++layer) {
        const int po = 9 * layer;
        REPF(PH_INPROJ0 + po) if (INS(PH_INPROJ0, PH_INPROJ0 + po)) {
            const Params q = kargs();
            const int nN = layer == 0 ? AIW / 256 : MINP / 256;
            const int nu = pg::fill_dense(lds, MT / 256, nN, G, bx);
            __syncthreads();
            pg::ListOrder S{(const LAS int*)(lds + pg::UD_OFF), nu};
            EpiBf16Store E{(bf16*)(q.ws + WS_QKV), layer == 0 ? AIW : MIWM, (float*)(q.ws + WS_G), layer == 0 ? -1 : MIWM / 256, 1.f / W13_SCALE};
            pg::gemm_phase<EpiBf16Store, false, true>(lds, q.ws + WS_HB, q.ws + (layer == 0 ? WT_AIN : WT_MIN), D, 0, S, E);
        }
        SEAM(PH_INPROJ0 + po);
        if (layer == 0) {
            REPF(PH_QKNORM) if (INS(PH_QKNORM, PH_QKNORM)) { const Params q = kargs(); ph_qknorm(q, vcu, G); }
            SEAM(PH_QKNORM);
            REPF(PH_ATTN0) if (INS(PH_ATTN0, PH_ATTN0)) { const Params q = kargs(); ph_attn0(q, (char*)lds_raw, vcu, G); }
            SEAM(PH_ATTN0);
        } else {
            REPF(PH_MLSTM) if (INS(PH_MLSTM, PH_MLSTM)) { const Params q = kargs(); ml::ph_mlstm(q, (char*)lds_raw, vcu, G); }
            SEAM(PH_MLSTM);
            REPF(PH_READOUT) if (INS(PH_READOUT, PH_READOUT)) { const Params q = kargs(); ph_readout(q, vcu, G); }
            SEAM(PH_READOUT);
        }
        REPF(PH_OUTPROJ0 + po) if (INS(PH_OUTPROJ0, PH_OUTPROJ0 + po)) {
            const Params q = kargs();
            const int nu = pg::fill_dense(lds, (layer == 0 ? MT : ML) / 256, D / 256, G, bx);
            __syncthreads();
            pg::ListOrder S{(const LAS int*)(lds + pg::UD_OFF), nu};
            EpiResid E{(bf16*)(q.ws + WS_X), (const float*)(q.ws + WS_MOD) + (size_t)layer * 5 * 6 * D};
            pg::gemm_phase<EpiResid, false, true>(lds, q.ws + WS_AO, q.ws + (layer == 0 ? WT_AOUT : WT_MOUT), D, 0, S, E);
        }
        SEAM(PH_OUTPROJ0 + po);
        REPF(PH_NORMR0 + po) if (INS(PH_NORMR0, PH_NORMR0 + po)) { const Params q = kargs(); ph_normr2(q, layer, layer == 0 ? MT : ML, ldsf, vcu, G); }
        SEAM(PH_NORMR0 + po);
        REPF(PH_G1_0 + po) if (INS(PH_G1_0, PH_G1_0 + po)) {
            const Params q = kargs();
            const int nu = moe_setup<true>(q, lds, layer, layer == 0 ? MT : ML, vcu, G);
            pg::ListOrder S{(const LAS int*)(lds + pg::UD_OFF), nu};
            EpiSwiGLU E{(bf16*)(q.ws + WS_ACT)};
            pg::gemm_phase<EpiSwiGLU, true, true>(lds, q.ws + WS_HB, q.ws + WT_W13 + (size_t)layer * 65 * 1024 * D, D, (size_t)1024 * D, S, E);
        }
        SEAM(PH_G1_0 + po);
        REPF(PH_G2_0 + po) if (INS(PH_G2_0, PH_G2_0 + po)) {
            const Params q = kargs();
            const int nu = moe_setup<false>(q, lds, layer, layer == 0 ? MT : ML, vcu, G);
            pg::ListOrder S{(const LAS int*)(lds + pg::UD_OFF), nu};
            EpiScale E{(unsigned char*)(q.ws + WS_Y), (const LAS float*)(lds + pg::GT_OFF)};
            pg::gemm_phase<EpiScale, false, true>(lds, q.ws + WS_ACT, q.ws + WT_W2 + (size_t)layer * 65 * D * EDIM, EDIM, (size_t)D * EDIM, S, E);
        }
        SEAM(PH_G2_0 + po);
        REPF(PH_COMB0 + po) if (INS(PH_COMB0, PH_COMB0 + po)) { const Params q = kargs(); ph_combine(q, layer, (int*)ldsf, vcu, G); }
        if (layer == 0) SEAM(PH_COMB0);
    }
#undef INF
#undef INS
#undef SEAM
}

#ifndef N_LAUNCH
#define N_LAUNCH 1
#endif
extern "C" void kernel_launch(void* const* d_in, const int* in_sizes, int n_in, void* d_out, int out_size, void* d_ws, size_t ws_size, hipStream_t stream) {
    static int grid = 0;
    if (grid == 0) {
        if (n_in != 26 || out_size != ML * D || ws_size < WS_END) { fprintf(stderr, "kernel_launch: unexpected shapes n_in %d out %d ws %zu\n", n_in, out_size, ws_size); grid = -1; return; }
        int dev = 0, cus = 0, per_cu = 0;
        if (hipGetDevice(&dev) != hipSuccess || hipDeviceGetAttribute(&cus, hipDeviceAttributeMultiprocessorCount, dev) != hipSuccess) { fprintf(stderr, "kernel_launch: device query failed\n"); grid = -1; return; }
        if (hipFuncSetAttribute((const void*)k_mega, hipFuncAttributeMaxDynamicSharedMemorySize, MEGA_LDS) != hipSuccess) { fprintf(stderr, "kernel_launch: hipFuncSetAttribute failed\n"); grid = -1; return; }
        if (hipOccupancyMaxActiveBlocksPerMultiprocessor(&per_cu, (const void*)k_mega, 512, MEGA_LDS) != hipSuccess || per_cu < 1) fprintf(stderr, "kernel_launch: note: occupancy query reports %d blocks per CU\n", per_cu);
        (void)hipGetLastError();
        grid = cus;
    }
    if (grid < 0) return;
    (void)hipMemsetAsync((char*)d_ws + WS_CTL, 0, CTL_BYTES, stream);
    Params p{};
    const float** pp = (const float**)&p;
    for (int i = 0; i < 26; ++i) pp[i] = (const float*)d_in[i];
    p.out = (float*)d_out; p.ws = (unsigned char*)d_ws;
#if N_LAUNCH == 1
    p.lo = 0; p.hi = PH_COUNT;
    hipLaunchKernelGGL(k_mega, dim3(grid), dim3(512), MEGA_LDS, stream, p);
#else
    for (int ph = 0; ph < PH_COUNT; ++ph) { p.lo = ph; p.hi = ph + 1; hipLaunchKernelGGL(k_mega, dim3(grid), dim3(512), MEGA_LDS, stream, p); }
#endif
    const hipError_t le = hipPeekAtLastError();
    if (le != hipSuccess) fprintf(stderr, "kernel_launch: launch failed: %s\n", hipGetErrorName(le));
}
```

```cpp
#include <hip/hip_runtime.h>
#include <cstdio>
#include <cstdint>
#include <type_traits>

#define DEVI __device__ __forceinline__
#define LAS __attribute__((address_space(3)))
typedef short bf16x8 __attribute__((ext_vector_type(8)));
typedef float f32x4 __attribute__((ext_vector_type(4)));
typedef unsigned u32x4 __attribute__((ext_vector_type(4)));
typedef int v4i32 __attribute__((ext_vector_type(4)));
typedef int v8i32 __attribute__((ext_vector_type(8)));
typedef unsigned short bf16;
typedef unsigned int u32;

constexpr int D = 2048, NB = 4, SEQ = 4096, CTXL = 256, GRIDW = 64;
constexpr int ML = NB * SEQ;
constexpr int MC = NB * CTXL;
constexpr int MT = ML + MC;
constexpr int AIW = 4608;
constexpr int MIW = 6176, MIWM = 6144;
constexpr int NE = 64, TOPK = 8, EDIM = 512;
constexpr int RS = MT * 8 + 64 * 256;
constexpr int SH0 = RS;
constexpr int NSLOT = RS + MT;
constexpr float EPS = 1e-6f;
constexpr float QSCALE = 0.08838834764831845f;

constexpr size_t MiB = (size_t)1 << 20;
constexpr size_t WS_CTL = 0, CTL_BYTES = 1 * MiB;
constexpr size_t WS_MOD = 1 * MiB;
constexpr size_t WS_XC = 2 * MiB;
constexpr size_t WS_G = 10 * MiB;
constexpr size_t WS_EIDX = 13 * MiB, WS_EW = 14 * MiB, WS_EPOS = 15 * MiB, WS_TSLOT = 16 * MiB, WS_STOK = 17 * MiB, WS_SW = 18 * MiB, WS_EOFF = 19 * MiB;
constexpr size_t WS_HB = 20 * MiB;
constexpr size_t WS_ACT = 88 * MiB;
constexpr size_t WS_Y = 257 * MiB;
constexpr size_t WS_QKV = 257 * MiB;
constexpr size_t WS_AO = 461 * MiB;
constexpr size_t WS_HD = 529 * MiB;
constexpr size_t WS_WT = 933 * MiB;
constexpr size_t WS_RWP = 1772 * MiB;
constexpr size_t WS_RC = 1777 * MiB;
constexpr size_t WS_LTOK = 1780 * MiB;
constexpr size_t WS_LW = 1785 * MiB;
constexpr size_t WS_X = 1790 * MiB;
constexpr size_t WS_END = 1858 * MiB;
constexpr int CW_TQ = 24576;
constexpr int CW_CNT = 16384, CNT_PAD = 32;

struct Params {
    const float *x, *c, *ctx, *c_ctx, *ada_w, *ada_b, *norm_mix, *norm_ffn, *attn_w_in, *attn_w_out, *attn_rpb, *attn_q_gain, *attn_k_gain,
        *ml_w_in, *ml_w_out, *ml_gate_b, *ml_head_gain, *router_w, *router_b, *exp_w1, *exp_w3, *exp_w2, *sh_w1, *sh_w3, *sh_w2, *final_norm;
    float* out; unsigned char* ws;
    int lo, hi;
};

DEVI int otid() { int t = threadIdx.x; asm volatile("" : "+v"(t)); return t; }
DEVI float bf2f(bf16 b) { return __uint_as_float(((u32)b) << 16); }
DEVI bf16 f2bf(float f) { u32 u = __float_as_uint(f); u += 0x7fffu + ((u >> 16) & 1u); return (bf16)(u >> 16); }
DEVI u32 pk2(float lo, float hi) { return (u32)f2bf(lo) | ((u32)f2bf(hi) << 16); }
DEVI float wave_sum(float v) {
#pragma unroll
    for (int o = 32; o >= 1; o >>= 1) v += __shfl_xor(v, o);
    return v;
}
DEVI unsigned pg_cvt_pk_bf16(float lo, float hi) { unsigned r; asm volatile("v_cvt_pk_bf16_f32 %0, %1, %2" : "=v"(r) : "v"(lo), "v"(hi)); return r; }
DEVI float wave_prefix_dpp(float x) {
#define WS_DPP(ctrl, rmask) x += __int_as_float(__builtin_amdgcn_update_dpp(0, __float_as_int(x), ctrl, rmask, 0xf, false))
    WS_DPP(0x111, 0xf); WS_DPP(0x112, 0xf); WS_DPP(0x114, 0xf); WS_DPP(0x118, 0xf); WS_DPP(0x142, 0xa); WS_DPP(0x143, 0xc);
#undef WS_DPP
    return x;
}
DEVI float wave_sum_dpp(float x) {
#define WS_DPP(ctrl, rmask) x += __int_as_float(__builtin_amdgcn_update_dpp(0, __float_as_int(x), ctrl, rmask, 0xf, false))
    WS_DPP(0x111, 0xf); WS_DPP(0x112, 0xf); WS_DPP(0x114, 0xf); WS_DPP(0x118, 0xf); WS_DPP(0x142, 0xa); WS_DPP(0x143, 0xc);
#undef WS_DPP
    return __int_as_float(__builtin_amdgcn_readlane(__float_as_int(x), 63));
}
DEVI u32 pk4_fp8(float a, float b, float c, float d) { int w = 0; w = __builtin_amdgcn_cvt_pk_fp8_f32(a, b, w, false); w = __builtin_amdgcn_cvt_pk_fp8_f32(c, d, w, true); return (u32)w; }
DEVI int bidx(int m) { return m < ML ? (m >> 12) : 4; }
DEVI int row_of_trip(int vcu, int wave, int k, int nrows, int G) {
    if (G == 256) { if (k < 8) return vcu * 8 + wave + k * 2048; return (k == 8 && nrows > ML && wave < 4) ? ML + vcu * 4 + wave : -1; }
    const int m = vcu * 8 + wave + k * G * 8; return m < nrows ? m : -1;
}
DEVI const float* modp(const Params& p, int layer, int bb, int i) { return (const float*)(p.ws + WS_MOD) + ((size_t)((layer * 5 + bb) * 6 + i)) * D; }
DEVI float silu(float x) { return x / (1.f + __expf(-x)); }
DEVI float sigmoidf(float x) { return 1.f / (1.f + __expf(-x)); }

DEVI void ph_mods(const Params& p, float* lds, int vcu, int G) {
    float* sc = lds;
    float* red = lds + 5 * D;
    const int tid = otid();
    for (int i = tid; i < 5 * D; i += 512) { const int bb = i / D, k = i % D; const float v = bb < 4 ? p.c[bb * D + k] : p.c_ctx[k]; sc[i] = silu(v); }
    __syncthreads();
    const int tn = tid & 7, tk = tid >> 3;
    for (int item = vcu; item < 2 * 384; item += G) {
        const int l = item / 384, n0 = (item % 384) * 32;
        const float* W = p.ada_w + (size_t)l * D * 12288 + n0 + tn * 4;
        float4 acc[5];
#pragma unroll
        for (int b = 0; b < 5; ++b) acc[b] = make_float4(0.f, 0.f, 0.f, 0.f);
#pragma unroll 1
        for (int k8 = 0; k8 < 4; ++k8) {
            float4 w[8];
#pragma unroll
            for (int j = 0; j < 8; ++j) w[j] = *(const float4*)(W + (size_t)(tk * 32 + k8 * 8 + j) * 12288);
#pragma unroll
            for (int j = 0; j < 8; ++j) { const int k = tk * 32 + k8 * 8 + j;
#pragma unroll
                for (int b = 0; b < 5; ++b) { const float s_ = sc[b * D + k]; acc[b].x += s_ * w[j].x; acc[b].y += s_ * w[j].y; acc[b].z += s_ * w[j].z; acc[b].w += s_ * w[j].w; } }
        }
#pragma unroll
        for (int b = 0; b < 5; ++b) *(float4*)(red + (tk * 5 + b) * 32 + tn * 4) = acc[b];
        __syncthreads();
        if (tid < 160) {
            const int b = tid / 32, n = tid % 32; float s_ = 0.f;
            for (int g = 0; g < 64; ++g) s_ += red[(g * 5 + b) * 32 + n];
            ((float*)(p.ws + WS_MOD))[(size_t)(l * 5 + b) * 12288 + n0 + n] = s_ + p.ada_b[l * 12288 + n0 + n];
        }
        __syncthreads();
    }
}

DEVI void norm_row_load(const float* src, float4 (&v)[8], float& rstd, int lane) {
    float ss = 0.f;
#pragma unroll
    for (int j = 0; j < 8; ++j) { v[j] = *(const float4*)(src + 4 * lane + 256 * j); ss += v[j].x * v[j].x + v[j].y * v[j].y + v[j].z * v[j].z + v[j].w * v[j].w; }
    ss = wave_sum(ss);
    rstd = rsqrtf(ss * (1.f / D) + EPS);
}
DEVI void ph_norm(const Params& p, int layer, const float* xlat, const float* xctx, const float* gain, int ish, int isc, int nrows, int vcu, int G) {
    const int tid = otid(), lane = tid & 63, wave = tid >> 6;
    bf16* HB = (bf16*)(p.ws + WS_HB); bf16* X = (bf16*)(p.ws + WS_X);
    const int rot = (vcu * 8 + wave) & 7;
    for (int t_ = 0;; ++t_) {
        const int mA = row_of_trip(vcu, wave, 2 * t_, nrows, G); if (mA < 0) break;
        const int mB_ = row_of_trip(vcu, wave, 2 * t_ + 1, nrows, G), mB = mB_ < 0 ? mA : mB_;
        const float* srcA = mA < ML ? xlat + (size_t)mA * D : xctx + (size_t)(mA - ML) * D;
        const float* srcB = mB < ML ? xlat + (size_t)mB * D : xctx + (size_t)(mB - ML) * D;
        float4 vA[8], vB[8]; float ssA = 0.f, ssB = 0.f;
#pragma unroll
        for (int j = 0; j < 8; ++j) { vA[j] = *(const float4*)(srcA + 4 * lane + 256 * ((j + rot) & 7)); vB[j] = *(const float4*)(srcB + 4 * lane + 256 * ((j + rot) & 7)); }
#pragma unroll
        for (int j = 0; j < 8; ++j) { ssA += vA[j].x * vA[j].x + vA[j].y * vA[j].y + vA[j].z * vA[j].z + vA[j].w * vA[j].w; ssB += vB[j].x * vB[j].x + vB[j].y * vB[j].y + vB[j].z * vB[j].z + vB[j].w * vB[j].w; }
        const float rstdA = rsqrtf(wave_sum_dpp(ssA) * (1.f / D) + EPS), rstdB = rsqrtf(wave_sum_dpp(ssB) * (1.f / D) + EPS);
        const int bA = bidx(mA), bB = bidx(mB);
        const float* shA = modp(p, layer, bA, ish); const float* sclA = modp(p, layer, bA, isc); const float* shB = modp(p, layer, bB, ish); const float* sclB = modp(p, layer, bB, isc);
#pragma unroll
        for (int j = 0; j < 8; ++j) {
            const int c = 4 * lane + 256 * ((j + rot) & 7);
            const float4 g = *(const float4*)(gain + c), s1 = *(const float4*)(sclA + c), s0 = *(const float4*)(shA + c), t1 = *(const float4*)(sclB + c), t0 = *(const float4*)(shB + c);
            *(u32*)((unsigned char*)HB + (size_t)mA * D + c) = pk4_fp8(vA[j].x * rstdA * g.x * (1.f + s1.x) + s0.x, vA[j].y * rstdA * g.y * (1.f + s1.y) + s0.y, vA[j].z * rstdA * g.z * (1.f + s1.z) + s0.z, vA[j].w * rstdA * g.w * (1.f + s1.w) + s0.w);
            *(u32*)((unsigned char*)HB + (size_t)mB * D + c) = pk4_fp8(vB[j].x * rstdB * g.x * (1.f + t1.x) + t0.x, vB[j].y * rstdB * g.y * (1.f + t1.y) + t0.y, vB[j].z * rstdB * g.z * (1.f + t1.z) + t0.z, vB[j].w * rstdB * g.w * (1.f + t1.w) + t0.w);
            uint2 xw; xw.x = pk2(vA[j].x, vA[j].y); xw.y = pk2(vA[j].z, vA[j].w); *(uint2*)(X + (size_t)mA * D + c) = xw;
            uint2 yw; yw.x = pk2(vB[j].x, vB[j].y); yw.y = pk2(vB[j].z, vB[j].w); *(uint2*)(X + (size_t)mB * D + c) = yw;
        }
    }
}

DEVI void ph_qknorm(const Params& p, int vcu, int G) {
    const int tid = otid(), lane = tid & 63, wave = tid >> 6;
    bf16* Q = (bf16*)(p.ws + WS_QKV);
    const float invf = exp2f(-(float)(lane & 31) * (13.287712379549449f / 32.f));
    const float gq0 = p.attn_q_gain[2 * lane], gq1 = p.attn_q_gain[2 * lane + 1], gk0 = p.attn_k_gain[2 * lane], gk1 = p.attn_k_gain[2 * lane + 1];
    for (int k_ = 0;; ++k_) { const int m = row_of_trip(vcu, wave, k_, MT, G); if (m < 0) break;
        bf16* ptr = Q + (size_t)m * AIW + 3072 + 2 * lane;
        u32 v[10];
#pragma unroll
        for (int hh = 0; hh < 10; ++hh) v[hh] = *(const u32*)(ptr + hh * 128);
        float sn = 0.f, cs = 1.f;
        if (m < ML) { const int sq = m & 4095; const float pos = lane < 32 ? (float)(sq >> 6) : (float)(sq & 63);
            sn = __sinf(pos * invf); cs = __cosf(pos * invf); }
#pragma unroll
        for (int hh = 0; hh < 10; ++hh) {
            float x0 = __uint_as_float(v[hh] << 16), x1 = __uint_as_float(v[hh] & 0xffff0000u);
            const float ss = wave_sum_dpp(x0 * x0 + x1 * x1); const float rstd = rsqrtf(ss * (1.f / 128.f) + EPS);
            x0 = x0 * rstd * (hh < 8 ? gq0 : gk0); x1 = x1 * rstd * (hh < 8 ? gq1 : gk1);
            const float y0 = x0 * cs - x1 * sn, y1 = x0 * sn + x1 * cs;
            *(u32*)(ptr + hh * 128) = pk2(y0, y1);
        }
    }
}

DEVI void ph_readout(const Params& p, int vcu, int G) {
    const int tid = otid(), lane = tid & 63, wave = tid >> 6;
    const bf16* HD = (const bf16*)(p.ws + WS_HD); const bf16* Q = (const bf16*)(p.ws + WS_QKV); bf16* AO = (bf16*)(p.ws + WS_AO);
    float4 g[8];
#pragma unroll
    for (int h = 0; h < 8; ++h) g[h] = *(const float4*)(p.ml_head_gain + h * 256 + 4 * lane);
    typedef unsigned u32x2_ __attribute__((ext_vector_type(2)));
    for (int m = vcu * 8 + wave; m < ML; m += G * 8) {
        u32x2_ a[8], b2[8], ov[8];
#pragma unroll
        for (int h = 0; h < 8; ++h) { const int c = h * 256 + 4 * lane;
            a[h] = __builtin_nontemporal_load((const u32x2_*)(HD + (size_t)m * D + c)); b2[h] = __builtin_nontemporal_load((const u32x2_*)(HD + ((size_t)ML + m) * D + c));
            ov[h] = __builtin_nontemporal_load((const u32x2_*)(Q + (size_t)m * MIWM + 4096 + c)); }
#pragma unroll
        for (int h = 0; h < 8; ++h) { const int c = h * 256 + 4 * lane;
            const float x[4] = {__uint_as_float(a[h].x << 16) + __uint_as_float(b2[h].x << 16), __uint_as_float(a[h].x & 0xffff0000u) + __uint_as_float(b2[h].x & 0xffff0000u),
                                __uint_as_float(a[h].y << 16) + __uint_as_float(b2[h].y << 16), __uint_as_float(a[h].y & 0xffff0000u) + __uint_as_float(b2[h].y & 0xffff0000u)};
            const float ss = wave_sum_dpp(x[0] * x[0] + x[1] * x[1] + x[2] * x[2] + x[3] * x[3]); const float rstd = rsqrtf(ss * (1.f / 256.f) + EPS);
            const float o0 = __uint_as_float(ov[h].x << 16), o1 = __uint_as_float(ov[h].x & 0xffff0000u), o2 = __uint_as_float(ov[h].y << 16), o3 = __uint_as_float(ov[h].y & 0xffff0000u);
            const float s0 = __builtin_amdgcn_rcpf(1.f + __expf(-o0)), s1 = __builtin_amdgcn_rcpf(1.f + __expf(-o1)), s2 = __builtin_amdgcn_rcpf(1.f + __expf(-o2)), s3 = __builtin_amdgcn_rcpf(1.f + __expf(-o3));
            *(u32*)((unsigned char*)AO + (size_t)m * D + c) = pk4_fp8(x[0] * rstd * g[h].x * s0, x[1] * rstd * g[h].y * s1, x[2] * rstd * g[h].z * s2, x[3] * rstd * g[h].w * s3);
        }
    }
}

DEVI void ph_combine(const Params& p, int layer, int* offl, int vcu, int G) {
    const int tid = otid(), lane = tid & 63, wave = tid >> 6;
    const unsigned char* Y = (const unsigned char*)(p.ws + WS_Y);
    unsigned char* HB = (unsigned char*)(p.ws + WS_HB); bf16* X = (bf16*)(p.ws + WS_X);
    const int nrows = layer == 0 ? MT : ML;
    {
        const u32* cnt = (const u32*)(p.ws + WS_CTL) + CW_CNT + layer * 64 * CNT_PAD;
        if (tid < 64) { const int c_ = (int)cnt[tid * CNT_PAD]; const int pc = (c_ + 255) & ~255; offl[64 + tid] = c_; offl[tid] = (int)wave_prefix_dpp((float)pc) - pc; }
        __syncthreads();
    }
    const int* eidx = (const int*)(p.ws + WS_EIDX); const int* epos = (const int*)(p.ws + WS_EPOS);
    for (int k_ = 0;; ++k_) {
        const int m = row_of_trip(vcu, wave, k_, nrows, G); if (m < 0) break;
        bf16* xr = X + (size_t)m * D; float* orow = p.out + (size_t)m * D;
        const int bb = bidx(m); const float* g5 = modp(p, layer, bb, 5);
        int sl[9];
#pragma unroll
        for (int k = 0; k < 8; ++k) sl[k] = offl[eidx[m * 8 + k]] + epos[m * 8 + k];
        sl[8] = SH0 + m;
        u32x4 y[2][9], xv[2][2];
#pragma unroll
        for (int j = 0; j < 2; ++j) {
#pragma unroll
            for (int k = 0; k < 9; ++k) y[j][k] = __builtin_nontemporal_load((const u32x4*)(Y + (size_t)sl[k] * D + j * 1024 + lane * 16));
            xv[j][0] = *(const u32x4*)(xr + j * 1024 + lane * 16); xv[j][1] = *(const u32x4*)(xr + j * 1024 + lane * 16 + 8);
        }
        float o[32]; float ss = 0.f;
#pragma unroll
        for (int j = 0; j < 2; ++j) {
            const int c = j * 1024 + lane * 16;
            float f[16];
#pragma unroll
            for (int i = 0; i < 16; ++i) f[i] = 0.f;
#pragma unroll
            for (int k = 0; k < 9; ++k) {
                const unsigned yy[4] = {y[j][k].x, y[j][k].y, y[j][k].z, y[j][k].w};
#pragma unroll
                for (int q = 0; q < 4; ++q) { const auto lo = __builtin_amdgcn_cvt_pk_f32_fp8((int)yy[q], false), hi = __builtin_amdgcn_cvt_pk_f32_fp8((int)yy[q], true);
                    f[4 * q + 0] += lo[0]; f[4 * q + 1] += lo[1]; f[4 * q + 2] += hi[0]; f[4 * q + 3] += hi[1]; }
            }
            const unsigned xw[8] = {xv[j][0].x, xv[j][0].y, xv[j][0].z, xv[j][0].w, xv[j][1].x, xv[j][1].y, xv[j][1].z, xv[j][1].w};
#pragma unroll
            for (int q = 0; q < 4; ++q) {
                const float4 g0 = *(const float4*)(g5 + c + 4 * q);
                const float o0 = __uint_as_float(xw[2 * q] << 16) + g0.x * f[4 * q + 0] * (1.f / 8.f), o1 = __uint_as_float(xw[2 * q] & 0xffff0000u) + g0.y * f[4 * q + 1] * (1.f / 8.f);
                const float o2 = __uint_as_float(xw[2 * q + 1] << 16) + g0.z * f[4 * q + 2] * (1.f / 8.f), o3 = __uint_as_float(xw[2 * q + 1] & 0xffff0000u) + g0.w * f[4 * q + 3] * (1.f / 8.f);
                ss += o0 * o0 + o1 * o1 + o2 * o2 + o3 * o3;
                o[j * 16 + 4 * q + 0] = o0; o[j * 16 + 4 * q + 1] = o1; o[j * 16 + 4 * q + 2] = o2; o[j * 16 + 4 * q + 3] = o3;
            }
        }
        const float rstd = rsqrtf(wave_sum_dpp(ss) * (1.f / D) + EPS);
        const float* gain = layer == 0 ? p.norm_mix + D : p.final_norm;
        const float* sh = modp(p, 1, bb, 0); const float* scl = modp(p, 1, bb, 1);
#pragma unroll
        for (int j = 0; j < 2; ++j) {
            const int c = j * 1024 + lane * 16;
            if (layer == 0) {
                u32x4 w0, w1, ob;
#pragma unroll
                for (int q = 0; q < 4; ++q) {
                    const float4 g0 = *(const float4*)(gain + c + 4 * q), a0 = *(const float4*)(scl + c + 4 * q), b0 = *(const float4*)(sh + c + 4 * q);
                    const float x0 = o[j * 16 + 4 * q + 0], x1 = o[j * 16 + 4 * q + 1], x2 = o[j * 16 + 4 * q + 2], x3 = o[j * 16 + 4 * q + 3];
                    const unsigned p0 = pg_cvt_pk_bf16(x0, x1), p1 = pg_cvt_pk_bf16(x2, x3);
                    if (q < 2) { w0[2 * q] = p0; w0[2 * q + 1] = p1; } else { w1[2 * (q - 2)] = p0; w1[2 * (q - 2) + 1] = p1; }
                    ob[q] = pk4_fp8(x0 * rstd * g0.x * (1.f + a0.x) + b0.x, x1 * rstd * g0.y * (1.f + a0.y) + b0.y, x2 * rstd * g0.z * (1.f + a0.z) + b0.z, x3 * rstd * g0.w * (1.f + a0.w) + b0.w);
                }
                *(u32x4*)(xr + c) = w0; *(u32x4*)(xr + c + 8) = w1;
                *(u32x4*)(HB + (size_t)m * D + c) = ob;
            } else {
#pragma unroll
                for (int q = 0; q < 4; ++q) {
                    const float4 g0 = *(const float4*)(gain + c + 4 * q);
                    float4 r0; r0.x = o[j * 16 + 4 * q + 0] * rstd * g0.x; r0.y = o[j * 16 + 4 * q + 1] * rstd * g0.y; r0.z = o[j * 16 + 4 * q + 2] * rstd * g0.z; r0.w = o[j * 16 + 4 * q + 3] * rstd * g0.w;
                    *(float4*)(orow + c + 4 * q) = r0;
                }
            }
        }
    }
}

namespace pg {
struct Frag2 { bf16x8 k[2]; };
template <bool F8> struct FragT { typedef Frag2 T; };
template <> struct FragT<true> { typedef v8i32 T; };
constexpr int BM = 256, BK = 64, HALF = 128, HTB = HALF * BK * 2, STAGE_BYTES = 8 * HTB, NXCD = 8, WGM = 8;
__host__ __device__ __forceinline__ int lds_byte(int r, int c) { const int st = (r >> 4) * 2 + (c >> 5), rr = r & 15, cc = c & 31, ob = rr * 64 + cc * 2; return st * 1024 + (ob ^ (((ob >> 9) & 1) << 5)); }
__host__ __device__ __forceinline__ void stage_rc(int b, int& R, int& C) { const int st = b / 1024, sb = b % 1024, swz = sb ^ (((sb >> 9) & 1) << 5); R = (st >> 1) * 16 + swz / 64; C = (st & 1) * 32 + (swz % 64) / 2; }
__host__ __device__ __forceinline__ int perm32(int rho) { const int n = rho >> 4, i = rho & 15; return 8 * (i >> 2) + 4 * n + (i & 3); }
DEVI unsigned cvt_pk_bf16(float lo, float hi) { unsigned r; asm volatile("v_cvt_pk_bf16_f32 %0, %1, %2" : "=v"(r) : "v"(lo), "v"(hi)); return r; }

struct Unit { int pm, pn, e; };
constexpr int GT_OFF = STAGE_BYTES;
constexpr int UD_OFF = GT_OFF + 24 * 256 * 4;
constexpr int EO_OFF = UD_OFF + 32 * 16;
constexpr int MISC_OFF = EO_OFF + 136 * 4;
constexpr int LDS_TOTAL = MISC_OFF + 64;

struct ListOrder {
    const LAS int* ud; int nu;
    DEVI bool next(int i, Unit& u) const {
        if (i >= nu) return false;
        u.pm = __builtin_amdgcn_readfirstlane(ud[i * 4 + 0]); u.pn = __builtin_amdgcn_readfirstlane(ud[i * 4 + 1]); u.e = __builtin_amdgcn_readfirstlane(ud[i * 4 + 2]); return true;
    }
};
DEVI bool dense_unit(int nM, int nN, int G, int c, int i, Unit& u) {
    const int nwg = nM * nN; const long L = (long)i * G + c; if (L >= nwg) return false;
    int wgid = (int)L; { const int q = nwg / NXCD, r = nwg % NXCD, xcd = wgid % NXCD, off = wgid / NXCD; wgid = (xcd < r ? xcd * (q + 1) : r * (q + 1) + (xcd - r) * q) + off; }
    const int nig = WGM * nN, gid = wgid / nig, fm = gid * WGM, gsz = (nM - fm) < WGM ? (nM - fm) : WGM;
    u.pm = fm + ((wgid % nig) % gsz); u.pn = (wgid % nig) / gsz; u.e = 0; return true;
}
DEVI int fill_dense(LAS unsigned char* lds, int nM, int nN, int G, int c) {
    LAS int* ud = (LAS int*)(lds + UD_OFF); int nu = 0;
    for (int i = 0; i < 32; ++i) { Unit u; if (!dense_unit(nM, nN, G, c, i, u)) break; if (otid() == 0) { ud[i * 4 + 0] = u.pm; ud[i * 4 + 1] = u.pn; ud[i * 4 + 2] = 0; } ++nu; }
    return nu;
}

template <class Epi, bool GATHER, bool F8 = false>
DEVI void gemm_phase(LAS unsigned char* lds, const void* A, const void* Bt, int KB, size_t bgroup_bytes, const ListOrder& S, const Epi& E) {
    const int tid = otid();
    const int wid = __builtin_amdgcn_readfirstlane(tid >> 6), lane = tid & 63, wr = wid >> 2, wc = wid & 3, fr = lane & 15, fq = lane >> 4;
    const int nt = KB / 128;
    const LAS int* gtab = (const LAS int*)(lds + GT_OFF);
    unsigned voffA[2], voffB[2];
#pragma unroll
    for (int i = 0; i < 2; ++i) { int R, C; stage_rc(tid * 16 + i * 8192, R, C); const int Rb = Epi::B16 ? (64 * (R >> 5) + 16 * ((R & 15) >> 2) + 4 * ((R >> 4) & 1) + (R & 3)) : (Epi::PERM ? ((R & ~31) + perm32(R & 31)) : R);
        voffA[i] = GATHER ? (unsigned)(C * 2) : (unsigned)(R * KB + C * 2); voffB[i] = (unsigned)(Rb * KB + C * 2); }
    const size_t kstep = (size_t)(BK * 2);
    const size_t hstep = (size_t)HALF * KB;
    const size_t bhs = Epi::B16 ? (size_t)8 * KB : hstep;
    const size_t tstep = 2 * hstep;
    const unsigned ldsw = (unsigned)wid * 1024u;
    const int aoff = lds_byte(wr * 64 + fr, fq * 8); int boff = 4 * HTB + lds_byte(wc * 32 + fr, fq * 8); asm volatile("" : "+v"(boff));
#define PG_SA(b, h) (((b) * 2 + (h)) * HTB)
#define PG_SB(b, h) ((4 + (b) * 2 + (h)) * HTB)
#define PG_STAGE(bufoff, gbase, voff) do { _Pragma("unroll") for (int _i = 0; _i < 2; ++_i) \
        __builtin_amdgcn_global_load_lds((const unsigned*)((const char*)(gbase) + (voff)[_i]), (LAS unsigned*)(lds + (bufoff) + ldsw + _i * 8192), 16, 0, 0); } while (0)
#define PG_STAGE_A(bufoff, abase, h, goff) do { if constexpr (GATHER) { PG_STAGE(bufoff, abase, goff[h]); } else { PG_STAGE(bufoff, (abase) + (h) * hstep, voffA); } } while (0)
#define PG_LD1(dst, addr) do { if constexpr (F8) { const v4i32 lo_ = *(const LAS v4i32*)(lds + (addr)), hi_ = *(const LAS v4i32*)(lds + (addr) + 1024); dst = __builtin_shufflevector(lo_, hi_, 0, 1, 2, 3, 4, 5, 6, 7); } \
        else { dst.k[0] = *(const LAS bf16x8*)(lds + (addr)); dst.k[1] = *(const LAS bf16x8*)(lds + (addr) + 1024); } } while (0)
#define PG_LDA(dst, b, h) do { _Pragma("unroll") for (int m = 0; m < 4; ++m) PG_LD1(dst[m], PG_SA(b, h) + aoff + m * 2048); } while (0)
#define PG_LDB(dst, b, h) do { _Pragma("unroll") for (int n = 0; n < 2; ++n) PG_LD1(dst[n], boff + ((b) * 2 + (h)) * HTB + n * 2048); } while (0)
#define PG_MMA(ai, bj, At, Bt_) do { __builtin_amdgcn_s_setprio(1); _Pragma("unroll") for (int m = 0; m < 4; ++m) _Pragma("unroll") for (int n = 0; n < 2; ++n) { \
        if constexpr (F8) { asm volatile("v_mfma_scale_f32_16x16x128_f8f6f4 %0, %1, %2, %0, %3, %3 op_sel_hi:[0,0,0]" : "+v"(acc[ai][bj][m][n]) : "v"(Bt_[n]), "v"(At[m]), "v"(sc1)); } \
        else { _Pragma("unroll") for (int k = 0; k < 2; ++k) acc[ai][bj][m][n] = __builtin_amdgcn_mfma_f32_16x16x32_bf16(Bt_[n].k[k], At[m].k[k], acc[ai][bj][m][n], 0, 0, 0); } } \
        __builtin_amdgcn_s_setprio(0); } while (0)
#define PG_MMAZ(ai, bj, At, Bt_) do { __builtin_amdgcn_s_setprio(1); _Pragma("unroll") for (int m = 0; m < 4; ++m) _Pragma("unroll") for (int n = 0; n < 2; ++n) \
        asm volatile("v_mfma_scale_f32_16x16x128_f8f6f4 %0, %1, %2, 0, %3, %3 op_sel_hi:[0,0,0]" : "+v"(acc[ai][bj][m][n]) : "v"(Bt_[n]), "v"(At[m]), "v"(sc1)); \
        __builtin_amdgcn_s_setprio(0); } while (0)
#define PG_WAIT_V(n) asm volatile("s_waitcnt vmcnt(" #n ")" ::: "memory")
#define PG_WAIT_L(n) asm volatile("s_waitcnt lgkmcnt(" #n ")" ::: "memory")
#define PG_WAIT_VR(rl) do { if ((rl) == 0) PG_WAIT_V(8); else if ((rl) == 8) PG_WAIT_V(16); else if ((rl) == 16) PG_WAIT_V(24); else PG_WAIT_V(40); } while (0)
#define PG_BAR __builtin_amdgcn_s_barrier()
#define PG_SCHED __builtin_amdgcn_sched_barrier(0)
    Unit cur, nxt; int ui = 0, relax = 0;
    if (!S.next(0, cur)) return;
    int sc1 = 0x7F7F7F7F; asm volatile("" : "+v"(sc1));
    static_assert(F8, "the first-tile C = 0 form below is written for the fp8 MFMA");
    f32x4 acc[2][2][4][2];
#pragma unroll
    for (int a = 0; a < 2; ++a)
#pragma unroll
        for (int b = 0; b < 2; ++b)
#pragma unroll
            for (int m = 0; m < 4; ++m)
#pragma unroll
                for (int n = 0; n < 2; ++n) acc[a][b][m][n] = (f32x4){0.f, 0.f, 0.f, 0.f};
    typename FragT<F8>::T At[4], B0[2], B1[2];
    unsigned gC[2][2];
    auto gload = [&](int uidx, unsigned (&g)[2][2]) {
        const int tt = otid();
#pragma unroll
        for (int i = 0; i < 2; ++i) { int R, C; stage_rc(tt * 16 + i * 8192, R, C);
#pragma unroll
            for (int h = 0; h < 2; ++h) g[h][i] = (unsigned)gtab[uidx * 256 + h * HALF + R] * (unsigned)KB + (unsigned)(C * 2); }
    };
    if constexpr (GATHER) gload(0, gC);
    const char* cA = GATHER ? (const char*)A : (const char*)A + (size_t)cur.pm * tstep;
    const char* cB = (const char*)Bt + (size_t)cur.e * bgroup_bytes + (size_t)cur.pn * tstep;
    PG_STAGE(PG_SB(0, 0), cB, voffB); PG_STAGE(PG_SB(0, 1), cB + bhs, voffB); PG_STAGE_A(PG_SA(0, 0), cA, 0, gC); PG_STAGE_A(PG_SA(0, 1), cA, 1, gC);
    if (wr == 1) PG_BAR;
    PG_WAIT_V(2); PG_BAR;
    PG_STAGE(PG_SB(1, 0), cB + kstep, voffB); PG_STAGE_A(PG_SA(1, 0), cA + kstep, 0, gC); PG_STAGE(PG_SB(1, 1), cB + bhs + kstep, voffB);
    PG_WAIT_V(6); PG_BAR;
    for (;;) {
        const bool has_next = S.next(ui + 1, nxt);
        const char* nA = GATHER ? (const char*)A : (has_next ? (const char*)A + (size_t)nxt.pm * tstep : cA);
        const char* nB = has_next ? (const char*)Bt + (size_t)nxt.e * bgroup_bytes + (size_t)nxt.pn * tstep : cB;
#define PG_KITER(MMAX, WAITX, LASTX) do { \
            const bool last = LASTX; \
            const char* a1 = cA + (size_t)(t + 1) * kstep; \
            const char* a2 = last ? nA : cA + (size_t)(t + 2) * kstep; const char* b2 = last ? nB : cB + (size_t)(t + 2) * kstep; \
            const char* a3 = a2 + kstep; const char* b3 = b2 + kstep; \
            unsigned gS[2][2]; \
            if constexpr (GATHER) { \
                if (last && has_next) gload(ui + 1, gS); \
                else { gS[0][0] = gC[0][0]; gS[0][1] = gC[0][1]; gS[1][0] = gC[1][0]; gS[1][1] = gC[1][1]; } \
            } \
 \
            PG_LDB(B0, 0, 0); PG_LDB(B1, 0, 1); PG_SCHED; PG_LDA(At, 0, 0); PG_STAGE_A(PG_SA(1, 1), a1, 1, gC); \
            WAITX; PG_WAIT_L(0); PG_BAR; MMAX(0, 0, At, B0); MMAX(0, 1, At, B1); PG_BAR; PG_SCHED; \
 \
            PG_LDA(At, 0, 1); PG_STAGE(PG_SB(0, 0), b2, voffB); PG_STAGE(PG_SB(0, 1), b2 + bhs, voffB); PG_STAGE_A(PG_SA(0, 0), a2, 0, gS); \
            WAITX; PG_WAIT_L(0); PG_BAR; MMAX(1, 0, At, B0); MMAX(1, 1, At, B1); PG_BAR; PG_SCHED; \
 \
            PG_LDB(B0, 1, 0); PG_LDB(B1, 1, 1); PG_SCHED; PG_LDA(At, 1, 0); PG_STAGE_A(PG_SA(0, 1), a2, 1, gS); \
            PG_WAIT_V(8); PG_WAIT_L(0); PG_BAR; PG_MMA(0, 0, At, B0); PG_MMA(0, 1, At, B1); PG_BAR; PG_SCHED; \
 \
            PG_LDA(At, 1, 1); PG_STAGE(PG_SB(1, 0), b3, voffB); PG_STAGE(PG_SB(1, 1), b3 + bhs, voffB); PG_STAGE_A(PG_SA(1, 0), a3, 0, gS); \
            PG_WAIT_V(8); PG_WAIT_L(0); PG_BAR; PG_MMA(1, 0, At, B0); PG_MMA(1, 1, At, B1); PG_BAR; PG_SCHED; \
        } while (0)
        { const int t = 0; PG_KITER(PG_MMAZ, PG_WAIT_VR(relax), false); }
#pragma unroll 1
        for (int t = 2; t < nt; t += 2) { PG_KITER(PG_MMA, PG_WAIT_V(8), (t == nt - 2)); }
#undef PG_KITER
        if (wr == 0) PG_BAR;
        if constexpr (F8) asm volatile("s_nop 15\n\ts_nop 15" ::: "memory");
        E(acc, cur, ui, wr, wc, fr, fq); relax = E.nst(cur);
        if (!has_next) break;
        cur = nxt; cA = nA; cB = nB; ++ui;
        if constexpr (GATHER) gload(ui, gC);
        if (wr == 1) PG_BAR;
    }
    PG_WAIT_V(0);
    PG_BAR;
#undef PG_SA
#undef PG_SB
#undef PG_STAGE
#undef PG_STAGE_A
#undef PG_LDA
#undef PG_LDB
#undef PG_MMA
#undef PG_MMAZ
#undef PG_WAIT_V
#undef PG_WAIT_VR
#undef PG_WAIT_L
#undef PG_BAR
#undef PG_SCHED
}
}

constexpr size_t WT_AIN = WS_WT, WT_AOUT = WS_WT + 18 * MiB, WT_MIN = WS_WT + 26 * MiB, WT_MOUT = WS_WT + 51 * MiB, WT_W13 = WS_WT + 59 * MiB, WT_W2 = WS_WT + 579 * MiB;
constexpr int MINP = 6400;
constexpr float W13_SCALE = 64.f, W2_SCALE = 32.f;
static_assert(WT_W2 + (size_t)2 * 65 * 2 * MiB <= WS_END, "weight copies fit");
#define LDS_WAIT() asm volatile("s_waitcnt lgkmcnt(0)" ::: "memory")
struct CvtDesc { const float* W; unsigned char* dst; int ldw, dK; float sc; };
DEVI CvtDesc cvt_decode(const Params& p, int it) {
    constexpr int I_AIN = 16 * 144, I_AOUT = 16 * 64, I_MIN = 16 * 193, I_MOUT = 16 * 64;
    CvtDesc d; int r = it; d.sc = W13_SCALE; d.dK = D;
    const float *w_ain = p.attn_w_in, *w_aout = p.attn_w_out, *w_min = p.ml_w_in, *w_mout = p.ml_w_out, *w_e1 = p.exp_w1, *w_e3 = p.exp_w3, *w_e2 = p.exp_w2, *w_s1 = p.sh_w1, *w_s3 = p.sh_w3, *w_s2 = p.sh_w2;
    asm volatile("" : "+s"(w_ain), "+s"(w_aout), "+s"(w_min), "+s"(w_mout), "+s"(w_e1), "+s"(w_e3), "+s"(w_e2), "+s"(w_s1), "+s"(w_s3), "+s"(w_s2));
    if (r < I_AIN) { const int kb = r / 144, nb = r % 144; d.W = w_ain + (size_t)(128 * kb) * AIW + 32 * nb; d.ldw = AIW; d.dst = (unsigned char*)(p.ws + WT_AIN) + (size_t)(32 * nb) * D + 128 * kb; return d; } r -= I_AIN;
    if (r < I_AOUT) { const int kb = r / 64, nb = r % 64; d.W = w_aout + (size_t)(128 * kb) * D + 32 * nb; d.ldw = D; d.dst = (unsigned char*)(p.ws + WT_AOUT) + (size_t)(32 * nb) * D + 128 * kb; return d; } r -= I_AOUT;
    if (r < I_MIN) { const int kb = r / 193, nb = r % 193; d.W = w_min + (size_t)(128 * kb) * MIW + 32 * nb; d.ldw = MIW; d.dst = (unsigned char*)(p.ws + WT_MIN) + (size_t)(32 * nb) * D + 128 * kb; return d; } r -= I_MIN;
    if (r < I_MOUT) { const int kb = r / 64, nb = r % 64; d.W = w_mout + (size_t)(128 * kb) * D + 32 * nb; d.ldw = D; d.dst = (unsigned char*)(p.ws + WT_MOUT) + (size_t)(32 * nb) * D + 128 * kb; return d; } r -= I_MOUT;
    const int mat = r >> 8, ii = r & 255; const int l = mat / 195, q = mat % 195, e = q / 3, which = q % 3;
    if (which < 2) {
        const float* W = e < 64 ? (which == 0 ? w_e1 : w_e3) + ((size_t)l * 64 + e) * D * EDIM : (which == 0 ? w_s1 : w_s3) + (size_t)l * D * EDIM;
        const int kb = ii / 16, nb = ii % 16, n0 = 32 * nb;
        d.W = W + (size_t)(128 * kb) * EDIM + n0; d.ldw = EDIM;
        d.dst = (unsigned char*)(p.ws + WT_W13) + ((size_t)l * 65 + e) * 1024 * D + (size_t)((n0 >> 7) * 256 + which * 128 + (n0 & 127)) * D + 128 * kb;
    } else {
        const float* W = e < 64 ? w_e2 + ((size_t)l * 64 + e) * EDIM * D : w_s2 + (size_t)l * EDIM * D;
        const int kb = ii / 64, nb = ii % 64;
        d.W = W + (size_t)(128 * kb) * D + 32 * nb; d.ldw = D; d.dK = EDIM; d.sc = W2_SCALE;
        d.dst = (unsigned char*)(p.ws + WT_W2) + ((size_t)l * 65 + e) * D * EDIM + (size_t)(32 * nb) * EDIM + 128 * kb;
    }
    return d;
}
DEVI void ph_cvt(const Params& p, LAS unsigned char* lds, int vcu, int G) {
    const int tid = otid(), lane = tid & 63, wave = __builtin_amdgcn_readfirstlane(tid >> 6);
    LAS float* scr = (LAS float*)(lds + wave * 17408);
    const int gw = vcu * 8 + wave, NGW = G * 8;
    constexpr int NITEMS = 16 * 144 + 16 * 64 + 16 * 193 + 16 * 64 + 2 * 65 * 3 * 256;
    const int lr = lane >> 3, lc = (lane & 7) * 4;
    const int sn = lane >> 3, sc8 = lane & 7;
    if (gw < NITEMS) {
        int it = gw; CvtDesc dc = cvt_decode(p, it);
        typedef const __attribute__((address_space(1))) f32x4* GV4;
        f32x4 cur[16];
#pragma unroll
        for (int i = 0; i < 16; ++i) cur[i] = __builtin_nontemporal_load((GV4)(dc.W + (size_t)(lr + 8 * i) * dc.ldw + lc));
        for (;;) {
            const int nx = it + NGW; const CvtDesc dn = cvt_decode(p, nx < NITEMS ? nx : it);
            f32x4 nxt[16];
#pragma unroll
            for (int i = 0; i < 16; ++i) nxt[i] = __builtin_nontemporal_load((GV4)(dn.W + (size_t)(lr + 8 * i) * dn.ldw + lc));
#pragma unroll
            for (int i = 0; i < 16; ++i) { LAS float* sp = scr + (lr + 8 * i) * 33 + 4 * (i >> 1) + lc; sp[0] = cur[i][0] * dc.sc; sp[1] = cur[i][1] * dc.sc; sp[2] = cur[i][2] * dc.sc; sp[3] = cur[i][3] * dc.sc; }
            LDS_WAIT(); asm volatile("" ::: "memory");
#pragma unroll
            for (int j = 0; j < 4; ++j) { const int n = sn + 8 * j; const LAS float* sp = scr + (16 * sc8) * 33 + 4 * sc8 + n;
                u32x4 o;
#pragma unroll
                for (int q = 0; q < 4; ++q) o[q] = pk4_fp8(sp[(4 * q + 0) * 33], sp[(4 * q + 1) * 33], sp[(4 * q + 2) * 33], sp[(4 * q + 3) * 33]);
                *(u32x4*)(dc.dst + (size_t)n * dc.dK + 16 * sc8) = o; }
            LDS_WAIT(); asm volatile("" ::: "memory");
            if (nx >= NITEMS) break;
#pragma unroll
            for (int i = 0; i < 16; ++i) cur[i] = nxt[i];
            dc = dn; it = nx;
        }
    }
    { u32x4* z = (u32x4*)((unsigned char*)(p.ws + WT_MIN) + (size_t)MIW * D); const int n16 = (MINP - MIW) * D / 16;
      for (int i = vcu * 512 + tid; i < n16; i += G * 512) z[i] = (u32x4){0u, 0u, 0u, 0u}; }
}

typedef float f32x4e __attribute__((ext_vector_type(4)));
struct EpiBf16Store {
    static constexpr bool PERM = true, B16 = false;
    bf16* O; int ld; float* gates; int gate_pn; float sc;
    DEVI int nst(const pg::Unit& u) const { return u.pn == gate_pn ? 0 : 16; }
    DEVI void operator()(const f32x4 (&acc)[2][2][4][2], const pg::Unit& u, int ui, int wr, int wc, int fr, int fq) const {
        const int row0 = u.pm * 256 + wr * 64 + fr;
        if (u.pn == gate_pn) {
            if (wc == 0) {
#pragma unroll
                for (int ai = 0; ai < 2; ++ai)
#pragma unroll
                    for (int m = 0; m < 4; ++m) { float* gp = gates + (size_t)(row0 + ai * 128 + m * 16) * 32 + 8 * fq;
                        *(f32x4*)(gp) = acc[ai][0][m][0] * sc; *(f32x4*)(gp + 4) = acc[ai][0][m][1] * sc; }
            }
            return;
        }
        const int col0 = u.pn * 256 + wc * 32 + 8 * fq;
#pragma unroll
        for (int ai = 0; ai < 2; ++ai)
#pragma unroll
            for (int m = 0; m < 4; ++m) { bf16* rowp = O + (size_t)(row0 + ai * 128 + m * 16) * ld + col0;
#pragma unroll
                for (int bj = 0; bj < 2; ++bj) { const f32x4 v0 = acc[ai][bj][m][0] * sc, v1 = acc[ai][bj][m][1] * sc;
                    u32x4 w; w.x = pg::cvt_pk_bf16(v0[0], v0[1]); w.y = pg::cvt_pk_bf16(v0[2], v0[3]); w.z = pg::cvt_pk_bf16(v1[0], v1[1]); w.w = pg::cvt_pk_bf16(v1[2], v1[3]);
                    *(u32x4*)(rowp + bj * 128) = w; } }
    }
};
struct EpiSwiGLU {
    static constexpr bool PERM = true, B16 = false;
    bf16* ACT;
    DEVI int nst(const pg::Unit&) const { return 8; }
    DEVI void operator()(const f32x4 (&acc)[2][2][4][2], const pg::Unit& u, int ui, int wr, int wc, int fr, int fq) const {
        const int row0 = u.pm * 256 + wr * 64 + fr, col0 = u.pn * 128 + wc * 32 + 8 * fq;
#pragma unroll
        for (int ai = 0; ai < 2; ++ai)
#pragma unroll
            for (int m = 0; m < 4; ++m) {
                f32x4 o[2];
#pragma unroll
                for (int n = 0; n < 2; ++n) { const f32x4 a = acc[ai][0][m][n], b = acc[ai][1][m][n]; const f32x4 t = a * (-1.4426950408889634f / W13_SCALE);
                    f32x4 e; e[0] = __builtin_amdgcn_exp2f(t[0]); e[1] = __builtin_amdgcn_exp2f(t[1]); e[2] = __builtin_amdgcn_exp2f(t[2]); e[3] = __builtin_amdgcn_exp2f(t[3]);
                    const f32x4 d = e * (W13_SCALE * W13_SCALE) + (W13_SCALE * W13_SCALE);
                    f32x4 r; r[0] = __builtin_amdgcn_rcpf(d[0]); r[1] = __builtin_amdgcn_rcpf(d[1]); r[2] = __builtin_amdgcn_rcpf(d[2]); r[3] = __builtin_amdgcn_rcpf(d[3]);
                    o[n] = (a * b) * r; }
                uint2 w; w.x = pk4_fp8(o[0][0], o[0][1], o[0][2], o[0][3]); w.y = pk4_fp8(o[1][0], o[1][1], o[1][2], o[1][3]);
                *(uint2*)((unsigned char*)ACT + (size_t)(row0 + ai * 128 + m * 16) * EDIM + col0) = w; }
    }
};
constexpr float Y_SCALE = 8.f;
struct EpiScale {
    static constexpr bool PERM = true, B16 = true;
    unsigned char* Y; const LAS float* swt;
    DEVI int nst(const pg::Unit&) const { return 8; }
    DEVI void operator()(const f32x4 (&acc)[2][2][4][2], const pg::Unit& u, int ui, int wr, int wc, int fr, int fq) const {
        const int row0 = u.pm * 256 + wr * 64 + fr, col0 = u.pn * 256 + wc * 64 + 16 * fq;
#pragma unroll
        for (int ai = 0; ai < 2; ++ai)
#pragma unroll
            for (int m = 0; m < 4; ++m) { const int slot = row0 + ai * 128 + m * 16; const float w8 = swt[ui * 256 + wr * 64 + fr + ai * 128 + m * 16];
                const f32x4 a = acc[ai][0][m][0] * w8, b = acc[ai][0][m][1] * w8, c = acc[ai][1][m][0] * w8, d = acc[ai][1][m][1] * w8;
                u32x4 w; w.x = pk4_fp8(a[0], a[1], a[2], a[3]); w.y = pk4_fp8(b[0], b[1], b[2], b[3]); w.z = pk4_fp8(c[0], c[1], c[2], c[3]); w.w = pk4_fp8(d[0], d[1], d[2], d[3]);
                __builtin_nontemporal_store(w, (u32x4*)(Y + (size_t)slot * D + col0)); }
    }
};
struct EpiResid {
    static constexpr bool PERM = true, B16 = false;
    bf16* X; const float* modl;
    DEVI int nst(const pg::Unit&) const { return 16; }
    DEVI void operator()(const f32x4 (&acc)[2][2][4][2], const pg::Unit& u, int ui, int wr, int wc, int fr, int fq) const {
        const int bb = u.pm < 64 ? (u.pm >> 4) : 4;
        const float* gate = modl + (size_t)(bb * 6 + 2) * D;
        const int row0 = u.pm * 256 + wr * 64 + fr, col0 = u.pn * 256 + wc * 32 + 8 * fq;
        f32x4 gv[2][2];
#pragma unroll
        for (int bj = 0; bj < 2; ++bj)
#pragma unroll
            for (int n = 0; n < 2; ++n) gv[bj][n] = *(const f32x4*)(gate + col0 + bj * 128 + 4 * n) * (1.f / W13_SCALE);
        u32x4 xa[2], xb[2];
#define RLOAD(Xr, g) do { const size_t off_ = (size_t)(row0 + ((g) >> 2) * 128 + ((g) & 3) * 16) * D + col0; _Pragma("unroll") for (int bj = 0; bj < 2; ++bj) Xr[bj] = *(const u32x4*)(X + off_ + bj * 128); } while (0)
#define RMIX(w, a, b, ga, gb) pg::cvt_pk_bf16(__uint_as_float((w) << 16) + (ga) * (a), __uint_as_float((w) & 0xffff0000u) + (gb) * (b))
#define RSTORE(Xr, g) do { const size_t off_ = (size_t)(row0 + ((g) >> 2) * 128 + ((g) & 3) * 16) * D + col0; _Pragma("unroll") for (int bj = 0; bj < 2; ++bj) { \
            const f32x4 a0 = acc[(g) >> 2][bj][(g) & 3][0], a1 = acc[(g) >> 2][bj][(g) & 3][1]; u32x4 w; \
            w.x = RMIX(Xr[bj].x, a0[0], a0[1], gv[bj][0][0], gv[bj][0][1]); w.y = RMIX(Xr[bj].y, a0[2], a0[3], gv[bj][0][2], gv[bj][0][3]); \
            w.z = RMIX(Xr[bj].z, a1[0], a1[1], gv[bj][1][0], gv[bj][1][1]); w.w = RMIX(Xr[bj].w, a1[2], a1[3], gv[bj][1][2], gv[bj][1][3]); \
            *(u32x4*)(X + off_ + bj * 128) = w; } } while (0)
        RLOAD(xa, 0);
#pragma unroll
        for (int g = 0; g < 8; g += 2) {
            RLOAD(xb, g + 1); asm volatile("" ::: "memory");
            RSTORE(xa, g); asm volatile("" ::: "memory");
            if (g + 2 < 8) { RLOAD(xa, g + 2); asm volatile("" ::: "memory"); }
            RSTORE(xb, g + 1); asm volatile("" ::: "memory");
        }
#undef RLOAD
#undef RMIX
#undef RSTORE
    }
};

template <bool G1>
DEVI int moe_setup(const Params& p, LAS unsigned char* lds, int layer, int nrows, int vcu, int G) {
    LAS int* eo = (LAS int*)(lds + pg::EO_OFF); LAS int* ud = (LAS int*)(lds + pg::UD_OFF); LAS int* gt = (LAS int*)(lds + pg::GT_OFF);
    const int tid = otid(); const u32* cnt = (const u32*)(p.ws + WS_CTL) + CW_CNT + layer * 64 * CNT_PAD;
    LAS int* ec = eo + 68;
    if (tid < 64) { const int c_ = (int)cnt[tid * CNT_PAD]; const int pc = (c_ + 255) & ~255; const int incl = (int)wave_prefix_dpp((float)pc);
        ec[tid] = c_; eo[tid] = incl - pc; if (tid == 63) eo[64] = incl; }
    __syncthreads();
    constexpr int NT = G1 ? 4 : 8, CAP = G1 ? 16 : 24;
    const int PR = eo[64] >> 8, PS = nrows >> 8, total = (PR + PS) * NT;
    int nu = total > vcu ? (total - vcu + G - 1) / G : 0; if (nu > CAP) nu = CAP;
    if (tid < nu) {
        const int L = tid * G + vcu, pp = L / NT, pn = L % NT; int e = 64, pm = SH0 / 256 + (pp - PR);
        if (pp < PR) { pm = pp; e = 0; for (int i = 1; i < 64; ++i) if (eo[i] <= pp * 256) e = i; }
        ud[tid * 4 + 0] = pm; ud[tid * 4 + 1] = pn; ud[tid * 4 + 2] = e;
    }
    __syncthreads();
    if (G1) { const int* ltok = (const int*)(p.ws + WS_LTOK);
        for (int idx = tid; idx < nu * 256; idx += 512) { const int u_ = idx >> 8, slot = ud[u_ * 4] * 256 + (idx & 255), e = ud[u_ * 4 + 2];
            int t = slot - SH0; if (slot < SH0) { const int pos = slot - eo[e]; t = pos < ec[e] ? ltok[(size_t)e * MT + pos] : 0; } gt[idx] = t; } }
    else { const float* lw = (const float*)(p.ws + WS_LW); LAS float* st = (LAS float*)gt;
        for (int idx = tid; idx < nu * 256; idx += 512) { const int u_ = idx >> 8, slot = ud[u_ * 4] * 256 + (idx & 255), e = ud[u_ * 4 + 2];
            float w = 1.f; if (slot < SH0) { const int pos = slot - eo[e]; w = pos < ec[e] ? lw[(size_t)e * MT + pos] : 0.f; } st[idx] = w * (Y_SCALE / W2_SCALE); } }
    __syncthreads();
    return nu;
}

namespace fa {
typedef short s16x4 __attribute__((ext_vector_type(4)));
typedef float f32x16 __attribute__((ext_vector_type(16)));
constexpr int HD = 128, NW = 8, QBLK = 32, KVBLK = 64;
constexpr float SCALE = 0.088388347648318440f, THR = 8.f;
constexpr int SHM_V = KVBLK * HD * 2, SHM_K = KVBLK * HD * 2, SCR_OFF = 2 * SHM_V + 2 * SHM_K, BIAS_OFF = SCR_OFF + NW * 64 * 4, SHM_ATTN = BIAS_OFF + 512 * 4;
#define KSWZ(row, colB) ((row) * 256 + ((colB) ^ (((row) & 7) << 4)))
#define SBAR() __builtin_amdgcn_sched_barrier(0)
DEVI int crow(int r, int hi) { return (r & 3) + 8 * (r >> 2) + 4 * hi; }
DEVI unsigned cvtpk(float lo, float hi) { unsigned r; asm volatile("v_cvt_pk_bf16_f32 %0, %1, %2" : "=v"(r) : "v"(lo), "v"(hi)); return r; }
DEVI void partialSM(f32x16& p0, f32x16& p1, float& m_reg, float& mn, float& alpha) {
    constexpr float C = SCALE * 1.4426950408889634f;
    float pmax = p0[0];
#pragma unroll
    for (int r = 1; r < 16; ++r) pmax = fmaxf(pmax, p0[r]);
#pragma unroll
    for (int r = 0; r < 16; ++r) pmax = fmaxf(pmax, p1[r]);
    { auto rr = __builtin_amdgcn_permlane32_swap(__float_as_uint(pmax), __float_as_uint(pmax), false, false); pmax = fmaxf(__uint_as_float(rr[0]), __uint_as_float(rr[1])); }
    if (__builtin_expect(__all(pmax - m_reg <= THR / SCALE), 1)) { mn = m_reg; alpha = 1.f; }
    else { mn = fmaxf(m_reg, pmax); alpha = __builtin_amdgcn_exp2f((m_reg - mn) * C); m_reg = mn; }
    const float mnC = -mn * C;
#pragma unroll
    for (int r = 0; r < 16; ++r) p0[r] = fmaf(p0[r], C, mnC);
#pragma unroll
    for (int r = 0; r < 16; ++r) p1[r] = fmaf(p1[r], C, mnC);
#pragma unroll
    for (int r = 0; r < 16; ++r) p0[r] = __builtin_amdgcn_exp2f(p0[r]);
}
DEVI void finishSM(f32x16& p0, f32x16& p1, float alpha, float& l_reg, bf16x8& pa0, bf16x8& pa1, bf16x8& pa2, bf16x8& pa3) {
#pragma unroll
    for (int r = 0; r < 16; ++r) p1[r] = __builtin_amdgcn_exp2f(p1[r]);
    float ps = 0;
#pragma unroll
    for (int r = 0; r < 16; ++r) ps += p0[r];
#pragma unroll
    for (int r = 0; r < 16; ++r) ps += p1[r];
    { auto rr = __builtin_amdgcn_permlane32_swap(__float_as_uint(ps), __float_as_uint(ps), false, false); ps = __uint_as_float(rr[0]) + __uint_as_float(rr[1]); }
    l_reg = l_reg * alpha + ps;
#define PK4(P, BASE, OUT) do { unsigned a0 = cvtpk(P[BASE + 0], P[BASE + 1]), a1 = cvtpk(P[BASE + 2], P[BASE + 3]);   \
    unsigned b0 = cvtpk(P[BASE + 4], P[BASE + 5]), b1 = cvtpk(P[BASE + 6], P[BASE + 7]);                              \
    auto r0 = __builtin_amdgcn_permlane32_swap(a0, b0, false, false); auto r1 = __builtin_amdgcn_permlane32_swap(a1, b1, false, false); \
    u32x4 w = {r0[0], r1[0], r0[1], r1[1]}; OUT = *reinterpret_cast<bf16x8*>(&w); } while (0)
    PK4(p0, 0, pa0); PK4(p0, 8, pa1); PK4(p1, 0, pa2); PK4(p1, 8, pa3);
#undef PK4
}
DEVI void qkt(f32x16& p0, f32x16& p1, const char* Ks, const bf16x8* qr, int r32, int hi) {
    p0 = f32x16{}; p1 = f32x16{};
#pragma unroll
    for (int d0 = 0; d0 < 8; ++d0) { const int cb = (d0 * 16 + hi * 8) * 2;
        const bf16x8 b0 = *reinterpret_cast<const bf16x8*>(Ks + KSWZ(r32, cb));
        const bf16x8 b1 = *reinterpret_cast<const bf16x8*>(Ks + KSWZ(32 + r32, cb));
        p0 = __builtin_amdgcn_mfma_f32_32x32x16_bf16(b0, qr[d0], p0, 0, 0, 0);
        p1 = __builtin_amdgcn_mfma_f32_32x32x16_bf16(b1, qr[d0], p1, 0, 0, 0); }
}
DEVI int v_st(int k, int c) { const int kk = (k & ~0xC) | ((k & 4) << 1) | ((k & 8) >> 1); return ((kk >> 3) * 4 + (c >> 5)) * 512 + ((kk & 7) * 32 + (c & 31)) * 2; }
DEVI int v_rd_base(int lane) { return ((lane & 3) << 3) | (((lane >> 2) & 3) << 6) | (((lane >> 4) & 1) << 5) | (((lane >> 5) & 1) << 8); }
constexpr int v_rd_off(int d0, int ks, int half) { return d0 * 512 + ks * 4096 + half * 2048; }
template <int OFF> DEVI s16x4 tr_read(int vb) { s16x4 r; asm volatile("ds_read_b64_tr_b16 %0, %1 offset:%2" : "=&v"(r) : "v"(vb), "i"(OFF) : "memory"); return r; }
template <int D0> DEVI void pv_one(f32x16& od, int vb, bf16x8 pa0, bf16x8 pa1, bf16x8 pa2, bf16x8 pa3) {
    const s16x4 l0 = tr_read<v_rd_off(D0, 0, 0)>(vb), h0 = tr_read<v_rd_off(D0, 0, 1)>(vb), l1 = tr_read<v_rd_off(D0, 1, 0)>(vb), h1 = tr_read<v_rd_off(D0, 1, 1)>(vb);
    const s16x4 l2 = tr_read<v_rd_off(D0, 2, 0)>(vb), h2 = tr_read<v_rd_off(D0, 2, 1)>(vb), l3 = tr_read<v_rd_off(D0, 3, 0)>(vb), h3 = tr_read<v_rd_off(D0, 3, 1)>(vb);
    asm volatile("s_waitcnt lgkmcnt(0)" ::: "memory"); SBAR();
#define PK(L, H) (bf16x8){L[0], L[1], L[2], L[3], H[0], H[1], H[2], H[3]}
    od = __builtin_amdgcn_mfma_f32_32x32x16_bf16(pa0, PK(l0, h0), od, 0, 0, 0);
    od = __builtin_amdgcn_mfma_f32_32x32x16_bf16(pa1, PK(l1, h1), od, 0, 0, 0);
    od = __builtin_amdgcn_mfma_f32_32x32x16_bf16(pa2, PK(l2, h2), od, 0, 0, 0);
    od = __builtin_amdgcn_mfma_f32_32x32x16_bf16(pa3, PK(l3, h3), od, 0, 0, 0);
#undef PK
}
DEVI void pv_d0(f32x16* o, int vb, bf16x8 pa0, bf16x8 pa1, bf16x8 pa2, bf16x8 pa3) {
    pv_one<0>(o[0], vb, pa0, pa1, pa2, pa3); pv_one<1>(o[1], vb, pa0, pa1, pa2, pa3); pv_one<2>(o[2], vb, pa0, pa1, pa2, pa3); pv_one<3>(o[3], vb, pa0, pa1, pa2, pa3);
}
DEVI void na_mask(f32x16& p0, f32x16& p1, const float* brow, int cq, int hi) {
    const int cs = min(max(cq - 8, 0), 48);
    const float* bl = brow + (4 * hi - cq + 15);
    const int d0 = 4 * hi - cs;
#pragma unroll
    for (int r = 0; r < 16; ++r) {
        const int kc0 = (r & 3) + 8 * (r >> 2), kc1 = kc0 + 32;
        const bool ok0 = (unsigned)(kc0 + d0) < 16u, ok1 = (unsigned)(kc1 + d0) < 16u;
        const float b0 = bl[ok0 ? kc0 : 0], b1 = bl[ok1 ? kc1 : 0];
        p0[r] = ok0 ? p0[r] + b0 : -1e30f; p1[r] = ok1 ? p1[r] + b1 : -1e30f;
    }
}
DEVI void attn_unit(const bf16* __restrict__ Qb, const bf16* __restrict__ kc, const bf16* __restrict__ kl, int vdelta, int NT, unsigned char* __restrict__ Ob, char* lds) {
    constexpr int ldq = AIW, ldk = AIW, ldo = D; constexpr bool NA = false; const int tbase = 0, nwin = 64, krmin = 0, rq0 = 0; const float* rpb_h = nullptr;
    auto tile = [&](int t, const bf16*& kp, const bf16*& vp) { kp = t < 4 ? kc + (size_t)t * 64 * ldk : kl + (size_t)(tbase + min(t - 4, nwin - 1)) * 64 * ldk; vp = kp + vdelta; };
    const int tid = otid(), wid = tid >> 6, lane = tid & 63, r32 = lane & 31, hi = lane >> 5;
    char* V_lds = lds; char* K_lds = lds + 2 * SHM_V;
    float* wsc = (float*)(lds + SCR_OFF) + wid * 64; float* li_l = wsc; float* al_l = wsc + 32;
    float* btab = (float*)(lds + BIAS_OFF);
    float m_reg = -1e30f, l_reg = 0; f32x16 o[4] = {}; bf16x8 qr[8];
    const bf16* Qw = Qb + (size_t)(wid * QBLK + r32) * ldq + hi * 8;
#pragma unroll
    for (int d0 = 0; d0 < 8; ++d0) qr[d0] = *reinterpret_cast<const bf16x8*>(Qw + d0 * 16);
    if (NA) { for (int i = tid; i < 465; i += 512) btab[i] = rpb_h[i] * (1.f / SCALE); }
    const int sr = tid >> 4, sc = (tid & 15) * 8, vst0 = v_st(sr, sc), vst1 = v_st(32 + sr, sc);
    const int vb0 = (int)(uintptr_t)V_lds + v_rd_base(lane);
    const int rq = rq0 + (wid >> 1), cq = (wid & 1) * 32 + r32, kr0 = min(max(rq - 4, 0), 56);
    struct { bf16x8 vs0, vs1, ks0, ks1; } st_[2];
#define SLOAD(i, t) do { const bf16* kp_; const bf16* vp_; tile((t), kp_, vp_); \
    st_[i].vs0 = *reinterpret_cast<const bf16x8*>(vp_ + (size_t)sr * ldk + sc); st_[i].vs1 = *reinterpret_cast<const bf16x8*>(vp_ + (size_t)(32 + sr) * ldk + sc); \
    st_[i].ks0 = *reinterpret_cast<const bf16x8*>(kp_ + (size_t)sr * ldk + sc); st_[i].ks1 = *reinterpret_cast<const bf16x8*>(kp_ + (size_t)(32 + sr) * ldk + sc); } while (0)
#define SWRITE(b, i) do { *(bf16x8*)(V_lds + (b) * SHM_V + vst0) = st_[i].vs0; *(bf16x8*)(V_lds + (b) * SHM_V + vst1) = st_[i].vs1; const int kc = sc * 2; \
    *(bf16x8*)(K_lds + (b) * SHM_K + KSWZ(sr, kc)) = st_[i].ks0; *(bf16x8*)(K_lds + (b) * SHM_K + KSWZ(32 + sr, kc)) = st_[i].ks1; } while (0)
#define SWAIT() asm volatile("s_waitcnt vmcnt(4)" ::: "memory")
#define RESC(a) do { if (__any((a) < 1.f)) { if (hi == 0) al_l[r32] = (a); asm volatile("s_waitcnt lgkmcnt(0)" ::: "memory"); \
    _Pragma("unroll") for (int d = 0; d < 4; ++d) _Pragma("unroll") for (int r = 0; r < 16; ++r) o[d][r] *= al_l[crow(r, hi)]; } } while (0)
#define MASK(P0, P1, t) do { if (NA) { if ((t) >= 4) { const int kr_ = krmin + (t) - 4; const bool v_ = ((t) - 4 < nwin) && kr_ >= kr0 && kr_ <= kr0 + 7; (void)v_; } } } while (0)
    f32x16 pA0, pA1, pB0, pB1; float mnA, mnB, alA, alB; bf16x8 pa0, pa1, pa2, pa3;
    constexpr int SE = 0, SO = 1;
    SLOAD(SE, 0); asm volatile("s_waitcnt vmcnt(0)" ::: "memory"); SWRITE(0, SE); __syncthreads();
    qkt(pA0, pA1, K_lds, qr, r32, hi); MASK(pA0, pA1, 0); partialSM(pA0, pA1, m_reg, mnA, alA);
    SLOAD(SO, 1); SLOAD(SE, 2);
    SWAIT(); SWRITE(1, SO); __syncthreads();
    for (int j = 1; j + 1 < NT; j += 2) {
        SBAR(); qkt(pB0, pB1, K_lds + SHM_K, qr, r32, hi); MASK(pB0, pB1, j);
        finishSM(pA0, pA1, alA, l_reg, pa0, pa1, pa2, pa3); SBAR();
        SLOAD(SO, j + 2); SBAR();
        pv_d0(o, vb0, pa0, pa1, pa2, pa3); partialSM(pB0, pB1, m_reg, mnB, alB);
        __syncthreads(); SWAIT(); SWRITE(0, SE);
        RESC(alB); __syncthreads();
        SBAR(); qkt(pA0, pA1, K_lds, qr, r32, hi); MASK(pA0, pA1, j + 1);
        finishSM(pB0, pB1, alB, l_reg, pa0, pa1, pa2, pa3); SBAR();
        SLOAD(SE, min(j + 3, NT - 1)); SBAR();
        pv_d0(o, vb0 + SHM_V, pa0, pa1, pa2, pa3); partialSM(pA0, pA1, m_reg, mnA, alA);
        __syncthreads(); SWAIT(); SWRITE(1, SO);
        RESC(alA); __syncthreads();
    }
    SBAR(); qkt(pB0, pB1, K_lds + SHM_K, qr, r32, hi); MASK(pB0, pB1, NT - 1);
    finishSM(pA0, pA1, alA, l_reg, pa0, pa1, pa2, pa3); SBAR();
    pv_d0(o, vb0, pa0, pa1, pa2, pa3); partialSM(pB0, pB1, m_reg, mnB, alB);
    __syncthreads(); RESC(alB);
    finishSM(pB0, pB1, alB, l_reg, pa0, pa1, pa2, pa3); SBAR();
    pv_d0(o, vb0 + SHM_V, pa0, pa1, pa2, pa3);
    if (hi == 0) li_l[r32] = l_reg; asm volatile("s_waitcnt lgkmcnt(0)" ::: "memory");
#pragma unroll
    for (int r = 0; r < 16; ++r) { const int orow = crow(r, hi); const float rl = __builtin_amdgcn_rcpf(li_l[orow]);
#pragma unroll
        for (int d0 = 0; d0 < 4; ++d0) ((unsigned char*)Ob)[(size_t)(wid * QBLK + orow) * ldo + d0 * 32 + r32] = (unsigned char)(pk4_fp8(o[d0][r] * rl, 0.f, 0.f, 0.f) & 0xffu); }
    __syncthreads();
#undef SLOAD
#undef SWRITE
#undef SWAIT
#undef RESC
#undef MASK
}
DEVI void attn_unit_na(const bf16* __restrict__ Qb, const bf16* __restrict__ kc, const bf16* __restrict__ kl, int krmin, int nwin, int vdelta, unsigned char* __restrict__ Ob, char* lds, int rq0, const float* rpb_h) {
    constexpr int ldq = AIW, ldk = AIW, ldo = D;
    const int tid = otid(), wid = tid >> 6, lane = tid & 63, r32 = lane & 31, hi = lane >> 5;
    char* V_lds = lds; char* K_lds = lds + 2 * SHM_V;
    float* wsc = (float*)(lds + SCR_OFF) + wid * 64; float* li_l = wsc; float* al_l = wsc + 32;
    float* btab = (float*)(lds + BIAS_OFF);
    float m_reg = -1e30f, l_reg = 0; f32x16 o[4] = {}; bf16x8 qr[8];
    const bf16* Qw = Qb + (size_t)(wid * QBLK + r32) * ldq + hi * 8;
#pragma unroll
    for (int d0 = 0; d0 < 8; ++d0) qr[d0] = *reinterpret_cast<const bf16x8*>(Qw + d0 * 16);
    for (int i = tid; i < 465; i += 512) btab[i] = rpb_h[i] * (1.f / SCALE);
    const int sr = tid >> 4, sc = (tid & 15) * 8, vst0 = v_st(sr, sc), vst1 = v_st(32 + sr, sc);
    const int vb0 = (int)(uintptr_t)V_lds + v_rd_base(lane);
    const int rq = rq0 + (wid >> 1), cq = (wid & 1) * 32 + r32, kr0 = min(max(rq - 4, 0), 56);
    bf16x8 vs0, vs1, ks0, ks1;
    const int NT = 4 + nwin;
#define NLOAD(t) do { const bf16* kp_ = (t) < 4 ? kc + (size_t)(t) * 64 * ldk : kl + (size_t)(krmin + (t) - 4) * 64 * ldk; const bf16* vp_ = kp_ + vdelta; \
    vs0 = *reinterpret_cast<const bf16x8*>(vp_ + (size_t)sr * ldk + sc); vs1 = *reinterpret_cast<const bf16x8*>(vp_ + (size_t)(32 + sr) * ldk + sc); \
    ks0 = *reinterpret_cast<const bf16x8*>(kp_ + (size_t)sr * ldk + sc); ks1 = *reinterpret_cast<const bf16x8*>(kp_ + (size_t)(32 + sr) * ldk + sc); } while (0)
    NLOAD(0);
    for (int t = 0; t < NT; ++t) {
        __syncthreads();
        *(bf16x8*)(V_lds + vst0) = vs0; *(bf16x8*)(V_lds + vst1) = vs1;
        *(bf16x8*)(K_lds + KSWZ(sr, sc * 2)) = ks0; *(bf16x8*)(K_lds + KSWZ(32 + sr, sc * 2)) = ks1;
        __syncthreads();
        NLOAD(min(t + 1, NT - 1));
        const int kr = krmin + t - 4;
        if (t < 4 || (kr >= kr0 && kr <= kr0 + 7)) {
            f32x16 p0, p1; float mn, al; bf16x8 pa0, pa1, pa2, pa3;
            qkt(p0, p1, K_lds, qr, r32, hi);
            if (t >= 4) na_mask(p0, p1, btab + (kr - rq + 7) * 31, cq, hi);
            partialSM(p0, p1, m_reg, mn, al);
            if (__any(al < 1.f)) { if (hi == 0) al_l[r32] = al; asm volatile("s_waitcnt lgkmcnt(0)" ::: "memory");
#pragma unroll
                for (int d = 0; d < 4; ++d)
#pragma unroll
                    for (int r = 0; r < 16; ++r) o[d][r] *= al_l[crow(r, hi)]; }
            finishSM(p0, p1, al, l_reg, pa0, pa1, pa2, pa3);
            pv_d0(o, vb0, pa0, pa1, pa2, pa3);
        }
    }
#undef NLOAD
    if (hi == 0) li_l[r32] = l_reg; asm volatile("s_waitcnt lgkmcnt(0)" ::: "memory");
#pragma unroll
    for (int r = 0; r < 16; ++r) { const int orow = crow(r, hi); const float rl = __builtin_amdgcn_rcpf(li_l[orow]);
#pragma unroll
        for (int d0 = 0; d0 < 4; ++d0) ((unsigned char*)Ob)[(size_t)(wid * QBLK + orow) * ldo + d0 * 32 + r32] = (unsigned char)(pk4_fp8(o[d0][r] * rl, 0.f, 0.f, 0.f) & 0xffu); }
    __syncthreads();
}
}

namespace ml {
using fa::f32x16; using fa::s16x4;
constexpr int K_OFF = 0, KP_OFF = 16384, V_OFF = 32768, C2_OFF = 49152, GA_OFF = C2_OFF + 2 * 24576, DEN_OFF = GA_OFF + 3072, CF_OFF = DEN_OFF + 1024, ML_LDS = CF_OFF + 49152;
static_assert(ML_LDS <= 157 * 1024, "mLSTM LDS map");
constexpr int GA_STRIDE = 6 * 64 * 4;
DEVI int tokrow(int b, int dir, int c, int i) {
    return c >= 4 ? (b * SEQ + (dir ? (SEQ - 1 - ((c - 4) * 64 + i)) : ((c - 4) * 64 + i))) : (ML + b * CTXL + (dir ? (CTXL - 1 - (c * 64 + i)) : (c * 64 + i)));
}
template <int CTRL, int ROWMASK> DEVI float dpp_f(float ident, float src) {
    return __int_as_float(__builtin_amdgcn_update_dpp(__float_as_int(ident), __float_as_int(src), CTRL, ROWMASK, 0xf, false));
}
DEVI float prefix_sum64(float x, int) {
    x += dpp_f<0x111, 0xf>(0.f, x); x += dpp_f<0x112, 0xf>(0.f, x); x += dpp_f<0x114, 0xf>(0.f, x); x += dpp_f<0x118, 0xf>(0.f, x);
    x += dpp_f<0x142, 0xa>(0.f, x); x += dpp_f<0x143, 0xc>(0.f, x);
    return x;
}
DEVI float prefix_max64(float x, int) {
    const float ninf = -INFINITY;
    x = fmaxf(x, dpp_f<0x111, 0xf>(ninf, x)); x = fmaxf(x, dpp_f<0x112, 0xf>(ninf, x)); x = fmaxf(x, dpp_f<0x114, 0xf>(ninf, x)); x = fmaxf(x, dpp_f<0x118, 0xf>(ninf, x));
    x = fmaxf(x, dpp_f<0x142, 0xa>(ninf, x)); x = fmaxf(x, dpp_f<0x143, 0xc>(ninf, x));
    return x;
}
DEVI float lane63(float v) { return __int_as_float(__builtin_amdgcn_readlane(__float_as_int(v), 63)); }
DEVI float gate_chunk(float li, float f, float mprev, float* ga, int lane) {
    const float lf = fminf(f, 0.f) - log1pf(__expf(-fabsf(f)));
    const float bc = prefix_sum64(lf, lane), btot = lane63(bc);
    const float colt = li - bc, aend = btot + colt, pm = prefix_max64(colt, lane), amax = btot + lane63(pm), mnew = fmaxf(btot + mprev, amax);
    const float cm = fmaxf(mprev, pm);
    ga[lane] = __expf(aend - mnew) * QSCALE;
    ga[64 + lane] = colt;
    ga[128 + lane] = -cm;
    ga[192 + lane] = __expf(mprev - cm);
    ga[256 + lane] = __expf(-bc - cm);
    if (lane == 0) ga[320] = __expf(btot + mprev - mnew);
    return mnew;
}
DEVI void ph_mlstm(const Params& p, char* lds, int vcu, int G) {
    const int tid = otid(), wid = __builtin_amdgcn_readfirstlane(tid >> 6), lane = tid & 63, r32 = lane & 31, hi = lane >> 5;
    const bf16* Q = (const bf16*)(p.ws + WS_QKV); const float* Gt = (const float*)(p.ws + WS_G); bf16* HD = (bf16*)(p.ws + WS_HD);
    char* K_lds = lds + K_OFF; char* Kp_lds = lds + KP_OFF; char* V_lds = lds + V_OFF; char* C_lds = lds + C2_OFF;
    float* GA = (float*)(lds + GA_OFF); float* den_l = (float*)(lds + DEN_OFF) + (wid & 3) * 64;
    const int sr = tid >> 4, sc = (tid & 15) * 8;
    const int vr = tid >> 3, vc = (tid & 7) * 8;
    const int vbK = (int)(uintptr_t)Kp_lds + fa::v_rd_base(lane), vbV = (int)(uintptr_t)V_lds + fa::v_rd_base(lane);
    for (int item = vcu; item < 256; item += G) {
        const int b = item >> 6, h = (item >> 3) & 7, dir = (item >> 2) & 1, sl = item & 3;
        const float bi = p.ml_gate_b[dir * 8 + h], bf_ = p.ml_gate_b[(2 + dir) * 8 + h];
        __syncthreads();
        for (int i = tid; i < 16384 / 16; i += 512) ((u32x4*)(V_lds))[i] = (u32x4){0u, 0u, 0u, 0u};
        for (int i = tid; i < 24576 / 16; i += 512) ((u32x4*)(C_lds))[i] = (u32x4){0u, 0u, 0u, 0u};
        __syncthreads();
        if (tid < 64) *(bf16*)(V_lds + fa::v_st(tid, 64)) = (bf16)0x3F80;
        for (int i = tid; i < 49152 / 16; i += 512) ((u32x4*)(lds + CF_OFF))[i] = (u32x4){0u, 0u, 0u, 0u};
        float mprev = 0.f;
        if (wid == 4) { const int row = tokrow(b, dir, 0, lane); mprev = gate_chunk(Gt[(size_t)row * 32 + dir * 8 + h] + bi, Gt[(size_t)row * 32 + 16 + dir * 8 + h] + bf_, 0.f, GA, lane); }
        bf16x8 kr0, kr1, vreg, qr[8];
        { const int r0 = tokrow(b, dir, 0, sr), r1 = tokrow(b, dir, 0, sr + 32), r2 = tokrow(b, dir, 0, vr);
          kr0 = *(const bf16x8*)(Q + (size_t)r0 * MIWM + 1024 + h * 128 + sc); kr1 = *(const bf16x8*)(Q + (size_t)r1 * MIWM + 1024 + h * 128 + sc);
          vreg = *(const bf16x8*)(Q + (size_t)r2 * MIWM + 2048 + h * 256 + sl * 64 + vc); }
#pragma unroll
        for (int d0 = 0; d0 < 8; ++d0) qr[d0] = (bf16x8){0, 0, 0, 0, 0, 0, 0, 0};
        __syncthreads();
        auto chunk_loop = [&](auto role_, auto lat_, const int c_begin, const int c_end) __attribute__((always_inline)) {
            constexpr bool OUT = decltype(role_)::value, LATC = decltype(lat_)::value;
#pragma unroll 1
            for (int c = c_begin; c < c_end; ++c) {
                const bool lat = c >= 4;
                const float* ga = GA + (c & 1) * (GA_STRIDE / 4);
                {
                    *(bf16x8*)(K_lds + KSWZ(sr, sc * 2)) = kr0; *(bf16x8*)(K_lds + KSWZ(32 + sr, sc * 2)) = kr1;
                    const float w0 = ga[sr], w1 = ga[sr + 32];
                    u32x4 a = *(u32x4*)&kr0, bq = *(u32x4*)&kr1, oa, ob;
#define SC2(x, w) fa::cvtpk(__uint_as_float((x) << 16) * (w), __uint_as_float((x) & 0xffff0000u) * (w))
                    oa.x = SC2(a.x, w0); oa.y = SC2(a.y, w0); oa.z = SC2(a.z, w0); oa.w = SC2(a.w, w0);
                    ob.x = SC2(bq.x, w1); ob.y = SC2(bq.y, w1); ob.z = SC2(bq.z, w1); ob.w = SC2(bq.w, w1);
#undef SC2
                    *(u32x4*)(Kp_lds + fa::v_st(sr, sc)) = oa; *(u32x4*)(Kp_lds + fa::v_st(32 + sr, sc)) = ob;
                    *(bf16x8*)(V_lds + fa::v_st(vr, vc)) = vreg;
                }
                float gli, gf;
                {
                    const int cn = c + 1 < 68 ? c + 1 : 67;
                    const int r0 = tokrow(b, dir, cn, sr), r1 = tokrow(b, dir, cn, sr + 32), r2 = tokrow(b, dir, cn, vr);
                    kr0 = *(const bf16x8*)(Q + (size_t)r0 * MIWM + 1024 + h * 128 + sc); kr1 = *(const bf16x8*)(Q + (size_t)r1 * MIWM + 1024 + h * 128 + sc);
                    vreg = *(const bf16x8*)(Q + (size_t)r2 * MIWM + 2048 + h * 256 + sl * 64 + vc);
                    const int row = tokrow(b, dir, cn, lane); gli = Gt[(size_t)row * 32 + dir * 8 + h] + bi; gf = Gt[(size_t)row * 32 + 16 + dir * 8 + h] + bf_;
                }
                __syncthreads();
                const char* Cc = C_lds + (c & 1) * 24576;
                if constexpr (OUT) {
                    if constexpr (LATC) {
                        const int tq = wid >> 1, vq = wid & 1, t = tq * 32 + r32;
                        bf16x8 kf0[8], kf1[8], cfr[8];
#pragma unroll
                        for (int d0 = 0; d0 < 8; ++d0) { const int cb = (d0 * 16 + hi * 8) * 2;
                            kf0[d0] = *reinterpret_cast<const bf16x8*>(K_lds + KSWZ(r32, cb)); kf1[d0] = *reinterpret_cast<const bf16x8*>(K_lds + KSWZ(32 + r32, cb));
                            cfr[d0] = *reinterpret_cast<const bf16x8*>(Cc + KSWZ(vq * 32 + r32, cb)); }
                        asm volatile("s_waitcnt lgkmcnt(0)" ::: "memory"); SBAR();
                        f32x16 p0 = {}, p1 = {}, acc = {};
#pragma unroll
                        for (int d0 = 0; d0 < 8; ++d0) p0 = __builtin_amdgcn_mfma_f32_32x32x16_bf16(kf0[d0], qr[d0], p0, 0, 0, 0);
                        if (tq == 1) {
#pragma unroll
                            for (int d0 = 0; d0 < 8; ++d0) p1 = __builtin_amdgcn_mfma_f32_32x32x16_bf16(kf1[d0], qr[d0], p1, 0, 0, 0); }
#pragma unroll
                        for (int d0 = 0; d0 < 8; ++d0) acc = __builtin_amdgcn_mfma_f32_32x32x16_bf16(qr[d0], cfr[d0], acc, 0, 0, 0);
                        bf16x8 cfn[8];
#pragma unroll
                        for (int d0 = 0; d0 < 8; ++d0) cfn[d0] = *reinterpret_cast<const bf16x8*>(Cc + KSWZ(64 + r32, (d0 * 16 + hi * 8) * 2));
                        asm volatile("s_waitcnt lgkmcnt(0)" ::: "memory"); SBAR();
                        f32x16 qnacc = {};
#pragma unroll
                        for (int d0 = 0; d0 < 8; ++d0) qnacc = __builtin_amdgcn_mfma_f32_32x32x16_bf16(cfn[d0], qr[d0], qnacc, 0, 0, 0);
                        { const int cq = c + 1 < 68 ? c + 1 : 67; const bf16* Qw = Q + (size_t)tokrow(b, dir, cq, (wid >> 1) * 32 + r32) * MIWM + h * 128 + hi * 8;
#pragma unroll
                          for (int d0 = 0; d0 < 8; ++d0) qr[d0] = *(const bf16x8*)(Qw + d0 * 16); }
                        float ct0[16], ct1[16], wi[16];
#pragma unroll
                        for (int r = 0; r < 16; ++r) { const int s0 = fa::crow(r, hi); ct0[r] = ga[64 + s0]; ct1[r] = ga[64 + s0 + 32]; wi[r] = ga[192 + tq * 32 + s0]; }
                        const float rown = ga[128 + t] * 1.4426950408889634f, wint_t = ga[192 + t], emr_t = ga[256 + t];
                        asm volatile("s_waitcnt lgkmcnt(0)" ::: "memory"); SBAR();
                        float ps = 0.f;
#pragma unroll
                        for (int r = 0; r < 16; ++r) {
                            const int s0 = fa::crow(r, hi), s1 = s0 + 32;
                            const float e0 = __builtin_amdgcn_exp2f(fmaf(ct0[r], 1.4426950408889634f, rown)), e1 = __builtin_amdgcn_exp2f(fmaf(ct1[r], 1.4426950408889634f, rown));
                            p0[r] = s0 <= t ? p0[r] * QSCALE * e0 : 0.f; p1[r] = s1 <= t ? p1[r] * QSCALE * e1 : 0.f;
                            ps += p0[r] + p1[r];
                        }
                        { auto rr = __builtin_amdgcn_permlane32_swap(__float_as_uint(ps), __float_as_uint(ps), false, false); ps = __uint_as_float(rr[0]) + __uint_as_float(rr[1]); }
                        bf16x8 pa0, pa1, pa2, pa3;
#define PK4(P, BASE, OUT) do { unsigned a0 = fa::cvtpk(P[BASE + 0], P[BASE + 1]), a1 = fa::cvtpk(P[BASE + 2], P[BASE + 3]);   \
        unsigned b0 = fa::cvtpk(P[BASE + 4], P[BASE + 5]), b1 = fa::cvtpk(P[BASE + 6], P[BASE + 7]);                              \
        auto r0 = __builtin_amdgcn_permlane32_swap(a0, b0, false, false); auto r1 = __builtin_amdgcn_permlane32_swap(a1, b1, false, false); \
        u32x4 w = {r0[0], r1[0], r0[1], r1[1]}; OUT = *reinterpret_cast<bf16x8*>(&w); } while (0)
                        PK4(p0, 0, pa0); PK4(p0, 8, pa1); PK4(p1, 0, pa2); PK4(p1, 8, pa3);
                        float qn_ = qnacc[0];
                        { auto rr = __builtin_amdgcn_permlane32_swap(__float_as_uint(qn_), __float_as_uint(qn_), false, false); qn_ = __uint_as_float(rr[0]); }
                        const float den = wint_t * qn_ + ps;
                        if (hi == 0) den_l[r32] = fmaxf(fabsf(den), emr_t);
#pragma unroll
                        for (int r = 0; r < 16; ++r) acc[r] *= wi[r];
                        fa::pv_one<0>(acc, vbV + vq * 512, pa0, pa1, pa2, pa3);
                        float dl[16];
#pragma unroll
                        for (int r = 0; r < 16; ++r) dl[r] = den_l[fa::crow(r, hi)];
                        asm volatile("s_waitcnt lgkmcnt(0)" ::: "memory"); SBAR();
                        const long stepE = dir ? -(long)D : (long)D;
                        bf16* hb = HD + ((size_t)dir * ML + tokrow(b, dir, c, tq * 32 + 4 * hi)) * D + h * 256 + sl * 64 + vq * 32 + r32;
#pragma unroll
                        for (int r = 0; r < 16; ++r) hb[stepE * ((r & 3) + 8 * (r >> 2))] = f2bf(acc[r] * __builtin_amdgcn_rcpf(dl[r]));
                    }
                    if constexpr (!LATC) if (c == 3) { const bf16* Qw = Q + (size_t)tokrow(b, dir, c + 1, (wid >> 1) * 32 + r32) * MIWM + h * 128 + hi * 8;
#pragma unroll
                        for (int d0 = 0; d0 < 8; ++d0) qr[d0] = *(const bf16x8*)(Qw + d0 * 16); }
                } else {
                    const int kq = wid - 4; const float decay = ga[320];
                    f32x4* CF = (f32x4*)(lds + CF_OFF) + kq * 3 * 4 * 64 + lane;
                    f32x4 cfv[12]; s16x4 kt[8], vt[24];
#pragma unroll
                    for (int i = 0; i < 12; ++i) cfv[i] = CF[i * 64];
                    typedef short v4i16_t __attribute__((ext_vector_type(4)));
#define TRB(base, off) __builtin_bit_cast(s16x4, __builtin_amdgcn_ds_read_tr16_b64_v4i16((LAS v4i16_t*)(size_t)(unsigned)((base) + (off))))
                    const int ak = vbK + kq * 512;
#pragma unroll
                    for (int ks = 0; ks < 4; ++ks) { kt[2 * ks] = TRB(ak, fa::v_rd_off(0, ks, 0)); kt[2 * ks + 1] = TRB(ak, fa::v_rd_off(0, ks, 1)); }
#pragma unroll
                    for (int j = 0; j < 3; ++j)
#pragma unroll
                        for (int ks = 0; ks < 4; ++ks) { vt[8 * j + 2 * ks] = TRB(vbV, fa::v_rd_off(j, ks, 0)); vt[8 * j + 2 * ks + 1] = TRB(vbV, fa::v_rd_off(j, ks, 1)); }
#undef TRB
                    f32x16 cacc[3];
#pragma unroll
                    for (int j = 0; j < 3; ++j)
#pragma unroll
                        for (int r4 = 0; r4 < 4; ++r4) { const f32x4 v4 = cfv[j * 4 + r4] * decay; cacc[j][r4 * 4 + 0] = v4[0]; cacc[j][r4 * 4 + 1] = v4[1]; cacc[j][r4 * 4 + 2] = v4[2]; cacc[j][r4 * 4 + 3] = v4[3]; }
#define PKF(L, H) (bf16x8){L[0], L[1], L[2], L[3], H[0], H[1], H[2], H[3]}
#pragma unroll
                    for (int j = 0; j < 3; ++j)
#pragma unroll
                        for (int ks = 0; ks < 4; ++ks) cacc[j] = __builtin_amdgcn_mfma_f32_32x32x16_bf16(PKF(kt[2 * ks], kt[2 * ks + 1]), PKF(vt[8 * j + 2 * ks], vt[8 * j + 2 * ks + 1]), cacc[j], 0, 0, 0);
#undef PKF
                    char* Cn = C_lds + ((c + 1) & 1) * 24576;
#pragma unroll
                    for (int j = 0; j < 3; ++j) { bf16x8 f0, f1; PK4(cacc[j], 0, f0); PK4(cacc[j], 8, f1);
                        *(bf16x8*)(Cn + KSWZ(j * 32 + r32, (kq * 32 + hi * 8) * 2)) = f0; *(bf16x8*)(Cn + KSWZ(j * 32 + r32, (kq * 32 + 16 + hi * 8) * 2)) = f1; }
#pragma unroll
                    for (int j = 0; j < 3; ++j)
#pragma unroll
                        for (int r4 = 0; r4 < 4; ++r4) CF[(j * 4 + r4) * 64] = (f32x4){cacc[j][r4 * 4 + 0], cacc[j][r4 * 4 + 1], cacc[j][r4 * 4 + 2], cacc[j][r4 * 4 + 3]};
                    if (wid == 4 && c + 1 < 68) mprev = gate_chunk(gli, gf, mprev, GA + ((c + 1) & 1) * (GA_STRIDE / 4), lane);
                }
                __syncthreads();
            }
        };
        if (wid < 4) { chunk_loop(std::true_type{}, std::false_type{}, 0, 4);
            __builtin_amdgcn_s_waitcnt(0);
            chunk_loop(std::true_type{}, std::true_type{}, 4, 68); }
        else chunk_loop(std::false_type{}, std::false_type{}, 0, 68);
#undef PK4
    }
}
}

DEVI void ph_attn0(const Params& p, char* lds, int vcu, int G) {
    const bf16* Q = (const bf16*)(p.ws + WS_QKV); unsigned char* AO = (unsigned char*)(p.ws + WS_AO);
    const bool edge = (vcu & 15) == 0 || (vcu & 15) == 15;
    const int nG = (512 - vcu + G - 1) / G, nC = G == 256 ? (edge ? 2 : 0) : (vcu < 64 ? (64 - vcu + G - 1) / G : 0);
    for (int i = 0; i < 2 * nG + nC; ++i) {
        const bf16 *Qb, *kc, *kl; unsigned char* Ob; int tbase = 0, nwin = 64, vdelta, NT, rq0 = 0; bool na = false; const float* rpb = p.attn_rpb;
        if (i < nG) {
            const int u = vcu + i * G; int b, qh, qb;
            if (G == 256) { const int grp = vcu >> 5, idx = (vcu & 31) + 32 * i; b = grp >> 1; qh = (grp & 1) * 4 + (idx >> 4); qb = idx & 15; } else { b = u >> 7; qh = (u >> 4) & 7; qb = u & 15; }
            const int kvh = qh >> 2;
            kc = Q + (size_t)(ML + b * CTXL) * AIW + 4096 + kvh * 128; kl = Q + (size_t)(b * SEQ) * AIW + 4096 + kvh * 128; vdelta = 256; NT = 68;
            Qb = Q + (size_t)(b * SEQ + qb * 256) * AIW + 3072 + qh * 128; Ob = AO + (size_t)(b * SEQ + qb * 256) * D + 1024 + qh * 128;
        } else if (i < 2 * nG) {
            const int u = vcu + (i - nG) * G; const int b = u >> 7, h = (u >> 4) & 7, qb = u & 15;
            const int krmin = min(max(4 * qb - 4, 0), 56), krmax = min(max(4 * qb - 1, 0), 56) + 7;
            tbase = krmin; nwin = krmax - krmin + 1; NT = (4 + nwin + 1) & ~1; na = true; rq0 = 4 * qb; rpb = p.attn_rpb + h * 465;
            kc = Q + (size_t)(ML + b * CTXL) * AIW + 1024 + h * 128; kl = Q + (size_t)(b * SEQ) * AIW + 1024 + h * 128; vdelta = 1024;
            Qb = Q + (size_t)(b * SEQ + qb * 256) * AIW + h * 128; Ob = AO + (size_t)(b * SEQ + qb * 256) * D + h * 128;
        } else {
            const int u = G == 256 ? ((vcu >> 4) * 2 + ((vcu & 15) == 15 ? 1 : 0)) + 32 * (i - 2 * nG) : vcu + (i - 2 * nG) * G; const int b = (u >> 3) & 3, hh = u & 7; const bool gq = u >= 32;
            const int qcol = gq ? 3072 + hh * 128 : hh * 128, kcol = gq ? 4096 + (hh >> 2) * 128 : 1024 + hh * 128, ocol = gq ? 1024 + hh * 128 : hh * 128;
            kc = Q + (size_t)(ML + b * CTXL) * AIW + kcol; kl = kc; vdelta = gq ? 256 : 1024; NT = 4;
            Qb = Q + (size_t)(ML + b * CTXL) * AIW + qcol; Ob = AO + (size_t)(ML + b * CTXL) * D + ocol;
        }
        if (na) fa::attn_unit_na(Qb, kc, kl, tbase, nwin, vdelta, Ob, lds, rq0, rpb); else fa::attn_unit(Qb, kc, kl, vdelta, NT, Ob, lds);
    }
}

DEVI unsigned cvtpk_s(float lo, float hi) { unsigned r; asm volatile("v_cvt_pk_bf16_f32 %0, %1, %2" : "=v"(r) : "v"(lo), "v"(hi)); return r; }
DEVI void ph_router_prep(const Params& p, float* lds, int vcu, int G) {
    const int tid = otid(), lane = tid & 63, wave = tid >> 6;
    bf16* RWP = (bf16*)(p.ws + WS_RWP); float* RC = (float*)(p.ws + WS_RC);
    const int vr = G - 1 - vcu;
    for (int idx = vr * 512 + tid; idx < 10 * 256 * 64; idx += G * 512) {
        const int e = idx & 63, kg = (idx >> 6) & 255, lb = idx >> 14, l = lb / 5, bb = lb % 5;
        const float* W = p.router_w + (size_t)l * D * NE + e; const float* gn = p.norm_ffn + l * D + kg * 8; const float* scl = modp(p, l, bb, 4) + kg * 8;
        float v[8]; unsigned hi[4], lo[4];
#pragma unroll
        for (int j = 0; j < 8; ++j) v[j] = gn[j] * (1.f + scl[j]) * W[(size_t)(kg * 8 + j) * NE];
#pragma unroll
        for (int j = 0; j < 4; ++j) { hi[j] = cvtpk_s(v[2 * j], v[2 * j + 1]); lo[j] = cvtpk_s(v[2 * j] - __uint_as_float(hi[j] << 16), v[2 * j + 1] - __uint_as_float(hi[j] & 0xffff0000u)); }
        bf16* dst = RWP + (((size_t)lb * 2 * 128 + (kg >> 1)) * 64 + e) * 16 + (kg & 1) * 8;
        *(u32x4*)dst = (u32x4){hi[0], hi[1], hi[2], hi[3]}; *(u32x4*)(dst + (size_t)128 * 64 * 16) = (u32x4){lo[0], lo[1], lo[2], lo[3]};
    }
    for (int c = vr; c < 80; c += G) {
        const int lb = c % 10, sl = c / 10, l = lb / 5, bb = lb % 5; const float* W = p.router_w + (size_t)l * D * NE + lane; const float* sh = modp(p, l, bb, 3);
        float a = 0.f;
#pragma unroll 32
        for (int k = sl * 256 + wave * 32; k < sl * 256 + wave * 32 + 32; ++k) a += sh[k] * W[(size_t)k * NE];
        __syncthreads(); lds[wave * 64 + lane] = a; __syncthreads();
        if (wave == 0) { float t = 0.f; for (int w = 0; w < 8; ++w) t += lds[w * 64 + lane]; RC[(lb * 8 + sl) * 64 + lane] = t; }
    }
}
DEVI void ph_normr2(const Params& p, int layer, int nrows, float* lds, int vcu, int G) {
    using fa::f32x16;
    float* part = lds; float* ssq = lds + 8 * 4096; float* rstd_l = ssq + 256; float* sraw = rstd_l + 32; float* ssel = sraw + 2048; float* gsc = ssel + 2048;
    int* gsel = (int*)(gsc + 256); int* esel = gsel + 256; float* wsel = (float*)(esel + 256);
    LAS int* hist = (LAS int*)(wsel + 256); LAS int* hbase = hist + 64;
    const int tid = otid(), lane = tid & 63, wave = __builtin_amdgcn_readfirstlane(tid >> 6), r32 = lane & 31, kgp = lane >> 5;
    bf16* HB = (bf16*)(p.ws + WS_HB);
    int* eidx = (int*)(p.ws + WS_EIDX); float* ew = (float*)(p.ws + WS_EW); int* epos = (int*)(p.ws + WS_EPOS);
    u32* cnt = (u32*)(p.ws + WS_CTL) + CW_CNT + layer * 64 * CNT_PAD;
    const float* RB = p.router_b + layer * NE; const float* gain = p.norm_ffn + layer * D;
    LAS int* tq = hbase + 64;
    unsigned* tcnt = (unsigned*)(p.ws + WS_CTL) + CW_TQ + layer * 64;
    const int ntiles = nrows >> 5;
    if (tid == 0) tq[0] = (int)atomicAdd(tcnt, 1u);
    __syncthreads();
    int tile = __builtin_amdgcn_readfirstlane(tq[0]);
    while (tile < ntiles) {
        int nxt_reg = 0;
        const int m0 = tile * 32, bb = bidx(m0);
        const bf16* xbase = (const bf16*)(p.ws + WS_X) + (size_t)m0 * D;
        {
            LAS unsigned char* xs = (LAS unsigned char*)lds + wave * 16384;
            {
                const int rr_ = lane >> 5, cc = lane & 31;
                const unsigned char* xg = (const unsigned char*)xbase + (size_t)rr_ * (D * 2) + wave * 512 + cc * 16;
                u32x4 xv[16];
#pragma unroll
                for (int i = 0; i < 16; ++i) xv[i] = *(const u32x4*)(xg + (size_t)(2 * i) * (D * 2));
#pragma unroll
                for (int i = 0; i < 16; ++i) { const int row = 2 * i + rr_; *(LAS u32x4*)(xs + row * 512 + ((cc ^ row) & 31) * 16) = xv[i]; }
            }
            const bf16* wb = (const bf16*)(p.ws + WS_RWP) + (((size_t)(layer * 5 + bb) * 2 * 128 + wave * 16) * 64 + r32) * 16 + kgp * 8;
            f32x16 acc0 = {}, acc1 = {}; float ss = 0.f;
            bf16x8 wv[2][4][4];
#pragma unroll
            for (int t = 0; t < 4; ++t) { const bf16* w_ = wb + (size_t)t * 1024;
                wv[0][t][0] = *(const bf16x8*)(w_); wv[0][t][1] = *(const bf16x8*)(w_ + 512); wv[0][t][2] = *(const bf16x8*)(w_ + (size_t)128 * 1024); wv[0][t][3] = *(const bf16x8*)(w_ + (size_t)128 * 1024 + 512); }
            asm volatile("s_waitcnt lgkmcnt(0)" ::: "memory");
#pragma unroll
            for (int sb = 0; sb < 4; ++sb) {
                if (sb < 3) {
#pragma unroll
                    for (int t = 0; t < 4; ++t) { const bf16* w_ = wb + (size_t)((sb + 1) * 4 + t) * 1024;
                        wv[(sb + 1) & 1][t][0] = *(const bf16x8*)(w_); wv[(sb + 1) & 1][t][1] = *(const bf16x8*)(w_ + 512); wv[(sb + 1) & 1][t][2] = *(const bf16x8*)(w_ + (size_t)128 * 1024); wv[(sb + 1) & 1][t][3] = *(const bf16x8*)(w_ + (size_t)128 * 1024 + 512); }
                }
                u32x4 ahv[4];
#pragma unroll
                for (int t = 0; t < 4; ++t) { const int ch = 2 * (sb * 4 + t) + kgp; ahv[t] = *(const LAS u32x4*)(xs + r32 * 512 + ((ch ^ r32) & 31) * 16); }
#pragma unroll
                for (int t = 0; t < 4; ++t) {
                    const u32x4 ah = ahv[t];
#pragma unroll
                    for (int q = 0; q < 4; ++q) { const float a = __uint_as_float(ah[q] << 16), b = __uint_as_float(ah[q] & 0xffff0000u); ss += a * a + b * b; }
                    const bf16x8 Ah = __builtin_bit_cast(bf16x8, ah);
                    acc0 = __builtin_amdgcn_mfma_f32_32x32x16_bf16(Ah, wv[sb & 1][t][0], acc0, 0, 0, 0); acc1 = __builtin_amdgcn_mfma_f32_32x32x16_bf16(Ah, wv[sb & 1][t][1], acc1, 0, 0, 0);
                    acc0 = __builtin_amdgcn_mfma_f32_32x32x16_bf16(Ah, wv[sb & 1][t][2], acc0, 0, 0, 0); acc1 = __builtin_amdgcn_mfma_f32_32x32x16_bf16(Ah, wv[sb & 1][t][3], acc1, 0, 0, 0);
                }
            }
            { auto rr = __builtin_amdgcn_permlane32_swap(__float_as_uint(ss), __float_as_uint(ss), false, false); ss = __uint_as_float(rr[0]) + __uint_as_float(rr[1]); }
            if (kgp == 0) ssq[wave * 32 + r32] = ss;
#pragma unroll
            for (int r = 0; r < 16; ++r) { part[wave * 4096 + (0 * 16 + r) * 64 + lane] = acc0[r]; part[wave * 4096 + (1 * 16 + r) * 64 + lane] = acc1[r]; }
        }
        __syncthreads();
        if (tid == 0) nxt_reg = (int)atomicAdd(tcnt, 1u);
        if (tid < 32) { float t = 0.f; for (int w = 0; w < 8; ++w) t += ssq[w * 32 + tid]; rstd_l[tid] = rsqrtf(t * (1.f / D) + EPS); }
        __syncthreads();
        {
            if (tid < 64) hist[tid] = 0;
            const float* rc = (const float*)(p.ws + WS_RC) + (layer * 5 + bb) * 8 * 64;
            float rcsum = 0.f;
#pragma unroll
            for (int sl = 0; sl < 8; ++sl) rcsum += rc[sl * 64 + lane];
            const float rbe = RB[lane]; const int g = lane >> 3;
#define DPPF(x, ctrl) __int_as_float(__builtin_amdgcn_update_dpp(0, __float_as_int(x), ctrl, 0xf, 0xf, false))
#pragma unroll 1
            for (int q = 0; q < 4; ++q) {
                const int row = wave + 8 * q, rr = (row & 3) + 4 * (row >> 3), ll = (lane & 31) + 32 * ((row >> 2) & 1), eb = lane >> 5;
                float t = 0.f;
#pragma unroll
                for (int w = 0; w < 8; ++w) t += part[w * 4096 + (eb * 16 + rr) * 64 + ll];
                const float lg = t * rstd_l[row] + rcsum; const float sg = 1.f / (1.f + expf(-lg));
                const float v = sg + rbe;
                float m1 = v, m2 = -INFINITY;
                { const float o1 = DPPF(m1, 0xB1); m2 = fminf(m1, o1); m1 = fmaxf(m1, o1); }
                { const float o1 = DPPF(m1, 0x4E), o2 = DPPF(m2, 0x4E); m2 = fmaxf(fminf(m1, o1), fmaxf(m2, o2)); m1 = fmaxf(m1, o1); }
                { const float o1 = DPPF(m1, 0x141), o2 = DPPF(m2, 0x141); m2 = fmaxf(fminf(m1, o1), fmaxf(m2, o2)); m1 = fmaxf(m1, o1); }
                const float gs = m1 + m2;
                int grank = 0;
#pragma unroll
                for (int j = 0; j < 8; ++j) { const float sj = __int_as_float(__builtin_amdgcn_readlane(__float_as_int(gs), 8 * j)); grank += (sj > gs || (sj == gs && j < g)) ? 1 : 0; }
                float vm = grank < 4 ? v : -INFINITY;
#pragma unroll 1
                for (int r = 0; r < 8; ++r) {
                    const float mx = ml::lane63(ml::prefix_max64(vm, 0));
                    const unsigned long long bal = __ballot(vm == mx);
                    const int idx = __ffsll((long long)bal) - 1;
                    if (lane == idx) { esel[row * 8 + r] = lane; wsel[row * 8 + r] = sg; vm = -INFINITY; }
                }
            }
#undef DPPF
        }
        __syncthreads();
        int lrank = 0;
        if (tid < 256) lrank = __hip_atomic_fetch_add(hist + esel[tid], 1, __ATOMIC_RELAXED, __HIP_MEMORY_SCOPE_WORKGROUP);
        __syncthreads();
        if (tid < 64) { const int c_ = hist[tid]; hbase[tid] = c_ > 0 ? (int)atomicAdd(&cnt[tid * CNT_PAD], (u32)c_) : 0; }
        __syncthreads();
        if (tid < 256) {
            const int row = tid >> 3, k = tid & 7; float wsum = 0.f;
#pragma unroll
            for (int j = 0; j < 8; ++j) wsum += wsel[row * 8 + j];
            const int e = esel[tid]; const int mm = m0 + row;
            const int pos = hbase[e] + lrank;
            eidx[mm * 8 + k] = e; epos[mm * 8 + k] = pos;
            ((int*)(p.ws + WS_LTOK))[(size_t)e * MT + pos] = mm; ((float*)(p.ws + WS_LW))[(size_t)e * MT + pos] = wsel[tid] * (2.5f / wsum);
        }
        {
            const float* sh = modp(p, layer, bb, 3); const float* scl = modp(p, layer, bb, 4);
            const float rs0 = rstd_l[wave * 4 + 0], rs1 = rstd_l[wave * 4 + 1], rs2 = rstd_l[wave * 4 + 2], rs3 = rstd_l[wave * 4 + 3];
            const bf16* src = xbase + (size_t)(wave * 4) * D; unsigned char* dstb = (unsigned char*)HB + (size_t)(m0 + wave * 4) * D;
#pragma unroll 2
            for (int j = 0; j < 8; ++j) {
                const int c = 4 * lane + 256 * j;
                uint2 xv[4];
#pragma unroll
                for (int rr = 0; rr < 4; ++rr) xv[rr] = *(const uint2*)(src + (size_t)rr * D + c);
                const float4 g = *(const float4*)(gain + c), s1 = *(const float4*)(scl + c), s0 = *(const float4*)(sh + c);
                const float gx = g.x * (1.f + s1.x), gy = g.y * (1.f + s1.y), gz = g.z * (1.f + s1.z), gw_ = g.w * (1.f + s1.w);
#pragma unroll
                for (int rr = 0; rr < 4; ++rr) { const float rs = rr == 0 ? rs0 : rr == 1 ? rs1 : rr == 2 ? rs2 : rs3;
                    const float vx = __uint_as_float(xv[rr].x << 16), vy = __uint_as_float(xv[rr].x & 0xffff0000u), vz = __uint_as_float(xv[rr].y << 16), vw = __uint_as_float(xv[rr].y & 0xffff0000u);
                    *(u32*)(dstb + (size_t)rr * D + c) = pk4_fp8(vx * rs * gx + s0.x, vy * rs * gy + s0.y, vz * rs * gz + s0.z, vw * rs * gw_ + s0.w); }
            }
        }
        if (tid == 0) tq[1] = nxt_reg;
        __syncthreads();
        tile = __builtin_amdgcn_readfirstlane(tq[1]);
    }
}

enum Phase { PH_MODS = 0, PH_NORM0, PH_INPROJ0, PH_QKNORM, PH_ATTN0, PH_OUTPROJ0, PH_NORMR0, PH_DISP0, PH_G1_0, PH_G2_0, PH_COMB0,
             PH_INPROJ1, PH_MLSTM, PH_READOUT, PH_OUTPROJ1, PH_NORMR1, PH_DISP1, PH_G1_1, PH_G2_1, PH_COMB1, PH_COUNT };

#define XB_TMO      128
#define XB_XCNT(j)  (256  + 64 * (j))
#define XB_XSUB(j)  (1280 + 64 * (j))
#define XB_XGEN(j)  (2304 + 64 * (j))
#define XB_TOP      3328
#define XB_TOPGEN   3392
#define XCD_BAR_WORDS 3456
#define XB_SPIN_CAP (1u << 18)
__device__ __forceinline__ unsigned xb_ld(unsigned* p)              { return __hip_atomic_load(p, __ATOMIC_RELAXED, __HIP_MEMORY_SCOPE_AGENT); }
__device__ __forceinline__ unsigned xb_add(unsigned* p, unsigned v) { return __hip_atomic_fetch_add(p, v, __ATOMIC_RELAXED, __HIP_MEMORY_SCOPE_AGENT); }
__device__ __forceinline__ unsigned xb_xcc_id() { return (unsigned)__builtin_amdgcn_s_getreg((3 << 11) | 20) & 0xFu; }
#define XB_SPIN(cond, bar) do { unsigned _sp = 0; while (cond) { __builtin_amdgcn_s_sleep(1); \
    if ((++_sp & 255u) == 0u) { if (xb_ld(&(bar)[XB_TMO])) break; if (_sp > XB_SPIN_CAP) { atomicAdd(&(bar)[XB_TMO], 1u); break; } } } } while (0)
struct XcdBarrier { unsigned* bar; unsigned x; volatile LAS unsigned* st; };
__device__ __forceinline__ XcdBarrier xcd_barrier_post(unsigned* bar, volatile LAS unsigned* st) {
    XcdBarrier b; b.bar = bar; b.x = xb_xcc_id(); b.st = st;
    if (threadIdx.x == 0) (void)xb_add(&bar[XB_XCNT(b.x)], 1u);
    return b;
}
__device__ __forceinline__ void xcd_barrier_complete(unsigned* bar, unsigned x, unsigned& nloc, unsigned& nx) {
    const unsigned G = gridDim.x * gridDim.y * gridDim.z;
    unsigned sum, cnt, mine, sp = 0u;
    for (;;) {
        sum = 0u; cnt = 0u; mine = 0u;
#pragma unroll 1
        for (unsigned j = 0; j < 16; ++j) { const unsigned c = xb_ld(&bar[XB_XCNT(j)]); sum += c; cnt += (c > 0u) ? 1u : 0u; mine = (j == x) ? c : mine; }
        if (sum == G) break;
        __builtin_amdgcn_s_sleep(1);
        if ((++sp & 255u) == 0u) { if (xb_ld(&bar[XB_TMO])) break; if (sp > XB_SPIN_CAP) { atomicAdd(&bar[XB_TMO], 1u); break; } }
    }
    nloc = mine > 0u ? mine : 1u; nx = cnt > 0u ? cnt : 1u;
}
__device__ __forceinline__ void xcd_barrier(const XcdBarrier& b) {
    asm volatile("s_waitcnt vmcnt(0)" ::: "memory");
    __syncthreads();
    if (threadIdx.x == 0) {
        unsigned* bar = b.bar;
        __builtin_amdgcn_s_waitcnt(0);
        unsigned nloc = b.st[0], nx = b.st[1];
        if (nloc == 0u) { xcd_barrier_complete(bar, b.x, nloc, nx); b.st[0] = nloc; b.st[1] = nx; }
        const unsigned old = xb_add(&bar[XB_XSUB(b.x)], 1u);
        const unsigned gen = old / nloc;
        if (old + 1u == (gen + 1u) * nloc) {
            __builtin_amdgcn_fence(__ATOMIC_RELEASE, "agent");
            asm volatile("s_waitcnt vmcnt(0)" ::: "memory");
            const unsigned og = xb_add(&bar[XB_TOP], 1u);
            const unsigned tg = og / nx;
            if (og + 1u == (tg + 1u) * nx) xb_add(&bar[XB_TOPGEN], 1u);
            else XB_SPIN(xb_ld(&bar[XB_TOPGEN]) == tg, bar);
            __builtin_amdgcn_fence(__ATOMIC_ACQUIRE, "agent");
            xb_add(&bar[XB_XGEN(b.x)], 1u);
            asm volatile("s_waitcnt vmcnt(0)" ::: "memory");
        } else {
            XB_SPIN(xb_ld(&bar[XB_XGEN(b.x)]) == gen, bar);
            __builtin_amdgcn_fence(__ATOMIC_ACQUIRE, "agent");
            asm volatile("s_waitcnt vmcnt(0)" ::: "memory");
        }
    }
    __syncthreads();
}
constexpr int CW_BAR = 4096;
static_assert((CW_BAR + XCD_BAR_WORDS) * 4 <= (int)CTL_BYTES, "barrier words inside the memset region");

typedef const __attribute__((address_space(4))) Params* KArgs;
#if defined(__HIP_DEVICE_COMPILE__)
DEVI Params kargs() { KArgs k = (KArgs)__builtin_amdgcn_kernarg_segment_ptr(); asm volatile("" : "+s"(k)); Params q; q.x = k->x; q.c = k->c; q.ctx = k->ctx; q.c_ctx = k->c_ctx; q.ada_w = k->ada_w; q.ada_b = k->ada_b; q.norm_mix = k->norm_mix; q.norm_ffn = k->norm_ffn; q.attn_w_in = k->attn_w_in; q.attn_w_out = k->attn_w_out; q.attn_rpb = k->attn_rpb; q.attn_q_gain = k->attn_q_gain; q.attn_k_gain = k->attn_k_gain; q.ml_w_in = k->ml_w_in; q.ml_w_out = k->ml_w_out; q.ml_gate_b = k->ml_gate_b; q.ml_head_gain = k->ml_head_gain; q.router_w = k->router_w; q.router_b = k->router_b; q.exp_w1 = k->exp_w1; q.exp_w3 = k->exp_w3; q.exp_w2 = k->exp_w2; q.sh_w1 = k->sh_w1; q.sh_w3 = k->sh_w3; q.sh_w2 = k->sh_w2; q.final_norm = k->final_norm; q.out = k->out; q.ws = k->ws; q.lo = k->lo; q.hi = k->hi; return q; }
#else
DEVI Params kargs() { return Params{}; }
#endif
constexpr int MEGA_LDS = 157 * 1024;
static_assert(pg::LDS_TOTAL <= MEGA_LDS, "LDS map");
__global__ void __launch_bounds__(512, 2) k_mega(Params p) {
    extern __shared__ __attribute__((aligned(16))) unsigned char lds_raw[];
    LAS unsigned char* lds = (LAS unsigned char*)lds_raw;
    float* ldsf = (float*)lds_raw;
    const int G = gridDim.x, bx = blockIdx.x;
    const int vcu = (G % 8 == 0) ? (bx % 8) * (G / 8) + bx / 8 : bx;
    if (threadIdx.x < 16) ((LAS unsigned*)(lds + pg::MISC_OFF))[threadIdx.x] = 0u;
    __syncthreads();
    XcdBarrier bar; bar.bar = (unsigned*)(p.ws + WS_CTL) + CW_BAR; bar.x = 0; bar.st = nullptr;
    if (p.hi - p.lo > 1) bar = xcd_barrier_post((unsigned*)(p.ws + WS_CTL) + CW_BAR, (volatile LAS unsigned*)(lds + pg::MISC_OFF));
#ifndef SITEMASK
#define SITEMASK 0xFFFFFu
#endif
#define INF(k) (p.lo <= (k) && (k) < p.hi)
#define INS(site, k) (((SITEMASK >> (site)) & 1u) && INF(k))
#ifdef PROBE_REP
#define REPF(k) for (int rep_ = 0; rep_ < (((k) == PROBE_REP) ? 2 : 1); ++rep_)
#else
#define REPF(k)
#endif
#define SEAM(k) do { if (INF(k) && INF((k) + 1)) xcd_barrier(bar); } while (0)
    REPF(PH_MODS) if (INS(PH_MODS, PH_MODS)) { const Params q = kargs(); __syncthreads(); ph_mods(q, ldsf, vcu, G); __syncthreads(); ph_cvt(q, lds, vcu, G); }
    SEAM(PH_MODS);
    REPF(PH_NORM0) if (INS(PH_NORM0, PH_NORM0)) { const Params q = kargs(); ph_norm(q, 0, q.x, q.ctx, q.norm_mix, 0, 1, MT, vcu, G); ph_router_prep(q, ldsf, vcu, G); }
    SEAM(PH_NORM0);
    for (int layer = 0; layer < 2; ++layer) {
        const int po = 9 * layer;
        REPF(PH_INPROJ0 + po) if (INS(PH_INPROJ0, PH_INPROJ0 + po)) {
            const Params q = kargs();
            const int nN = layer == 0 ? AIW / 256 : MINP / 256;
            const int nu = pg::fill_dense(lds, MT / 256, nN, G, bx);
            __syncthreads();
            pg::ListOrder S{(const LAS int*)(lds + pg::UD_OFF), nu};
            EpiBf16Store E{(bf16*)(q.ws + WS_QKV), layer == 0 ? AIW : MIWM, (float*)(q.ws + WS_G), layer == 0 ? -1 : MIWM / 256, 1.f / W13_SCALE};
            pg::gemm_phase<EpiBf16Store, false, true>(lds, q.ws + WS_HB, q.ws + (layer == 0 ? WT_AIN : WT_MIN), D, 0, S, E);
        }
        SEAM(PH_INPROJ0 + po);
        if (layer == 0) {
            REPF(PH_QKNORM) if (INS(PH_QKNORM, PH_QKNORM)) { const Params q = kargs(); ph_qknorm(q, vcu, G); }
            SEAM(PH_QKNORM);
            REPF(PH_ATTN0) if (INS(PH_ATTN0, PH_ATTN0)) { const Params q = kargs(); ph_attn0(q, (char*)lds_raw, vcu, G); }
            SEAM(PH_ATTN0);
        } else {
            REPF(PH_MLSTM) if (INS(PH_MLSTM, PH_MLSTM)) { const Params q = kargs(); ml::ph_mlstm(q, (char*)lds_raw, vcu, G); }
            SEAM(PH_MLSTM);
            REPF(PH_READOUT) if (INS(PH_READOUT, PH_READOUT)) { const Params q = kargs(); ph_readout(q, vcu, G); }
            SEAM(PH_READOUT);
        }
        REPF(PH_OUTPROJ0 + po) if (INS(PH_OUTPROJ0, PH_OUTPROJ0 + po)) {
            const Params q = kargs();
            const int nu = pg::fill_dense(lds, (layer == 0 ? MT : ML) / 256, D / 256, G, bx);
            __syncthreads();
            pg::ListOrder S{(const LAS int*)(lds + pg::UD_OFF), nu};
            EpiResid E{(bf16*)(q.ws + WS_X), (const float*)(q.ws + WS_MOD) + (size_t)layer * 5 * 6 * D};
            pg::gemm_phase<EpiResid, false, true>(lds, q.ws + WS_AO, q.ws + (layer == 0 ? WT_AOUT : WT_MOUT), D, 0, S, E);
        }
        SEAM(PH_OUTPROJ0 + po);
        REPF(PH_NORMR0 + po) if (INS(PH_NORMR0, PH_NORMR0 + po)) { const Params q = kargs(); ph_normr2(q, layer, layer == 0 ? MT : ML, ldsf, vcu, G); }
        SEAM(PH_NORMR0 + po);
        REPF(PH_G1_0 + po) if (INS(PH_G1_0, PH_G1_0 + po)) {
            const Params q = kargs();
            const int nu = moe_setup<true>(q, lds, layer, layer == 0 ? MT : ML, vcu, G);
            pg::ListOrder S{(const LAS int*)(lds + pg::UD_OFF), nu};
            EpiSwiGLU E{(bf16*)(q.ws + WS_ACT)};
            pg::gemm_phase<EpiSwiGLU, true, true>(lds, q.ws + WS_HB, q.ws + WT_W13 + (size_t)layer * 65 * 1024 * D, D, (size_t)1024 * D, S, E);
        }
        SEAM(PH_G1_0 + po);
        REPF(PH_G2_0 + po) if (INS(PH_G2_0, PH_G2_0 + po)) {
            const Params q = kargs();
            const int nu = moe_setup<false>(q, lds, layer, layer == 0 ? MT : ML, vcu, G);
            pg::ListOrder S{(const LAS int*)(lds + pg::UD_OFF), nu};
            EpiScale E{(unsigned char*)(q.ws + WS_Y), (const LAS float*)(lds + pg::GT_OFF)};
            pg::gemm_phase<EpiScale, false, true>(lds, q.ws + WS_ACT, q.ws + WT_W2 + (size_t)layer * 65 * D * EDIM, EDIM, (size_t)D * EDIM, S, E);
        }
        SEAM(PH_G2_0 + po);
        REPF(PH_COMB0 + po) if (INS(PH_COMB0, PH_COMB0 + po)) { const Params q = kargs(); ph_combine(q, layer, (int*)ldsf, vcu, G); }
        if (layer == 0) SEAM(PH_COMB0);
    }
#undef INF
#undef INS
#undef SEAM
}

#ifndef N_LAUNCH
#define N_LAUNCH 1
#endif
extern "C" void kernel_launch(void* const* d_in, const int* in_sizes, int n_in, void* d_out, int out_size, void* d_ws, size_t ws_size, hipStream_t stream) {
    static int grid = 0;
    if (grid == 0) {
        if (n_in != 26 || out_size != ML * D || ws_size < WS_END) { fprintf(stderr, "kernel_launch: unexpected shapes n_in %d out %d ws %zu\n", n_in, out_size, ws_size); grid = -1; return; }
        int dev = 0, cus = 0, per_cu = 0;
        if (hipGetDevice(&dev) != hipSuccess || hipDeviceGetAttribute(&cus, hipDeviceAttributeMultiprocessorCount, dev) != hipSuccess) { fprintf(stderr, "kernel_launch: device query failed\n"); grid = -1; return; }
        if (hipFuncSetAttribute((const void*)k_mega, hipFuncAttributeMaxDynamicSharedMemorySize, MEGA_LDS) != hipSuccess) { fprintf(stderr, "kernel_launch: hipFuncSetAttribute failed\n"); grid = -1; return; }
        if (hipOccupancyMaxActiveBlocksPerMultiprocessor(&per_cu, (const void*)k_mega, 512, MEGA_LDS) != hipSuccess || per_cu < 1) fprintf(stderr, "kernel_launch: note: occupancy query reports %d blocks per CU\n", per_cu);
        (void)hipGetLastError();
        grid = cus;
    }
    if (grid < 0) return;
    (void)hipMemsetAsync((char*)d_ws + WS_CTL, 0, CTL_BYTES, stream);
    Params p{};
    const float** pp = (const float**)&p;
    for (int i = 0; i < 26; ++i) pp[i] = (const float*)d_in[i];
    p.out = (float*)d_out; p.ws = (unsigned char*)d_ws;
#if N_LAUNCH == 1
    p.lo = 0; p.hi = PH_COUNT;
    hipLaunchKernelGGL(k_mega, dim3(grid), dim3(512), MEGA_LDS, stream, p);
#else
    for (int ph = 0; ph < PH_COUNT; ++ph) { p.lo = ph; p.hi = ph + 1; hipLaunchKernelGGL(k_mega, dim3(grid), dim3(512), MEGA_LDS, stream, p); }
#endif
    const hipError_t le = hipPeekAtLastError();
    if (le != hipSuccess) fprintf(stderr, "kernel_launch: launch failed: %s\n", hipGetErrorName(le));
}
```
